# Optimizing an MI355X kernel written in HIP

```python
import math
import jax, jax.numpy as jnp
from jax import lax
import numpy as np

D_MODEL = 1024
BATCH = 8
SEQ = 2048
DEPTH = 1

HEAD_DIM = 64
N_MIX_HEADS = D_MODEL // HEAD_DIM
FOX_HEADS = N_MIX_HEADS // 2
NSA_HEADS = N_MIX_HEADS - FOX_HEADS
NSA_GQA = 4
NSA_KV_GROUPS = NSA_HEADS // NSA_GQA
Q_BLOCK = 128
SEL_Q_CHUNK = 64
CMP_BLOCK = 32
CMP_STRIDE = 16
CMP_HIDDEN = 256
SEL_BLOCK = 64
N_SEL = 16
WINDOW = 512
N_BUCKETS = 32
MAX_DISTANCE = 128
N_EXPERTS = 64
N_EXPERT_GROUPS = 8
TOPK_GROUPS = 4
TOP_K = 8
D_EXPERT = 256
D_SHARED = 256
ROUTED_SCALE = 2.5
LN_EPS = 1e-5
NEG_BIG = -1e30
FORCE_SCORE = 1e4
DEEPNORM_ALPHA = (2 * DEPTH) ** 0.25
DEEPNORM_BETA = (8 * DEPTH) ** -0.25

FOX_W = FOX_HEADS * HEAD_DIM
NSA_W = NSA_HEADS * HEAD_DIM
KV_W = NSA_KV_GROUPS * HEAD_DIM
IN_WIDTHS = (FOX_W, FOX_W, FOX_W, FOX_HEADS, NSA_W, KV_W, KV_W, KV_W, KV_W, KV_W, KV_W, 3 * NSA_HEADS)
IN_IS_VALUE = (False, False, True, False, False, False, True, False, True, False, True, False)
D_IN_PROJ = sum(IN_WIDTHS)

kernel_name = 'fox_nsa_moe_deepnorm_adaln_hybrid'


def layer_norm(x, g, b):
    xf = x.astype(jnp.float32)
    mu = jnp.mean(xf, axis=-1, keepdims=True)
    var = jnp.mean(jnp.square(xf - mu), axis=-1, keepdims=True)
    y = (xf - mu) * lax.rsqrt(var + LN_EPS)
    return (y * g.astype(jnp.float32) + b.astype(jnp.float32)).astype(x.dtype)


def t5_bucket(dist):
    n = jnp.maximum(dist, 0)
    max_exact = N_BUCKETS // 2
    nf = jnp.maximum(n, 1).astype(jnp.float32)
    large = max_exact + (jnp.log(nf / max_exact) / math.log(MAX_DISTANCE / max_exact)
                         * (N_BUCKETS - max_exact)).astype(jnp.int32)
    large = jnp.minimum(large, N_BUCKETS - 1)
    return jnp.where(n < max_exact, n, large)


def forgetting_attention(q, k, v, log_f):
    B, S, H, Dh = q.shape
    scale = Dh ** -0.5
    cum = jnp.cumsum(log_f, axis=1).transpose(0, 2, 1)
    outs = []
    for i in range(S // Q_BLOCK):
        q0, kend = i * Q_BLOCK, (i + 1) * Q_BLOCK
        logits = jnp.einsum('bqhd,bkhd->bhqk', q[:, q0:kend], k[:, :kend]).astype(jnp.float32) * scale
        decay = cum[:, :, q0:kend, None] - cum[:, :, None, :kend]
        qpos = q0 + jnp.arange(Q_BLOCK)
        mask = jnp.arange(kend)[None, :] <= qpos[:, None]
        logits = jnp.where(mask, logits + decay, -jnp.inf)
        p = jax.nn.softmax(logits, axis=-1)
        outs.append(jnp.einsum('bhqk,bkhd->bqhd', p.astype(v.dtype), v[:, :kend]))
    return jnp.concatenate(outs, axis=1)


def compress_blocks(x, blk_idx, pos, w1, w2):
    B, G = x.shape[0], x.shape[2]
    n_cmp = blk_idx.shape[0]
    xb = x[:, blk_idx] + pos[None, None, :, None, :]
    flat = xb.transpose(0, 1, 3, 2, 4).reshape(B, n_cmp, G, CMP_BLOCK * HEAD_DIM)
    return jax.nn.silu(flat @ w1) @ w2


def nsa_attention(q, k_cmp, v_cmp, k_sel, v_sel, k_win, v_win, gate_logits, rel_bias,
                  cmp_pos_k, cmp_w1_k, cmp_w2_k, cmp_pos_v, cmp_w1_v, cmp_w2_v):
    B, S = q.shape[0], q.shape[1]
    G, R, Dh = NSA_KV_GROUPS, NSA_GQA, HEAD_DIM
    scale = Dh ** -0.5
    qg = q.reshape(B, S, G, R, Dh)
    t = jnp.arange(S)

    n_cmp = (S - CMP_BLOCK) // CMP_STRIDE + 1
    blk_idx = np.arange(n_cmp)[:, None] * CMP_STRIDE + np.arange(CMP_BLOCK)[None, :]
    blk_end = jnp.asarray(blk_idx[:, -1])
    kc = compress_blocks(k_cmp, blk_idx, cmp_pos_k, cmp_w1_k, cmp_w2_k)
    vc = compress_blocks(v_cmp, blk_idx, cmp_pos_v, cmp_w1_v, cmp_w2_v)
    dist_c = t[:, None] - blk_end[None, :]
    bias_c = rel_bias[t5_bucket(dist_c)].reshape(S, n_cmp, G, R).transpose(2, 3, 0, 1)
    valid_c = dist_c >= 0
    logits_c = jnp.einsum('bsgrd,bngd->bgrsn', qg, kc).astype(jnp.float32) * scale
    logits_c = jnp.where(valid_c, logits_c + bias_c, NEG_BIG)
    p_c = jax.nn.softmax(logits_c, axis=-1) * valid_c
    o_c = jnp.einsum('bgrsn,bngd->bsgrd', p_c.astype(vc.dtype), vc)

    n_slc = S // SEL_BLOCK
    n_sel = min(N_SEL, n_slc)
    cs = np.arange(n_cmp)[:, None] * CMP_STRIDE
    sj = np.arange(n_slc)[None, :] * SEL_BLOCK
    overlap = ((cs < sj + SEL_BLOCK) & (cs + CMP_BLOCK > sj)).astype(np.float32)
    imp = jnp.einsum('bgrsn,nj->bgsj', p_c, jnp.asarray(overlap))
    q_blk = t // SEL_BLOCK
    j = jnp.arange(n_slc)
    forced = (j[None, :] == 0) | (j[None, :] == q_blk[:, None]) | (j[None, :] == q_blk[:, None] - 1)
    causal_blk = j[None, :] <= q_blk[:, None]
    sel_score = jnp.where(causal_blk, imp + FORCE_SCORE * forced, -FORCE_SCORE)
    _, sel_idx = lax.top_k(sel_score, n_sel)

    kT = k_sel.transpose(0, 2, 1, 3)
    vT = v_sel.transpose(0, 2, 1, 3)
    tbl = rel_bias.reshape(N_BUCKETS, G, R).transpose(1, 0, 2)
    b_ix = jnp.arange(B)[:, None, None, None]
    g_ix = jnp.arange(G)[None, :, None, None]
    n_chunks = S // SEL_Q_CHUNK
    n_tok = n_sel * SEL_BLOCK

    def sel_chunk(args):
        qc, ic, start = args
        tq = start + jnp.arange(SEL_Q_CHUNK)
        pos = (ic[..., None] * SEL_BLOCK + jnp.arange(SEL_BLOCK)).reshape(B, G, SEL_Q_CHUNK, n_tok)
        kg = kT[b_ix, g_ix, pos]
        vg = vT[b_ix, g_ix, pos]
        dist = tq[None, None, :, None] - pos
        bias = tbl[g_ix, t5_bucket(dist)]
        logits = jnp.einsum('bqgrd,bgqtd->bgrqt', qc, kg).astype(jnp.float32) * scale
        logits = jnp.where((dist >= 0)[:, :, None], logits + jnp.moveaxis(bias, -1, 2), -jnp.inf)
        p = jax.nn.softmax(logits, axis=-1)
        return jnp.einsum('bgrqt,bgqtd->bqgrd', p.astype(vg.dtype), vg)

    q_chunks = jnp.moveaxis(qg.reshape(B, n_chunks, SEL_Q_CHUNK, G, R, Dh), 1, 0)
    i_chunks = jnp.moveaxis(sel_idx.reshape(B, G, n_chunks, SEL_Q_CHUNK, n_sel), 2, 0)
    starts = jnp.arange(n_chunks) * SEL_Q_CHUNK
    o_s = lax.map(sel_chunk, (q_chunks, i_chunks, starts))
    o_s = jnp.moveaxis(o_s, 0, 1).reshape(B, S, G, R, Dh)

    nb = S // Q_BLOCK
    span = WINDOW + Q_BLOCK
    kp = jnp.pad(k_win, ((0, 0), (WINDOW, 0), (0, 0), (0, 0)))
    vp = jnp.pad(v_win, ((0, 0), (WINDOW, 0), (0, 0), (0, 0)))
    widx = np.arange(nb)[:, None] * Q_BLOCK + np.arange(span)[None, :]
    kw = kp[:, widx]
    vw = vp[:, widx]
    qw = qg.reshape(B, nb, Q_BLOCK, G, R, Dh)
    dist_w = np.arange(Q_BLOCK)[:, None] - np.arange(span)[None, :] + WINDOW
    key_pos = widx - WINDOW
    valid_w = ((dist_w >= 0) & (dist_w < WINDOW))[None] & (key_pos >= 0)[:, None, :]
    bias_w = rel_bias[t5_bucket(jnp.asarray(dist_w))].reshape(Q_BLOCK, span, G, R).transpose(2, 3, 0, 1)
    logits_w = jnp.einsum('bnqgrd,bnkgd->bngrqk', qw, kw).astype(jnp.float32) * scale
    logits_w = jnp.where(jnp.asarray(valid_w)[None, :, None, None], logits_w + bias_w, -jnp.inf)
    p_w = jax.nn.softmax(logits_w, axis=-1)
    o_w = jnp.einsum('bngrqk,bnkgd->bnqgrd', p_w.astype(vw.dtype), vw).reshape(B, S, G, R, Dh)

    gates = jax.nn.sigmoid(gate_logits.astype(jnp.float32)).reshape(B, S, G, R, 3).astype(q.dtype)
    o = gates[..., 0:1] * o_c + gates[..., 1:2] * o_s + gates[..., 2:3] * o_w
    return o.reshape(B, S, NSA_HEADS * Dh)


def moe_ffn(h, w_router, e_bias, w_gate, w_up, w_down, ws_gate, ws_up, ws_down):
    B, S, D = h.shape
    scores = jax.nn.sigmoid(jnp.einsum('bsd,de->bse', h, w_router).astype(jnp.float32))
    biased = scores + e_bias.astype(jnp.float32)
    grouped = biased.reshape(B, S, N_EXPERT_GROUPS, N_EXPERTS // N_EXPERT_GROUPS)
    group_score = lax.top_k(grouped, 2)[0].sum(-1)
    _, gidx = lax.top_k(group_score, TOPK_GROUPS)
    gmask = jax.nn.one_hot(gidx, N_EXPERT_GROUPS).sum(-2) > 0
    masked = jnp.where(gmask[..., None], grouped, -jnp.inf).reshape(B, S, N_EXPERTS)
    _, eidx = lax.top_k(masked, TOP_K)
    w = jnp.take_along_axis(scores, eidx, axis=-1)
    w = w / jnp.sum(w, axis=-1, keepdims=True) * ROUTED_SCALE
    gates = jnp.sum(jax.nn.one_hot(eidx, N_EXPERTS, dtype=jnp.float32) * w[..., None], axis=-2)

    def per_seq(args):
        xs, gs = args
        a = jnp.einsum('sd,edf->sef', xs, w_gate)
        u = jnp.einsum('sd,edf->sef', xs, w_up)
        act = jax.nn.silu(a) * u * gs[..., None].astype(xs.dtype)
        return jnp.einsum('sef,efd->sd', act, w_down)

    routed = lax.map(per_seq, (h, gates))
    shared = (jax.nn.silu(h @ ws_gate) * (h @ ws_up)) @ ws_down
    return routed + shared


def setup_inputs(seed: int = 0) -> dict:
    key = jax.random.key(seed)
    ks = jax.random.split(key, 32)
    f32 = jnp.float32

    def nrm(k, shape, scale):
        return jax.random.normal(k, shape, f32) * scale

    D = D_MODEL
    in_keys = jax.random.split(ks[4], len(IN_WIDTHS))
    w_in = jnp.concatenate(
        [nrm(kk, (DEPTH, D, wd), D ** -0.5 * (DEEPNORM_BETA if isv else 1.0))
         for kk, wd, isv in zip(in_keys, IN_WIDTHS, IN_IS_VALUE)], axis=-1)
    return {
        'x': nrm(ks[0], (BATCH, SEQ, D), 1.0),
        'c': nrm(ks[1], (BATCH, D), 1.0),
        'w_ada': nrm(ks[2], (DEPTH, D, 6 * D), D ** -0.5),
        'b_ada': nrm(ks[3], (DEPTH, 6 * D), 0.02),
        'w_in': w_in,
        'b_f': 3.0 + nrm(ks[5], (DEPTH, FOX_HEADS), 0.5),
        'cmp_pos_k': nrm(ks[6], (DEPTH, CMP_BLOCK, HEAD_DIM), 0.1),
        'cmp_w1_k': nrm(ks[7], (DEPTH, CMP_BLOCK * HEAD_DIM, CMP_HIDDEN), (CMP_BLOCK * HEAD_DIM) ** -0.5),
        'cmp_w2_k': nrm(ks[8], (DEPTH, CMP_HIDDEN, HEAD_DIM), CMP_HIDDEN ** -0.5),
        'cmp_pos_v': nrm(ks[9], (DEPTH, CMP_BLOCK, HEAD_DIM), 0.1),
        'cmp_w1_v': nrm(ks[10], (DEPTH, CMP_BLOCK * HEAD_DIM, CMP_HIDDEN), (CMP_BLOCK * HEAD_DIM) ** -0.5),
        'cmp_w2_v': nrm(ks[11], (DEPTH, CMP_HIDDEN, HEAD_DIM), CMP_HIDDEN ** -0.5),
        'rel_bias': nrm(ks[12], (N_BUCKETS, NSA_HEADS), 0.5),
        'w_out': nrm(ks[13], (DEPTH, D, D), D ** -0.5 * DEEPNORM_BETA),
        'ln1_g': 1.0 + nrm(ks[14], (DEPTH, D), 0.05),
        'ln1_b': nrm(ks[15], (DEPTH, D), 0.02),
        'w_router': nrm(ks[16], (DEPTH, D, N_EXPERTS), D ** -0.5),
        'e_bias': nrm(ks[17], (DEPTH, N_EXPERTS), 0.01),
        'w_gate': nrm(ks[18], (DEPTH, N_EXPERTS, D, D_EXPERT), D ** -0.5),
        'w_up': nrm(ks[19], (DEPTH, N_EXPERTS, D, D_EXPERT), D ** -0.5),
        'w_down': nrm(ks[20], (DEPTH, N_EXPERTS, D_EXPERT, D), D_EXPERT ** -0.5 * DEEPNORM_BETA),
        'ws_gate': nrm(ks[21], (DEPTH, D, D_SHARED), D ** -0.5),
        'ws_up': nrm(ks[22], (DEPTH, D, D_SHARED), D ** -0.5),
        'ws_down': nrm(ks[23], (DEPTH, D_SHARED, D), D_SHARED ** -0.5 * DEEPNORM_BETA),
        'ln2_g': 1.0 + nrm(ks[24], (DEPTH, D), 0.05),
        'ln2_b': nrm(ks[25], (DEPTH, D), 0.02),
    }


def reference(x, c, w_ada, b_ada, w_in, b_f, cmp_pos_k, cmp_w1_k, cmp_w2_k, cmp_pos_v, cmp_w1_v,
              cmp_w2_v, rel_bias, w_out, ln1_g, ln1_b, w_router, e_bias, w_gate, w_up, w_down,
              ws_gate, ws_up, ws_down, ln2_g, ln2_b):
    B, S, D = x.shape
    split_pts = [int(v) for v in np.cumsum(IN_WIDTHS)[:-1]]
    kv_shape = (B, S, NSA_KV_GROUPS, HEAD_DIM)
    for l in range(DEPTH):
        mod = jnp.einsum('bd,de->be', jax.nn.silu(c), w_ada[l]) + b_ada[l]
        sh1, sc1, g1, sh2, sc2, g2 = jnp.split(mod[:, None, :], 6, axis=-1)

        h = x * (1.0 + sc1) + sh1
        fq, fk, fv, ff, nq, kc, vc, ksl, vsl, kwn, vwn, ng = jnp.split(h @ w_in[l], split_pts, axis=-1)
        log_f = jax.nn.log_sigmoid(ff.astype(jnp.float32) + b_f[l].astype(jnp.float32))
        o_fox = forgetting_attention(fq.reshape(B, S, FOX_HEADS, HEAD_DIM),
                                     fk.reshape(B, S, FOX_HEADS, HEAD_DIM),
                                     fv.reshape(B, S, FOX_HEADS, HEAD_DIM), log_f)
        o_nsa = nsa_attention(nq.reshape(B, S, NSA_HEADS, HEAD_DIM),
                              kc.reshape(kv_shape), vc.reshape(kv_shape),
                              ksl.reshape(kv_shape), vsl.reshape(kv_shape),
                              kwn.reshape(kv_shape), vwn.reshape(kv_shape), ng, rel_bias,
                              cmp_pos_k[l], cmp_w1_k[l], cmp_w2_k[l],
                              cmp_pos_v[l], cmp_w1_v[l], cmp_w2_v[l])
        mixed = jnp.concatenate([o_fox.reshape(B, S, FOX_W), o_nsa], axis=-1) @ w_out[l]
        x = layer_norm(DEEPNORM_ALPHA * x + g1 * mixed, ln1_g[l], ln1_b[l])

        h = x * (1.0 + sc2) + sh2
        ffn = moe_ffn(h, w_router[l], e_bias[l], w_gate[l], w_up[l], w_down[l],
                      ws_gate[l], ws_up[l], ws_down[l])
        x = layer_norm(DEEPNORM_ALPHA * x + g2 * ffn, ln2_g[l], ln2_b[l])
    return x
```

```cpp
#include <hip/hip_runtime.h>
#include <stdint.h>

namespace nv {
constexpr int D = 1024, B = 8, S = 2048, T = B * S;
constexpr int NPROJ = 2848;
constexpr int OFF_FQ = 0, OFF_FK = 512, OFF_FV = 1024, OFF_FF = 1536, OFF_NQ = 1544, OFF_KC = 2056, OFF_VC = 2184,
              OFF_KS = 2312, OFF_VS = 2440, OFF_KW = 2568, OFF_VW = 2696, OFF_NG = 2824;
constexpr int NCMP = 127;
constexpr float ALPHA = 1.189207115002721f;
constexpr float LN_EPS = 1e-5f;

__device__ __forceinline__ float silu_f(float x) { return x / (1.f + expf(-x)); }
__device__ __forceinline__ float sigmoid_f(float x) { return 1.f / (1.f + expf(-x)); }
__device__ __forceinline__ int t5_bucket(int dist) {
    const int n = dist < 0 ? 0 : dist;
    if (n < 16) return n;
    int b = 16;
    b += (n >= 19) + (n >= 21) + (n >= 24) + (n >= 27) + (n >= 31) + (n >= 35) + (n >= 40) + (n >= 46) + (n >= 52) + (n >= 59) +
         (n >= 67) + (n >= 77) + (n >= 87) + (n >= 99) + (n >= 113);
    return b;
}

__global__ void k_mod(const float* __restrict__ c, const float* __restrict__ w_ada, const float* __restrict__ b_ada, float* __restrict__ mod) {
    const int i = blockIdx.x * blockDim.x + threadIdx.x;
    if (i >= B * 6 * D) return;
    const int b = i / (6 * D), e = i % (6 * D);
    float acc = b_ada[e];
    for (int d = 0; d < D; ++d) acc += silu_f(c[b * D + d]) * w_ada[(size_t)d * 6 * D + e];
    mod[i] = acc;
}

template <int AMODE>
__global__ void k_gemm(const float* __restrict__ A, int lda, const float* __restrict__ Bm, int ldb, float* __restrict__ C, int ldc, int M, int N, int K,
                       const float* __restrict__ mod, int sh_off, int sc_off) {
    __shared__ float As[16][65];
    __shared__ float Bs[16][64];
    const int tx = threadIdx.x % 16, ty = threadIdx.x / 16;
    const int m0 = blockIdx.y * 64, n0 = blockIdx.x * 64;
    float acc[4][4];
#pragma unroll
    for (int i = 0; i < 4; ++i)
#pragma unroll
        for (int j = 0; j < 4; ++j) acc[i][j] = 0.f;
    for (int k0 = 0; k0 < K; k0 += 16) {
#pragma unroll
        for (int i = 0; i < 4; ++i) {
            const int idx = threadIdx.x + i * 256;
            const int r = idx / 16, kk = idx % 16;
            const int m = m0 + r;
            float a = 0.f;
            if (m < M) {
                a = A[(size_t)m * lda + k0 + kk];
                if (AMODE == 1) { const int b = m / S; a = a * (1.f + mod[b * 6 * D + sc_off + k0 + kk]) + mod[b * 6 * D + sh_off + k0 + kk]; }
            }
            As[kk][r] = a;
            const int kb = idx / 64, cb = idx % 64;
            Bs[kb][cb] = (n0 + cb < N) ? Bm[(size_t)(k0 + kb) * ldb + n0 + cb] : 0.f;
        }
        __syncthreads();
#pragma unroll
        for (int kk = 0; kk < 16; ++kk) {
            float a[4], bv[4];
#pragma unroll
            for (int i = 0; i < 4; ++i) a[i] = As[kk][ty * 4 + i];
#pragma unroll
            for (int j = 0; j < 4; ++j) bv[j] = Bs[kk][tx * 4 + j];
#pragma unroll
            for (int i = 0; i < 4; ++i)
#pragma unroll
                for (int j = 0; j < 4; ++j) acc[i][j] += a[i] * bv[j];
        }
        __syncthreads();
    }
#pragma unroll
    for (int i = 0; i < 4; ++i)
#pragma unroll
        for (int j = 0; j < 4; ++j) {
            const int m = m0 + ty * 4 + i, n = n0 + tx * 4 + j;
            if (m < M && n < N) C[(size_t)m * ldc + n] = acc[i][j];
        }
}

__global__ void k_cum(const float* __restrict__ proj, const float* __restrict__ b_f, float* __restrict__ cum) {
    const int w = (blockIdx.x * blockDim.x + threadIdx.x) / 64, lane = threadIdx.x % 64;
    if (w >= B * 8) return;
    const int b = w / 8, h = w % 8;
    float carry = 0.f;
    for (int c0 = 0; c0 < S; c0 += 64) {
        const int t = c0 + lane;
        const float x = proj[((size_t)b * S + t) * NPROJ + OFF_FF + h] + b_f[h];
        float v = fminf(x, 0.f) - log1pf(expf(-fabsf(x)));
#pragma unroll
        for (int o = 1; o < 64; o <<= 1) { const float u = __shfl_up(v, o); if (lane >= o) v += u; }
        v += carry;
        cum[(size_t)w * S + t] = v;
        carry = __shfl(v, 63);
    }
}

__global__ void k_cmp1(const float* __restrict__ proj, const float* __restrict__ pos_k, const float* __restrict__ w1_k, const float* __restrict__ pos_v,
                       const float* __restrict__ w1_v, float* __restrict__ hid) {
    const int i = blockIdx.x * blockDim.x + threadIdx.x;
    const int NR = B * NCMP * 2;
    if (i >= 2 * NR * 256) return;
    const int j = i % 256, row = (i / 256) % NR, which = i / (256 * NR);
    const int g = row % 2, n = (row / 2) % NCMP, b = row / (2 * NCMP);
    const float* pos = which ? pos_v : pos_k;
    const float* w1 = which ? w1_v : w1_k;
    const int off = (which ? OFF_VC : OFF_KC) + g * 64;
    float acc = 0.f;
    for (int l = 0; l < 32; ++l) {
        const float* xr = proj + ((size_t)b * S + 16 * n + l) * NPROJ + off;
        for (int d = 0; d < 64; ++d) acc += (xr[d] + pos[l * 64 + d]) * w1[(size_t)(l * 64 + d) * 256 + j];
    }
    hid[i] = silu_f(acc);
}
__global__ void k_cmp2(const float* __restrict__ hid, const float* __restrict__ w2_k, const float* __restrict__ w2_v, float* __restrict__ kvc) {
    const int i = blockIdx.x * blockDim.x + threadIdx.x;
    const int NR = B * NCMP * 2;
    if (i >= 2 * NR * 64) return;
    const int d = i % 64, row = (i / 64) % NR, which = i / (64 * NR);
    const float* w2 = which ? w2_v : w2_k;
    const float* hr = hid + ((size_t)which * NR + row) * 256;
    float acc = 0.f;
    for (int j = 0; j < 256; ++j) acc += hr[j] * w2[j * 64 + d];
    kvc[i] = acc;
}

__global__ void __launch_bounds__(256) k_cmp_attn(const float* __restrict__ proj, const float* __restrict__ kvc, const float* __restrict__ rel_bias, float* __restrict__ pc,
                           float* __restrict__ attn_out) {
    const int i = blockIdx.x * blockDim.x + threadIdx.x;
    if (i >= B * 8 * S) return;
    const int t = i % S, h = (i / S) % 8, b = i / (S * 8), g = h / 4;
    const size_t tok = (size_t)b * S + t;
    const int NR = B * NCMP * 2;
    const float* kc = kvc;
    const float* vc = kvc + (size_t)NR * 64;
    float q[64], o[64];
#pragma unroll
    for (int d = 0; d < 64; ++d) { q[d] = proj[tok * NPROJ + OFF_NQ + h * 64 + d]; o[d] = 0.f; }
    float* prow = pc + ((size_t)(b * 8 + h) * S + t) * 128;
    const int nvalid = t >= 31 ? min(NCMP, (t - 31) / 16 + 1) : 0;
    float m = -1e30f;
    for (int n = 0; n < nvalid; ++n) {
        const float* kr = kc + ((size_t)(b * NCMP + n) * 2 + g) * 64;
        float dot = 0.f;
#pragma unroll
        for (int d = 0; d < 64; ++d) dot += q[d] * kr[d];
        const float lg = dot * 0.125f + rel_bias[t5_bucket(t - (16 * n + 31)) * 8 + h];
        prow[n] = lg;
        m = fmaxf(m, lg);
    }
    float l = 0.f;
    for (int n = 0; n < nvalid; ++n) l += expf(prow[n] - m);
    const float il = nvalid ? 1.f / l : 0.f;
    for (int n = 0; n < 128; ++n) {
        float p = 0.f;
        if (n < nvalid) {
            p = expf(prow[n] - m) * il;
            const float* vr = vc + ((size_t)(b * NCMP + n) * 2 + g) * 64;
#pragma unroll
            for (int d = 0; d < 64; ++d) o[d] += p * vr[d];
        }
        prow[n] = p;
    }
    const float g0 = sigmoid_f(proj[tok * NPROJ + OFF_NG + h * 3 + 0]);
#pragma unroll
    for (int d = 0; d < 64; ++d) attn_out[tok * 1024 + 512 + h * 64 + d] = g0 * o[d];
}

__global__ void k_imp_topk(const float* __restrict__ pc, float* __restrict__ scorebuf, unsigned* __restrict__ selmask) {
    const int i = blockIdx.x * blockDim.x + threadIdx.x;
    if (i >= B * 2 * S) return;
    const int t = i % S, g = (i / S) % 2, b = i / (S * 2);
    const int qb = t >> 6;
    float* sc = scorebuf + (size_t)i * 32;
    for (int j = 0; j < 32; ++j) {
        float imp = 0.f;
        for (int r = 0; r < 4; ++r) {
            const float* prow = pc + ((size_t)(b * 8 + g * 4 + r) * S + t) * 128;
            for (int n = 4 * j - 1; n <= 4 * j + 3; ++n)
                if (n >= 0 && n < NCMP) imp += prow[n];
        }
        const bool causal = j <= qb, forced = (j == 0) || (j == qb) || (j == qb - 1);
        sc[j] = causal ? imp + (forced ? 1e4f : 0.f) : -1e4f;
    }
    unsigned taken = 0u;
    for (int k = 0; k < 16; ++k) {
        float best = -3e38f; int bi = 0;
        for (int j = 0; j < 32; ++j)
            if (!((taken >> j) & 1u)) { const float v = sc[j]; if (v > best) { best = v; bi = j; } }
        taken |= 1u << bi;
    }
    selmask[i] = taken;
}

template <int MODE>
__global__ void __launch_bounds__(256) k_attn(const float* __restrict__ proj, const float* __restrict__ cum, const unsigned* __restrict__ selmask, const float* __restrict__ rel_bias,
                       float* __restrict__ attn_out) {
    const int i = blockIdx.x * blockDim.x + threadIdx.x;
    if (i >= B * 8 * S) return;
    const int t = i % S, h = (i / S) % 8, b = i / (S * 8), g = h / 4;
    const size_t tok = (size_t)b * S + t;
    const int qoff = (MODE == 0 ? OFF_FQ : OFF_NQ) + h * 64;
    const int koff = MODE == 0 ? OFF_FK + h * 64 : (MODE == 1 ? OFF_KS : OFF_KW) + g * 64;
    const int voff = MODE == 0 ? OFF_FV + h * 64 : (MODE == 1 ? OFF_VS : OFF_VW) + g * 64;
    float q[64], o[64];
#pragma unroll
    for (int d = 0; d < 64; ++d) { q[d] = proj[tok * NPROJ + qoff + d]; o[d] = 0.f; }
    float m = -INFINITY, l = 0.f;
    const int s_lo = MODE == 2 ? max(0, t - 511) : 0;
    const unsigned mask = MODE == 1 ? selmask[(b * 2 + g) * S + t] : 0xffffffffu;
    const float* cr = cum + (size_t)(b * 8 + h) * S;
    const float cumt = MODE == 0 ? cr[t] : 0.f;
    for (int s = s_lo; s <= t; ++s) {
        if (MODE == 1 && !((mask >> (s >> 6)) & 1u)) continue;
        const float* kr = proj + ((size_t)b * S + s) * NPROJ + koff;
        const float* vr = proj + ((size_t)b * S + s) * NPROJ + voff;
        float dot = 0.f;
#pragma unroll
        for (int d = 0; d < 64; ++d) dot += q[d] * kr[d];
        const float bias = MODE == 0 ? cumt - cr[s] : rel_bias[t5_bucket(t - s) * 8 + h];
        const float lg = dot * 0.125f + bias;
        const float mn = fmaxf(m, lg), corr = expf(m - mn), p = expf(lg - mn);
        l = l * corr + p;
#pragma unroll
        for (int d = 0; d < 64; ++d) o[d] = o[d] * corr + p * vr[d];
        m = mn;
    }
    const float il = 1.f / l;
    if (MODE == 0) {
#pragma unroll
        for (int d = 0; d < 64; ++d) attn_out[tok * 1024 + h * 64 + d] = o[d] * il;
    } else {
        const float gt = sigmoid_f(proj[tok * NPROJ + OFF_NG + h * 3 + MODE]) * il;
#pragma unroll
        for (int d = 0; d < 64; ++d) attn_out[tok * 1024 + 512 + h * 64 + d] += gt * o[d];
    }
}

__device__ __forceinline__ float block_sum256(float v, float* red) {
#pragma unroll
    for (int o = 32; o > 0; o >>= 1) v += __shfl_xor(v, o);
    const int w = threadIdx.x / 64;
    __syncthreads();
    if ((threadIdx.x & 63) == 0) red[w] = v;
    __syncthreads();
    return red[0] + red[1] + red[2] + red[3];
}
template <int WHICH>
__global__ void k_ln(const float* __restrict__ xin, const float* __restrict__ mixed, const float* __restrict__ mod, const float* __restrict__ gam,
                     const float* __restrict__ bet, float* __restrict__ out, float* __restrict__ h2) {
    __shared__ float red[4];
    const int row = blockIdx.x, b = row / S;
    float v[4];
    float s = 0.f;
#pragma unroll
    for (int i = 0; i < 4; ++i) {
        const int c = threadIdx.x + i * 256;
        if (WHICH == 1) v[i] = ALPHA * xin[(size_t)row * D + c] + mod[b * 6 * D + 2 * D + c] * mixed[(size_t)row * D + c];
        else v[i] = xin[(size_t)row * D + c];
        s += v[i];
    }
    const float mean = block_sum256(s, red) * (1.f / D);
    float qv = 0.f;
#pragma unroll
    for (int i = 0; i < 4; ++i) { const float dlt = v[i] - mean; qv += dlt * dlt; }
    const float var = block_sum256(qv, red) * (1.f / D);
    const float rs = rsqrtf(var + LN_EPS);
#pragma unroll
    for (int i = 0; i < 4; ++i) {
        const int c = threadIdx.x + i * 256;
        const float y = (v[i] - mean) * rs * gam[c] + bet[c];
        out[(size_t)row * D + c] = y;
        if (WHICH == 1) h2[(size_t)row * D + c] = y * (1.f + mod[b * 6 * D + 4 * D + c]) + mod[b * 6 * D + 3 * D + c];
    }
}

__global__ void k_router(const float* __restrict__ h2, const float* __restrict__ w_router, float* __restrict__ scores) {
    const int i = blockIdx.x * blockDim.x + threadIdx.x;
    if (i >= T * 64) return;
    const int e = i % 64, tok = i / 64;
    float acc = 0.f;
    for (int d = 0; d < D; ++d) acc += h2[(size_t)tok * D + d] * w_router[d * 64 + e];
    scores[i] = sigmoid_f(acc);
}
__global__ void k_route(const float* __restrict__ scores, const float* __restrict__ e_bias, int* __restrict__ eidx, float* __restrict__ ew) {
    const int tok = blockIdx.x * blockDim.x + threadIdx.x;
    if (tok >= T) return;
    const float* sc = scores + (size_t)tok * 64;
    unsigned gtaken = 0u;
    for (int k = 0; k < 4; ++k) {
        float best = -3e38f; int bg = 0;
        for (int g = 0; g < 8; ++g) {
            if ((gtaken >> g) & 1u) continue;
            float m1 = -3e38f, m2 = -3e38f;
            for (int j = 0; j < 8; ++j) { const float v = sc[g * 8 + j] + e_bias[g * 8 + j]; if (v > m1) { m2 = m1; m1 = v; } else if (v > m2) m2 = v; }
            const float gs = m1 + m2;
            if (gs > best) { best = gs; bg = g; }
        }
        gtaken |= 1u << bg;
    }
    unsigned long long taken = 0ull;
    float wsum = 0.f;
    for (int k = 0; k < 8; ++k) {
        float best = -3e38f; int be = 0;
        for (int e = 0; e < 64; ++e) {
            if (!((gtaken >> (e >> 3)) & 1u) || ((taken >> e) & 1ull)) continue;
            const float v = sc[e] + e_bias[e];
            if (v > best) { best = v; be = e; }
        }
        taken |= 1ull << be;
        eidx[tok * 8 + k] = be;
        wsum += sc[be];
    }
    for (int k = 0; k < 8; ++k) ew[tok * 8 + k] = sc[eidx[tok * 8 + k]] / wsum * 2.5f;
}

__global__ void k_moe_gateup(const float* __restrict__ h2, const int* __restrict__ eidx, const float* __restrict__ ew, const float* __restrict__ w_gate,
                             const float* __restrict__ w_up, const float* __restrict__ ws_gate, const float* __restrict__ ws_up, float* __restrict__ act) {
    const size_t i = (size_t)blockIdx.x * blockDim.x + threadIdx.x;
    if (i >= (size_t)T * 9 * 256) return;
    const int j = (int)(i % 256), slot = (int)((i / 256) % 9), tok = (int)(i / (256 * 9));
    const float *Wg, *Wu; float wt = 1.f;
    if (slot < 8) { const int e = eidx[tok * 8 + slot]; Wg = w_gate + (size_t)e * D * 256; Wu = w_up + (size_t)e * D * 256; wt = ew[tok * 8 + slot]; }
    else { Wg = ws_gate; Wu = ws_up; }
    const float* hr = h2 + (size_t)tok * D;
    float a = 0.f, u = 0.f;
    for (int d = 0; d < D; ++d) { const float hv = hr[d]; a += hv * Wg[(size_t)d * 256 + j]; u += hv * Wu[(size_t)d * 256 + j]; }
    act[i] = silu_f(a) * u * wt;
}
__global__ void k_moe_down(const float* __restrict__ act, const int* __restrict__ eidx, const float* __restrict__ w_down, const float* __restrict__ ws_down,
                           const float* __restrict__ x1, const float* __restrict__ mod, float* __restrict__ ybuf) {
    const size_t i = (size_t)blockIdx.x * blockDim.x + threadIdx.x;
    if (i >= (size_t)T * D) return;
    const int col = (int)(i % D), tok = (int)(i / D), b = tok / S;
    float acc = 0.f;
    for (int slot = 0; slot < 9; ++slot) {
        const float* Wd = slot < 8 ? w_down + (size_t)eidx[tok * 8 + slot] * 256 * D : ws_down;
        const float* ar = act + ((size_t)tok * 9 + slot) * 256;
        for (int k = 0; k < 256; ++k) acc += ar[k] * Wd[(size_t)k * D + col];
    }
    ybuf[i] = ALPHA * x1[i] + mod[b * 6 * D + 5 * D + col] * acc;
}
}

extern "C" void kernel_launch(void* const* d_in, const int* in_sizes, int n_in, void* d_out, int out_size, void* d_ws, size_t ws_size, hipStream_t stream) {
    using namespace nv;
    const float* x = (const float*)d_in[0];
    const float* c = (const float*)d_in[1];
    const float* w_ada = (const float*)d_in[2];
    const float* b_ada = (const float*)d_in[3];
    const float* w_in = (const float*)d_in[4];
    const float* b_f = (const float*)d_in[5];
    const float* cmp_pos_k = (const float*)d_in[6];
    const float* cmp_w1_k = (const float*)d_in[7];
    const float* cmp_w2_k = (const float*)d_in[8];
    const float* cmp_pos_v = (const float*)d_in[9];
    const float* cmp_w1_v = (const float*)d_in[10];
    const float* cmp_w2_v = (const float*)d_in[11];
    const float* rel_bias = (const float*)d_in[12];
    const float* w_out = (const float*)d_in[13];
    const float* ln1_g = (const float*)d_in[14];
    const float* ln1_b = (const float*)d_in[15];
    const float* w_router = (const float*)d_in[16];
    const float* e_bias = (const float*)d_in[17];
    const float* w_gate = (const float*)d_in[18];
    const float* w_up = (const float*)d_in[19];
    const float* w_down = (const float*)d_in[20];
    const float* ws_gate = (const float*)d_in[21];
    const float* ws_up = (const float*)d_in[22];
    const float* ws_down = (const float*)d_in[23];
    const float* ln2_g = (const float*)d_in[24];
    const float* ln2_b = (const float*)d_in[25];
    float* out = (float*)d_out;
    char* ws = (char*)d_ws;
    const size_t MiB = 1u << 20;
    float* mod = (float*)(ws + 0 * MiB);
    float* cum = (float*)(ws + 1 * MiB);
    float* kvc = (float*)(ws + 2 * MiB);
    float* hid = (float*)(ws + 4 * MiB);
    unsigned* selmask = (unsigned*)(ws + 8 * MiB);
    float* scorebuf = (float*)(ws + 9 * MiB);
    float* scores = (float*)(ws + 13 * MiB);
    int* eidx = (int*)(ws + 17 * MiB);
    float* ew = (float*)(ws + 18 * MiB);
    float* proj = (float*)(ws + 20 * MiB);
    float* pc = (float*)(ws + 198 * MiB);
    float* attn_out = out;
    float* mixed = (float*)(ws + 20 * MiB);
    float* x1 = out;
    float* h2 = (float*)(ws + 84 * MiB);
    float* act = (float*)(ws + 148 * MiB);
    float* ybuf = (float*)(ws + 20 * MiB);

    k_mod<<<(B * 6 * D + 255) / 256, 256, 0, stream>>>(c, w_ada, b_ada, mod);
    k_gemm<1><<<dim3((NPROJ + 63) / 64, T / 64), 256, 0, stream>>>(x, D, w_in, NPROJ, proj, NPROJ, T, NPROJ, D, mod, 0, D);
    k_cum<<<(B * 8 * 64 + 255) / 256, 256, 0, stream>>>(proj, b_f, cum);
    k_cmp1<<<(2 * B * NCMP * 2 * 256 + 255) / 256, 256, 0, stream>>>(proj, cmp_pos_k, cmp_w1_k, cmp_pos_v, cmp_w1_v, hid);
    k_cmp2<<<(2 * B * NCMP * 2 * 64 + 255) / 256, 256, 0, stream>>>(hid, cmp_w2_k, cmp_w2_v, kvc);
    k_attn<0><<<(B * 8 * S + 255) / 256, 256, 0, stream>>>(proj, cum, selmask, rel_bias, attn_out);
    k_cmp_attn<<<(B * 8 * S + 255) / 256, 256, 0, stream>>>(proj, kvc, rel_bias, pc, attn_out);
    k_imp_topk<<<(B * 2 * S + 255) / 256, 256, 0, stream>>>(pc, scorebuf, selmask);
    k_attn<1><<<(B * 8 * S + 255) / 256, 256, 0, stream>>>(proj, cum, selmask, rel_bias, attn_out);
    k_attn<2><<<(B * 8 * S + 255) / 256, 256, 0, stream>>>(proj, cum, selmask, rel_bias, attn_out);
    k_gemm<0><<<dim3(D / 64, T / 64), 256, 0, stream>>>(attn_out, D, w_out, D, mixed, D, T, D, D, nullptr, 0, 0);
    k_ln<1><<<T, 256, 0, stream>>>(x, mixed, mod, ln1_g, ln1_b, x1, h2);
    k_router<<<(T * 64 + 255) / 256, 256, 0, stream>>>(h2, w_router, scores);
    k_route<<<(T + 255) / 256, 256, 0, stream>>>(scores, e_bias, eidx, ew);
    k_moe_gateup<<<(unsigned)(((size_t)T * 9 * 256 + 255) / 256), 256, 0, stream>>>(h2, eidx, ew, w_gate, w_up, ws_gate, ws_up, act);
    k_moe_down<<<(unsigned)(((size_t)T * D + 255) / 256), 256, 0, stream>>>(act, eidx, w_down, ws_down, x1, mod, ybuf);
    k_ln<2><<<T, 256, 0, stream>>>(ybuf, nullptr, mod, ln2_g, ln2_b, out, nullptr);
}
```

```cpp
#include <hip/hip_runtime.h>
#include <cstdio>
#include <cstdint>

#define GAS __attribute__((address_space(1)))
#define LAS __attribute__((address_space(3)))
typedef unsigned short bf16;
typedef float f32x4 __attribute__((ext_vector_type(4)));
typedef unsigned u32x4 __attribute__((ext_vector_type(4)));
typedef unsigned u32x2 __attribute__((ext_vector_type(2)));
typedef GAS unsigned gu32;
#define RLX_AGENT __ATOMIC_RELAXED, __HIP_MEMORY_SCOPE_AGENT

constexpr int D = 1024, NB = 8, S = 2048, T = NB * S;
constexpr int NPROJ = 2848;
constexpr int PITCH = 2816;
constexpr int PC_FQ = 0, PC_FK = 512, PC_FV = 1024, PC_NQ = 1536, PC_KC = 2048, PC_VC = 2176, PC_KS = 2304, PC_VS = 2432, PC_KW = 2560, PC_VW = 2688;
constexpr int FGW = 32;
constexpr int NCMP = 127;
constexpr float ALPHA = 1.189207115002721f;
constexpr float LN_EPS = 1e-5f;
constexpr float LOG2E = 1.4426950408889634f;
constexpr float C2 = 0.125f * LOG2E;
constexpr int NWAVES = 8, NTHR = NWAVES * 64;

constexpr size_t MiB = 1u << 20;
constexpr size_t WS_CTL = 0, CTL_ZERO_BYTES = 1 * MiB;
constexpr size_t WS_MOD = 1 * MiB, WS_CUM = 2 * MiB, WS_KVC = 3 * MiB, WS_HID = 4 * MiB, WS_SELM = 8 * MiB, WS_SCB = 9 * MiB, WS_SCORES = 13 * MiB,
                 WS_EIDX = 17 * MiB, WS_EW = 18 * MiB, WS_FG = 19 * MiB;
constexpr size_t WS_HBUF = 22 * MiB;
constexpr size_t WS_PROJ = 54 * MiB;
constexpr size_t WS_PC = 142 * MiB;
constexpr size_t WS_AO = 206 * MiB;
constexpr size_t WS_ACT = 86 * MiB;
constexpr size_t WS_END = 270 * MiB;
constexpr int CW_BAR = 4096;

constexpr int LDS_BYTES = 147456;
constexpr int MISC_OFF = 131072 + 320;

#define XB_TMO      128
#define XB_XCNT(j)  (256  + 64 * (j))
#define XB_XSUB(j)  (1280 + 64 * (j))
#define XB_XGEN(j)  (2304 + 64 * (j))
#define XB_TOP      3328
#define XB_TOPGEN   3392
#define XCD_BAR_WORDS 3456
#define XB_SPIN_CAP (1u << 20)
__device__ __forceinline__ unsigned xb_ld(unsigned* p)              { return __hip_atomic_load(p, __ATOMIC_RELAXED, __HIP_MEMORY_SCOPE_AGENT); }
__device__ __forceinline__ unsigned xb_add(unsigned* p, unsigned v) { return __hip_atomic_fetch_add(p, v, __ATOMIC_RELAXED, __HIP_MEMORY_SCOPE_AGENT); }
__device__ __forceinline__ unsigned xb_xcc_id() { return (unsigned)__builtin_amdgcn_s_getreg((3 << 11) | 20) & 0xFu; }
#define XB_SPIN(cond, bar) do { unsigned _sp = 0; while (cond) { __builtin_amdgcn_s_sleep(1); \
    if ((++_sp & 255u) == 0u) { if (xb_ld(&(bar)[XB_TMO])) break; if (_sp > XB_SPIN_CAP) { atomicAdd(&(bar)[XB_TMO], 1u); break; } } } } while (0)
struct XcdBarrier { unsigned* bar; unsigned x; volatile LAS unsigned* st; };
__device__ __forceinline__ XcdBarrier xcd_barrier_post(unsigned* bar, volatile LAS unsigned* st) {
    XcdBarrier b; b.bar = bar; b.x = xb_xcc_id(); b.st = st;
    if (threadIdx.x == 0) (void)xb_add(&bar[XB_XCNT(b.x)], 1u);
    return b;
}
__device__ __forceinline__ void xcd_barrier_complete(unsigned* bar, unsigned x, unsigned& nloc, unsigned& nx) {
    const unsigned G = gridDim.x * gridDim.y * gridDim.z;
    unsigned sum, cnt, mine, sp = 0u;
    for (;;) {
        sum = 0u; cnt = 0u; mine = 0u;
#pragma unroll
        for (unsigned j = 0; j < 16; ++j) { const unsigned c = xb_ld(&bar[XB_XCNT(j)]); sum += c; cnt += (c > 0u) ? 1u : 0u; mine = (j == x) ? c : mine; }
        if (sum == G) break;
        __builtin_amdgcn_s_sleep(1);
        if ((++sp & 255u) == 0u) { if (xb_ld(&bar[XB_TMO])) break; if (sp > XB_SPIN_CAP) { atomicAdd(&bar[XB_TMO], 1u); break; } }
    }
    nloc = mine > 0u ? mine : 1u; nx = cnt > 0u ? cnt : 1u;
}
__device__ __forceinline__ void xcd_barrier(const XcdBarrier& b) {
    asm volatile("s_waitcnt vmcnt(0)" ::: "memory");
    __syncthreads();
    if (threadIdx.x == 0) {
        unsigned* bar = b.bar;
        __builtin_amdgcn_s_waitcnt(0);
        unsigned nloc = b.st[0], nx = b.st[1];
        if (nloc == 0u) { xcd_barrier_complete(bar, b.x, nloc, nx); b.st[0] = nloc; b.st[1] = nx; }
        const unsigned old = xb_add(&bar[XB_XSUB(b.x)], 1u);
        const unsigned gen = old / nloc;
        if (old + 1u == (gen + 1u) * nloc) {
            __builtin_amdgcn_fence(__ATOMIC_RELEASE, "agent");
            asm volatile("s_waitcnt vmcnt(0)" ::: "memory");
            const unsigned og = xb_add(&bar[XB_TOP], 1u);
            const unsigned tg = og / nx;
            if (og + 1u == (tg + 1u) * nx) xb_add(&bar[XB_TOPGEN], 1u);
            else XB_SPIN(xb_ld(&bar[XB_TOPGEN]) == tg, bar);
            __builtin_amdgcn_fence(__ATOMIC_ACQUIRE, "agent");
            xb_add(&bar[XB_XGEN(b.x)], 1u);
            asm volatile("s_waitcnt vmcnt(0)" ::: "memory");
        } else {
            XB_SPIN(xb_ld(&bar[XB_XGEN(b.x)]) == gen, bar);
            __builtin_amdgcn_fence(__ATOMIC_ACQUIRE, "agent");
            asm volatile("s_waitcnt vmcnt(0)" ::: "memory");
        }
    }
    __syncthreads();
}

__device__ __forceinline__ float silu_f(float x) { return x / (1.f + expf(-x)); }
__device__ __forceinline__ float sigmoid_f(float x) { return 1.f / (1.f + expf(-x)); }
__device__ __forceinline__ unsigned f2bf(float f) { unsigned u = __builtin_bit_cast(unsigned, f); return (u + 0x7fffu + ((u >> 16) & 1u)) >> 16; }
__device__ __forceinline__ unsigned pk2(float lo, float hi) { return f2bf(lo) | (f2bf(hi) << 16); }
__device__ __forceinline__ float bf2f(bf16 v) { return __builtin_bit_cast(float, (unsigned)v << 16); }
__device__ __forceinline__ float wave_sum(float v) {
#pragma unroll
    for (int o = 1; o < 64; o <<= 1) v += __shfl_xor(v, o);
    return v;
}
__device__ __forceinline__ int t5_bucket(int dist) {
    const int n = dist < 0 ? 0 : dist;
    if (n < 16) return n;
    int b = 16;
    b += (n >= 19) + (n >= 21) + (n >= 24) + (n >= 27) + (n >= 31) + (n >= 35) + (n >= 40) + (n >= 46) + (n >= 52) + (n >= 59) +
         (n >= 67) + (n >= 77) + (n >= 87) + (n >= 99) + (n >= 113);
    return b;
}

struct Args {
    const float* in[26];
    float* out; unsigned char* ws;
    int ph_lo, ph_hi;
};

struct Ctx {
    LAS unsigned char* lds;
    int tid, lane, wave, gtid, GT, gw, NGW;
    const float *x, *c, *w_ada, *b_ada, *w_in, *b_f, *cmp_pos_k, *cmp_w1_k, *cmp_w2_k, *cmp_pos_v, *cmp_w1_v, *cmp_w2_v, *rel_bias, *w_out, *ln1_g, *ln1_b,
        *w_router, *e_bias, *w_gate, *w_up, *w_down, *ws_gate, *ws_up, *ws_down, *ln2_g, *ln2_b;
    float* out;
    float *mod, *cum, *kvc, *hid, *scorebuf, *scores, *ew, *fg, *pc, *ao, *act;
    unsigned* selmask; int* eidx;
    bf16 *hbuf, *proj, *h2lo;
};

__device__ __forceinline__ void ph_mod(Ctx& C) {
    for (int i = C.gtid; i < NB * 6 * D; i += C.GT) {
        const int b = i / (6 * D), e = i % (6 * D);
        float acc = C.b_ada[e];
        for (int d = 0; d < D; ++d) acc += silu_f(C.c[b * D + d]) * C.w_ada[(size_t)d * 6 * D + e];
        C.mod[i] = acc;
    }
}
__device__ __forceinline__ void ph_hpass(Ctx& C) {
    for (int m = C.gw; m < T; m += C.NGW) {
        const int b = m / S;
        const float* md = C.mod + b * 6 * D;
#pragma unroll
        for (int j = 0; j < 4; ++j) {
            const int c0 = (C.lane + 64 * j) * 4;
            const f32x4 xv = *(const f32x4*)(C.x + (size_t)m * D + c0);
            const f32x4 sh = *(const f32x4*)(md + c0), sc = *(const f32x4*)(md + D + c0);
            const f32x4 h = xv * (1.f + sc) + sh;
            u32x2 o; o.x = pk2(h.x, h.y); o.y = pk2(h.z, h.w);
            *(u32x2*)(C.hbuf + (size_t)m * D + c0) = o;
        }
    }
}
template <int MODE>
__device__ __forceinline__ void ph_gemm(Ctx& C) {
    const int half = C.tid >> 8, t256 = C.tid & 255;
    LAS float* As = (LAS float*)(C.lds + half * 16384);
    LAS float* Bs = As + 16 * 65;
    const int N = MODE == 0 ? NPROJ : D;
    const int ntn = (N + 63) / 64, ntiles = ntn * (T / 64), npairs = ntiles / 2;
    const int tx = t256 % 16, ty = t256 / 16;
    for (int p = blockIdx.x; p < npairs; p += gridDim.x) {
        const int tile = 2 * p + half;
        const int m0 = (tile / ntn) * 64, n0 = (tile % ntn) * 64;
        float acc[4][4];
#pragma unroll
        for (int i = 0; i < 4; ++i)
#pragma unroll
            for (int j = 0; j < 4; ++j) acc[i][j] = 0.f;
        for (int k0 = 0; k0 < D; k0 += 16) {
#pragma unroll
            for (int i = 0; i < 4; ++i) {
                const int idx = t256 + i * 256;
                const int r = idx / 16, kk = idx % 16;
                float a;
                if (MODE == 0) a = bf2f(C.hbuf[(size_t)(m0 + r) * D + k0 + kk]); else a = C.ao[(size_t)(m0 + r) * D + k0 + kk];
                As[kk * 65 + r] = a;
                const int kb = idx / 64, cb = idx % 64;
                const float* Bm = MODE == 0 ? C.w_in : C.w_out;
                Bs[kb * 64 + cb] = (n0 + cb < N) ? Bm[(size_t)(k0 + kb) * N + n0 + cb] : 0.f;
            }
            __syncthreads();
#pragma unroll
            for (int kk = 0; kk < 16; ++kk) {
                float a[4], bv[4];
#pragma unroll
                for (int i = 0; i < 4; ++i) a[i] = As[kk * 65 + ty * 4 + i];
#pragma unroll
                for (int j = 0; j < 4; ++j) bv[j] = Bs[kk * 64 + tx * 4 + j];
#pragma unroll
                for (int i = 0; i < 4; ++i)
#pragma unroll
                    for (int j = 0; j < 4; ++j) acc[i][j] += a[i] * bv[j];
            }
            __syncthreads();
        }
#pragma unroll
        for (int i = 0; i < 4; ++i)
#pragma unroll
            for (int j = 0; j < 4; ++j) {
                const int m = m0 + ty * 4 + i, n = n0 + tx * 4 + j;
                if (n >= N) continue;
                if (MODE == 0) {
                    if (n >= 1536 && n < 1544) C.fg[(size_t)m * FGW + (n - 1536)] = acc[i][j];
                    else if (n >= 2824) C.fg[(size_t)m * FGW + 8 + (n - 2824)] = acc[i][j];
                    else {
                        const int dc = n < 1536 ? n : n - 8;
                        const bool isq = dc < 512 || (dc >= PC_NQ && dc < PC_NQ + 512);
                        C.proj[(size_t)m * PITCH + dc] = (bf16)f2bf(isq ? acc[i][j] * C2 : acc[i][j]);
                    }
                } else {
                    const int b = m / S;
                    C.out[(size_t)m * D + n] = ALPHA * C.x[(size_t)m * D + n] + C.mod[b * 6 * D + 2 * D + n] * acc[i][j];
                }
            }
    }
}
__device__ __forceinline__ void ph_cum_cmp1(Ctx& C) {
    for (int w = C.gw; w < NB * 8; w += C.NGW) {
        const int b = w / 8, h = w % 8;
        float carry = 0.f;
        for (int c0 = 0; c0 < S; c0 += 64) {
            const int t = c0 + C.lane;
            const float xx = C.fg[((size_t)b * S + t) * FGW + h] + C.b_f[h];
            float v = fminf(xx, 0.f) - log1pf(expf(-fabsf(xx)));
#pragma unroll
            for (int o = 1; o < 64; o <<= 1) { const float u = __shfl_up(v, o); if (C.lane >= o) v += u; }
            v += carry;
            C.cum[(size_t)w * S + t] = v;
            carry = __shfl(v, 63);
        }
    }
    const int NR = NB * NCMP * 2;
    for (int i = C.gtid; i < 2 * NR * 256; i += C.GT) {
        const int j = i % 256, row = (i / 256) % NR, which = i / (256 * NR);
        const int g = row % 2, n = (row / 2) % NCMP, b = row / (2 * NCMP);
        const float* pos = which ? C.cmp_pos_v : C.cmp_pos_k;
        const float* w1 = which ? C.cmp_w1_v : C.cmp_w1_k;
        const int off = (which ? PC_VC : PC_KC) + g * 64;
        float acc = 0.f;
        for (int l = 0; l < 32; ++l) {
            const bf16* xr = C.proj + ((size_t)b * S + 16 * n + l) * PITCH + off;
            for (int d = 0; d < 64; ++d) acc += (bf2f(xr[d]) + pos[l * 64 + d]) * w1[(size_t)(l * 64 + d) * 256 + j];
        }
        C.hid[i] = silu_f(acc);
    }
}
__device__ __forceinline__ void ph_cmp2(Ctx& C) {
    const int NR = NB * NCMP * 2;
    for (int i = C.gtid; i < 2 * NR * 64; i += C.GT) {
        const int d = i % 64, row = (i / 64) % NR, which = i / (64 * NR);
        const float* w2 = which ? C.cmp_w2_v : C.cmp_w2_k;
        const float* hr = C.hid + ((size_t)which * NR + row) * 256;
        float acc = 0.f;
        for (int j = 0; j < 256; ++j) acc += hr[j] * w2[j * 64 + d];
        C.kvc[i] = acc;
    }
}
__device__ __forceinline__ void cmp_attn_item(Ctx& C, int i) {
    const int t = i % S, h = (i / S) % 8, b = i / (S * 8), g = h / 4;
    const size_t tok = (size_t)b * S + t;
    const int NR = NB * NCMP * 2;
    const float* kc = C.kvc;
    const float* vc = C.kvc + (size_t)NR * 64;
    float q[64], o[64];
#pragma unroll
    for (int d = 0; d < 64; ++d) { q[d] = bf2f(C.proj[tok * PITCH + PC_NQ + h * 64 + d]); o[d] = 0.f; }
    float* prow = C.pc + ((size_t)(b * 8 + h) * S + t) * 128;
    const int nvalid = t >= 31 ? min(NCMP, (t - 31) / 16 + 1) : 0;
    float m = -1e30f;
    for (int n = 0; n < nvalid; ++n) {
        const float* kr = kc + ((size_t)(b * NCMP + n) * 2 + g) * 64;
        float dot = 0.f;
#pragma unroll
        for (int d = 0; d < 64; ++d) dot += q[d] * kr[d];
        const float lg = dot + C.rel_bias[t5_bucket(t - (16 * n + 31)) * 8 + h] * LOG2E;
        prow[n] = lg;
        m = fmaxf(m, lg);
    }
    float l = 0.f;
    for (int n = 0; n < nvalid; ++n) l += exp2f(prow[n] - m);
    const float il = nvalid ? 1.f / l : 0.f;
    for (int n = 0; n < 128; ++n) {
        float p = 0.f;
        if (n < nvalid) {
            p = exp2f(prow[n] - m) * il;
            const float* vr = vc + ((size_t)(b * NCMP + n) * 2 + g) * 64;
#pragma unroll
            for (int d = 0; d < 64; ++d) o[d] += p * vr[d];
        }
        prow[n] = p;
    }
    const float g0 = sigmoid_f(C.fg[tok * FGW + 8 + h * 3 + 0]);
#pragma unroll
    for (int d = 0; d < 64; ++d) C.ao[tok * D + 512 + h * 64 + d] = g0 * o[d];
}
template <int MODE>
__device__ __forceinline__ void attn_item(Ctx& C, int i) {
    const int t = i % S, h = (i / S) % 8, b = i / (S * 8), g = h / 4;
    const size_t tok = (size_t)b * S + t;
    const int qoff = (MODE == 0 ? PC_FQ : PC_NQ) + h * 64;
    const int koff = MODE == 0 ? PC_FK + h * 64 : (MODE == 1 ? PC_KS : PC_KW) + g * 64;
    const int voff = MODE == 0 ? PC_FV + h * 64 : (MODE == 1 ? PC_VS : PC_VW) + g * 64;
    float q[64], o[64];
#pragma unroll
    for (int d = 0; d < 64; ++d) { q[d] = bf2f(C.proj[tok * PITCH + qoff + d]); o[d] = 0.f; }
    float m = -INFINITY, l = 0.f;
    const int s_lo = MODE == 2 ? max(0, t - 511) : 0;
    const unsigned mask = MODE == 1 ? C.selmask[(b * 2 + g) * S + t] : 0xffffffffu;
    const float* cr = C.cum + (size_t)(b * 8 + h) * S;
    const float cumt = MODE == 0 ? cr[t] : 0.f;
    for (int s = s_lo; s <= t; ++s) {
        if (MODE == 1 && !((mask >> (s >> 6)) & 1u)) continue;
        const bf16* kr = C.proj + ((size_t)b * S + s) * PITCH + koff;
        const bf16* vr = C.proj + ((size_t)b * S + s) * PITCH + voff;
        float dot = 0.f;
#pragma unroll
        for (int d = 0; d < 64; ++d) dot += q[d] * bf2f(kr[d]);
        const float bias = MODE == 0 ? cumt - cr[s] : C.rel_bias[t5_bucket(t - s) * 8 + h];
        const float lg = dot + bias * LOG2E;
        const float mn = fmaxf(m, lg), corr = exp2f(m - mn), p = exp2f(lg - mn);
        l = l * corr + p;
#pragma unroll
        for (int d = 0; d < 64; ++d) o[d] = o[d] * corr + p * bf2f(vr[d]);
        m = mn;
    }
    const float il = 1.f / l;
    if (MODE == 0) {
#pragma unroll
        for (int d = 0; d < 64; ++d) C.ao[tok * D + h * 64 + d] = o[d] * il;
    } else {
        const float gt = sigmoid_f(C.fg[tok * FGW + 8 + h * 3 + MODE]) * il;
#pragma unroll
        for (int d = 0; d < 64; ++d) C.ao[tok * D + 512 + h * 64 + d] += gt * o[d];
    }
}
__device__ __forceinline__ void ph_imp_topk(Ctx& C) {
    for (int i = C.gtid; i < NB * 2 * S; i += C.GT) {
        const int t = i % S, g = (i / S) % 2, b = i / (S * 2);
        const int qb = t >> 6;
        float* sc = C.scorebuf + (size_t)i * 32;
        for (int j = 0; j < 32; ++j) {
            float imp = 0.f;
            for (int r = 0; r < 4; ++r) {
                const float* prow = C.pc + ((size_t)(b * 8 + g * 4 + r) * S + t) * 128;
                for (int n = 4 * j - 1; n <= 4 * j + 3; ++n)
                    if (n >= 0 && n < NCMP) imp += prow[n];
            }
            const bool causal = j <= qb, forced = (j == 0) || (j == qb) || (j == qb - 1);
            sc[j] = causal ? imp + (forced ? 1e4f : 0.f) : -1e4f;
        }
        unsigned taken = 0u;
        for (int k = 0; k < 16; ++k) {
            float best = -3e38f; int bi = 0;
            for (int j = 0; j < 32; ++j)
                if (!((taken >> j) & 1u)) { const float v = sc[j]; if (v > best) { best = v; bi = j; } }
            taken |= 1u << bi;
        }
        C.selmask[i] = taken;
    }
}
template <int WHICH>
__device__ __forceinline__ void ph_ln(Ctx& C) {
    const float* gam = WHICH == 1 ? C.ln1_g : C.ln2_g;
    const float* bet = WHICH == 1 ? C.ln1_b : C.ln2_b;
    for (int m = C.gw; m < T; m += C.NGW) {
        const int b = m / S;
        float* row = C.out + (size_t)m * D;
        f32x4 v[4]; float s = 0.f;
#pragma unroll
        for (int j = 0; j < 4; ++j) { v[j] = *(const f32x4*)(row + (C.lane + 64 * j) * 4); s += (v[j].x + v[j].y) + (v[j].z + v[j].w); }
        const float mean = wave_sum(s) * (1.f / D); float s2 = 0.f;
#pragma unroll
        for (int j = 0; j < 4; ++j) { v[j] = v[j] - mean; s2 += (v[j].x * v[j].x + v[j].y * v[j].y) + (v[j].z * v[j].z + v[j].w * v[j].w); }
        const float rstd = rsqrtf(wave_sum(s2) * (1.f / D) + LN_EPS);
#pragma unroll
        for (int j = 0; j < 4; ++j) {
            const int c0 = (C.lane + 64 * j) * 4;
            const f32x4 y = v[j] * rstd * *(const f32x4*)(gam + c0) + *(const f32x4*)(bet + c0);
            *(f32x4*)(row + c0) = y;
            if (WHICH == 1) {
                const float* md = C.mod + b * 6 * D;
                const f32x4 h2 = y * (1.f + *(const f32x4*)(md + 4 * D + c0)) + *(const f32x4*)(md + 3 * D + c0);
                u32x2 hi; hi.x = pk2(h2.x, h2.y); hi.y = pk2(h2.z, h2.w);
                const float r0 = h2.x - __builtin_bit_cast(float, hi.x << 16), r1 = h2.y - __builtin_bit_cast(float, hi.x & 0xffff0000u);
                const float r2 = h2.z - __builtin_bit_cast(float, hi.y << 16), r3 = h2.w - __builtin_bit_cast(float, hi.y & 0xffff0000u);
                u32x2 lo; lo.x = pk2(r0, r1); lo.y = pk2(r2, r3);
                *(u32x2*)(C.hbuf + (size_t)m * D + c0) = hi;
                *(u32x2*)(C.h2lo + (size_t)m * D + c0) = lo;
            }
        }
    }
}
__device__ __forceinline__ float h2_at(Ctx& C, size_t idx) { return bf2f(C.hbuf[idx]) + bf2f(C.h2lo[idx]); }
__device__ __forceinline__ void ph_router(Ctx& C) {
    for (int i = C.gtid; i < T * 64; i += C.GT) {
        const int e = i % 64, tok = i / 64;
        float acc = 0.f;
        for (int d = 0; d < D; ++d) acc += h2_at(C, (size_t)tok * D + d) * C.w_router[d * 64 + e];
        C.scores[i] = sigmoid_f(acc);
    }
}
__device__ __forceinline__ void ph_route(Ctx& C) {
    for (int tok = C.gtid; tok < T; tok += C.GT) {
        const float* sc = C.scores + (size_t)tok * 64;
        unsigned gtaken = 0u;
        for (int k = 0; k < 4; ++k) {
            float best = -3e38f; int bg = 0;
            for (int g = 0; g < 8; ++g) {
                if ((gtaken >> g) & 1u) continue;
                float m1 = -3e38f, m2 = -3e38f;
                for (int j = 0; j < 8; ++j) { const float v = sc[g * 8 + j] + C.e_bias[g * 8 + j]; if (v > m1) { m2 = m1; m1 = v; } else if (v > m2) m2 = v; }
                const float gs = m1 + m2;
                if (gs > best) { best = gs; bg = g; }
            }
            gtaken |= 1u << bg;
        }
        unsigned long long taken = 0ull;
        float wsum = 0.f;
        for (int k = 0; k < 8; ++k) {
            float best = -3e38f; int be = 0;
            for (int e = 0; e < 64; ++e) {
                if (!((gtaken >> (e >> 3)) & 1u) || ((taken >> e) & 1ull)) continue;
                const float v = sc[e] + C.e_bias[e];
                if (v > best) { best = v; be = e; }
            }
            taken |= 1ull << be;
            C.eidx[tok * 8 + k] = be;
            wsum += sc[be];
        }
        for (int k = 0; k < 8; ++k) C.ew[tok * 8 + k] = sc[C.eidx[tok * 8 + k]] / wsum * 2.5f;
    }
}
__device__ __forceinline__ void ph_moe_gateup(Ctx& C) {
    for (size_t i = C.gtid; i < (size_t)T * 9 * 256; i += C.GT) {
        const int j = (int)(i % 256), slot = (int)((i / 256) % 9), tok = (int)(i / (256 * 9));
        const float *Wg, *Wu; float wt = 1.f;
        if (slot < 8) { const int e = C.eidx[tok * 8 + slot]; Wg = C.w_gate + (size_t)e * D * 256; Wu = C.w_up + (size_t)e * D * 256; wt = C.ew[tok * 8 + slot]; }
        else { Wg = C.ws_gate; Wu = C.ws_up; }
        float a = 0.f, u = 0.f;
        for (int d = 0; d < D; ++d) { const float hv = bf2f(C.hbuf[(size_t)tok * D + d]); a += hv * Wg[(size_t)d * 256 + j]; u += hv * Wu[(size_t)d * 256 + j]; }
        C.act[i] = silu_f(a) * u * wt;
    }
}
__device__ __forceinline__ void ph_moe_down(Ctx& C) {
    for (size_t i = C.gtid; i < (size_t)T * D; i += C.GT) {
        const int col = (int)(i % D), tok = (int)(i / D), b = tok / S;
        float acc = 0.f;
        for (int slot = 0; slot < 9; ++slot) {
            const float* Wd = slot < 8 ? C.w_down + (size_t)C.eidx[tok * 8 + slot] * 256 * D : C.ws_down;
            const float* ar = C.act + ((size_t)tok * 9 + slot) * 256;
            for (int k = 0; k < 256; ++k) acc += ar[k] * Wd[(size_t)k * D + col];
        }
        C.out[i] = ALPHA * C.out[i] + C.mod[b * 6 * D + 5 * D + col] * acc;
    }
}

constexpr int N_PHASES = 14;
__global__ void __launch_bounds__(NTHR, 2) mk_fwd(Args args) {
    extern __shared__ __attribute__((aligned(16))) unsigned char lds[];
    Ctx C;
    C.lds = (LAS unsigned char*)lds;
    C.tid = threadIdx.x; C.lane = C.tid & 63; C.wave = __builtin_amdgcn_readfirstlane(C.tid >> 6);
    C.gtid = blockIdx.x * NTHR + C.tid; C.GT = gridDim.x * NTHR; C.gw = blockIdx.x * NWAVES + C.wave; C.NGW = gridDim.x * NWAVES;
    C.x = args.in[0]; C.c = args.in[1]; C.w_ada = args.in[2]; C.b_ada = args.in[3]; C.w_in = args.in[4]; C.b_f = args.in[5];
    C.cmp_pos_k = args.in[6]; C.cmp_w1_k = args.in[7]; C.cmp_w2_k = args.in[8]; C.cmp_pos_v = args.in[9]; C.cmp_w1_v = args.in[10]; C.cmp_w2_v = args.in[11];
    C.rel_bias = args.in[12]; C.w_out = args.in[13]; C.ln1_g = args.in[14]; C.ln1_b = args.in[15]; C.w_router = args.in[16]; C.e_bias = args.in[17];
    C.w_gate = args.in[18]; C.w_up = args.in[19]; C.w_down = args.in[20]; C.ws_gate = args.in[21]; C.ws_up = args.in[22]; C.ws_down = args.in[23];
    C.ln2_g = args.in[24]; C.ln2_b = args.in[25];
    C.out = args.out;
    unsigned char* ws = args.ws;
    C.mod = (float*)(ws + WS_MOD); C.cum = (float*)(ws + WS_CUM); C.kvc = (float*)(ws + WS_KVC); C.hid = (float*)(ws + WS_HID);
    C.selmask = (unsigned*)(ws + WS_SELM); C.scorebuf = (float*)(ws + WS_SCB); C.scores = (float*)(ws + WS_SCORES);
    C.eidx = (int*)(ws + WS_EIDX); C.ew = (float*)(ws + WS_EW); C.fg = (float*)(ws + WS_FG);
    C.hbuf = (bf16*)(ws + WS_HBUF); C.proj = (bf16*)(ws + WS_PROJ); C.h2lo = (bf16*)(ws + WS_PROJ);
    C.pc = (float*)(ws + WS_PC); C.ao = (float*)(ws + WS_AO); C.act = (float*)(ws + WS_ACT);
    volatile LAS unsigned* MISC = (volatile LAS unsigned*)(C.lds + MISC_OFF);
    if (C.tid < 32) MISC[C.tid] = 0u;
    __syncthreads();
    gu32* ctl = (gu32*)(ws + WS_CTL);
    XcdBarrier bar = xcd_barrier_post((unsigned*)(ctl + CW_BAR), MISC + 8);
    const int lo = args.ph_lo, hi = args.ph_hi;
#define IN(k) (lo <= (k) && (k) < hi)
#define SEAM(k) do { if (IN(k) && IN((k) + 1)) xcd_barrier(bar); } while (0)
    if (IN(0)) ph_mod(C);
    SEAM(0);
    if (IN(1)) ph_hpass(C);
    SEAM(1);
    if (IN(2)) ph_gemm<0>(C);
    SEAM(2);
    if (IN(3)) ph_cum_cmp1(C);
    SEAM(3);
    if (IN(4)) ph_cmp2(C);
    SEAM(4);
    if (IN(5)) { for (int i = C.gtid; i < NB * 8 * S; i += C.GT) { attn_item<0>(C, i); cmp_attn_item(C, i); } }
    SEAM(5);
    if (IN(6)) ph_imp_topk(C);
    SEAM(6);
    if (IN(7)) { for (int i = C.gtid; i < NB * 8 * S; i += C.GT) { attn_item<1>(C, i); attn_item<2>(C, i); } }
    SEAM(7);
    if (IN(8)) ph_gemm<1>(C);
    SEAM(8);
    if (IN(9)) ph_ln<1>(C);
    SEAM(9);
    if (IN(10)) ph_router(C);
    SEAM(10);
    if (IN(11)) ph_route(C);
    SEAM(11);
    if (IN(12)) ph_moe_gateup(C);
    SEAM(12);
    if (IN(13)) {
        ph_moe_down(C);
        xcd_barrier(bar);
        ph_ln<2>(C);
    }
#undef IN
#undef SEAM
}

extern "C" void kernel_launch(void* const* d_in, const int* in_sizes, int n_in, void* d_out, int out_size, void* d_ws, size_t ws_size, hipStream_t stream) {
    static int grid = 0;
    if (grid == 0) {
        if (n_in != 26 || out_size != T * D || ws_size < WS_END) { fprintf(stderr, "kernel_launch: unexpected problem (n_in %d out %d ws %zu)\n", n_in, out_size, ws_size); grid = -1; return; }
        int dev = 0, cus = 0, per_cu = 0;
        if (hipGetDevice(&dev) != hipSuccess || hipDeviceGetAttribute(&cus, hipDeviceAttributeMultiprocessorCount, dev) != hipSuccess) { grid = -1; return; }
        if (hipFuncSetAttribute((const void*)mk_fwd, hipFuncAttributeMaxDynamicSharedMemorySize, LDS_BYTES) != hipSuccess) { fprintf(stderr, "kernel_launch: hipFuncSetAttribute failed\n"); grid = -1; return; }
        if (hipOccupancyMaxActiveBlocksPerMultiprocessor(&per_cu, (const void*)mk_fwd, NTHR, LDS_BYTES) != hipSuccess || per_cu < 1) { fprintf(stderr, "kernel_launch: occupancy query says %d\n", per_cu); grid = -1; (void)hipGetLastError(); return; }
        grid = cus;
    }
    if (grid < 0) return;
    (void)hipMemsetAsync((char*)d_ws + WS_CTL, 0, CTL_ZERO_BYTES, stream);
    Args a{};
    for (int i = 0; i < 26; ++i) a.in[i] = (const float*)d_in[i];
    a.out = (float*)d_out; a.ws = (unsigned char*)d_ws; a.ph_lo = 0; a.ph_hi = N_PHASES;
    hipLaunchKernelGGL(mk_fwd, dim3(grid), dim3(NTHR), LDS_BYTES, stream, a);
}
```

```cpp
#include <hip/hip_runtime.h>
#include <cstdio>
#include <cstdint>

#define GAS __attribute__((address_space(1)))
#define LAS __attribute__((address_space(3)))
typedef unsigned short bf16;
typedef float f32x4 __attribute__((ext_vector_type(4)));
typedef unsigned u32x4 __attribute__((ext_vector_type(4)));
typedef unsigned u32x2 __attribute__((ext_vector_type(2)));
typedef GAS unsigned gu32;
#define RLX_AGENT __ATOMIC_RELAXED, __HIP_MEMORY_SCOPE_AGENT

constexpr int D = 1024, NB = 8, S = 2048, T = NB * S;
constexpr int NPROJ = 2848;
constexpr int PITCH = 2816;
constexpr int PC_FQ = 0, PC_FK = 512, PC_FV = 1024, PC_NQ = 1536, PC_KC = 2048, PC_VC = 2176, PC_KS = 2304, PC_VS = 2432, PC_KW = 2560, PC_VW = 2688;
constexpr int FGW = 32;
constexpr int NCMP = 127;
constexpr float ALPHA = 1.189207115002721f;
constexpr float LN_EPS = 1e-5f;
constexpr float LOG2E = 1.4426950408889634f;
constexpr float C2 = 0.125f * LOG2E;
constexpr int NWAVES = 8, NTHR = NWAVES * 64;

constexpr size_t MiB = 1u << 20;
constexpr size_t WS_CTL = 0, CTL_ZERO_BYTES = 1 * MiB;
constexpr size_t WS_MOD = 1 * MiB, WS_CUM = 2 * MiB, WS_KVC = 3 * MiB, WS_HID = 4 * MiB, WS_SELM = 8 * MiB, WS_SCB = 9 * MiB, WS_SCORES = 13 * MiB,
                 WS_EIDX = 17 * MiB, WS_EW = 18 * MiB, WS_FG = 19 * MiB;
constexpr size_t WS_WIN_T = 22 * MiB;
constexpr size_t WS_WOUT_T = 28 * MiB;
constexpr size_t WS_HBUF = 30 * MiB;
constexpr size_t WS_PROJ = 62 * MiB;
constexpr size_t WS_PC = 150 * MiB;
constexpr size_t WS_AO = 214 * MiB;
constexpr size_t WS_WGU = 94 * MiB;
constexpr size_t WS_WDN = 167 * MiB;
constexpr size_t WS_ACT16 = 200 * MiB;
constexpr size_t WS_SLOT = 22 * MiB;
constexpr size_t WS_LROW = 280 * MiB, WS_LW = 285 * MiB;
constexpr size_t WS_END = 290 * MiB;
constexpr int CW_CNT = 8192;
constexpr int CW_BAR = 4096;

constexpr int LDS_BYTES = 147456;
constexpr int MISC_OFF = 131072 + 320;
constexpr int LDS_TSTART = 131072 + 1024, LDS_CNT = 131072 + 1536, LDS_TAB = 131072 + 2048;

#define XB_TMO      128
#define XB_XCNT(j)  (256  + 64 * (j))
#define XB_XSUB(j)  (1280 + 64 * (j))
#define XB_XGEN(j)  (2304 + 64 * (j))
#define XB_TOP      3328
#define XB_TOPGEN   3392
#define XCD_BAR_WORDS 3456
#define XB_SPIN_CAP (1u << 20)
__device__ __forceinline__ unsigned xb_ld(unsigned* p)              { return __hip_atomic_load(p, __ATOMIC_RELAXED, __HIP_MEMORY_SCOPE_AGENT); }
__device__ __forceinline__ unsigned xb_add(unsigned* p, unsigned v) { return __hip_atomic_fetch_add(p, v, __ATOMIC_RELAXED, __HIP_MEMORY_SCOPE_AGENT); }
__device__ __forceinline__ unsigned xb_xcc_id() { return (unsigned)__builtin_amdgcn_s_getreg((3 << 11) | 20) & 0xFu; }
#define XB_SPIN(cond, bar) do { unsigned _sp = 0; while (cond) { __builtin_amdgcn_s_sleep(1); \
    if ((++_sp & 255u) == 0u) { if (xb_ld(&(bar)[XB_TMO])) break; if (_sp > XB_SPIN_CAP) { atomicAdd(&(bar)[XB_TMO], 1u); break; } } } } while (0)
struct XcdBarrier { unsigned* bar; unsigned x; volatile LAS unsigned* st; };
__device__ __forceinline__ XcdBarrier xcd_barrier_post(unsigned* bar, volatile LAS unsigned* st) {
    XcdBarrier b; b.bar = bar; b.x = xb_xcc_id(); b.st = st;
    if (threadIdx.x == 0) (void)xb_add(&bar[XB_XCNT(b.x)], 1u);
    return b;
}
__device__ __forceinline__ void xcd_barrier_complete(unsigned* bar, unsigned x, unsigned& nloc, unsigned& nx) {
    const unsigned G = gridDim.x * gridDim.y * gridDim.z;
    unsigned sum, cnt, mine, sp = 0u;
    for (;;) {
        sum = 0u; cnt = 0u; mine = 0u;
#pragma unroll
        for (unsigned j = 0; j < 16; ++j) { const unsigned c = xb_ld(&bar[XB_XCNT(j)]); sum += c; cnt += (c > 0u) ? 1u : 0u; mine = (j == x) ? c : mine; }
        if (sum == G) break;
        __builtin_amdgcn_s_sleep(1);
        if ((++sp & 255u) == 0u) { if (xb_ld(&bar[XB_TMO])) break; if (sp > XB_SPIN_CAP) { atomicAdd(&bar[XB_TMO], 1u); break; } }
    }
    nloc = mine > 0u ? mine : 1u; nx = cnt > 0u ? cnt : 1u;
}
__device__ __forceinline__ void xcd_barrier(const XcdBarrier& b) {
    asm volatile("s_waitcnt vmcnt(0)" ::: "memory");
    __syncthreads();
    if (threadIdx.x == 0) {
        unsigned* bar = b.bar;
        __builtin_amdgcn_s_waitcnt(0);
        unsigned nloc = b.st[0], nx = b.st[1];
        if (nloc == 0u) { xcd_barrier_complete(bar, b.x, nloc, nx); b.st[0] = nloc; b.st[1] = nx; }
        const unsigned old = xb_add(&bar[XB_XSUB(b.x)], 1u);
        const unsigned gen = old / nloc;
        if (old + 1u == (gen + 1u) * nloc) {
            __builtin_amdgcn_fence(__ATOMIC_RELEASE, "agent");
            asm volatile("s_waitcnt vmcnt(0)" ::: "memory");
            const unsigned og = xb_add(&bar[XB_TOP], 1u);
            const unsigned tg = og / nx;
            if (og + 1u == (tg + 1u) * nx) xb_add(&bar[XB_TOPGEN], 1u);
            else XB_SPIN(xb_ld(&bar[XB_TOPGEN]) == tg, bar);
            __builtin_amdgcn_fence(__ATOMIC_ACQUIRE, "agent");
            xb_add(&bar[XB_XGEN(b.x)], 1u);
            asm volatile("s_waitcnt vmcnt(0)" ::: "memory");
        } else {
            XB_SPIN(xb_ld(&bar[XB_XGEN(b.x)]) == gen, bar);
            __builtin_amdgcn_fence(__ATOMIC_ACQUIRE, "agent");
            asm volatile("s_waitcnt vmcnt(0)" ::: "memory");
        }
    }
    __syncthreads();
}

namespace pg8 {
#define PG8_LAS __attribute__((address_space(3)))
typedef unsigned short bf16_t;
typedef short bf16x8 __attribute__((ext_vector_type(8)));
typedef float f32x4 __attribute__((ext_vector_type(4)));
typedef unsigned u32x4 __attribute__((ext_vector_type(4)));
constexpr int BM = 256, BK = 64, HALF = 128, HTB = HALF * BK * 2  , STAGE_BYTES = 8 * HTB, NXCD = 8, WGM = 8;

__host__ __device__ __forceinline__ int lds_byte(int r, int c) { const int st = (r >> 4) * 2 + (c >> 5), rr = r & 15, cc = c & 31, ob = rr * 64 + cc * 2; return st * 1024 + (ob ^ (((ob >> 9) & 1) << 5)); }
__host__ __device__ __forceinline__ void stage_rc(int b, int& R, int& C) { const int st = b / 1024, sb = b % 1024, swz = sb ^ (((sb >> 9) & 1) << 5); R = (st >> 1) * 16 + swz / 64; C = (st & 1) * 32 + (swz % 64) / 2; }
__host__ __device__ __forceinline__ int perm32(int rho) { const int n = rho >> 4, i = rho & 15; return 8 * (i >> 2) + 4 * n + (i & 3); }

struct Unit { int pm, pn; };
struct Gemm { const bf16_t* A; const bf16_t* Bt; int M, N, K; };

struct StaticOrder {
    int nM, nN, nwg, G, c;
    __host__ __device__ void init(int M, int N, int G_, int c_) { nM = M / BM; nN = N / BM; nwg = nM * nN; G = G_; c = c_; }
    __host__ __device__ bool next(int i, Unit& u) const {
        const long L = (long)i * G + c; if (L >= nwg) return false;
        int wgid = (int)L; { const int q = nwg / NXCD, r = nwg % NXCD, xcd = wgid % NXCD, off = wgid / NXCD; wgid = (xcd < r ? xcd * (q + 1) : r * (q + 1) + (xcd - r) * q) + off; }
        const int nig = WGM * nN, gid = wgid / nig, fm = gid * WGM, gsz = (nM - fm) < WGM ? (nM - fm) : WGM;
        u.pm = fm + ((wgid % nig) % gsz); u.pn = (wgid % nig) / gsz; return true;
    }
    __device__ __forceinline__ void a_ready(const Unit&) const {}
    __device__ __forceinline__ void done(const Unit&) const {}
};


__device__ __forceinline__ unsigned cvt_pk_bf16(float lo, float hi) { unsigned r; asm volatile("v_cvt_pk_bf16_f32 %0, %1, %2" : "=v"(r) : "v"(lo), "v"(hi)); return r; }
struct EpiProj {
    static constexpr bool PERM = true, AFTER_DRAIN = false;
    bf16_t* proj; float* fg; int pitch; float qscale;
    __device__ __forceinline__ void operator()(const f32x4 (&acc)[2][2][4][2], const Unit& u, int wr, int wc, int fr, int fq) const {
        const int row0 = u.pm * BM + wr * 64 + fr;
        if (u.pn < 11) {
            const float sc = (u.pn < 2 || u.pn == 6 || u.pn == 7) ? qscale : 1.f;
            const int col0 = u.pn * BM + wc * 32 + 8 * fq;
#pragma unroll
            for (int ai = 0; ai < 2; ++ai)
#pragma unroll
                for (int m = 0; m < 4; ++m) { bf16_t* rowp = proj + (size_t)(row0 + ai * HALF + m * 16) * pitch + col0;
#pragma unroll
                    for (int bj = 0; bj < 2; ++bj) { const f32x4 v0 = acc[ai][bj][m][0] * sc, v1 = acc[ai][bj][m][1] * sc;
                        u32x4 w; w.x = cvt_pk_bf16(v0[0], v0[1]); w.y = cvt_pk_bf16(v0[2], v0[3]); w.z = cvt_pk_bf16(v1[0], v1[1]); w.w = cvt_pk_bf16(v1[2], v1[3]);
                        *(u32x4*)(rowp + bj * HALF) = w; } }
        } else if (wc == 0) {
#pragma unroll
            for (int ai = 0; ai < 2; ++ai)
#pragma unroll
                for (int m = 0; m < 4; ++m) { float* fp = fg + (size_t)(row0 + ai * HALF + m * 16) * 32 + 8 * fq;
                    *(f32x4*)fp = acc[ai][0][m][0]; *(f32x4*)(fp + 4) = acc[ai][0][m][1]; }
        }
    }
};
struct EpiOut {
    static constexpr bool PERM = false, AFTER_DRAIN = false;
    const float* x; const float* mod; float* out; float alpha;
    __device__ __forceinline__ void operator()(const f32x4 (&acc)[2][2][4][2], const Unit& u, int wr, int wc, int fr, int fq) const {
        const int row0 = u.pm * BM + wr * 64 + fr;
#pragma unroll
        for (int ai = 0; ai < 2; ++ai)
#pragma unroll
            for (int m = 0; m < 4; ++m) { const int r = row0 + ai * HALF + m * 16; const float* g1 = mod + (r / 2048) * 6144 + 2048;
#pragma unroll
                for (int bj = 0; bj < 2; ++bj)
#pragma unroll
                    for (int n = 0; n < 2; ++n) { const int c = u.pn * BM + bj * HALF + wc * 32 + 16 * n + 4 * fq;
                        const f32x4 xv = *(const f32x4*)(x + (size_t)r * 1024 + c), gv = *(const f32x4*)(g1 + c);
                        *(f32x4*)(out + (size_t)r * 1024 + c) = xv * alpha + gv * acc[ai][bj][m][n]; } }
    }
};
template <class Epi, class Sched, bool ALIGN_EPI = false, bool SP2 = false>
__device__ __forceinline__ void gemm_phase(PG8_LAS unsigned char* lds, const Gemm g, const Sched& S, const Epi& E) {
    const int tid = threadIdx.x, wid = __builtin_amdgcn_readfirstlane(tid >> 6), lane = tid & 63, wr = wid >> 2, wc = wid & 3, fr = lane & 15, fq = lane >> 4;
    const int K = g.K, nt = K / BK;
    unsigned voffA[2], voffB[2];
#pragma unroll
    for (int i = 0; i < 2; ++i) { int R, C; stage_rc(tid * 16 + i * 8192, R, C); const int Rb = Epi::PERM ? ((R & ~31) + perm32(R & 31)) : R;
        voffA[i] = (unsigned)(R * K + C) * 2u; voffB[i] = (unsigned)(Rb * K + C) * 2u; }
    const size_t kstep = (size_t)(BK * 2);
    const size_t hstep = (size_t)HALF * K * 2;
    const size_t tstep = 2 * hstep;
    const unsigned ldsw = (unsigned)wid * 1024u;
    const int aoff = lds_byte(wr * 64 + fr, fq * 8), boff = lds_byte(wc * 32 + fr, fq * 8);
#define PG8_SA(b, h) (((b) * 2 + (h)) * HTB)
#define PG8_SB(b, h) ((4 + (b) * 2 + (h)) * HTB)
#define PG8_STAGE(bufoff, gbase, voff) do { _Pragma("unroll") for (int _i = 0; _i < 2; ++_i) \
        __builtin_amdgcn_global_load_lds((const unsigned*)((const char*)(gbase) + (voff)[_i]), (PG8_LAS unsigned*)(lds + (bufoff) + ldsw + _i * 8192), 16, 0, 0); } while (0)
#define PG8_LDA(dst, b, h) do { _Pragma("unroll") for (int m = 0; m < 4; ++m) _Pragma("unroll") for (int k = 0; k < 2; ++k) dst[m][k] = *(const PG8_LAS bf16x8*)(lds + PG8_SA(b, h) + aoff + m * 2048 + k * 1024); } while (0)
#define PG8_LDB(dst, b, h) do { _Pragma("unroll") for (int n = 0; n < 2; ++n) _Pragma("unroll") for (int k = 0; k < 2; ++k) dst[n][k] = *(const PG8_LAS bf16x8*)(lds + PG8_SB(b, h) + boff + n * 2048 + k * 1024); } while (0)
#define PG8_MMA(ai, bj, At, Bt) do { __builtin_amdgcn_s_setprio(1); _Pragma("unroll") for (int m = 0; m < 4; ++m) _Pragma("unroll") for (int n = 0; n < 2; ++n) _Pragma("unroll") for (int k = 0; k < 2; ++k) \
        acc[ai][bj][m][n] = __builtin_amdgcn_mfma_f32_16x16x32_bf16(Bt[n][k], At[m][k], acc[ai][bj][m][n], 0, 0, 0); __builtin_amdgcn_s_setprio(0); } while (0)
#define PG8_WAIT_V(n) asm volatile("s_waitcnt vmcnt(" #n ")" ::: "memory")
#define PG8_WAIT_L(n) asm volatile("s_waitcnt lgkmcnt(" #n ")" ::: "memory")
#define PG8_BAR __builtin_amdgcn_s_barrier()
#define PG8_SCHED __builtin_amdgcn_sched_barrier(0)
    Unit cur, nxt; int ui = 0;
    if (!S.next(0, cur)) return;
    f32x4 acc[2][2][4][2];
#pragma unroll
    for (int a = 0; a < 2; ++a)
#pragma unroll
        for (int b = 0; b < 2; ++b)
#pragma unroll
            for (int m = 0; m < 4; ++m)
#pragma unroll
                for (int n = 0; n < 2; ++n) acc[a][b][m][n] = (f32x4){0.f, 0.f, 0.f, 0.f};
    bf16x8 At[4][2], B0[2][2], B1[2][2];
    const char* cA = (const char*)g.A + (size_t)cur.pm * tstep; const char* cB = (const char*)g.Bt + (size_t)cur.pn * tstep;
    S.a_ready(cur);
    if constexpr (SP2) {
        PG8_STAGE(PG8_SB(0, 0), cB, voffB); PG8_STAGE(PG8_SB(0, 1), cB + hstep, voffB); PG8_STAGE(PG8_SA(0, 0), cA, voffA); PG8_STAGE(PG8_SA(0, 1), cA + hstep, voffA);
        if (wr == 1) PG8_BAR;
        PG8_WAIT_V(2); PG8_BAR;
        PG8_STAGE(PG8_SB(1, 0), cB + kstep, voffB); PG8_STAGE(PG8_SA(1, 0), cA + kstep, voffA); PG8_STAGE(PG8_SB(1, 1), cB + hstep + kstep, voffB);
        PG8_WAIT_V(6); PG8_BAR;
    } else {
        PG8_STAGE(PG8_SB(0, 0), cB, voffB); PG8_STAGE(PG8_SA(0, 0), cA, voffA); PG8_STAGE(PG8_SB(0, 1), cB + hstep, voffB); PG8_STAGE(PG8_SA(0, 1), cA + hstep, voffA);
        if (wr == 1) PG8_BAR;
        PG8_WAIT_V(4); PG8_BAR;
        PG8_STAGE(PG8_SB(1, 0), cB + kstep, voffB); PG8_STAGE(PG8_SA(1, 0), cA + kstep, voffA); PG8_STAGE(PG8_SB(1, 1), cB + hstep + kstep, voffB);
        PG8_WAIT_V(6); PG8_BAR;
    }
    for (;;) {
        const bool has_next = S.next(ui + 1, nxt);
        const char* nA = has_next ? (const char*)g.A + (size_t)nxt.pm * tstep : cA; const char* nB = has_next ? (const char*)g.Bt + (size_t)nxt.pn * tstep : cB;
        for (int t = 0; t < nt; t += 2) {
            const bool last = (t == nt - 2);
            const char* a1 = cA + (size_t)(t + 1) * kstep;
            const char* a2 = last ? nA : cA + (size_t)(t + 2) * kstep; const char* b2 = last ? nB : cB + (size_t)(t + 2) * kstep;
            const char* a3 = a2 + kstep; const char* b3 = b2 + kstep;
            if (last && has_next) S.a_ready(nxt);
            if constexpr (SP2) {
            PG8_LDB(B0, 0, 0); PG8_LDB(B1, 0, 1); PG8_SCHED; PG8_LDA(At, 0, 0); PG8_STAGE(PG8_SA(1, 1), a1 + hstep, voffA);
            PG8_WAIT_V(8); PG8_WAIT_L(0); PG8_BAR; PG8_MMA(0, 0, At, B0); PG8_MMA(0, 1, At, B1); PG8_BAR; PG8_SCHED;
            PG8_LDA(At, 0, 1); PG8_STAGE(PG8_SB(0, 0), b2, voffB); PG8_STAGE(PG8_SB(0, 1), b2 + hstep, voffB); PG8_STAGE(PG8_SA(0, 0), a2, voffA);
            PG8_WAIT_V(8); PG8_WAIT_L(0); PG8_BAR; PG8_MMA(1, 0, At, B0); PG8_MMA(1, 1, At, B1); PG8_BAR; PG8_SCHED;
            PG8_LDB(B0, 1, 0); PG8_LDB(B1, 1, 1); PG8_SCHED; PG8_LDA(At, 1, 0); PG8_STAGE(PG8_SA(0, 1), a2 + hstep, voffA);
            PG8_WAIT_V(8); PG8_WAIT_L(0); PG8_BAR; PG8_MMA(0, 0, At, B0); PG8_MMA(0, 1, At, B1); PG8_BAR; PG8_SCHED;
            PG8_LDA(At, 1, 1); PG8_STAGE(PG8_SB(1, 0), b3, voffB); PG8_STAGE(PG8_SB(1, 1), b3 + hstep, voffB); PG8_STAGE(PG8_SA(1, 0), a3, voffA);
            PG8_WAIT_V(8); PG8_WAIT_L(0); PG8_BAR; PG8_MMA(1, 0, At, B0); PG8_MMA(1, 1, At, B1); PG8_BAR; PG8_SCHED;
            } else {
            PG8_LDB(B0, 0, 0); PG8_SCHED; PG8_LDA(At, 0, 0); PG8_STAGE(PG8_SA(1, 1), a1 + hstep, voffA);
            PG8_WAIT_L(8); PG8_BAR; PG8_WAIT_L(0); PG8_MMA(0, 0, At, B0); PG8_BAR; PG8_SCHED;
            PG8_LDB(B1, 0, 1); PG8_STAGE(PG8_SB(0, 0), b2, voffB);
            PG8_BAR; PG8_WAIT_L(0); PG8_MMA(0, 1, At, B1); PG8_BAR;
            PG8_LDA(At, 0, 1); PG8_STAGE(PG8_SA(0, 0), a2, voffA);
            PG8_BAR; PG8_WAIT_L(0); PG8_MMA(1, 0, At, B0); PG8_BAR; PG8_SCHED;
            PG8_STAGE(PG8_SB(0, 1), b2 + hstep, voffB);
            PG8_WAIT_V(6); PG8_BAR; PG8_MMA(1, 1, At, B1); PG8_BAR;
            PG8_LDB(B0, 1, 0); PG8_SCHED; PG8_LDA(At, 1, 0); PG8_STAGE(PG8_SA(0, 1), a2 + hstep, voffA);
            PG8_WAIT_L(8); PG8_BAR; PG8_WAIT_L(0); PG8_MMA(0, 0, At, B0); PG8_BAR; PG8_SCHED;
            PG8_LDB(B1, 1, 1); PG8_STAGE(PG8_SB(1, 0), b3, voffB);
            PG8_BAR; PG8_WAIT_L(0); PG8_MMA(0, 1, At, B1); PG8_BAR;
            PG8_LDA(At, 1, 1); PG8_STAGE(PG8_SA(1, 0), a3, voffA);
            PG8_BAR; PG8_WAIT_L(0); PG8_MMA(1, 0, At, B0); PG8_BAR; PG8_SCHED;
            PG8_STAGE(PG8_SB(1, 1), b3 + hstep, voffB);
            PG8_WAIT_V(6); PG8_BAR; PG8_MMA(1, 1, At, B1); PG8_BAR;
            }
        }
        if constexpr (ALIGN_EPI) { if (wr == 0) PG8_BAR; }
        if constexpr (!Epi::AFTER_DRAIN) { E(acc, cur, wr, wc, fr, fq); S.done(cur); }
        if (!has_next) break;
#pragma unroll
        for (int a = 0; a < 2; ++a)
#pragma unroll
            for (int b = 0; b < 2; ++b)
#pragma unroll
                for (int m = 0; m < 4; ++m)
#pragma unroll
                    for (int n = 0; n < 2; ++n) acc[a][b][m][n] = (f32x4){0.f, 0.f, 0.f, 0.f};
        cur = nxt; cA = nA; cB = nB; ++ui;
        if constexpr (ALIGN_EPI) { if (wr == 1) PG8_BAR; }
    }
    PG8_WAIT_V(0);
    if constexpr (!ALIGN_EPI) { if (wr == 0) PG8_BAR; }
    PG8_BAR;
    if constexpr (Epi::AFTER_DRAIN) { E.fused(acc, cur, wr, wc, fr, fq, lds, wid, lane); S.done(cur); }
#undef PG8_SA
#undef PG8_SB
#undef PG8_STAGE
#undef PG8_LDA
#undef PG8_LDB
#undef PG8_MMA
#undef PG8_WAIT_V
#undef PG8_WAIT_L
#undef PG8_BAR
#undef PG8_SCHED
}
struct UnitM { int e, mt, pn, arow0, nvalid; };
constexpr int TAB_SLOT_BYTES = 2048;
template <class Epi, class Sched, bool GATHER>
__device__ __forceinline__ void gemm_phase_g(PG8_LAS unsigned char* lds, PG8_LAS unsigned char* tab, const bf16_t* A, const int K, const Sched& S, const Epi& E) {
    const int tid = threadIdx.x, wid = __builtin_amdgcn_readfirstlane(tid >> 6), lane = tid & 63, wr = wid >> 2, wc = wid & 3, fr = lane & 15, fq = lane >> 4;
    const int nt = K / BK;
    unsigned voffB[2];
#pragma unroll
    for (int i = 0; i < 2; ++i) { int R, C; stage_rc(tid * 16 + i * 8192, R, C); const int Rb = Epi::PERM ? ((R & ~31) + perm32(R & 31)) : R;
        voffB[i] = (unsigned)(Rb * K + C) * 2u; }
    const size_t kstep = (size_t)(BK * 2);
    const size_t hstep = (size_t)HALF * K * 2;
    const unsigned ldsw = (unsigned)wid * 1024u;
    const int aoff = lds_byte(wr * 64 + fr, fq * 8), boff = lds_byte(wc * 32 + fr, fq * 8);
#define PG8_SA(b, h) (((b) * 2 + (h)) * HTB)
#define PG8_SB(b, h) ((4 + (b) * 2 + (h)) * HTB)
#define PG8_STAGE(bufoff, gbase, voff) do { _Pragma("unroll") for (int _i = 0; _i < 2; ++_i) \
        __builtin_amdgcn_global_load_lds((const unsigned*)((const char*)(gbase) + (voff)[_i]), (PG8_LAS unsigned*)(lds + (bufoff) + ldsw + _i * 8192), 16, 0, 0); } while (0)
#define PG8_STAGEA(bufoff, gbase, o0, o1) do { \
        __builtin_amdgcn_global_load_lds((const unsigned*)((const char*)(gbase) + (o0)), (PG8_LAS unsigned*)(lds + (bufoff) + ldsw), 16, 0, 0); \
        __builtin_amdgcn_global_load_lds((const unsigned*)((const char*)(gbase) + (o1)), (PG8_LAS unsigned*)(lds + (bufoff) + ldsw + 8192), 16, 0, 0); } while (0)
#define PG8_LDA(dst, b, h) do { _Pragma("unroll") for (int m = 0; m < 4; ++m) _Pragma("unroll") for (int k = 0; k < 2; ++k) dst[m][k] = *(const PG8_LAS bf16x8*)(lds + PG8_SA(b, h) + aoff + m * 2048 + k * 1024); } while (0)
#define PG8_LDB(dst, b, h) do { _Pragma("unroll") for (int n = 0; n < 2; ++n) _Pragma("unroll") for (int k = 0; k < 2; ++k) dst[n][k] = *(const PG8_LAS bf16x8*)(lds + PG8_SB(b, h) + boff + n * 2048 + k * 1024); } while (0)
#define PG8_MMA(ai, bj, At, Bt) do { __builtin_amdgcn_s_setprio(1); _Pragma("unroll") for (int m = 0; m < 4; ++m) _Pragma("unroll") for (int n = 0; n < 2; ++n) _Pragma("unroll") for (int k = 0; k < 2; ++k) \
        acc[ai][bj][m][n] = __builtin_amdgcn_mfma_f32_16x16x32_bf16(Bt[n][k], At[m][k], acc[ai][bj][m][n], 0, 0, 0); __builtin_amdgcn_s_setprio(0); } while (0)
#define PG8_WAIT_V(n) asm volatile("s_waitcnt vmcnt(" #n ")" ::: "memory")
#define PG8_WAIT_L(n) asm volatile("s_waitcnt lgkmcnt(" #n ")" ::: "memory")
#define PG8_BAR __builtin_amdgcn_s_barrier()
#define PG8_SCHED __builtin_amdgcn_sched_barrier(0)
#define PG8_AOFFS(dst, u, tslot) do { _Pragma("unroll") for (int h = 0; h < 2; ++h) _Pragma("unroll") for (int i = 0; i < 2; ++i) { int RA_, CA_; stage_rc(tid * 16 + i * 8192, RA_, CA_); const int R_ = h * HALF + RA_; int row_; \
        if (GATHER) { const int inf_ = *(const PG8_LAS int*)(tab + (tslot) * TAB_SLOT_BYTES + R_ * 4); row_ = R_ < (u).nvalid ? (inf_ >> 4) : 0; } else row_ = (u).arow0 + R_; \
        dst[h][i] = (unsigned)(row_ * K + CA_) * 2u; } } while (0)
    UnitM cur, nxt; int ui = 0;
    if (!S.next(0, cur)) return;
    if (wid == 0) S.load_tab(cur, tab, lane);
    asm volatile("s_waitcnt vmcnt(0)" ::: "memory"); __builtin_amdgcn_s_barrier(); asm volatile("" ::: "memory");
    f32x4 acc[2][2][4][2];
#pragma unroll
    for (int a = 0; a < 2; ++a)
#pragma unroll
        for (int b = 0; b < 2; ++b)
#pragma unroll
            for (int m = 0; m < 4; ++m)
#pragma unroll
                for (int n = 0; n < 2; ++n) acc[a][b][m][n] = (f32x4){0.f, 0.f, 0.f, 0.f};
    bf16x8 At[4][2], B0[2][2], B1[2][2];
    unsigned cao[2][2];
    PG8_AOFFS(cao, cur, 0);
    const char* cB = S.b_base(cur);
    const char* Ab = (const char*)A;
    PG8_STAGE(PG8_SB(0, 0), cB, voffB); PG8_STAGE(PG8_SB(0, 1), cB + hstep, voffB); PG8_STAGEA(PG8_SA(0, 0), Ab, cao[0][0], cao[0][1]); PG8_STAGEA(PG8_SA(0, 1), Ab, cao[1][0], cao[1][1]);
    if (wr == 1) PG8_BAR;
    PG8_WAIT_V(2); PG8_BAR;
    PG8_STAGE(PG8_SB(1, 0), cB + kstep, voffB); PG8_STAGEA(PG8_SA(1, 0), Ab + kstep, cao[0][0], cao[0][1]); PG8_STAGE(PG8_SB(1, 1), cB + hstep + kstep, voffB);
    PG8_WAIT_V(6); PG8_BAR;
    for (;;) {
        const bool has_next = S.next(ui + 1, nxt);
        const int tslot_n = (ui + 1) % 3;
        if (has_next && wid == 0) S.load_tab(nxt, tab + tslot_n * TAB_SLOT_BYTES, lane);
        const char* nB = has_next ? S.b_base(nxt) : cB;
#pragma unroll 1
        for (int t = 0; t < nt; t += 2) {
            const bool last = (t == nt - 2);
            const char* a1 = Ab + (size_t)(t + 1) * kstep;
            const char* a2 = last ? Ab : Ab + (size_t)(t + 2) * kstep; const char* b2 = last ? nB : cB + (size_t)(t + 2) * kstep;
            const char* a3 = a2 + kstep; const char* b3 = b2 + kstep;
            PG8_LDB(B0, 0, 0); PG8_LDB(B1, 0, 1); PG8_SCHED; PG8_LDA(At, 0, 0); PG8_STAGEA(PG8_SA(1, 1), a1, cao[1][0], cao[1][1]);
            PG8_WAIT_V(8); PG8_WAIT_L(0); PG8_BAR; PG8_MMA(0, 0, At, B0); PG8_MMA(0, 1, At, B1); PG8_BAR; PG8_SCHED;
            if (last && has_next) { PG8_AOFFS(cao, nxt, tslot_n); }
            PG8_LDA(At, 0, 1); PG8_STAGE(PG8_SB(0, 0), b2, voffB); PG8_STAGE(PG8_SB(0, 1), b2 + hstep, voffB); PG8_STAGEA(PG8_SA(0, 0), a2, cao[0][0], cao[0][1]);
            PG8_WAIT_V(8); PG8_WAIT_L(0); PG8_BAR; PG8_MMA(1, 0, At, B0); PG8_MMA(1, 1, At, B1); PG8_BAR; PG8_SCHED;
            PG8_LDB(B0, 1, 0); PG8_LDB(B1, 1, 1); PG8_SCHED; PG8_LDA(At, 1, 0); PG8_STAGEA(PG8_SA(0, 1), a2, cao[1][0], cao[1][1]);
            PG8_WAIT_V(8); PG8_WAIT_L(0); PG8_BAR; PG8_MMA(0, 0, At, B0); PG8_MMA(0, 1, At, B1); PG8_BAR; PG8_SCHED;
            PG8_LDA(At, 1, 1); PG8_STAGE(PG8_SB(1, 0), b3, voffB); PG8_STAGE(PG8_SB(1, 1), b3 + hstep, voffB); PG8_STAGEA(PG8_SA(1, 0), a3, cao[0][0], cao[0][1]);
            PG8_WAIT_V(8); PG8_WAIT_L(0); PG8_BAR; PG8_MMA(1, 0, At, B0); PG8_MMA(1, 1, At, B1); PG8_BAR; PG8_SCHED;
        }
        if (wr == 0) PG8_BAR;
        E(acc, cur, wr, wc, fr, fq, tab + (ui % 3) * TAB_SLOT_BYTES);
        if (!has_next) break;
#pragma unroll
        for (int a = 0; a < 2; ++a)
#pragma unroll
            for (int b = 0; b < 2; ++b)
#pragma unroll
                for (int m = 0; m < 4; ++m)
#pragma unroll
                    for (int n = 0; n < 2; ++n) acc[a][b][m][n] = (f32x4){0.f, 0.f, 0.f, 0.f};
        cur = nxt; cB = nB; ++ui;
        if (wr == 1) PG8_BAR;
    }
    PG8_WAIT_V(0);
    PG8_BAR;
#undef PG8_SA
#undef PG8_SB
#undef PG8_STAGE
#undef PG8_STAGEA
#undef PG8_LDA
#undef PG8_LDB
#undef PG8_MMA
#undef PG8_WAIT_V
#undef PG8_WAIT_L
#undef PG8_BAR
#undef PG8_SCHED
#undef PG8_AOFFS
}
struct MoeSched {
    const PG8_LAS int* tstart; const PG8_LAS int* cnt;
    const int* lrow; const float* lw;
    const char* Bt; size_t e_stride, pn_stride;
    int MT, NP, pn0, G, c;
    __device__ __forceinline__ bool next(int i, UnitM& u) const {
        const int L = i * G + c; if (L >= MT * NP) return false;
        const int mtg = L / NP; u.pn = pn0 + L % NP;
        int e = 0;
        for (int k = 1; k < 65; ++k) e += (tstart[k] <= mtg) ? 1 : 0;
        u.e = e; u.mt = mtg - tstart[e]; u.arow0 = mtg * 256; const int rem = cnt[e] - u.mt * 256; u.nvalid = rem < 256 ? rem : 256;
        return true;
    }
    __device__ __forceinline__ const char* b_base(const UnitM& u) const { return Bt + (size_t)u.e * e_stride + (size_t)u.pn * pn_stride; }
    __device__ __forceinline__ void load_tab(const UnitM& u, PG8_LAS unsigned char* dst, int lane) const {
        const size_t off = (size_t)u.e * 16384 + u.mt * 256 + lane * 4;
        __builtin_amdgcn_global_load_lds((const unsigned*)(lrow + off), (PG8_LAS unsigned*)dst, 16, 0, 0);
        __builtin_amdgcn_global_load_lds((const unsigned*)(lw + off), (PG8_LAS unsigned*)(dst + 1024), 16, 0, 0);
    }
};
struct EpiAct {
    static constexpr bool PERM = true;
    bf16_t* act;
    __device__ __forceinline__ void operator()(const f32x4 (&acc)[2][2][4][2], const UnitM& u, int wr, int wc, int fr, int fq, const PG8_LAS unsigned char* tab) const {
#pragma unroll
        for (int ai = 0; ai < 2; ++ai)
#pragma unroll
            for (int m = 0; m < 4; ++m) { const int r = ai * HALF + wr * 64 + m * 16 + fr;
                float w = *(const PG8_LAS float*)(tab + 1024 + r * 4); w = r < u.nvalid ? w : 0.f;
                float v[8];
#pragma unroll
                for (int n = 0; n < 2; ++n)
#pragma unroll
                    for (int i = 0; i < 4; ++i) { const float g = acc[ai][0][m][n][i], up = acc[ai][1][m][n][i];
                        v[n * 4 + i] = g * __builtin_amdgcn_rcpf(1.f + __builtin_amdgcn_exp2f(-1.4426950408889634f * g)) * up * w; }
                u32x4 o; o.x = cvt_pk_bf16(v[0], v[1]); o.y = cvt_pk_bf16(v[2], v[3]); o.z = cvt_pk_bf16(v[4], v[5]); o.w = cvt_pk_bf16(v[6], v[7]);
                *(u32x4*)(act + (size_t)(u.arow0 + r) * 256 + u.pn * 128 + wc * 32 + 8 * fq) = o; }
    }
};
struct EpiSlot {
    static constexpr bool PERM = true;
    bf16_t* slot; int pn_half0; unsigned dump_row;
    __device__ __forceinline__ void operator()(const f32x4 (&acc)[2][2][4][2], const UnitM& u, int wr, int wc, int fr, int fq, const PG8_LAS unsigned char* tab) const {
#pragma unroll
        for (int ai = 0; ai < 2; ++ai)
#pragma unroll
            for (int m = 0; m < 4; ++m) { const int r = ai * HALF + wr * 64 + m * 16 + fr;
                const int inf = *(const PG8_LAS int*)(tab + r * 4);
                const unsigned srow = r < u.nvalid ? (unsigned)(inf >> 4) * 9u + (unsigned)(inf & 15) : dump_row;
                bf16_t* dst = slot + (size_t)srow * 512 + (u.pn - pn_half0) * 256 + wc * 32 + 8 * fq;
#pragma unroll
                for (int bj = 0; bj < 2; ++bj) { const f32x4 v0 = acc[ai][bj][m][0], v1 = acc[ai][bj][m][1];
                    u32x4 o; o.x = cvt_pk_bf16(v0[0], v0[1]); o.y = cvt_pk_bf16(v0[2], v0[3]); o.z = cvt_pk_bf16(v1[0], v1[1]); o.w = cvt_pk_bf16(v1[2], v1[3]);
                    *(u32x4*)(dst + bj * HALF) = o; }
                asm volatile("" ::: "memory"); }
    }
};
}

__device__ __forceinline__ float silu_f(float x) { return x / (1.f + expf(-x)); }
__device__ __forceinline__ float sigmoid_f(float x) { return 1.f / (1.f + expf(-x)); }
__device__ __forceinline__ unsigned f2bf(float f) { unsigned u = __builtin_bit_cast(unsigned, f); return (u + 0x7fffu + ((u >> 16) & 1u)) >> 16; }
__device__ __forceinline__ unsigned pk2(float lo, float hi) { return f2bf(lo) | (f2bf(hi) << 16); }
__device__ __forceinline__ float bf2f(bf16 v) { return __builtin_bit_cast(float, (unsigned)v << 16); }
__device__ __forceinline__ float wave_sum(float v) {
#pragma unroll
    for (int o = 1; o < 64; o <<= 1) v += __shfl_xor(v, o);
    return v;
}
__device__ __forceinline__ int t5_bucket(int dist) {
    const int n = dist < 0 ? 0 : dist;
    if (n < 16) return n;
    int b = 16;
    b += (n >= 19) + (n >= 21) + (n >= 24) + (n >= 27) + (n >= 31) + (n >= 35) + (n >= 40) + (n >= 46) + (n >= 52) + (n >= 59) +
         (n >= 67) + (n >= 77) + (n >= 87) + (n >= 99) + (n >= 113);
    return b;
}

struct Args {
    const float* in[26];
    float* out; unsigned char* ws;
    int ph_lo, ph_hi;
};

struct Ctx {
    LAS unsigned char* lds;
    int tid, lane, wave, gtid, GT, gw, NGW;
    const float *x, *c, *w_ada, *b_ada, *w_in, *b_f, *cmp_pos_k, *cmp_w1_k, *cmp_w2_k, *cmp_pos_v, *cmp_w1_v, *cmp_w2_v, *rel_bias, *w_out, *ln1_g, *ln1_b,
        *w_router, *e_bias, *w_gate, *w_up, *w_down, *ws_gate, *ws_up, *ws_down, *ln2_g, *ln2_b;
    float* out;
    float *mod, *cum, *kvc, *hid, *scorebuf, *scores, *ew, *fg, *pc, *ao, *lw;
    int* lrow; gu32* ctl;
    unsigned* selmask; int* eidx;
    bf16 *hbuf, *proj, *h2lo, *win_t, *wout_t, *ao16, *wgu, *wdn, *act16, *slot;
};


__device__ __forceinline__ int map_inproj(int n) { return n < 1536 ? n : (n < 1544 ? 2816 + (n - 1536) : (n < 2824 ? n - 8 : n)); }
template <int MAP>
__device__ __forceinline__ void transpose_item(const float* W, int K, int N, bf16* WT, LAS float* scr, int item, int lane) {
    const int nblk = N / 32, kb = item / nblk, nb = item % nblk, k0 = 64 * kb, n0 = 32 * nb;
#pragma unroll 8
    for (int i = 0; i < 32; ++i) { const int kk = 2 * i + (lane >> 5); scr[kk * 33 + (lane & 31)] = W[(size_t)(k0 + kk) * N + n0 + (lane & 31)]; }
    asm volatile("s_waitcnt lgkmcnt(0)" ::: "memory");
    const int c = lane & 7;
#pragma unroll
    for (int j = 0; j < 4; ++j) { const int n = (lane >> 3) + 8 * j; const LAS float* s = scr + (8 * c) * 33 + n;
        u32x4 o; o.x = pk2(s[0 * 33], s[1 * 33]); o.y = pk2(s[2 * 33], s[3 * 33]); o.z = pk2(s[4 * 33], s[5 * 33]); o.w = pk2(s[6 * 33], s[7 * 33]);
        const int dr = MAP == 1 ? map_inproj(n0 + n) : n0 + n;
        *(u32x4*)(WT + (size_t)dr * K + k0 + 8 * c) = o; }
    asm volatile("s_waitcnt lgkmcnt(0)" ::: "memory");
}
__device__ __forceinline__ void ph_prologue(Ctx& C) {
    LAS float* scr = (LAS float*)(C.lds + C.wave * 8704);
    constexpr int I_IN = (D / 64) * (NPROJ / 32), I_OUT = (D / 64) * (D / 32);
    for (int it = C.gw; it < I_IN + I_OUT; it += C.NGW) {
        if (it < I_IN) transpose_item<1>(C.w_in, D, NPROJ, C.win_t, scr, it, C.lane);
        else transpose_item<0>(C.w_out, D, D, C.wout_t, scr, it - I_IN, C.lane);
    }
    for (int i = C.gtid; i < (3072 - NPROJ) * D / 8; i += C.GT) *(u32x4*)(C.win_t + (size_t)NPROJ * D + (size_t)i * 8) = (u32x4){0u, 0u, 0u, 0u};
}
__device__ __forceinline__ void ph_ao16(Ctx& C) {
    for (int m = C.gw; m < T; m += C.NGW) {
#pragma unroll
        for (int j = 0; j < 4; ++j) { const int c0 = (C.lane + 64 * j) * 4; const f32x4 v = *(const f32x4*)(C.ao + (size_t)m * D + c0);
            u32x2 o; o.x = pk2(v.x, v.y); o.y = pk2(v.z, v.w); *(u32x2*)(C.ao16 + (size_t)m * D + c0) = o; }
    }
}
__device__ __forceinline__ void ph_mod(Ctx& C) {
    for (int i = C.gtid; i < NB * 6 * D; i += C.GT) {
        const int b = i / (6 * D), e = i % (6 * D);
        float acc = C.b_ada[e];
        for (int d = 0; d < D; ++d) acc += silu_f(C.c[b * D + d]) * C.w_ada[(size_t)d * 6 * D + e];
        C.mod[i] = acc;
    }
}
__device__ __forceinline__ void ph_hpass(Ctx& C) {
    for (int m = C.gw; m < T; m += C.NGW) {
        const int b = m / S;
        const float* md = C.mod + b * 6 * D;
#pragma unroll
        for (int j = 0; j < 4; ++j) {
            const int c0 = (C.lane + 64 * j) * 4;
            const f32x4 xv = *(const f32x4*)(C.x + (size_t)m * D + c0);
            const f32x4 sh = *(const f32x4*)(md + c0), sc = *(const f32x4*)(md + D + c0);
            const f32x4 h = xv * (1.f + sc) + sh;
            u32x2 o; o.x = pk2(h.x, h.y); o.y = pk2(h.z, h.w);
            *(u32x2*)(C.hbuf + (size_t)m * D + c0) = o;
        }
    }
}
template <int MODE>
__device__ __forceinline__ void ph_gemm(Ctx& C) {
    const int half = C.tid >> 8, t256 = C.tid & 255;
    LAS float* As = (LAS float*)(C.lds + half * 16384);
    LAS float* Bs = As + 16 * 65;
    const int N = MODE == 0 ? NPROJ : D;
    const int ntn = (N + 63) / 64, ntiles = ntn * (T / 64), npairs = ntiles / 2;
    const int tx = t256 % 16, ty = t256 / 16;
    for (int p = blockIdx.x; p < npairs; p += gridDim.x) {
        const int tile = 2 * p + half;
        const int m0 = (tile / ntn) * 64, n0 = (tile % ntn) * 64;
        float acc[4][4];
#pragma unroll
        for (int i = 0; i < 4; ++i)
#pragma unroll
            for (int j = 0; j < 4; ++j) acc[i][j] = 0.f;
        for (int k0 = 0; k0 < D; k0 += 16) {
#pragma unroll
            for (int i = 0; i < 4; ++i) {
                const int idx = t256 + i * 256;
                const int r = idx / 16, kk = idx % 16;
                float a;
                if (MODE == 0) a = bf2f(C.hbuf[(size_t)(m0 + r) * D + k0 + kk]); else a = C.ao[(size_t)(m0 + r) * D + k0 + kk];
                As[kk * 65 + r] = a;
                const int kb = idx / 64, cb = idx % 64;
                const float* Bm = MODE == 0 ? C.w_in : C.w_out;
                Bs[kb * 64 + cb] = (n0 + cb < N) ? Bm[(size_t)(k0 + kb) * N + n0 + cb] : 0.f;
            }
            __syncthreads();
#pragma unroll
            for (int kk = 0; kk < 16; ++kk) {
                float a[4], bv[4];
#pragma unroll
                for (int i = 0; i < 4; ++i) a[i] = As[kk * 65 + ty * 4 + i];
#pragma unroll
                for (int j = 0; j < 4; ++j) bv[j] = Bs[kk * 64 + tx * 4 + j];
#pragma unroll
                for (int i = 0; i < 4; ++i)
#pragma unroll
                    for (int j = 0; j < 4; ++j) acc[i][j] += a[i] * bv[j];
            }
            __syncthreads();
        }
#pragma unroll
        for (int i = 0; i < 4; ++i)
#pragma unroll
            for (int j = 0; j < 4; ++j) {
                const int m = m0 + ty * 4 + i, n = n0 + tx * 4 + j;
                if (n >= N) continue;
                if (MODE == 0) {
                    if (n >= 1536 && n < 1544) C.fg[(size_t)m * FGW + (n - 1536)] = acc[i][j];
                    else if (n >= 2824) C.fg[(size_t)m * FGW + 8 + (n - 2824)] = acc[i][j];
                    else {
                        const int dc = n < 1536 ? n : n - 8;
                        const bool isq = dc < 512 || (dc >= PC_NQ && dc < PC_NQ + 512);
                        C.proj[(size_t)m * PITCH + dc] = (bf16)f2bf(isq ? acc[i][j] * C2 : acc[i][j]);
                    }
                } else {
                    const int b = m / S;
                    C.out[(size_t)m * D + n] = ALPHA * C.x[(size_t)m * D + n] + C.mod[b * 6 * D + 2 * D + n] * acc[i][j];
                }
            }
    }
}
__device__ __forceinline__ void ph_cum_cmp1(Ctx& C) {
    for (int w = C.gw; w < NB * 8; w += C.NGW) {
        const int b = w / 8, h = w % 8;
        float carry = 0.f;
        for (int c0 = 0; c0 < S; c0 += 64) {
            const int t = c0 + C.lane;
            const float xx = C.fg[((size_t)b * S + t) * FGW + h] + C.b_f[h];
            float v = fminf(xx, 0.f) - log1pf(expf(-fabsf(xx)));
#pragma unroll
            for (int o = 1; o < 64; o <<= 1) { const float u = __shfl_up(v, o); if (C.lane >= o) v += u; }
            v += carry;
            C.cum[(size_t)w * S + t] = v;
            carry = __shfl(v, 63);
        }
    }
    const int NR = NB * NCMP * 2;
    for (int i = C.gtid; i < 2 * NR * 256; i += C.GT) {
        const int j = i % 256, row = (i / 256) % NR, which = i / (256 * NR);
        const int g = row % 2, n = (row / 2) % NCMP, b = row / (2 * NCMP);
        const float* pos = which ? C.cmp_pos_v : C.cmp_pos_k;
        const float* w1 = which ? C.cmp_w1_v : C.cmp_w1_k;
        const int off = (which ? PC_VC : PC_KC) + g * 64;
        float acc = 0.f;
        for (int l = 0; l < 32; ++l) {
            const bf16* xr = C.proj + ((size_t)b * S + 16 * n + l) * PITCH + off;
            for (int d = 0; d < 64; ++d) acc += (bf2f(xr[d]) + pos[l * 64 + d]) * w1[(size_t)(l * 64 + d) * 256 + j];
        }
        C.hid[i] = silu_f(acc);
    }
}
__device__ __forceinline__ void ph_cmp2(Ctx& C) {
    const int NR = NB * NCMP * 2;
    for (int i = C.gtid; i < 2 * NR * 64; i += C.GT) {
        const int d = i % 64, row = (i / 64) % NR, which = i / (64 * NR);
        const float* w2 = which ? C.cmp_w2_v : C.cmp_w2_k;
        const float* hr = C.hid + ((size_t)which * NR + row) * 256;
        float acc = 0.f;
        for (int j = 0; j < 256; ++j) acc += hr[j] * w2[j * 64 + d];
        C.kvc[i] = acc;
    }
}
__device__ __forceinline__ void cmp_attn_item(Ctx& C, int i) {
    const int t = i % S, h = (i / S) % 8, b = i / (S * 8), g = h / 4;
    const size_t tok = (size_t)b * S + t;
    const int NR = NB * NCMP * 2;
    const float* kc = C.kvc;
    const float* vc = C.kvc + (size_t)NR * 64;
    float q[64], o[64];
#pragma unroll
    for (int d = 0; d < 64; ++d) { q[d] = bf2f(C.proj[tok * PITCH + PC_NQ + h * 64 + d]); o[d] = 0.f; }
    float* prow = C.pc + ((size_t)(b * 8 + h) * S + t) * 128;
    const int nvalid = t >= 31 ? min(NCMP, (t - 31) / 16 + 1) : 0;
    float m = -1e30f;
    for (int n = 0; n < nvalid; ++n) {
        const float* kr = kc + ((size_t)(b * NCMP + n) * 2 + g) * 64;
        float dot = 0.f;
#pragma unroll
        for (int d = 0; d < 64; ++d) dot += q[d] * kr[d];
        const float lg = dot + C.rel_bias[t5_bucket(t - (16 * n + 31)) * 8 + h] * LOG2E;
        prow[n] = lg;
        m = fmaxf(m, lg);
    }
    float l = 0.f;
    for (int n = 0; n < nvalid; ++n) l += exp2f(prow[n] - m);
    const float il = nvalid ? 1.f / l : 0.f;
    for (int n = 0; n < 128; ++n) {
        float p = 0.f;
        if (n < nvalid) {
            p = exp2f(prow[n] - m) * il;
            const float* vr = vc + ((size_t)(b * NCMP + n) * 2 + g) * 64;
#pragma unroll
            for (int d = 0; d < 64; ++d) o[d] += p * vr[d];
        }
        prow[n] = p;
    }
    const float g0 = sigmoid_f(C.fg[tok * FGW + 8 + h * 3 + 0]);
#pragma unroll
    for (int d = 0; d < 64; ++d) C.ao[tok * D + 512 + h * 64 + d] = g0 * o[d];
}
template <int MODE>
__device__ __forceinline__ void attn_item(Ctx& C, int i) {
    const int t = i % S, h = (i / S) % 8, b = i / (S * 8), g = h / 4;
    const size_t tok = (size_t)b * S + t;
    const int qoff = (MODE == 0 ? PC_FQ : PC_NQ) + h * 64;
    const int koff = MODE == 0 ? PC_FK + h * 64 : (MODE == 1 ? PC_KS : PC_KW) + g * 64;
    const int voff = MODE == 0 ? PC_FV + h * 64 : (MODE == 1 ? PC_VS : PC_VW) + g * 64;
    float q[64], o[64];
#pragma unroll
    for (int d = 0; d < 64; ++d) { q[d] = bf2f(C.proj[tok * PITCH + qoff + d]); o[d] = 0.f; }
    float m = -INFINITY, l = 0.f;
    const int s_lo = MODE == 2 ? max(0, t - 511) : 0;
    const unsigned mask = MODE == 1 ? C.selmask[(b * 2 + g) * S + t] : 0xffffffffu;
    const float* cr = C.cum + (size_t)(b * 8 + h) * S;
    const float cumt = MODE == 0 ? cr[t] : 0.f;
    for (int s = s_lo; s <= t; ++s) {
        if (MODE == 1 && !((mask >> (s >> 6)) & 1u)) continue;
        const bf16* kr = C.proj + ((size_t)b * S + s) * PITCH + koff;
        const bf16* vr = C.proj + ((size_t)b * S + s) * PITCH + voff;
        float dot = 0.f;
#pragma unroll
        for (int d = 0; d < 64; ++d) dot += q[d] * bf2f(kr[d]);
        const float bias = MODE == 0 ? cumt - cr[s] : C.rel_bias[t5_bucket(t - s) * 8 + h];
        const float lg = dot + bias * LOG2E;
        const float mn = fmaxf(m, lg), corr = exp2f(m - mn), p = exp2f(lg - mn);
        l = l * corr + p;
#pragma unroll
        for (int d = 0; d < 64; ++d) o[d] = o[d] * corr + p * bf2f(vr[d]);
        m = mn;
    }
    const float il = 1.f / l;
    if (MODE == 0) {
#pragma unroll
        for (int d = 0; d < 64; ++d) C.ao[tok * D + h * 64 + d] = o[d] * il;
    } else {
        const float gt = sigmoid_f(C.fg[tok * FGW + 8 + h * 3 + MODE]) * il;
#pragma unroll
        for (int d = 0; d < 64; ++d) C.ao[tok * D + 512 + h * 64 + d] += gt * o[d];
    }
}
__device__ __forceinline__ void ph_imp_topk(Ctx& C) {
    for (int i = C.gtid; i < NB * 2 * S; i += C.GT) {
        const int t = i % S, g = (i / S) % 2, b = i / (S * 2);
        const int qb = t >> 6;
        float* sc = C.scorebuf + (size_t)i * 32;
        for (int j = 0; j < 32; ++j) {
            float imp = 0.f;
            for (int r = 0; r < 4; ++r) {
                const float* prow = C.pc + ((size_t)(b * 8 + g * 4 + r) * S + t) * 128;
                for (int n = 4 * j - 1; n <= 4 * j + 3; ++n)
                    if (n >= 0 && n < NCMP) imp += prow[n];
            }
            const bool causal = j <= qb, forced = (j == 0) || (j == qb) || (j == qb - 1);
            sc[j] = causal ? imp + (forced ? 1e4f : 0.f) : -1e4f;
        }
        unsigned taken = 0u;
        for (int k = 0; k < 16; ++k) {
            float best = -3e38f; int bi = 0;
            for (int j = 0; j < 32; ++j)
                if (!((taken >> j) & 1u)) { const float v = sc[j]; if (v > best) { best = v; bi = j; } }
            taken |= 1u << bi;
        }
        C.selmask[i] = taken;
    }
}
template <int WHICH>
__device__ __forceinline__ void ph_ln(Ctx& C) {
    const float* gam = WHICH == 1 ? C.ln1_g : C.ln2_g;
    const float* bet = WHICH == 1 ? C.ln1_b : C.ln2_b;
    for (int m = C.gw; m < T; m += C.NGW) {
        const int b = m / S;
        float* row = C.out + (size_t)m * D;
        f32x4 v[4]; float s = 0.f;
#pragma unroll
        for (int j = 0; j < 4; ++j) { v[j] = *(const f32x4*)(row + (C.lane + 64 * j) * 4); s += (v[j].x + v[j].y) + (v[j].z + v[j].w); }
        const float mean = wave_sum(s) * (1.f / D); float s2 = 0.f;
#pragma unroll
        for (int j = 0; j < 4; ++j) { v[j] = v[j] - mean; s2 += (v[j].x * v[j].x + v[j].y * v[j].y) + (v[j].z * v[j].z + v[j].w * v[j].w); }
        const float rstd = rsqrtf(wave_sum(s2) * (1.f / D) + LN_EPS);
#pragma unroll
        for (int j = 0; j < 4; ++j) {
            const int c0 = (C.lane + 64 * j) * 4;
            const f32x4 y = v[j] * rstd * *(const f32x4*)(gam + c0) + *(const f32x4*)(bet + c0);
            *(f32x4*)(row + c0) = y;
            if (WHICH == 1) {
                const float* md = C.mod + b * 6 * D;
                const f32x4 h2 = y * (1.f + *(const f32x4*)(md + 4 * D + c0)) + *(const f32x4*)(md + 3 * D + c0);
                u32x2 hi; hi.x = pk2(h2.x, h2.y); hi.y = pk2(h2.z, h2.w);
                const float r0 = h2.x - __builtin_bit_cast(float, hi.x << 16), r1 = h2.y - __builtin_bit_cast(float, hi.x & 0xffff0000u);
                const float r2 = h2.z - __builtin_bit_cast(float, hi.y << 16), r3 = h2.w - __builtin_bit_cast(float, hi.y & 0xffff0000u);
                u32x2 lo; lo.x = pk2(r0, r1); lo.y = pk2(r2, r3);
                *(u32x2*)(C.hbuf + (size_t)m * D + c0) = hi;
                *(u32x2*)(C.h2lo + (size_t)m * D + c0) = lo;
            }
        }
    }
}
__device__ __forceinline__ float h2_at(Ctx& C, size_t idx) { return bf2f(C.hbuf[idx]) + bf2f(C.h2lo[idx]); }
__device__ __forceinline__ void ph_router(Ctx& C) {
    for (int i = C.gtid; i < T * 64; i += C.GT) {
        const int e = i % 64, tok = i / 64;
        float acc = 0.f;
        for (int d = 0; d < D; ++d) acc += h2_at(C, (size_t)tok * D + d) * C.w_router[d * 64 + e];
        C.scores[i] = sigmoid_f(acc);
    }
}
__device__ __forceinline__ void ph_route(Ctx& C) {
    for (int tok = C.gtid; tok < T; tok += C.GT) {
        const float* sc = C.scores + (size_t)tok * 64;
        unsigned gtaken = 0u;
        for (int k = 0; k < 4; ++k) {
            float best = -3e38f; int bg = 0;
            for (int g = 0; g < 8; ++g) {
                if ((gtaken >> g) & 1u) continue;
                float m1 = -3e38f, m2 = -3e38f;
                for (int j = 0; j < 8; ++j) { const float v = sc[g * 8 + j] + C.e_bias[g * 8 + j]; if (v > m1) { m2 = m1; m1 = v; } else if (v > m2) m2 = v; }
                const float gs = m1 + m2;
                if (gs > best) { best = gs; bg = g; }
            }
            gtaken |= 1u << bg;
        }
        unsigned long long taken = 0ull;
        float wsum = 0.f;
        for (int k = 0; k < 8; ++k) {
            float best = -3e38f; int be = 0;
            for (int e = 0; e < 64; ++e) {
                if (!((gtaken >> (e >> 3)) & 1u) || ((taken >> e) & 1ull)) continue;
                const float v = sc[e] + C.e_bias[e];
                if (v > best) { best = v; be = e; }
            }
            taken |= 1ull << be;
            C.eidx[tok * 8 + k] = be;
            wsum += sc[be];
        }
        for (int k = 0; k < 8; ++k) {
            const int e = C.eidx[tok * 8 + k]; const float w = sc[e] / wsum * 2.5f;
            C.ew[tok * 8 + k] = w;
            const unsigned pos = __hip_atomic_fetch_add(C.ctl + CW_CNT + 64 * e, 1u, RLX_AGENT);
            C.lrow[(size_t)e * 16384 + pos] = tok * 16 + k; C.lw[(size_t)e * 16384 + pos] = w;
        }
        C.lrow[(size_t)64 * 16384 + tok] = tok * 16 + 8; C.lw[(size_t)64 * 16384 + tok] = 1.f;
    }
}
__device__ __forceinline__ void ph_convert_experts(Ctx& C) {
    LAS float* scr = (LAS float*)(C.lds + C.wave * 8704);
    for (int it = C.gw; it < 65 * 384; it += C.NGW) {
        const int e = it / 384, r = it % 384, kind = r / 128, item = r % 128;
        if (kind < 2) {
            const float* W = e < 64 ? (kind == 0 ? C.w_gate : C.w_up) + (size_t)e * D * 256 : (kind == 0 ? C.ws_gate : C.ws_up);
            const int n0 = 32 * (item % 8);
            bf16* WT = C.wgu + ((size_t)e * 512 + (n0 / 128) * 128 + kind * 128) * D;
            transpose_item<0>(W, D, 256, WT, scr, item, C.lane);
        } else {
            const float* W = e < 64 ? C.w_down + (size_t)e * 256 * D : C.ws_down;
            transpose_item<0>(W, 256, D, C.wdn + (size_t)e * D * 256, scr, item, C.lane);
        }
    }
}
__device__ __forceinline__ int moe_tables(Ctx& C) {
    LAS int* tstart = (LAS int*)(C.lds + LDS_TSTART); LAS int* cntl = (LAS int*)(C.lds + LDS_CNT);
    if (C.tid < 64) cntl[C.tid] = (int)__hip_atomic_load(C.ctl + CW_CNT + 64 * C.tid, RLX_AGENT);
    if (C.tid == 64) cntl[64] = T;
    __syncthreads();
    if (C.tid == 0) { int s = 0; for (int e = 0; e < 65; ++e) { tstart[e] = s; s += (cntl[e] + 255) >> 8; } tstart[65] = s; }
    __syncthreads();
    return tstart[65];
}
__device__ __forceinline__ void ph_moe_gateup(Ctx& C) {
    const int MT = moe_tables(C);
    pg8::MoeSched So{(const LAS int*)(C.lds + LDS_TSTART), (const LAS int*)(C.lds + LDS_CNT), C.lrow, C.lw, (const char*)C.wgu, (size_t)512 * D * 2, (size_t)256 * D * 2, MT, 2, 0, (int)gridDim.x, (int)blockIdx.x};
    pg8::EpiAct E{C.act16};
    pg8::gemm_phase_g<pg8::EpiAct, pg8::MoeSched, true>(C.lds, C.lds + LDS_TAB, C.hbuf, D, So, E);
}
template <int HF>
__device__ __forceinline__ void ph_moe_down(Ctx& C) {
    const int MT = moe_tables(C);
    pg8::MoeSched So{(const LAS int*)(C.lds + LDS_TSTART), (const LAS int*)(C.lds + LDS_CNT), C.lrow, C.lw, (const char*)C.wdn, (size_t)D * 256 * 2, (size_t)256 * 256 * 2, MT, 2, 2 * HF, (int)gridDim.x, (int)blockIdx.x};
    pg8::EpiSlot E{C.slot, 2 * HF, (unsigned)T * 9u};
    pg8::gemm_phase_g<pg8::EpiSlot, pg8::MoeSched, false>(C.lds, C.lds + LDS_TAB, C.act16, 256, So, E);
}
template <int HF>
__device__ __forceinline__ void ph_combine(Ctx& C) {
    for (int m = C.gw; m < T; m += C.NGW) {
        const int b = m / S, c0 = HF * 512 + C.lane * 8;
        float acc[8];
#pragma unroll
        for (int i = 0; i < 8; ++i) acc[i] = 0.f;
#pragma unroll
        for (int s = 0; s < 9; ++s) {
            const u32x4 v = *(const u32x4*)(C.slot + ((size_t)m * 9 + s) * 512 + C.lane * 8);
            acc[0] += __builtin_bit_cast(float, v.x << 16); acc[1] += __builtin_bit_cast(float, v.x & 0xffff0000u);
            acc[2] += __builtin_bit_cast(float, v.y << 16); acc[3] += __builtin_bit_cast(float, v.y & 0xffff0000u);
            acc[4] += __builtin_bit_cast(float, v.z << 16); acc[5] += __builtin_bit_cast(float, v.z & 0xffff0000u);
            acc[6] += __builtin_bit_cast(float, v.w << 16); acc[7] += __builtin_bit_cast(float, v.w & 0xffff0000u);
        }
        float* row = C.out + (size_t)m * D;
        const float* g2 = C.mod + b * 6 * D + 5 * D + c0;
        f32x4 y0 = *(const f32x4*)(row + c0) * ALPHA + *(const f32x4*)g2 * (f32x4){acc[0], acc[1], acc[2], acc[3]};
        f32x4 y1 = *(const f32x4*)(row + c0 + 4) * ALPHA + *(const f32x4*)(g2 + 4) * (f32x4){acc[4], acc[5], acc[6], acc[7]};
        if (HF == 0) { *(f32x4*)(row + c0) = y0; *(f32x4*)(row + c0 + 4) = y1; }
        else {
            f32x4 z0 = *(const f32x4*)(row + C.lane * 8), z1 = *(const f32x4*)(row + C.lane * 8 + 4);
            float s = (y0.x + y0.y) + (y0.z + y0.w) + (y1.x + y1.y) + (y1.z + y1.w) + (z0.x + z0.y) + (z0.z + z0.w) + (z1.x + z1.y) + (z1.z + z1.w);
            const float mean = wave_sum(s) * (1.f / D);
            y0 = y0 - mean; y1 = y1 - mean; z0 = z0 - mean; z1 = z1 - mean;
            float q = (y0.x * y0.x + y0.y * y0.y) + (y0.z * y0.z + y0.w * y0.w) + (y1.x * y1.x + y1.y * y1.y) + (y1.z * y1.z + y1.w * y1.w)
                    + (z0.x * z0.x + z0.y * z0.y) + (z0.z * z0.z + z0.w * z0.w) + (z1.x * z1.x + z1.y * z1.y) + (z1.z * z1.z + z1.w * z1.w);
            const float rstd = rsqrtf(wave_sum(q) * (1.f / D) + LN_EPS);
            const int cz = C.lane * 8;
            *(f32x4*)(row + cz) = z0 * rstd * *(const f32x4*)(C.ln2_g + cz) + *(const f32x4*)(C.ln2_b + cz);
            *(f32x4*)(row + cz + 4) = z1 * rstd * *(const f32x4*)(C.ln2_g + cz + 4) + *(const f32x4*)(C.ln2_b + cz + 4);
            *(f32x4*)(row + c0) = y0 * rstd * *(const f32x4*)(C.ln2_g + c0) + *(const f32x4*)(C.ln2_b + c0);
            *(f32x4*)(row + c0 + 4) = y1 * rstd * *(const f32x4*)(C.ln2_g + c0 + 4) + *(const f32x4*)(C.ln2_b + c0 + 4);
        }
    }
}

constexpr int N_PHASES = 17;
__global__ void __launch_bounds__(NTHR, 2) mk_fwd(Args args) {
    extern __shared__ __attribute__((aligned(16))) unsigned char lds[];
    Ctx C;
    C.lds = (LAS unsigned char*)lds;
    C.tid = threadIdx.x; C.lane = C.tid & 63; C.wave = __builtin_amdgcn_readfirstlane(C.tid >> 6);
    C.gtid = blockIdx.x * NTHR + C.tid; C.GT = gridDim.x * NTHR; C.gw = blockIdx.x * NWAVES + C.wave; C.NGW = gridDim.x * NWAVES;
    C.x = args.in[0]; C.c = args.in[1]; C.w_ada = args.in[2]; C.b_ada = args.in[3]; C.w_in = args.in[4]; C.b_f = args.in[5];
    C.cmp_pos_k = args.in[6]; C.cmp_w1_k = args.in[7]; C.cmp_w2_k = args.in[8]; C.cmp_pos_v = args.in[9]; C.cmp_w1_v = args.in[10]; C.cmp_w2_v = args.in[11];
    C.rel_bias = args.in[12]; C.w_out = args.in[13]; C.ln1_g = args.in[14]; C.ln1_b = args.in[15]; C.w_router = args.in[16]; C.e_bias = args.in[17];
    C.w_gate = args.in[18]; C.w_up = args.in[19]; C.w_down = args.in[20]; C.ws_gate = args.in[21]; C.ws_up = args.in[22]; C.ws_down = args.in[23];
    C.ln2_g = args.in[24]; C.ln2_b = args.in[25];
    C.out = args.out;
    unsigned char* ws = args.ws;
    C.mod = (float*)(ws + WS_MOD); C.cum = (float*)(ws + WS_CUM); C.kvc = (float*)(ws + WS_KVC); C.hid = (float*)(ws + WS_HID);
    C.selmask = (unsigned*)(ws + WS_SELM); C.scorebuf = (float*)(ws + WS_SCB); C.scores = (float*)(ws + WS_SCORES);
    C.eidx = (int*)(ws + WS_EIDX); C.ew = (float*)(ws + WS_EW); C.fg = (float*)(ws + WS_FG);
    C.win_t = (bf16*)(ws + WS_WIN_T); C.wout_t = (bf16*)(ws + WS_WOUT_T); C.ao16 = (bf16*)(ws + WS_PC);
    C.hbuf = (bf16*)(ws + WS_HBUF); C.proj = (bf16*)(ws + WS_PROJ); C.h2lo = (bf16*)(ws + WS_PROJ);
    C.pc = (float*)(ws + WS_PC); C.ao = (float*)(ws + WS_AO);
    C.wgu = (bf16*)(ws + WS_WGU); C.wdn = (bf16*)(ws + WS_WDN); C.act16 = (bf16*)(ws + WS_ACT16); C.slot = (bf16*)(ws + WS_SLOT);
    C.lrow = (int*)(ws + WS_LROW); C.lw = (float*)(ws + WS_LW); C.ctl = (gu32*)(ws + WS_CTL);
    volatile LAS unsigned* MISC = (volatile LAS unsigned*)(C.lds + MISC_OFF);
    if (C.tid < 32) MISC[C.tid] = 0u;
    __syncthreads();
    gu32* ctl = (gu32*)(ws + WS_CTL);
    XcdBarrier bar = xcd_barrier_post((unsigned*)(ctl + CW_BAR), MISC + 8);
    const int lo = args.ph_lo, hi = args.ph_hi;
#ifndef PHASE_MASK
#define PHASE_MASK 0xffffffffu
#endif
#define IN(k) (((PHASE_MASK >> (k)) & 1u) && lo <= (k) && (k) < hi)
#define SEAM(k) do { if (IN(k) && IN((k) + 1)) xcd_barrier(bar); } while (0)
    if (IN(0)) { ph_prologue(C); ph_mod(C); }
    SEAM(0);
    if (IN(1)) ph_hpass(C);
    SEAM(1);
    if (IN(2)) {
        pg8::Gemm g{C.hbuf, C.win_t, T, 3072, D}; pg8::StaticOrder So; So.init(T, 3072, (int)gridDim.x, (int)blockIdx.x);
        pg8::EpiProj E{C.proj, C.fg, PITCH, C2};
        pg8::gemm_phase<pg8::EpiProj, pg8::StaticOrder, true, true>(C.lds, g, So, E);
    }
    SEAM(2);
    if (IN(3)) ph_cum_cmp1(C);
    SEAM(3);
    if (IN(4)) ph_cmp2(C);
    SEAM(4);
    if (IN(5)) { for (int i = C.gtid; i < NB * 8 * S; i += C.GT) { attn_item<0>(C, i); cmp_attn_item(C, i); } }
    SEAM(5);
    if (IN(6)) ph_imp_topk(C);
    SEAM(6);
    if (IN(7)) { for (int i = C.gtid; i < NB * 8 * S; i += C.GT) { attn_item<1>(C, i); attn_item<2>(C, i); } }
    SEAM(7);
    if (IN(8)) {
        ph_ao16(C);
        xcd_barrier(bar);
        pg8::Gemm g{C.ao16, C.wout_t, T, D, D}; pg8::StaticOrder So; So.init(T, D, (int)gridDim.x, (int)blockIdx.x);
        pg8::EpiOut E{C.x, C.mod, C.out, ALPHA};
        pg8::gemm_phase<pg8::EpiOut, pg8::StaticOrder, true, true>(C.lds, g, So, E);
    }
    SEAM(8);
    if (IN(9)) { ph_ln<1>(C); ph_convert_experts(C); }
    SEAM(9);
    if (IN(10)) ph_router(C);
    SEAM(10);
    if (IN(11)) ph_route(C);
    SEAM(11);
    if (IN(12)) ph_moe_gateup(C);
    SEAM(12);
    if (IN(13)) ph_moe_down<0>(C);
    SEAM(13);
    if (IN(14)) ph_combine<0>(C);
    SEAM(14);
    if (IN(15)) ph_moe_down<1>(C);
    SEAM(15);
    if (IN(16)) ph_combine<1>(C);
#undef IN
#undef SEAM
}

extern "C" void kernel_launch(void* const* d_in, const int* in_sizes, int n_in, void* d_out, int out_size, void* d_ws, size_t ws_size, hipStream_t stream) {
    static int grid = 0;
    if (grid == 0) {
        if (n_in != 26 || out_size != T * D || ws_size < WS_END) { fprintf(stderr, "kernel_launch: unexpected problem (n_in %d out %d ws %zu)\n", n_in, out_size, ws_size); grid = -1; return; }
        int dev = 0, cus = 0, per_cu = 0;
        if (hipGetDevice(&dev) != hipSuccess || hipDeviceGetAttribute(&cus, hipDeviceAttributeMultiprocessorCount, dev) != hipSuccess) { grid = -1; return; }
        if (hipFuncSetAttribute((const void*)mk_fwd, hipFuncAttributeMaxDynamicSharedMemorySize, LDS_BYTES) != hipSuccess) { fprintf(stderr, "kernel_launch: hipFuncSetAttribute failed\n"); grid = -1; return; }
        if (hipOccupancyMaxActiveBlocksPerMultiprocessor(&per_cu, (const void*)mk_fwd, NTHR, LDS_BYTES) != hipSuccess || per_cu < 1) { fprintf(stderr, "kernel_launch: occupancy query says %d\n", per_cu); grid = -1; (void)hipGetLastError(); return; }
        grid = cus;
    }
    if (grid < 0) return;
    (void)hipMemsetAsync((char*)d_ws + WS_CTL, 0, CTL_ZERO_BYTES, stream);
    Args a{};
    for (int i = 0; i < 26; ++i) a.in[i] = (const float*)d_in[i];
    a.out = (float*)d_out; a.ws = (unsigned char*)d_ws; a.ph_lo = 0; a.ph_hi = N_PHASES;
    hipLaunchKernelGGL(mk_fwd, dim3(grid), dim3(NTHR), LDS_BYTES, stream, a);
}
```

```cpp
#include <hip/hip_runtime.h>
#include <cstdio>
#include <cstdint>
#include <hip/hip_bf16.h>
#include <cmath>

#define GAS __attribute__((address_space(1)))
#define LAS __attribute__((address_space(3)))
typedef unsigned short bf16;
typedef float f32x4 __attribute__((ext_vector_type(4)));
typedef unsigned u32x4 __attribute__((ext_vector_type(4)));
typedef unsigned u32x2 __attribute__((ext_vector_type(2)));
typedef GAS unsigned gu32;
#define RLX_AGENT __ATOMIC_RELAXED, __HIP_MEMORY_SCOPE_AGENT

constexpr int D = 1024, NB = 8, S = 2048, T = NB * S;
constexpr int NPROJ = 2848;
constexpr int PITCH = 2816;
constexpr int PC_FQ = 0, PC_FK = 512, PC_FV = 1024, PC_NQ = 1536, PC_KC = 2048, PC_VC = 2176, PC_KS = 2304, PC_VS = 2432, PC_KW = 2560, PC_VW = 2688;
constexpr int FGW = 32;
constexpr int NCMP = 127;
constexpr float ALPHA = 1.189207115002721f;
constexpr float LN_EPS = 1e-5f;
constexpr float LOG2E = 1.4426950408889634f;
constexpr float C2 = 0.125f * LOG2E;
constexpr int NWAVES = 8, NTHR = NWAVES * 64;

constexpr size_t MiB = 1u << 20;
constexpr size_t WS_CTL = 0, CTL_ZERO_BYTES = 1 * MiB;
constexpr size_t WS_MOD = 1 * MiB, WS_CUM = 2 * MiB, WS_KVC = 3 * MiB, WS_HID = 4 * MiB, WS_SELM = 8 * MiB, WS_SCB = 9 * MiB, WS_SCORES = 13 * MiB,
                 WS_EIDX = 17 * MiB, WS_EW = 18 * MiB, WS_FG = 19 * MiB;
constexpr size_t WS_WIN_T = 22 * MiB;
constexpr size_t WS_WOUT_T = 28 * MiB;
constexpr size_t WS_HBUF = 30 * MiB;
constexpr size_t WS_PROJ = 62 * MiB;
constexpr size_t WS_PC = 150 * MiB;
constexpr size_t WS_AO16 = 214 * MiB;
constexpr size_t WS_OC = 246 * MiB, WS_OW = 262 * MiB;
constexpr size_t WS_WGU = 94 * MiB;
constexpr size_t WS_WDN = 167 * MiB;
constexpr size_t WS_ACT16 = 200 * MiB;
constexpr size_t WS_SLOT = 22 * MiB;
constexpr size_t WS_LROW = 280 * MiB, WS_LW = 285 * MiB;
constexpr size_t WS_END = 290 * MiB;
constexpr int CW_CNT = 8192;
constexpr int CW_BAR = 4096;

constexpr int LDS_BYTES = 147456;
constexpr int MISC_OFF = 131072 + 320;
constexpr int LDS_TSTART = 131072 + 1024, LDS_CNT = 131072 + 1536, LDS_TAB = 131072 + 2048;

#define XB_TMO      128
#define XB_XCNT(j)  (256  + 64 * (j))
#define XB_XSUB(j)  (1280 + 64 * (j))
#define XB_XGEN(j)  (2304 + 64 * (j))
#define XB_TOP      3328
#define XB_TOPGEN   3392
#define XCD_BAR_WORDS 3456
#define XB_SPIN_CAP (1u << 20)
__device__ __forceinline__ unsigned xb_ld(unsigned* p)              { return __hip_atomic_load(p, __ATOMIC_RELAXED, __HIP_MEMORY_SCOPE_AGENT); }
__device__ __forceinline__ unsigned xb_add(unsigned* p, unsigned v) { return __hip_atomic_fetch_add(p, v, __ATOMIC_RELAXED, __HIP_MEMORY_SCOPE_AGENT); }
__device__ __forceinline__ unsigned xb_xcc_id() { return (unsigned)__builtin_amdgcn_s_getreg((3 << 11) | 20) & 0xFu; }
#define XB_SPIN(cond, bar) do { unsigned _sp = 0; while (cond) { __builtin_amdgcn_s_sleep(1); \
    if ((++_sp & 255u) == 0u) { if (xb_ld(&(bar)[XB_TMO])) break; if (_sp > XB_SPIN_CAP) { atomicAdd(&(bar)[XB_TMO], 1u); break; } } } } while (0)
struct XcdBarrier { unsigned* bar; unsigned x; volatile LAS unsigned* st; };
__device__ __forceinline__ XcdBarrier xcd_barrier_post(unsigned* bar, volatile LAS unsigned* st) {
    XcdBarrier b; b.bar = bar; b.x = xb_xcc_id(); b.st = st;
    if (threadIdx.x == 0) (void)xb_add(&bar[XB_XCNT(b.x)], 1u);
    return b;
}
__device__ __forceinline__ void xcd_barrier_complete(unsigned* bar, unsigned x, unsigned& nloc, unsigned& nx) {
    const unsigned G = gridDim.x * gridDim.y * gridDim.z;
    unsigned sum, cnt, mine, sp = 0u;
    for (;;) {
        sum = 0u; cnt = 0u; mine = 0u;
#pragma unroll
        for (unsigned j = 0; j < 16; ++j) { const unsigned c = xb_ld(&bar[XB_XCNT(j)]); sum += c; cnt += (c > 0u) ? 1u : 0u; mine = (j == x) ? c : mine; }
        if (sum == G) break;
        __builtin_amdgcn_s_sleep(1);
        if ((++sp & 255u) == 0u) { if (xb_ld(&bar[XB_TMO])) break; if (sp > XB_SPIN_CAP) { atomicAdd(&bar[XB_TMO], 1u); break; } }
    }
    nloc = mine > 0u ? mine : 1u; nx = cnt > 0u ? cnt : 1u;
}
__device__ __forceinline__ void xcd_barrier(const XcdBarrier& b) {
    asm volatile("s_waitcnt vmcnt(0)" ::: "memory");
    __syncthreads();
    if (threadIdx.x == 0) {
        unsigned* bar = b.bar;
        __builtin_amdgcn_s_waitcnt(0);
        unsigned nloc = b.st[0], nx = b.st[1];
        if (nloc == 0u) { xcd_barrier_complete(bar, b.x, nloc, nx); b.st[0] = nloc; b.st[1] = nx; }
        const unsigned old = xb_add(&bar[XB_XSUB(b.x)], 1u);
        const unsigned gen = old / nloc;
        if (old + 1u == (gen + 1u) * nloc) {
            __builtin_amdgcn_fence(__ATOMIC_RELEASE, "agent");
            asm volatile("s_waitcnt vmcnt(0)" ::: "memory");
            const unsigned og = xb_add(&bar[XB_TOP], 1u);
            const unsigned tg = og / nx;
            if (og + 1u == (tg + 1u) * nx) xb_add(&bar[XB_TOPGEN], 1u);
            else XB_SPIN(xb_ld(&bar[XB_TOPGEN]) == tg, bar);
            __builtin_amdgcn_fence(__ATOMIC_ACQUIRE, "agent");
            xb_add(&bar[XB_XGEN(b.x)], 1u);
            asm volatile("s_waitcnt vmcnt(0)" ::: "memory");
        } else {
            XB_SPIN(xb_ld(&bar[XB_XGEN(b.x)]) == gen, bar);
            __builtin_amdgcn_fence(__ATOMIC_ACQUIRE, "agent");
            asm volatile("s_waitcnt vmcnt(0)" ::: "memory");
        }
    }
    __syncthreads();
}

namespace pg8 {
#define PG8_LAS __attribute__((address_space(3)))
typedef unsigned short bf16_t;
typedef short bf16x8 __attribute__((ext_vector_type(8)));
typedef float f32x4 __attribute__((ext_vector_type(4)));
typedef unsigned u32x4 __attribute__((ext_vector_type(4)));
constexpr int BM = 256, BK = 64, HALF = 128, HTB = HALF * BK * 2  , STAGE_BYTES = 8 * HTB, NXCD = 8, WGM = 8;

__host__ __device__ __forceinline__ int lds_byte(int r, int c) { const int st = (r >> 4) * 2 + (c >> 5), rr = r & 15, cc = c & 31, ob = rr * 64 + cc * 2; return st * 1024 + (ob ^ (((ob >> 9) & 1) << 5)); }
__host__ __device__ __forceinline__ void stage_rc(int b, int& R, int& C) { const int st = b / 1024, sb = b % 1024, swz = sb ^ (((sb >> 9) & 1) << 5); R = (st >> 1) * 16 + swz / 64; C = (st & 1) * 32 + (swz % 64) / 2; }
__host__ __device__ __forceinline__ int perm32(int rho) { const int n = rho >> 4, i = rho & 15; return 8 * (i >> 2) + 4 * n + (i & 3); }

struct Unit { int pm, pn; };
struct Gemm { const bf16_t* A; const bf16_t* Bt; int M, N, K; };

struct StaticOrder {
    int nM, nN, nwg, G, c;
    __host__ __device__ void init(int M, int N, int G_, int c_) { nM = M / BM; nN = N / BM; nwg = nM * nN; G = G_; c = c_; }
    __host__ __device__ bool next(int i, Unit& u) const {
        const long L = (long)i * G + c; if (L >= nwg) return false;
        int wgid = (int)L; { const int q = nwg / NXCD, r = nwg % NXCD, xcd = wgid % NXCD, off = wgid / NXCD; wgid = (xcd < r ? xcd * (q + 1) : r * (q + 1) + (xcd - r) * q) + off; }
        const int nig = WGM * nN, gid = wgid / nig, fm = gid * WGM, gsz = (nM - fm) < WGM ? (nM - fm) : WGM;
        u.pm = fm + ((wgid % nig) % gsz); u.pn = (wgid % nig) / gsz; return true;
    }
    __device__ __forceinline__ void a_ready(const Unit&) const {}
    __device__ __forceinline__ void done(const Unit&) const {}
};


__device__ __forceinline__ unsigned cvt_pk_bf16(float lo, float hi) { unsigned r; asm volatile("v_cvt_pk_bf16_f32 %0, %1, %2" : "=v"(r) : "v"(lo), "v"(hi)); return r; }
struct EpiProj {
    static constexpr bool PERM = true, AFTER_DRAIN = false;
    bf16_t* proj; float* fg; int pitch; float qscale;
    __device__ __forceinline__ void operator()(const f32x4 (&acc)[2][2][4][2], const Unit& u, int wr, int wc, int fr, int fq) const {
        const int row0 = u.pm * BM + wr * 64 + fr;
        if (u.pn < 11) {
            const float sc = (u.pn < 2 || u.pn == 6 || u.pn == 7) ? qscale : 1.f;
            const int col0 = u.pn * BM + wc * 32 + 8 * fq;
#pragma unroll
            for (int ai = 0; ai < 2; ++ai)
#pragma unroll
                for (int m = 0; m < 4; ++m) { bf16_t* rowp = proj + (size_t)(row0 + ai * HALF + m * 16) * pitch + col0;
#pragma unroll
                    for (int bj = 0; bj < 2; ++bj) { const f32x4 v0 = acc[ai][bj][m][0] * sc, v1 = acc[ai][bj][m][1] * sc;
                        u32x4 w; w.x = cvt_pk_bf16(v0[0], v0[1]); w.y = cvt_pk_bf16(v0[2], v0[3]); w.z = cvt_pk_bf16(v1[0], v1[1]); w.w = cvt_pk_bf16(v1[2], v1[3]);
                        *(u32x4*)(rowp + bj * HALF) = w; } }
        } else if (wc == 0) {
#pragma unroll
            for (int ai = 0; ai < 2; ++ai)
#pragma unroll
                for (int m = 0; m < 4; ++m) { float* fp = fg + (size_t)(row0 + ai * HALF + m * 16) * 32 + 8 * fq;
                    *(f32x4*)fp = acc[ai][0][m][0]; *(f32x4*)(fp + 4) = acc[ai][0][m][1]; }
        }
    }
};
struct EpiOut {
    static constexpr bool PERM = false, AFTER_DRAIN = false;
    const float* x; const float* mod; float* out; float alpha;
    __device__ __forceinline__ void operator()(const f32x4 (&acc)[2][2][4][2], const Unit& u, int wr, int wc, int fr, int fq) const {
        const int row0 = u.pm * BM + wr * 64 + fr;
#pragma unroll
        for (int ai = 0; ai < 2; ++ai)
#pragma unroll
            for (int m = 0; m < 4; ++m) { const int r = row0 + ai * HALF + m * 16; const float* g1 = mod + (r / 2048) * 6144 + 2048;
#pragma unroll
                for (int bj = 0; bj < 2; ++bj)
#pragma unroll
                    for (int n = 0; n < 2; ++n) { const int c = u.pn * BM + bj * HALF + wc * 32 + 16 * n + 4 * fq;
                        const f32x4 xv = *(const f32x4*)(x + (size_t)r * 1024 + c), gv = *(const f32x4*)(g1 + c);
                        *(f32x4*)(out + (size_t)r * 1024 + c) = xv * alpha + gv * acc[ai][bj][m][n]; } }
    }
};
template <class Epi, class Sched, bool ALIGN_EPI = false, bool SP2 = false>
__device__ __forceinline__ void gemm_phase(PG8_LAS unsigned char* lds, const Gemm g, const Sched& S, const Epi& E) {
    const int tid = threadIdx.x, wid = __builtin_amdgcn_readfirstlane(tid >> 6), lane = tid & 63, wr = wid >> 2, wc = wid & 3, fr = lane & 15, fq = lane >> 4;
    const int K = g.K, nt = K / BK;
    unsigned voffA[2], voffB[2];
#pragma unroll
    for (int i = 0; i < 2; ++i) { int R, C; stage_rc(tid * 16 + i * 8192, R, C); const int Rb = Epi::PERM ? ((R & ~31) + perm32(R & 31)) : R;
        voffA[i] = (unsigned)(R * K + C) * 2u; voffB[i] = (unsigned)(Rb * K + C) * 2u; }
    const size_t kstep = (size_t)(BK * 2);
    const size_t hstep = (size_t)HALF * K * 2;
    const size_t tstep = 2 * hstep;
    const unsigned ldsw = (unsigned)wid * 1024u;
    const int aoff = lds_byte(wr * 64 + fr, fq * 8), boff = lds_byte(wc * 32 + fr, fq * 8);
#define PG8_SA(b, h) (((b) * 2 + (h)) * HTB)
#define PG8_SB(b, h) ((4 + (b) * 2 + (h)) * HTB)
#define PG8_STAGE(bufoff, gbase, voff) do { _Pragma("unroll") for (int _i = 0; _i < 2; ++_i) \
        __builtin_amdgcn_global_load_lds((const unsigned*)((const char*)(gbase) + (voff)[_i]), (PG8_LAS unsigned*)(lds + (bufoff) + ldsw + _i * 8192), 16, 0, 0); } while (0)
#define PG8_LDA(dst, b, h) do { _Pragma("unroll") for (int m = 0; m < 4; ++m) _Pragma("unroll") for (int k = 0; k < 2; ++k) dst[m][k] = *(const PG8_LAS bf16x8*)(lds + PG8_SA(b, h) + aoff + m * 2048 + k * 1024); } while (0)
#define PG8_LDB(dst, b, h) do { _Pragma("unroll") for (int n = 0; n < 2; ++n) _Pragma("unroll") for (int k = 0; k < 2; ++k) dst[n][k] = *(const PG8_LAS bf16x8*)(lds + PG8_SB(b, h) + boff + n * 2048 + k * 1024); } while (0)
#define PG8_MMA(ai, bj, At, Bt) do { __builtin_amdgcn_s_setprio(1); _Pragma("unroll") for (int m = 0; m < 4; ++m) _Pragma("unroll") for (int n = 0; n < 2; ++n) _Pragma("unroll") for (int k = 0; k < 2; ++k) \
        acc[ai][bj][m][n] = __builtin_amdgcn_mfma_f32_16x16x32_bf16(Bt[n][k], At[m][k], acc[ai][bj][m][n], 0, 0, 0); __builtin_amdgcn_s_setprio(0); } while (0)
#define PG8_WAIT_V(n) asm volatile("s_waitcnt vmcnt(" #n ")" ::: "memory")
#define PG8_WAIT_L(n) asm volatile("s_waitcnt lgkmcnt(" #n ")" ::: "memory")
#define PG8_BAR __builtin_amdgcn_s_barrier()
#define PG8_SCHED __builtin_amdgcn_sched_barrier(0)
    Unit cur, nxt; int ui = 0;
    if (!S.next(0, cur)) return;
    f32x4 acc[2][2][4][2];
#pragma unroll
    for (int a = 0; a < 2; ++a)
#pragma unroll
        for (int b = 0; b < 2; ++b)
#pragma unroll
            for (int m = 0; m < 4; ++m)
#pragma unroll
                for (int n = 0; n < 2; ++n) acc[a][b][m][n] = (f32x4){0.f, 0.f, 0.f, 0.f};
    bf16x8 At[4][2], B0[2][2], B1[2][2];
    const char* cA = (const char*)g.A + (size_t)cur.pm * tstep; const char* cB = (const char*)g.Bt + (size_t)cur.pn * tstep;
    S.a_ready(cur);
    if constexpr (SP2) {
        PG8_STAGE(PG8_SB(0, 0), cB, voffB); PG8_STAGE(PG8_SB(0, 1), cB + hstep, voffB); PG8_STAGE(PG8_SA(0, 0), cA, voffA); PG8_STAGE(PG8_SA(0, 1), cA + hstep, voffA);
        if (wr == 1) PG8_BAR;
        PG8_WAIT_V(2); PG8_BAR;
        PG8_STAGE(PG8_SB(1, 0), cB + kstep, voffB); PG8_STAGE(PG8_SA(1, 0), cA + kstep, voffA); PG8_STAGE(PG8_SB(1, 1), cB + hstep + kstep, voffB);
        PG8_WAIT_V(6); PG8_BAR;
    } else {
        PG8_STAGE(PG8_SB(0, 0), cB, voffB); PG8_STAGE(PG8_SA(0, 0), cA, voffA); PG8_STAGE(PG8_SB(0, 1), cB + hstep, voffB); PG8_STAGE(PG8_SA(0, 1), cA + hstep, voffA);
        if (wr == 1) PG8_BAR;
        PG8_WAIT_V(4); PG8_BAR;
        PG8_STAGE(PG8_SB(1, 0), cB + kstep, voffB); PG8_STAGE(PG8_SA(1, 0), cA + kstep, voffA); PG8_STAGE(PG8_SB(1, 1), cB + hstep + kstep, voffB);
        PG8_WAIT_V(6); PG8_BAR;
    }
    for (;;) {
        const bool has_next = S.next(ui + 1, nxt);
        const char* nA = has_next ? (const char*)g.A + (size_t)nxt.pm * tstep : cA; const char* nB = has_next ? (const char*)g.Bt + (size_t)nxt.pn * tstep : cB;
        for (int t = 0; t < nt; t += 2) {
            const bool last = (t == nt - 2);
            const char* a1 = cA + (size_t)(t + 1) * kstep;
            const char* a2 = last ? nA : cA + (size_t)(t + 2) * kstep; const char* b2 = last ? nB : cB + (size_t)(t + 2) * kstep;
            const char* a3 = a2 + kstep; const char* b3 = b2 + kstep;
            if (last && has_next) S.a_ready(nxt);
            if constexpr (SP2) {
            PG8_LDB(B0, 0, 0); PG8_LDB(B1, 0, 1); PG8_SCHED; PG8_LDA(At, 0, 0); PG8_STAGE(PG8_SA(1, 1), a1 + hstep, voffA);
            PG8_WAIT_V(8); PG8_WAIT_L(0); PG8_BAR; PG8_MMA(0, 0, At, B0); PG8_MMA(0, 1, At, B1); PG8_BAR; PG8_SCHED;
            PG8_LDA(At, 0, 1); PG8_STAGE(PG8_SB(0, 0), b2, voffB); PG8_STAGE(PG8_SB(0, 1), b2 + hstep, voffB); PG8_STAGE(PG8_SA(0, 0), a2, voffA);
            PG8_WAIT_V(8); PG8_WAIT_L(0); PG8_BAR; PG8_MMA(1, 0, At, B0); PG8_MMA(1, 1, At, B1); PG8_BAR; PG8_SCHED;
            PG8_LDB(B0, 1, 0); PG8_LDB(B1, 1, 1); PG8_SCHED; PG8_LDA(At, 1, 0); PG8_STAGE(PG8_SA(0, 1), a2 + hstep, voffA);
            PG8_WAIT_V(8); PG8_WAIT_L(0); PG8_BAR; PG8_MMA(0, 0, At, B0); PG8_MMA(0, 1, At, B1); PG8_BAR; PG8_SCHED;
            PG8_LDA(At, 1, 1); PG8_STAGE(PG8_SB(1, 0), b3, voffB); PG8_STAGE(PG8_SB(1, 1), b3 + hstep, voffB); PG8_STAGE(PG8_SA(1, 0), a3, voffA);
            PG8_WAIT_V(8); PG8_WAIT_L(0); PG8_BAR; PG8_MMA(1, 0, At, B0); PG8_MMA(1, 1, At, B1); PG8_BAR; PG8_SCHED;
            } else {
            PG8_LDB(B0, 0, 0); PG8_SCHED; PG8_LDA(At, 0, 0); PG8_STAGE(PG8_SA(1, 1), a1 + hstep, voffA);
            PG8_WAIT_L(8); PG8_BAR; PG8_WAIT_L(0); PG8_MMA(0, 0, At, B0); PG8_BAR; PG8_SCHED;
            PG8_LDB(B1, 0, 1); PG8_STAGE(PG8_SB(0, 0), b2, voffB);
            PG8_BAR; PG8_WAIT_L(0); PG8_MMA(0, 1, At, B1); PG8_BAR;
            PG8_LDA(At, 0, 1); PG8_STAGE(PG8_SA(0, 0), a2, voffA);
            PG8_BAR; PG8_WAIT_L(0); PG8_MMA(1, 0, At, B0); PG8_BAR; PG8_SCHED;
            PG8_STAGE(PG8_SB(0, 1), b2 + hstep, voffB);
            PG8_WAIT_V(6); PG8_BAR; PG8_MMA(1, 1, At, B1); PG8_BAR;
            PG8_LDB(B0, 1, 0); PG8_SCHED; PG8_LDA(At, 1, 0); PG8_STAGE(PG8_SA(0, 1), a2 + hstep, voffA);
            PG8_WAIT_L(8); PG8_BAR; PG8_WAIT_L(0); PG8_MMA(0, 0, At, B0); PG8_BAR; PG8_SCHED;
            PG8_LDB(B1, 1, 1); PG8_STAGE(PG8_SB(1, 0), b3, voffB);
            PG8_BAR; PG8_WAIT_L(0); PG8_MMA(0, 1, At, B1); PG8_BAR;
            PG8_LDA(At, 1, 1); PG8_STAGE(PG8_SA(1, 0), a3, voffA);
            PG8_BAR; PG8_WAIT_L(0); PG8_MMA(1, 0, At, B0); PG8_BAR; PG8_SCHED;
            PG8_STAGE(PG8_SB(1, 1), b3 + hstep, voffB);
            PG8_WAIT_V(6); PG8_BAR; PG8_MMA(1, 1, At, B1); PG8_BAR;
            }
        }
        if constexpr (ALIGN_EPI) { if (wr == 0) PG8_BAR; }
        if constexpr (!Epi::AFTER_DRAIN) { E(acc, cur, wr, wc, fr, fq); S.done(cur); }
        if (!has_next) break;
#pragma unroll
        for (int a = 0; a < 2; ++a)
#pragma unroll
            for (int b = 0; b < 2; ++b)
#pragma unroll
                for (int m = 0; m < 4; ++m)
#pragma unroll
                    for (int n = 0; n < 2; ++n) acc[a][b][m][n] = (f32x4){0.f, 0.f, 0.f, 0.f};
        cur = nxt; cA = nA; cB = nB; ++ui;
        if constexpr (ALIGN_EPI) { if (wr == 1) PG8_BAR; }
    }
    PG8_WAIT_V(0);
    if constexpr (!ALIGN_EPI) { if (wr == 0) PG8_BAR; }
    PG8_BAR;
    if constexpr (Epi::AFTER_DRAIN) { E.fused(acc, cur, wr, wc, fr, fq, lds, wid, lane); S.done(cur); }
#undef PG8_SA
#undef PG8_SB
#undef PG8_STAGE
#undef PG8_LDA
#undef PG8_LDB
#undef PG8_MMA
#undef PG8_WAIT_V
#undef PG8_WAIT_L
#undef PG8_BAR
#undef PG8_SCHED
}
struct UnitM { int e, mt, pn, arow0, nvalid; };
constexpr int TAB_SLOT_BYTES = 2048;
template <class Epi, class Sched, bool GATHER>
__device__ __forceinline__ void gemm_phase_g(PG8_LAS unsigned char* lds, PG8_LAS unsigned char* tab, const bf16_t* A, const int K, const Sched& S, const Epi& E) {
    const int tid = threadIdx.x, wid = __builtin_amdgcn_readfirstlane(tid >> 6), lane = tid & 63, wr = wid >> 2, wc = wid & 3, fr = lane & 15, fq = lane >> 4;
    const int nt = K / BK;
    unsigned voffB[2];
#pragma unroll
    for (int i = 0; i < 2; ++i) { int R, C; stage_rc(tid * 16 + i * 8192, R, C); const int Rb = Epi::PERM ? ((R & ~31) + perm32(R & 31)) : R;
        voffB[i] = (unsigned)(Rb * K + C) * 2u; }
    const size_t kstep = (size_t)(BK * 2);
    const size_t hstep = (size_t)HALF * K * 2;
    const unsigned ldsw = (unsigned)wid * 1024u;
    const int aoff = lds_byte(wr * 64 + fr, fq * 8), boff = lds_byte(wc * 32 + fr, fq * 8);
#define PG8_SA(b, h) (((b) * 2 + (h)) * HTB)
#define PG8_SB(b, h) ((4 + (b) * 2 + (h)) * HTB)
#define PG8_STAGE(bufoff, gbase, voff) do { _Pragma("unroll") for (int _i = 0; _i < 2; ++_i) \
        __builtin_amdgcn_global_load_lds((const unsigned*)((const char*)(gbase) + (voff)[_i]), (PG8_LAS unsigned*)(lds + (bufoff) + ldsw + _i * 8192), 16, 0, 0); } while (0)
#define PG8_STAGEA(bufoff, gbase, o0, o1) do { \
        __builtin_amdgcn_global_load_lds((const unsigned*)((const char*)(gbase) + (o0)), (PG8_LAS unsigned*)(lds + (bufoff) + ldsw), 16, 0, 0); \
        __builtin_amdgcn_global_load_lds((const unsigned*)((const char*)(gbase) + (o1)), (PG8_LAS unsigned*)(lds + (bufoff) + ldsw + 8192), 16, 0, 0); } while (0)
#define PG8_LDA(dst, b, h) do { _Pragma("unroll") for (int m = 0; m < 4; ++m) _Pragma("unroll") for (int k = 0; k < 2; ++k) dst[m][k] = *(const PG8_LAS bf16x8*)(lds + PG8_SA(b, h) + aoff + m * 2048 + k * 1024); } while (0)
#define PG8_LDB(dst, b, h) do { _Pragma("unroll") for (int n = 0; n < 2; ++n) _Pragma("unroll") for (int k = 0; k < 2; ++k) dst[n][k] = *(const PG8_LAS bf16x8*)(lds + PG8_SB(b, h) + boff + n * 2048 + k * 1024); } while (0)
#define PG8_MMA(ai, bj, At, Bt) do { __builtin_amdgcn_s_setprio(1); _Pragma("unroll") for (int m = 0; m < 4; ++m) _Pragma("unroll") for (int n = 0; n < 2; ++n) _Pragma("unroll") for (int k = 0; k < 2; ++k) \
        acc[ai][bj][m][n] = __builtin_amdgcn_mfma_f32_16x16x32_bf16(Bt[n][k], At[m][k], acc[ai][bj][m][n], 0, 0, 0); __builtin_amdgcn_s_setprio(0); } while (0)
#define PG8_WAIT_V(n) asm volatile("s_waitcnt vmcnt(" #n ")" ::: "memory")
#define PG8_WAIT_L(n) asm volatile("s_waitcnt lgkmcnt(" #n ")" ::: "memory")
#define PG8_BAR __builtin_amdgcn_s_barrier()
#define PG8_SCHED __builtin_amdgcn_sched_barrier(0)
#define PG8_AOFFS(dst, u, tslot) do { _Pragma("unroll") for (int h = 0; h < 2; ++h) _Pragma("unroll") for (int i = 0; i < 2; ++i) { int RA_, CA_; stage_rc(tid * 16 + i * 8192, RA_, CA_); const int R_ = h * HALF + RA_; int row_; \
        if (GATHER) { const int inf_ = *(const PG8_LAS int*)(tab + (tslot) * TAB_SLOT_BYTES + R_ * 4); row_ = R_ < (u).nvalid ? (inf_ >> 4) : 0; } else row_ = (u).arow0 + R_; \
        dst[h][i] = (unsigned)(row_ * K + CA_) * 2u; } } while (0)
    UnitM cur, nxt; int ui = 0;
    if (!S.next(0, cur)) return;
    if (wid == 0) S.load_tab(cur, tab, lane);
    asm volatile("s_waitcnt vmcnt(0)" ::: "memory"); __builtin_amdgcn_s_barrier(); asm volatile("" ::: "memory");
    f32x4 acc[2][2][4][2];
#pragma unroll
    for (int a = 0; a < 2; ++a)
#pragma unroll
        for (int b = 0; b < 2; ++b)
#pragma unroll
            for (int m = 0; m < 4; ++m)
#pragma unroll
                for (int n = 0; n < 2; ++n) acc[a][b][m][n] = (f32x4){0.f, 0.f, 0.f, 0.f};
    bf16x8 At[4][2], B0[2][2], B1[2][2];
    unsigned cao[2][2];
    PG8_AOFFS(cao, cur, 0);
    const char* cB = S.b_base(cur);
    const char* Ab = (const char*)A;
    PG8_STAGE(PG8_SB(0, 0), cB, voffB); PG8_STAGE(PG8_SB(0, 1), cB + hstep, voffB); PG8_STAGEA(PG8_SA(0, 0), Ab, cao[0][0], cao[0][1]); PG8_STAGEA(PG8_SA(0, 1), Ab, cao[1][0], cao[1][1]);
    if (wr == 1) PG8_BAR;
    PG8_WAIT_V(2); PG8_BAR;
    PG8_STAGE(PG8_SB(1, 0), cB + kstep, voffB); PG8_STAGEA(PG8_SA(1, 0), Ab + kstep, cao[0][0], cao[0][1]); PG8_STAGE(PG8_SB(1, 1), cB + hstep + kstep, voffB);
    PG8_WAIT_V(6); PG8_BAR;
    for (;;) {
        const bool has_next = S.next(ui + 1, nxt);
        const int tslot_n = (ui + 1) % 3;
        if (has_next && wid == 0) S.load_tab(nxt, tab + tslot_n * TAB_SLOT_BYTES, lane);
        const char* nB = has_next ? S.b_base(nxt) : cB;
#pragma unroll 1
        for (int t = 0; t < nt; t += 2) {
            const bool last = (t == nt - 2);
            const char* a1 = Ab + (size_t)(t + 1) * kstep;
            const char* a2 = last ? Ab : Ab + (size_t)(t + 2) * kstep; const char* b2 = last ? nB : cB + (size_t)(t + 2) * kstep;
            const char* a3 = a2 + kstep; const char* b3 = b2 + kstep;
            PG8_LDB(B0, 0, 0); PG8_LDB(B1, 0, 1); PG8_SCHED; PG8_LDA(At, 0, 0); PG8_STAGEA(PG8_SA(1, 1), a1, cao[1][0], cao[1][1]);
            PG8_WAIT_V(8); PG8_WAIT_L(0); PG8_BAR; PG8_MMA(0, 0, At, B0); PG8_MMA(0, 1, At, B1); PG8_BAR; PG8_SCHED;
            if (last && has_next) { PG8_AOFFS(cao, nxt, tslot_n); }
            PG8_LDA(At, 0, 1); PG8_STAGE(PG8_SB(0, 0), b2, voffB); PG8_STAGE(PG8_SB(0, 1), b2 + hstep, voffB); PG8_STAGEA(PG8_SA(0, 0), a2, cao[0][0], cao[0][1]);
            PG8_WAIT_V(8); PG8_WAIT_L(0); PG8_BAR; PG8_MMA(1, 0, At, B0); PG8_MMA(1, 1, At, B1); PG8_BAR; PG8_SCHED;
            PG8_LDB(B0, 1, 0); PG8_LDB(B1, 1, 1); PG8_SCHED; PG8_LDA(At, 1, 0); PG8_STAGEA(PG8_SA(0, 1), a2, cao[1][0], cao[1][1]);
            PG8_WAIT_V(8); PG8_WAIT_L(0); PG8_BAR; PG8_MMA(0, 0, At, B0); PG8_MMA(0, 1, At, B1); PG8_BAR; PG8_SCHED;
            PG8_LDA(At, 1, 1); PG8_STAGE(PG8_SB(1, 0), b3, voffB); PG8_STAGE(PG8_SB(1, 1), b3 + hstep, voffB); PG8_STAGEA(PG8_SA(1, 0), a3, cao[0][0], cao[0][1]);
            PG8_WAIT_V(8); PG8_WAIT_L(0); PG8_BAR; PG8_MMA(1, 0, At, B0); PG8_MMA(1, 1, At, B1); PG8_BAR; PG8_SCHED;
        }
        if (wr == 0) PG8_BAR;
        E(acc, cur, wr, wc, fr, fq, tab + (ui % 3) * TAB_SLOT_BYTES);
        if (!has_next) break;
#pragma unroll
        for (int a = 0; a < 2; ++a)
#pragma unroll
            for (int b = 0; b < 2; ++b)
#pragma unroll
                for (int m = 0; m < 4; ++m)
#pragma unroll
                    for (int n = 0; n < 2; ++n) acc[a][b][m][n] = (f32x4){0.f, 0.f, 0.f, 0.f};
        cur = nxt; cB = nB; ++ui;
        if (wr == 1) PG8_BAR;
    }
    PG8_WAIT_V(0);
    PG8_BAR;
#undef PG8_SA
#undef PG8_SB
#undef PG8_STAGE
#undef PG8_STAGEA
#undef PG8_LDA
#undef PG8_LDB
#undef PG8_MMA
#undef PG8_WAIT_V
#undef PG8_WAIT_L
#undef PG8_BAR
#undef PG8_SCHED
#undef PG8_AOFFS
}
struct MoeSched {
    const PG8_LAS int* tstart; const PG8_LAS int* cnt;
    const int* lrow; const float* lw;
    const char* Bt; size_t e_stride, pn_stride;
    int MT, NP, pn0, G, c;
    __device__ __forceinline__ bool next(int i, UnitM& u) const {
        const int L = i * G + c; if (L >= MT * NP) return false;
        const int mtg = L / NP; u.pn = pn0 + L % NP;
        int e = 0;
        for (int k = 1; k < 65; ++k) e += (tstart[k] <= mtg) ? 1 : 0;
        u.e = e; u.mt = mtg - tstart[e]; u.arow0 = mtg * 256; const int rem = cnt[e] - u.mt * 256; u.nvalid = rem < 256 ? rem : 256;
        return true;
    }
    __device__ __forceinline__ const char* b_base(const UnitM& u) const { return Bt + (size_t)u.e * e_stride + (size_t)u.pn * pn_stride; }
    __device__ __forceinline__ void load_tab(const UnitM& u, PG8_LAS unsigned char* dst, int lane) const {
        const size_t off = (size_t)u.e * 16384 + u.mt * 256 + lane * 4;
        __builtin_amdgcn_global_load_lds((const unsigned*)(lrow + off), (PG8_LAS unsigned*)dst, 16, 0, 0);
        __builtin_amdgcn_global_load_lds((const unsigned*)(lw + off), (PG8_LAS unsigned*)(dst + 1024), 16, 0, 0);
    }
};
struct EpiAct {
    static constexpr bool PERM = true;
    bf16_t* act;
    __device__ __forceinline__ void operator()(const f32x4 (&acc)[2][2][4][2], const UnitM& u, int wr, int wc, int fr, int fq, const PG8_LAS unsigned char* tab) const {
#pragma unroll
        for (int ai = 0; ai < 2; ++ai)
#pragma unroll
            for (int m = 0; m < 4; ++m) { const int r = ai * HALF + wr * 64 + m * 16 + fr;
                float w = *(const PG8_LAS float*)(tab + 1024 + r * 4); w = r < u.nvalid ? w : 0.f;
                float v[8];
#pragma unroll
                for (int n = 0; n < 2; ++n)
#pragma unroll
                    for (int i = 0; i < 4; ++i) { const float g = acc[ai][0][m][n][i], up = acc[ai][1][m][n][i];
                        v[n * 4 + i] = g * __builtin_amdgcn_rcpf(1.f + __builtin_amdgcn_exp2f(-1.4426950408889634f * g)) * up * w; }
                u32x4 o; o.x = cvt_pk_bf16(v[0], v[1]); o.y = cvt_pk_bf16(v[2], v[3]); o.z = cvt_pk_bf16(v[4], v[5]); o.w = cvt_pk_bf16(v[6], v[7]);
                *(u32x4*)(act + (size_t)(u.arow0 + r) * 256 + u.pn * 128 + wc * 32 + 8 * fq) = o; }
    }
};
struct EpiSlot {
    static constexpr bool PERM = true;
    bf16_t* slot; int pn_half0; unsigned dump_row;
    __device__ __forceinline__ void operator()(const f32x4 (&acc)[2][2][4][2], const UnitM& u, int wr, int wc, int fr, int fq, const PG8_LAS unsigned char* tab) const {
#pragma unroll
        for (int ai = 0; ai < 2; ++ai)
#pragma unroll
            for (int m = 0; m < 4; ++m) { const int r = ai * HALF + wr * 64 + m * 16 + fr;
                const int inf = *(const PG8_LAS int*)(tab + r * 4);
                const unsigned srow = r < u.nvalid ? (unsigned)(inf >> 4) * 9u + (unsigned)(inf & 15) : dump_row;
                bf16_t* dst = slot + (size_t)srow * 512 + (u.pn - pn_half0) * 256 + wc * 32 + 8 * fq;
#pragma unroll
                for (int bj = 0; bj < 2; ++bj) { const f32x4 v0 = acc[ai][bj][m][0], v1 = acc[ai][bj][m][1];
                    u32x4 o; o.x = cvt_pk_bf16(v0[0], v0[1]); o.y = cvt_pk_bf16(v0[2], v0[3]); o.z = cvt_pk_bf16(v1[0], v1[1]); o.w = cvt_pk_bf16(v1[2], v1[3]);
                    *(u32x4*)(dst + bj * HALF) = o; }
                asm volatile("" ::: "memory"); }
    }
};
}

namespace attn_body {
using bf16=__hip_bfloat16;
using bf16x8=__attribute__((ext_vector_type(8)))short;
using s16x4=__attribute__((ext_vector_type(4)))short;
using f32x16=__attribute__((ext_vector_type(16)))float;
using u32x4=__attribute__((ext_vector_type(4)))unsigned;
using f32x4_t=__attribute__((ext_vector_type(4)))float;
constexpr int SEQ=2048,D=64,DM=2816;
constexpr int NW=8,QBLK=32,QB=QBLK*NW,KVBLK=64,NQB=SEQ/QB;
__device__ __forceinline__ int crow(int r,int hi){return (r&3)+8*(r>>2)+4*hi;}
#define SBAR() __builtin_amdgcn_sched_barrier(0)
__device__ __forceinline__ void cmask(f32x16&p0,f32x16&p1,int jb,int qrel,int hi){
  const float NEG=-INFINITY; int kb=64*jb+4*hi;
  #pragma unroll
  for(int r=0;r<16;++r){int kv=kb+(r&3)+8*(r>>2); if(kv>qrel)p0[r]=NEG; if(kv+32>qrel)p1[r]=NEG;}
}

typedef __attribute__((address_space(3))) const float* lds_fptr;
template<int MODE> __device__ __forceinline__ void tilefix(f32x16&p0,f32x16&p1,int t,int NT,int ta,int qrel,int hi,lds_fptr cl,lds_fptr dt,unsigned maskq,float mhat){
  const float NEG=-INFINITY;
  if(MODE==0){
  } else {
    #pragma unroll
    for(int r=0;r<16;++r){p0[r]-=mhat;p1[r]-=mhat;}
  }
  if(MODE==1){ if(__any(((maskq>>ta)&1u)==0u)){ const bool off=((maskq>>ta)&1u)==0u;
      #pragma unroll
      for(int r=0;r<16;++r){p0[r]=off?NEG:p0[r];p1[r]=off?NEG:p1[r];} } }
  if(MODE!=0){
    const int dbase=qrel+64*(NT-4-t)-4*hi;
    if(MODE==2 && t<4){
      { const int e511=dbase-511;
      #pragma unroll
      for(int r=0;r<16;++r){ if(e511>((r&3)+8*(r>>2)))p0[r]=NEG; if(e511>((r&3)+8*(r>>2)+32))p1[r]=NEG; } } }
    if(t>=NT-6){
      #pragma unroll
      for(int g=0;g<4;++g){
        #pragma unroll
        for(int i=0;i<4;++i){const int r=4*g+i; const int d=dbase-((r&3)+8*(r>>2)); const int i0=min(max(d,0),127),i1=min(max(d-32,0),127); p0[r]+=dt[i0]; p1[r]+=dt[i1];}
        __builtin_amdgcn_sched_barrier(0); } }
  }
  { const int jb=t-(NT-4); if(jb>=0)cmask(p0,p1,jb,qrel,hi); }
}

constexpr int NSLOT=3, SLOTB=8192;
constexpr int LDS_K=0, LDS_V=NSLOT*SLOTB, LDS_WS=2*NSLOT*SLOTB, LDS_OST=LDS_WS+NW*64*4, LDS_CUM=LDS_OST+NW*4096, LDS_DT=LDS_CUM+8192, LDS_BYTES=LDS_DT+4096;
constexpr float C2=0.125f*1.4426950408889634f;
__device__ __forceinline__ void glds16(const void*gsrc,unsigned lds_dst){unsigned keep;
  asm volatile("s_mov_b32 %0, m0\n\ts_mov_b32 m0, %2\n\ts_nop 0\n\tglobal_load_lds_dwordx4 %1, off\n\ts_mov_b32 m0, %0":"=&s"(keep):"v"(gsrc),"s"(lds_dst):"memory");}
__device__ __forceinline__ float max3f(float a,float b,float c){float r;asm("v_max3_f32 %0, %1, %2, %3":"=v"(r):"v"(a),"v"(b),"v"(c));return r;}
__device__ __forceinline__ float max2f(float a,float b){float r;asm("v_max_f32_e32 %0, %1, %2":"=v"(r):"v"(a),"v"(b));return r;}
__device__ __forceinline__ float fadd_s(float a,float b){float r;asm("v_add_f32_e32 %0, %1, %2":"=v"(r):"v"(a),"v"(b));return r;}
__device__ __forceinline__ float fsub_s(float a,float b){float r;asm("v_sub_f32_e32 %0, %1, %2":"=v"(r):"v"(a),"v"(b));return r;}
typedef float f32x2_t __attribute__((ext_vector_type(2))); typedef __bf16 bf16x2_t __attribute__((ext_vector_type(2)));
__device__ __forceinline__ unsigned cvtpk_s(float lo,float hi){f32x2_t v={lo,hi};bf16x2_t b=__builtin_convertvector(v,bf16x2_t);return __builtin_bit_cast(unsigned,b);}
#define WAIT_BAR(N) asm volatile("s_waitcnt vmcnt(" #N ") lgkmcnt(0)\n\ts_barrier":::"memory")

__device__ __forceinline__ void qkt(f32x16&p0,f32x16&p1,const char*Kslot,const bf16x8*qr,const f32x16&ci0,const f32x16&ci1,int r32,int hi){
  const char*kb=Kslot+hi*1024+r32*16;
  #pragma unroll
  for(int d0=0;d0<4;++d0){
    const bf16x8 b0=*reinterpret_cast<const bf16x8*>(kb+d0*2048);
    const bf16x8 b1=*reinterpret_cast<const bf16x8*>(kb+d0*2048+512);
    if(d0==0){p0=__builtin_amdgcn_mfma_f32_32x32x16_bf16(b0,qr[0],ci0,0,0,0);p1=__builtin_amdgcn_mfma_f32_32x32x16_bf16(b1,qr[0],ci1,0,0,0);}
    else{p0=__builtin_amdgcn_mfma_f32_32x32x16_bf16(b0,qr[d0],p0,0,0,0);p1=__builtin_amdgcn_mfma_f32_32x32x16_bf16(b1,qr[d0],p1,0,0,0);}}
}
typedef __attribute__((address_space(3))) const char* lds_cptr;
typedef short v4i16_t __attribute__((ext_vector_type(4)));
__device__ __forceinline__ void kload8(bf16x8*kf,lds_cptr kp){
  kf[0]=*(const __attribute__((address_space(3))) bf16x8*)(kp);      kf[1]=*(const __attribute__((address_space(3))) bf16x8*)(kp+512);
  kf[2]=*(const __attribute__((address_space(3))) bf16x8*)(kp+2048); kf[3]=*(const __attribute__((address_space(3))) bf16x8*)(kp+2560);
  kf[4]=*(const __attribute__((address_space(3))) bf16x8*)(kp+4096); kf[5]=*(const __attribute__((address_space(3))) bf16x8*)(kp+4608);
  kf[6]=*(const __attribute__((address_space(3))) bf16x8*)(kp+6144); kf[7]=*(const __attribute__((address_space(3))) bf16x8*)(kp+6656);
}
__device__ __forceinline__ void kload2(bf16x8*kf,lds_cptr kp,int j){ kf[2*j]=*(const __attribute__((address_space(3))) bf16x8*)(kp+j*2048); kf[2*j+1]=*(const __attribute__((address_space(3))) bf16x8*)(kp+j*2048+512); }
__device__ __forceinline__ s16x4 vtr(lds_cptr p){ return __builtin_bit_cast(s16x4,__builtin_amdgcn_ds_read_tr16_b64_v4i16((__attribute__((address_space(3))) v4i16_t*)p)); }
__device__ __forceinline__ float rowmax(const f32x16&p0,const f32x16&p1){
  float a=max3f(p0[0],p0[1],p1[0]),b=max3f(p0[2],p0[3],p1[1]);a=max3f(a,p1[2],p1[3]);
  #pragma unroll
  for(int r=4;r<16;r+=4){a=max3f(a,p0[r],p0[r+1]);b=max3f(b,p0[r+2],p0[r+3]);a=max3f(a,p1[r],p1[r+1]);b=max3f(b,p1[r+2],p1[r+3]);}
  const float m=max2f(a,b);
  auto rr=__builtin_amdgcn_permlane32_swap(__float_as_uint(m),__float_as_uint(m),false,false);
  return max2f(__uint_as_float(rr[0]),__uint_as_float(rr[1]));
}
__device__ __forceinline__ void pv(f32x16*o,int vb,bf16x8 pa0,bf16x8 pa1,bf16x8 pa2,bf16x8 pa3){
  #pragma unroll
  for(int d0=0;d0<2;++d0){s16x4 lo[4],hi[4];
    #pragma unroll
    for(int ks=0;ks<4;++ks){
      asm volatile("ds_read_b64_tr_b16 %0,%1 offset:%c2":"=&v"(lo[ks]):"v"(vb),"i"(d0*4096+ks*1024):"memory");
      asm volatile("ds_read_b64_tr_b16 %0,%1 offset:%c2":"=&v"(hi[ks]):"v"(vb),"i"(d0*4096+ks*1024+512):"memory");}
    asm volatile("s_waitcnt lgkmcnt(0)":::"memory");SBAR();
    #define PK(k) (bf16x8){lo[k][0],lo[k][1],lo[k][2],lo[k][3],hi[k][0],hi[k][1],hi[k][2],hi[k][3]}
    o[d0]=__builtin_amdgcn_mfma_f32_32x32x16_bf16(pa0,PK(0),o[d0],0,0,0);
    o[d0]=__builtin_amdgcn_mfma_f32_32x32x16_bf16(pa1,PK(1),o[d0],0,0,0);
    o[d0]=__builtin_amdgcn_mfma_f32_32x32x16_bf16(pa2,PK(2),o[d0],0,0,0);
    o[d0]=__builtin_amdgcn_mfma_f32_32x32x16_bf16(pa3,PK(3),o[d0],0,0,0);
    #undef PK
  }
}

__device__ __forceinline__ void attn_fill_dt(char*shm,const float*rel_bias){
  const int tid=threadIdx.x;
  #pragma unroll
  for(int k=0;k<2;++k){ const int e=tid+512*k, hh=e>>7, n=e&127;
    const int bk=n<16?n:16+(n>=19)+(n>=21)+(n>=24)+(n>=27)+(n>=31)+(n>=35)+(n>=40)+(n>=46)+(n>=52)+(n>=59)+(n>=67)+(n>=77)+(n>=87)+(n>=99)+(n>=113);
    ((float*)(shm+LDS_DT))[e]=(rel_bias[bk*8+hh]-rel_bias[31*8+hh])*1.4426950408889634f; }
  __syncthreads();
}
#ifndef ATTN_STORE16
#define ATTN_STORE16(p,v) (*(u32x4*)(p)=(v))
#endif
struct AttnIO { unsigned char* ws; };
#define IO_PROJ ((const bf16*)(io.ws+WS_PROJ))
#define IO_CUM ((const float*)(io.ws+WS_CUM))
#define IO_SELM ((const unsigned*)(io.ws+WS_SELM))
#define IO_FG ((const float*)(io.ws+WS_FG))
#define IO_OC ((const bf16*)(io.ws+WS_OC))
#define IO_OW ((bf16*)(io.ws+WS_OW))
#define IO_AO16 ((bf16*)(io.ws+WS_AO16))

template<int MODE,int THRL> __device__ __forceinline__ void attn_unit(int b,int h,int qb,const AttnIO&io,char*shm,const int tidv){
  const int tid=tidv,lane=tid&63,r32=lane&31,hi=lane>>5; const int wid=__builtin_amdgcn_readfirstlane(tid>>6);
  const long rowbase=(long)b*SEQ; const int q0=qb*QB; const int g=h>>2;
  const int NT=(MODE==2)?((4*qb+4)<12?(4*qb+4):12):(4*qb+4);
  const int t0=4*qb+4-NT;
  const int qcol=(MODE==0?0:1536)+h*D, kcol=(MODE==0?512+h*D:(MODE==1?2304:2560)+g*D), vcol=(MODE==0?1024+h*D:(MODE==1?2432:2688)+g*D);
  const bf16*Qw=IO_PROJ+(rowbase+q0+wid*QBLK)*DM+qcol;
  const bf16*Kh=IO_PROJ+(rowbase+(long)t0*KVBLK)*DM+kcol,*Vh=IO_PROJ+(rowbase+(long)t0*KVBLK)*DM+vcol;
  const unsigned lds0=(unsigned)(uintptr_t)shm;
  float*wsf=(float*)(shm+LDS_WS)+wid*64;
  const bf16*ksrc=Kh+(long)lane*DM+wid*8;
  const bf16*vsrc=Vh+(long)(16*(wid&3)+(lane>>2))*DM+(wid>>2)*32+(lane&3)*8;
  const unsigned kdst=lds0+LDS_K+wid*1024, vdst=lds0+LDS_V+wid*1024;
  #define DMA_K(t,slot) glds16(ksrc+(long)(t)*KVBLK*DM,(unsigned)__builtin_amdgcn_readfirstlane(kdst+(slot)))
  #define DMA_V(t,slot) glds16(vsrc+(long)(t)*KVBLK*DM,(unsigned)__builtin_amdgcn_readfirstlane(vdst+(slot)))
  const int vb0=(int)(lds0+LDS_V)+((lane>>4)&1)*32+(lane&3)*8+(4*hi+((lane&15)>>2))*64;
  const char*Kbase=shm+LDS_K; bf16x8 kf[8];
  const lds_cptr shm3=(lds_cptr)shm; const lds_cptr kp0=shm3+LDS_K+hi*1024+r32*16; const lds_cptr vp0=shm3+LDS_V+((lane>>4)&1)*32+(lane&3)*8+(4*hi+((lane&15)>>2))*64;
  DMA_K(0,0);DMA_V(0,0);DMA_K(1,SLOTB);
  bf16x8 qr[4];
  #pragma unroll
  for(int d0=0;d0<4;++d0)qr[d0]=*reinterpret_cast<const bf16x8*>(&Qw[(long)r32*DM+d0*16+hi*8]);
  const lds_cptr qst=(lds_cptr)shm+LDS_OST+wid*4096+lane*16;
  #pragma unroll
  for(int d0=0;d0<4;++d0)*(__attribute__((address_space(3))) bf16x8*)((__attribute__((address_space(3))) char*)qst+d0*1024)=qr[d0];
  const lds_fptr cl=(lds_fptr)(shm+LDS_CUM), dt=(lds_fptr)(shm+LDS_DT)+h*128;
  unsigned maskq=0xffffffffu;
  if(MODE==0){ const f32x4_t c4=*(const f32x4_t*)(IO_CUM+((long)(b*8+h))*SEQ+tid*4); *(f32x4_t*)(shm+LDS_CUM+tid*16)=c4*1.4426950408889634f; }
  else {
    if(MODE==1) maskq=IO_SELM[((long)(b*2+g))*SEQ+q0+wid*QBLK+r32]; }
  float mhat=0.f,l_reg=0.f;f32x16 o[2];o[0]=f32x16{};o[1]=f32x16{};const f32x16 negm=f32x16{};
  #define SPLIT3(v,hb,lb,l2) const unsigned hb=cvtpk_s(v,0.f)&0xffffu; const float r1_=(v)-__uint_as_float(hb<<16); const unsigned lb=cvtpk_s(r1_,0.f)&0xffffu; const float r2_=r1_-__uint_as_float(lb<<16); const unsigned l2=cvtpk_s(r2_,0.f)&0xffffu
  #define KAUG(dst,cval) do{ const float v_=-(cval); SPLIT3(v_,hb_,lb_,l2_); u32x4 w_; w_[0]=hi?0u:(hb_|(lb_<<16)); w_[1]=hi?0u:(l2_|0x3f800000u); w_[2]=hi?0u:0x3f803f80u; w_[3]=0u; dst=__builtin_bit_cast(bf16x8,w_); }while(0)
  #define QAUG(dst,mval) do{ const float v_=-(mval); SPLIT3(v_,hb_,lb_,l2_); u32x4 w_; w_[0]=0x3f803f80u; w_[1]=0x3f80u|(hb_<<16); w_[2]=lb_|(l2_<<16); w_[3]=0u; dst=__builtin_bit_cast(bf16x8,w_); }while(0)
  bf16x8 qa; QAUG(qa,0.f);
  const int qrel=wid*QBLK+r32;
  #define CMASK(P0,P1,t) tilefix<MODE>(P0,P1,(t),NT,t0+(t),qrel,hi,cl,dt,maskq,mhat)
  bool resc=false;
  #define START(P0,P1) do{ const float rm=rowmax(P0,P1); resc=false; \
    { const float dl=(rm==-INFINITY)?0.f:rm; mhat=fadd_s(mhat,dl); if(MODE==0){QAUG(qa,mhat);} \
      _Pragma("unroll") for(int r=0;r<16;++r){P0[r]=fsub_s(P0[r],dl);P1[r]=fsub_s(P1[r],dl);} \
      } \
    _Pragma("unroll") for(int r=0;r<16;++r)P0[r]=__builtin_amdgcn_exp2f(P0[r]); }while(0)
  #define RESC() do{ if(resc){ asm volatile("s_waitcnt lgkmcnt(0)":::"memory"); \
      _Pragma("unroll") for(int d_=0;d_<2;++d_) _Pragma("unroll") for(int r=0;r<16;++r)o[d_][r]*=wsf[crow(r,hi)]; } }while(0)
  f32x16 pA0,pA1,pB0,pB1;
  int sl_prev=0,sl_cur=0,sl_next=SLOTB;
  #define ROT() do{sl_prev=sl_cur;sl_cur=sl_next;sl_next=(sl_next==(NSLOT-1)*SLOTB)?0:sl_next+SLOTB;}while(0)
  DMA_K(2,2*SLOTB);
  WAIT_BAR(3);
  if(MODE==0){ bf16x8 ka0,ka1; KAUG(ka0,cl[64*t0+r32]); KAUG(ka1,cl[64*t0+32+r32]);
    pA0=__builtin_amdgcn_mfma_f32_32x32x16_bf16(ka0,qa,negm,0,0,0); pA1=__builtin_amdgcn_mfma_f32_32x32x16_bf16(ka1,qa,negm,0,0,0); qkt(pA0,pA1,Kbase,qr,pA0,pA1,r32,hi); }
  else qkt(pA0,pA1,Kbase,qr,negm,negm,r32,hi);
  asm volatile("s_nop 15\n\ts_nop 7":"+v"(pA0),"+v"(pA1));CMASK(pA0,pA1,0);
  START(pA0,pA1);
  _Pragma("unroll") for(int r=0;r<16;++r)pA1[r]=__builtin_amdgcn_exp2f(pA1[r]);
  WAIT_BAR(0);
  DMA_K(3,0);DMA_V(1,SLOTB);
  ROT();
  kload8(kf,kp0+sl_cur);
  WAIT_BAR(2);
  s16x4 vlo[8],vhi[8]; u32x4 pw0,pw1,pw2,pw3;
  #define PKW(P,B) cvtpk_s(P[B],P[B+1])
  #define PAF(k) __builtin_bit_cast(bf16x8,pw##k)
  #define VFR(i) (bf16x8){vlo[i][0],vlo[i][1],vlo[i][2],vlo[i][3],vhi[i][0],vhi[i][1],vhi[i][2],vhi[i][3]}
  #define PIN(x) asm volatile("":"+v"(x))
  #define MX3(a,b,c) __builtin_fmaxf(__builtin_fmaxf((a),(b)),(c))
  #define GAPA(MF,A0,A1,A2,A3,W0,W1,PW) do{ MF; sacc+=A0; sacc+=A1; sacc+=A2; sacc+=A3; PIN(sacc); W0; W1; PIN(PW); SBAR(); }while(0)
  #define EX(v) __builtin_amdgcn_exp2f(v)
  #define GAPB(MF,X,B) do{ MF; X[B]=EX(X[B]); X[B+1]=EX(X[B+1]); X[B+2]=EX(X[B+2]); X[B+3]=EX(X[B+3]); PIN(X); SBAR(); }while(0)
  #define VRD(i) do{ vlo[i]=vtr(vp_+(((i)>>2)*4096+((i)&3)*1024)); vhi[i]=vtr(vp_+(((i)>>2)*4096+((i)&3)*1024+512)); }while(0)
  #define KRD(G,j) do{ if(G){ kload2(kf,kp0+sl_next,j); SBAR(); } }while(0)
  #define STEP(C0,C1,P0,P1,t,GK,GV,GL) do{ SBAR(); \
    if(MODE==0){ bf16x8 ka0_,ka1_; KAUG(ka0_,cl[64*(t0+(t))+r32]); KAUG(ka1_,cl[64*(t0+(t))+32+r32]); \
      C0=__builtin_amdgcn_mfma_f32_32x32x16_bf16(ka0_,qa,negm,0,0,0); C1=__builtin_amdgcn_mfma_f32_32x32x16_bf16(ka1_,qa,negm,0,0,0); SBAR(); } \
    const lds_cptr vp_=vp0+sl_prev; \
    const bf16x8 qq0=*(const __attribute__((address_space(3))) bf16x8*)(qst),qq1=*(const __attribute__((address_space(3))) bf16x8*)(qst+1024),qq2=*(const __attribute__((address_space(3))) bf16x8*)(qst+2048),qq3=*(const __attribute__((address_space(3))) bf16x8*)(qst+3072); \
    VRD(0); SBAR(); float sacc=(P0[0]+P0[1]); \
    GAPA(C0=__builtin_amdgcn_mfma_f32_32x32x16_bf16(kf[0],qq0,(MODE==0?C0:negm),0,0,0), P0[2],P0[3],P0[4],P0[5],     pw0[0]=PKW(P0,0), pw0[1]=PKW(P0,2), pw0); \
    VRD(4); SBAR(); GAPA(C1=__builtin_amdgcn_mfma_f32_32x32x16_bf16(kf[1],qq0,(MODE==0?C1:negm),0,0,0), P0[6],P0[7],P0[8],P0[9],     pw0[2]=PKW(P0,4), pw0[3]=PKW(P0,6), pw0); \
    VRD(1); SBAR(); GAPA(C0=__builtin_amdgcn_mfma_f32_32x32x16_bf16(kf[2],qq1,C0,0,0,0),   P0[10],P0[11],P0[12],P0[13], pw1[0]=PKW(P0,8), pw1[1]=PKW(P0,10), pw1); \
    VRD(5); SBAR(); GAPA(C1=__builtin_amdgcn_mfma_f32_32x32x16_bf16(kf[3],qq1,C1,0,0,0),   P0[14],P0[15],P1[0],P1[1],   pw1[2]=PKW(P0,12),pw1[3]=PKW(P0,14), pw1); \
    VRD(2); SBAR(); GAPA(C0=__builtin_amdgcn_mfma_f32_32x32x16_bf16(kf[4],qq2,C0,0,0,0),   P1[2],P1[3],P1[4],P1[5],     pw2[0]=PKW(P1,0), pw2[1]=PKW(P1,2), pw2); \
    VRD(6); SBAR(); GAPA(C1=__builtin_amdgcn_mfma_f32_32x32x16_bf16(kf[5],qq2,C1,0,0,0),   P1[6],P1[7],P1[8],P1[9],     pw2[2]=PKW(P1,4), pw2[3]=PKW(P1,6), pw2); \
    VRD(3); SBAR(); GAPA(C0=__builtin_amdgcn_mfma_f32_32x32x16_bf16(kf[6],qq3,C0,0,0,0),   P1[10],P1[11],P1[12],P1[13], pw3[0]=PKW(P1,8), pw3[1]=PKW(P1,10), pw3); \
    VRD(7); SBAR(); GAPA(C1=__builtin_amdgcn_mfma_f32_32x32x16_bf16(kf[7],qq3,C1,0,0,0),   P1[14],P1[15],0.f,0.f,       pw3[2]=PKW(P1,12),pw3[3]=PKW(P1,14), pw3); \
    l_reg+=sacc; \
    if(GK){DMA_K((t)+3,sl_cur);} if(GV){DMA_V((t)+1,sl_next);} \
    CMASK(C0,C1,t); \
    { float a=MX3(C0[0],C0[1],C1[0]),b=MX3(C0[2],C0[3],C1[1]); a=MX3(a,C1[2],C1[3]); \
      _Pragma("unroll") for(int r=4;r<16;r+=4){a=MX3(a,C0[r],C0[r+1]);b=MX3(b,C0[r+2],C0[r+3]);a=MX3(a,C1[r],C1[r+1]);b=MX3(b,C1[r+2],C1[r+3]);} \
      float rm=__builtin_fmaxf(a,b); { auto rr=__builtin_amdgcn_permlane32_swap(__float_as_uint(rm),__float_as_uint(rm),false,false); rm=__builtin_fmaxf(__uint_as_float(rr[0]),__uint_as_float(rr[1])); } \
      resc=false; \
      if(__builtin_expect(__any(rm>(float)THRL),0)){ const float dl=__builtin_fmaxf(rm,0.f); mhat+=dl; if(MODE==0){QAUG(qa,mhat);} \
        _Pragma("unroll") for(int r=0;r<16;++r){C0[r]-=dl;C1[r]-=dl;} \
        const float f=__builtin_amdgcn_exp2f(-dl); l_reg*=f; if(hi==0)wsf[r32]=f; resc=true; } } \
    SBAR(); \
    GAPB(o[0]=__builtin_amdgcn_mfma_f32_32x32x16_bf16(PAF(0),VFR(0),o[0],0,0,0), C0,0); \
    GAPB(o[1]=__builtin_amdgcn_mfma_f32_32x32x16_bf16(PAF(0),VFR(4),o[1],0,0,0), C0,4); \
    KRD(GL,0); GAPB(o[0]=__builtin_amdgcn_mfma_f32_32x32x16_bf16(PAF(1),VFR(1),o[0],0,0,0), C0,8); \
    KRD(GL,1); GAPB(o[1]=__builtin_amdgcn_mfma_f32_32x32x16_bf16(PAF(1),VFR(5),o[1],0,0,0), C0,12); \
    KRD(GL,2); GAPB(o[0]=__builtin_amdgcn_mfma_f32_32x32x16_bf16(PAF(2),VFR(2),o[0],0,0,0), C1,0); \
    KRD(GL,3); GAPB(o[1]=__builtin_amdgcn_mfma_f32_32x32x16_bf16(PAF(2),VFR(6),o[1],0,0,0), C1,4); \
    GAPB(o[0]=__builtin_amdgcn_mfma_f32_32x32x16_bf16(PAF(3),VFR(3),o[0],0,0,0), C1,8); \
    GAPB(o[1]=__builtin_amdgcn_mfma_f32_32x32x16_bf16(PAF(3),VFR(7),o[1],0,0,0), C1,12); \
    }while(0)
  int t=1;
  for(;t+5<NT;t+=2){
    STEP(pB0,pB1,pA0,pA1,t,true,true,true);     WAIT_BAR(2); RESC(); ROT();
    STEP(pA0,pA1,pB0,pB1,t+1,true,true,true);   WAIT_BAR(2); RESC(); ROT();
  }
  #define ENDW(tt) do{ if((tt)+3<NT){WAIT_BAR(2);} else if((tt)+2<NT){WAIT_BAR(1);} else {WAIT_BAR(0);} }while(0)
  for(;t+1<NT;t+=2){
    STEP(pB0,pB1,pA0,pA1,t,(t+3<NT),(t+1<NT),(t+1<NT));       ENDW(t);   RESC(); ROT();
    STEP(pA0,pA1,pB0,pB1,t+1,(t+4<NT),(t+2<NT),(t+2<NT));     ENDW(t+1); RESC(); ROT();
  }
  STEP(pB0,pB1,pA0,pA1,NT-1,false,false,false); RESC();
  { float sacc=pB0[0]+pB0[1]; _Pragma("unroll") for(int r=2;r<16;++r)sacc+=pB0[r]; _Pragma("unroll") for(int r=0;r<16;++r)sacc+=pB1[r]; l_reg+=sacc;
    pw0=(u32x4){PKW(pB0,0),PKW(pB0,2),PKW(pB0,4),PKW(pB0,6)};pw1=(u32x4){PKW(pB0,8),PKW(pB0,10),PKW(pB0,12),PKW(pB0,14)};pw2=(u32x4){PKW(pB1,0),PKW(pB1,2),PKW(pB1,4),PKW(pB1,6)};pw3=(u32x4){PKW(pB1,8),PKW(pB1,10),PKW(pB1,12),PKW(pB1,14)};
    SBAR(); pv(o,vb0+sl_cur,PAF(0),PAF(1),PAF(2),PAF(3)); }
  #undef PKW
  #undef PAF
  #undef VFR
  #undef PIN
  #undef MX3
  #undef GAPA
  #undef GAPB
  #undef EX
  #undef VRD
  #undef KRD
  #undef STEP
  #undef ENDW
  {auto rr=__builtin_amdgcn_permlane32_swap(__float_as_uint(l_reg),__float_as_uint(l_reg),false,false);l_reg=__uint_as_float(rr[0])+__uint_as_float(rr[1]);}
  if(hi==0)wsf[32+r32]=l_reg;asm volatile("s_waitcnt lgkmcnt(0)":::"memory");
  float rli[16];
  #pragma unroll
  for(int r=0;r<16;++r)rli[r]=__builtin_amdgcn_rcpf(wsf[32+crow(r,hi)]);
  { bf16*stg=(bf16*)(shm+LDS_OST)+wid*2048;
    #pragma unroll
    for(int r=0;r<16;++r){const int orow=crow(r,hi);
      #pragma unroll
      for(int d0=0;d0<2;++d0)stg[orow*64+d0*32+r32]=__float2bfloat16(o[d0][r]*rli[r]);}
    asm volatile("s_waitcnt lgkmcnt(0)":::"memory");
    const long tok0=rowbase+q0+wid*QBLK;
    #pragma unroll
    for(int i=0;i<4;++i){const int row=i*8+(lane>>3),ch=lane&7; const u32x4 v=*(const u32x4*)(stg+row*64+ch*8);
      if(MODE==0){ *(u32x4*)(IO_AO16+(tok0+row)*1024+h*D+ch*8)=v; }
      else if(MODE==2){ *(u32x4*)(IO_OW+(tok0+row)*512+h*D+ch*8)=v; }
      else { const u32x4 c=*(const u32x4*)(IO_OC+(tok0+row)*512+h*D+ch*8), w=*(const u32x4*)(IO_OW+(tok0+row)*512+h*D+ch*8);
        const float*gp=IO_FG+(tok0+row)*32+8+h*3;
        const float g0=1.f/(1.f+__expf(-gp[0])),g1=1.f/(1.f+__expf(-gp[1])),g2=1.f/(1.f+__expf(-gp[2]));
        u32x4 o4;
        #pragma unroll
        for(int k=0;k<4;++k){ const float c_lo=__uint_as_float(c[k]<<16),c_hi=__uint_as_float(c[k]&0xffff0000u),s_lo=__uint_as_float(v[k]<<16),s_hi=__uint_as_float(v[k]&0xffff0000u),w_lo=__uint_as_float(w[k]<<16),w_hi=__uint_as_float(w[k]&0xffff0000u);
          o4[k]=cvtpk_s(g0*c_lo+g1*s_lo+g2*w_lo,g0*c_hi+g1*s_hi+g2*w_hi); }
        *(u32x4*)(IO_AO16+(tok0+row)*1024+512+h*D+ch*8)=o4; } } }
  asm volatile("s_waitcnt lgkmcnt(0)\n\ts_barrier":::"memory");
  #undef DMA_K
  #undef DMA_V
  #undef CMASK
  #undef START
  #undef RESC
  #undef ROT
}
constexpr int ATTN_LDS_BYTES=LDS_BYTES;
#undef SBAR
#undef WAIT_BAR
}

__device__ __forceinline__ float silu_f(float x) { return x / (1.f + expf(-x)); }
__device__ __forceinline__ float sigmoid_f(float x) { return 1.f / (1.f + expf(-x)); }
__device__ __forceinline__ unsigned f2bf(float f) { unsigned u = __builtin_bit_cast(unsigned, f); return (u + 0x7fffu + ((u >> 16) & 1u)) >> 16; }
__device__ __forceinline__ unsigned pk2(float lo, float hi) { return f2bf(lo) | (f2bf(hi) << 16); }
__device__ __forceinline__ float bf2f(bf16 v) { return __builtin_bit_cast(float, (unsigned)v << 16); }
__device__ __forceinline__ float wave_sum(float v) {
#pragma unroll
    for (int o = 1; o < 64; o <<= 1) v += __shfl_xor(v, o);
    return v;
}
__device__ __forceinline__ int t5_bucket(int dist) {
    const int n = dist < 0 ? 0 : dist;
    if (n < 16) return n;
    int b = 16;
    b += (n >= 19) + (n >= 21) + (n >= 24) + (n >= 27) + (n >= 31) + (n >= 35) + (n >= 40) + (n >= 46) + (n >= 52) + (n >= 59) +
         (n >= 67) + (n >= 77) + (n >= 87) + (n >= 99) + (n >= 113);
    return b;
}

struct Args {
    const float* in[26];
    float* out; unsigned char* ws;
    int ph_lo, ph_hi;
};

struct Ctx {
    LAS unsigned char* lds;
    int tid, lane, wave, gtid, GT, gw, NGW;
    const float *x, *c, *w_ada, *b_ada, *w_in, *b_f, *cmp_pos_k, *cmp_w1_k, *cmp_w2_k, *cmp_pos_v, *cmp_w1_v, *cmp_w2_v, *rel_bias, *w_out, *ln1_g, *ln1_b,
        *w_router, *e_bias, *w_gate, *w_up, *w_down, *ws_gate, *ws_up, *ws_down, *ln2_g, *ln2_b;
    float* out;
    float *mod, *cum, *kvc, *hid, *scorebuf, *scores, *ew, *fg, *pc, *lw;
    int* lrow; gu32* ctl; unsigned char* wsb;
    unsigned* selmask; int* eidx;
    bf16 *hbuf, *proj, *h2lo, *win_t, *wout_t, *ao16, *oc, *ow, *wgu, *wdn, *act16, *slot;
};


__device__ __forceinline__ int map_inproj(int n) { return n < 1536 ? n : (n < 1544 ? 2816 + (n - 1536) : (n < 2824 ? n - 8 : n)); }
template <int MAP>
__device__ __forceinline__ void transpose_item(const float* W, int K, int N, bf16* WT, LAS float* scr, int item, int lane) {
    const int nblk = N / 32, kb = item / nblk, nb = item % nblk, k0 = 64 * kb, n0 = 32 * nb;
#pragma unroll 8
    for (int i = 0; i < 32; ++i) { const int kk = 2 * i + (lane >> 5); scr[kk * 33 + (lane & 31)] = W[(size_t)(k0 + kk) * N + n0 + (lane & 31)]; }
    asm volatile("s_waitcnt lgkmcnt(0)" ::: "memory");
    const int c = lane & 7;
#pragma unroll
    for (int j = 0; j < 4; ++j) { const int n = (lane >> 3) + 8 * j; const LAS float* s = scr + (8 * c) * 33 + n;
        u32x4 o; o.x = pk2(s[0 * 33], s[1 * 33]); o.y = pk2(s[2 * 33], s[3 * 33]); o.z = pk2(s[4 * 33], s[5 * 33]); o.w = pk2(s[6 * 33], s[7 * 33]);
        const int dr = MAP == 1 ? map_inproj(n0 + n) : n0 + n;
        *(u32x4*)(WT + (size_t)dr * K + k0 + 8 * c) = o; }
    asm volatile("s_waitcnt lgkmcnt(0)" ::: "memory");
}
__device__ __forceinline__ void ph_prologue(Ctx& C) {
    LAS float* scr = (LAS float*)(C.lds + C.wave * 8704);
    constexpr int I_IN = (D / 64) * (NPROJ / 32), I_OUT = (D / 64) * (D / 32);
    for (int it = C.gw; it < I_IN + I_OUT; it += C.NGW) {
        if (it < I_IN) transpose_item<1>(C.w_in, D, NPROJ, C.win_t, scr, it, C.lane);
        else transpose_item<0>(C.w_out, D, D, C.wout_t, scr, it - I_IN, C.lane);
    }
    for (int i = C.gtid; i < (3072 - NPROJ) * D / 8; i += C.GT) *(u32x4*)(C.win_t + (size_t)NPROJ * D + (size_t)i * 8) = (u32x4){0u, 0u, 0u, 0u};
}
__device__ __forceinline__ void ph_mod(Ctx& C) {
    for (int i = C.gtid; i < NB * 6 * D; i += C.GT) {
        const int b = i / (6 * D), e = i % (6 * D);
        float acc = C.b_ada[e];
        for (int d = 0; d < D; ++d) acc += silu_f(C.c[b * D + d]) * C.w_ada[(size_t)d * 6 * D + e];
        C.mod[i] = acc;
    }
}
__device__ __forceinline__ void ph_hpass(Ctx& C) {
    for (int m = C.gw; m < T; m += C.NGW) {
        const int b = m / S;
        const float* md = C.mod + b * 6 * D;
#pragma unroll
        for (int j = 0; j < 4; ++j) {
            const int c0 = (C.lane + 64 * j) * 4;
            const f32x4 xv = *(const f32x4*)(C.x + (size_t)m * D + c0);
            const f32x4 sh = *(const f32x4*)(md + c0), sc = *(const f32x4*)(md + D + c0);
            const f32x4 h = xv * (1.f + sc) + sh;
            u32x2 o; o.x = pk2(h.x, h.y); o.y = pk2(h.z, h.w);
            *(u32x2*)(C.hbuf + (size_t)m * D + c0) = o;
        }
    }
}
__device__ __forceinline__ void ph_cum_cmp1(Ctx& C) {
    for (int w = C.gw; w < NB * 8; w += C.NGW) {
        const int b = w / 8, h = w % 8;
        float carry = 0.f;
        for (int c0 = 0; c0 < S; c0 += 64) {
            const int t = c0 + C.lane;
            const float xx = C.fg[((size_t)b * S + t) * FGW + h] + C.b_f[h];
            float v = fminf(xx, 0.f) - log1pf(expf(-fabsf(xx)));
#pragma unroll
            for (int o = 1; o < 64; o <<= 1) { const float u = __shfl_up(v, o); if (C.lane >= o) v += u; }
            v += carry;
            C.cum[(size_t)w * S + t] = v;
            carry = __shfl(v, 63);
        }
    }
    const int NR = NB * NCMP * 2;
    for (int i = C.gtid; i < 2 * NR * 256; i += C.GT) {
        const int j = i % 256, row = (i / 256) % NR, which = i / (256 * NR);
        const int g = row % 2, n = (row / 2) % NCMP, b = row / (2 * NCMP);
        const float* pos = which ? C.cmp_pos_v : C.cmp_pos_k;
        const float* w1 = which ? C.cmp_w1_v : C.cmp_w1_k;
        const int off = (which ? PC_VC : PC_KC) + g * 64;
        float acc = 0.f;
        for (int l = 0; l < 32; ++l) {
            const bf16* xr = C.proj + ((size_t)b * S + 16 * n + l) * PITCH + off;
            for (int d = 0; d < 64; ++d) acc += (bf2f(xr[d]) + pos[l * 64 + d]) * w1[(size_t)(l * 64 + d) * 256 + j];
        }
        C.hid[i] = silu_f(acc);
    }
}
__device__ __forceinline__ void ph_cmp2(Ctx& C) {
    const int NR = NB * NCMP * 2;
    for (int i = C.gtid; i < 2 * NR * 64; i += C.GT) {
        const int d = i % 64, row = (i / 64) % NR, which = i / (64 * NR);
        const float* w2 = which ? C.cmp_w2_v : C.cmp_w2_k;
        const float* hr = C.hid + ((size_t)which * NR + row) * 256;
        float acc = 0.f;
        for (int j = 0; j < 256; ++j) acc += hr[j] * w2[j * 64 + d];
        C.kvc[i] = acc;
    }
}
__device__ __forceinline__ void cmp_attn_item(Ctx& C, int i) {
    const int t = i % S, h = (i / S) % 8, b = i / (S * 8), g = h / 4;
    const size_t tok = (size_t)b * S + t;
    const int NR = NB * NCMP * 2;
    const float* kc = C.kvc;
    const float* vc = C.kvc + (size_t)NR * 64;
    float q[64], o[64];
#pragma unroll
    for (int d = 0; d < 64; ++d) { q[d] = bf2f(C.proj[tok * PITCH + PC_NQ + h * 64 + d]); o[d] = 0.f; }
    float* prow = C.pc + ((size_t)(b * 8 + h) * S + t) * 128;
    const int nvalid = t >= 31 ? min(NCMP, (t - 31) / 16 + 1) : 0;
    float m = -1e30f;
    for (int n = 0; n < nvalid; ++n) {
        const float* kr = kc + ((size_t)(b * NCMP + n) * 2 + g) * 64;
        float dot = 0.f;
#pragma unroll
        for (int d = 0; d < 64; ++d) dot += q[d] * kr[d];
        const float lg = dot + C.rel_bias[t5_bucket(t - (16 * n + 31)) * 8 + h] * LOG2E;
        prow[n] = lg;
        m = fmaxf(m, lg);
    }
    float l = 0.f;
    for (int n = 0; n < nvalid; ++n) l += exp2f(prow[n] - m);
    const float il = nvalid ? 1.f / l : 0.f;
    for (int n = 0; n < 128; ++n) {
        float p = 0.f;
        if (n < nvalid) {
            p = exp2f(prow[n] - m) * il;
            const float* vr = vc + ((size_t)(b * NCMP + n) * 2 + g) * 64;
#pragma unroll
            for (int d = 0; d < 64; ++d) o[d] += p * vr[d];
        }
        prow[n] = p;
    }
#pragma unroll
    for (int d = 0; d < 64; ++d) C.oc[tok * 512 + h * 64 + d] = (bf16)f2bf(o[d]);
}
__device__ __forceinline__ void ph_imp_topk(Ctx& C) {
    for (int i = C.gtid; i < NB * 2 * S; i += C.GT) {
        const int t = i % S, g = (i / S) % 2, b = i / (S * 2);
        const int qb = t >> 6;
        float* sc = C.scorebuf + (size_t)i * 32;
        for (int j = 0; j < 32; ++j) {
            float imp = 0.f;
            for (int r = 0; r < 4; ++r) {
                const float* prow = C.pc + ((size_t)(b * 8 + g * 4 + r) * S + t) * 128;
                for (int n = 4 * j - 1; n <= 4 * j + 3; ++n)
                    if (n >= 0 && n < NCMP) imp += prow[n];
            }
            const bool causal = j <= qb, forced = (j == 0) || (j == qb) || (j == qb - 1);
            sc[j] = causal ? imp + (forced ? 1e4f : 0.f) : -1e4f;
        }
        unsigned taken = 0u;
        for (int k = 0; k < 16; ++k) {
            float best = -3e38f; int bi = 0;
            for (int j = 0; j < 32; ++j)
                if (!((taken >> j) & 1u)) { const float v = sc[j]; if (v > best) { best = v; bi = j; } }
            taken |= 1u << bi;
        }
        C.selmask[i] = taken;
    }
}
#define ATTN_IO(C) attn_body::AttnIO{C.wsb}
__device__ __forceinline__ unsigned pick4(unsigned a, unsigned b, unsigned c, unsigned d, int k) { return k == 0 ? a : (k == 1 ? b : (k == 2 ? c : d)); }
__device__ __forceinline__ void ph_attn_a(Ctx& C, char* shm) {
    const attn_body::AttnIO io = ATTN_IO(C);
    const int c = blockIdx.x, k = c >> 6, j = c & 63, b = j >> 3, h = j & 7;
    if (c >= 256) return;
    attn_body::attn_fill_dt(shm, C.rel_bias);
    { int tv = threadIdx.x; asm volatile("" : "+v"(tv));
    for (unsigned l = pick4(0xF07u, 0xF16u, 0xF25u, 0xF34u, k); (l & 15u) != 15u; l >>= 4) attn_body::attn_unit<0, 8>(b, h, (int)(l & 15u), io, shm, tv); }
    { int tv = threadIdx.x; asm volatile("" : "+v"(tv));
    for (unsigned l = pick4(0xF07u, 0xF16u, 0xF25u, 0xF34u, k); (l & 15u) != 15u; l >>= 4) attn_body::attn_unit<2, 8>(b, h, (int)(l & 15u), io, shm, tv); }
}
__device__ __forceinline__ void ph_attn_b(Ctx& C, char* shm) {
    const attn_body::AttnIO io = ATTN_IO(C);
    const int c = blockIdx.x, k = c >> 6, j = c & 63, b = j >> 3, h = j & 7;
    if (c >= 256) return;
    attn_body::attn_fill_dt(shm, C.rel_bias);
    { int tv = threadIdx.x; asm volatile("" : "+v"(tv));
    for (unsigned l = pick4(0xF07u, 0xF16u, 0xF25u, 0xF34u, k); (l & 15u) != 15u; l >>= 4) attn_body::attn_unit<1, 8>(b, h, (int)(l & 15u), io, shm, tv); }
}
template <int WHICH>
__device__ __forceinline__ void ph_ln(Ctx& C) {
    const float* gam = WHICH == 1 ? C.ln1_g : C.ln2_g;
    const float* bet = WHICH == 1 ? C.ln1_b : C.ln2_b;
    for (int m = C.gw; m < T; m += C.NGW) {
        const int b = m / S;
        float* row = C.out + (size_t)m * D;
        f32x4 v[4]; float s = 0.f;
#pragma unroll
        for (int j = 0; j < 4; ++j) { v[j] = *(const f32x4*)(row + (C.lane + 64 * j) * 4); s += (v[j].x + v[j].y) + (v[j].z + v[j].w); }
        const float mean = wave_sum(s) * (1.f / D); float s2 = 0.f;
#pragma unroll
        for (int j = 0; j < 4; ++j) { v[j] = v[j] - mean; s2 += (v[j].x * v[j].x + v[j].y * v[j].y) + (v[j].z * v[j].z + v[j].w * v[j].w); }
        const float rstd = rsqrtf(wave_sum(s2) * (1.f / D) + LN_EPS);
#pragma unroll
        for (int j = 0; j < 4; ++j) {
            const int c0 = (C.lane + 64 * j) * 4;
            const f32x4 y = v[j] * rstd * *(const f32x4*)(gam + c0) + *(const f32x4*)(bet + c0);
            *(f32x4*)(row + c0) = y;
            if (WHICH == 1) {
                const float* md = C.mod + b * 6 * D;
                const f32x4 h2 = y * (1.f + *(const f32x4*)(md + 4 * D + c0)) + *(const f32x4*)(md + 3 * D + c0);
                u32x2 hi; hi.x = pk2(h2.x, h2.y); hi.y = pk2(h2.z, h2.w);
                const float r0 = h2.x - __builtin_bit_cast(float, hi.x << 16), r1 = h2.y - __builtin_bit_cast(float, hi.x & 0xffff0000u);
                const float r2 = h2.z - __builtin_bit_cast(float, hi.y << 16), r3 = h2.w - __builtin_bit_cast(float, hi.y & 0xffff0000u);
                u32x2 lo; lo.x = pk2(r0, r1); lo.y = pk2(r2, r3);
                *(u32x2*)(C.hbuf + (size_t)m * D + c0) = hi;
                *(u32x2*)(C.h2lo + (size_t)m * D + c0) = lo;
            }
        }
    }
}
__device__ __forceinline__ float h2_at(Ctx& C, size_t idx) { return bf2f(C.hbuf[idx]) + bf2f(C.h2lo[idx]); }
__device__ __forceinline__ void ph_router(Ctx& C) {
    for (int i = C.gtid; i < T * 64; i += C.GT) {
        const int e = i % 64, tok = i / 64;
        float acc = 0.f;
        for (int d = 0; d < D; ++d) acc += h2_at(C, (size_t)tok * D + d) * C.w_router[d * 64 + e];
        C.scores[i] = sigmoid_f(acc);
    }
}
__device__ __forceinline__ void ph_route(Ctx& C) {
    for (int tok = C.gtid; tok < T; tok += C.GT) {
        const float* sc = C.scores + (size_t)tok * 64;
        unsigned gtaken = 0u;
        for (int k = 0; k < 4; ++k) {
            float best = -3e38f; int bg = 0;
            for (int g = 0; g < 8; ++g) {
                if ((gtaken >> g) & 1u) continue;
                float m1 = -3e38f, m2 = -3e38f;
                for (int j = 0; j < 8; ++j) { const float v = sc[g * 8 + j] + C.e_bias[g * 8 + j]; if (v > m1) { m2 = m1; m1 = v; } else if (v > m2) m2 = v; }
                const float gs = m1 + m2;
                if (gs > best) { best = gs; bg = g; }
            }
            gtaken |= 1u << bg;
        }
        unsigned long long taken = 0ull;
        float wsum = 0.f;
        for (int k = 0; k < 8; ++k) {
            float best = -3e38f; int be = 0;
            for (int e = 0; e < 64; ++e) {
                if (!((gtaken >> (e >> 3)) & 1u) || ((taken >> e) & 1ull)) continue;
                const float v = sc[e] + C.e_bias[e];
                if (v > best) { best = v; be = e; }
            }
            taken |= 1ull << be;
            C.eidx[tok * 8 + k] = be;
            wsum += sc[be];
        }
        for (int k = 0; k < 8; ++k) {
            const int e = C.eidx[tok * 8 + k]; const float w = sc[e] / wsum * 2.5f;
            C.ew[tok * 8 + k] = w;
            const unsigned pos = __hip_atomic_fetch_add(C.ctl + CW_CNT + 64 * e, 1u, RLX_AGENT);
            C.lrow[(size_t)e * 16384 + pos] = tok * 16 + k; C.lw[(size_t)e * 16384 + pos] = w;
        }
        C.lrow[(size_t)64 * 16384 + tok] = tok * 16 + 8; C.lw[(size_t)64 * 16384 + tok] = 1.f;
    }
}
__device__ __forceinline__ void ph_convert_experts(Ctx& C) {
    LAS float* scr = (LAS float*)(C.lds + C.wave * 8704);
    for (int it = C.gw; it < 65 * 384; it += C.NGW) {
        const int e = it / 384, r = it % 384, kind = r / 128, item = r % 128;
        if (kind < 2) {
            const float* W = e < 64 ? (kind == 0 ? C.w_gate : C.w_up) + (size_t)e * D * 256 : (kind == 0 ? C.ws_gate : C.ws_up);
            const int n0 = 32 * (item % 8);
            bf16* WT = C.wgu + ((size_t)e * 512 + (n0 / 128) * 128 + kind * 128) * D;
            transpose_item<0>(W, D, 256, WT, scr, item, C.lane);
        } else {
            const float* W = e < 64 ? C.w_down + (size_t)e * 256 * D : C.ws_down;
            transpose_item<0>(W, 256, D, C.wdn + (size_t)e * D * 256, scr, item, C.lane);
        }
    }
}
__device__ __forceinline__ int moe_tables(Ctx& C) {
    LAS int* tstart = (LAS int*)(C.lds + LDS_TSTART); LAS int* cntl = (LAS int*)(C.lds + LDS_CNT);
    if (C.tid < 64) cntl[C.tid] = (int)__hip_atomic_load(C.ctl + CW_CNT + 64 * C.tid, RLX_AGENT);
    if (C.tid == 64) cntl[64] = T;
    __syncthreads();
    if (C.tid == 0) { int s = 0; for (int e = 0; e < 65; ++e) { tstart[e] = s; s += (cntl[e] + 255) >> 8; } tstart[65] = s; }
    __syncthreads();
    return tstart[65];
}
__device__ __forceinline__ void ph_moe_gateup(Ctx& C) {
    const int MT = moe_tables(C);
    pg8::MoeSched So{(const LAS int*)(C.lds + LDS_TSTART), (const LAS int*)(C.lds + LDS_CNT), C.lrow, C.lw, (const char*)C.wgu, (size_t)512 * D * 2, (size_t)256 * D * 2, MT, 2, 0, (int)gridDim.x, (int)blockIdx.x};
    pg8::EpiAct E{C.act16};
    pg8::gemm_phase_g<pg8::EpiAct, pg8::MoeSched, true>(C.lds, C.lds + LDS_TAB, C.hbuf, D, So, E);
}
template <int HF>
__device__ __forceinline__ void ph_moe_down(Ctx& C) {
    const int MT = moe_tables(C);
    pg8::MoeSched So{(const LAS int*)(C.lds + LDS_TSTART), (const LAS int*)(C.lds + LDS_CNT), C.lrow, C.lw, (const char*)C.wdn, (size_t)D * 256 * 2, (size_t)256 * 256 * 2, MT, 2, 2 * HF, (int)gridDim.x, (int)blockIdx.x};
    pg8::EpiSlot E{C.slot, 2 * HF, (unsigned)T * 9u};
    pg8::gemm_phase_g<pg8::EpiSlot, pg8::MoeSched, false>(C.lds, C.lds + LDS_TAB, C.act16, 256, So, E);
}
template <int HF>
__device__ __forceinline__ void ph_combine(Ctx& C) {
    for (int m = C.gw; m < T; m += C.NGW) {
        const int b = m / S, c0 = HF * 512 + C.lane * 8;
        float acc[8];
#pragma unroll
        for (int i = 0; i < 8; ++i) acc[i] = 0.f;
#pragma unroll
        for (int s = 0; s < 9; ++s) {
            const u32x4 v = *(const u32x4*)(C.slot + ((size_t)m * 9 + s) * 512 + C.lane * 8);
            acc[0] += __builtin_bit_cast(float, v.x << 16); acc[1] += __builtin_bit_cast(float, v.x & 0xffff0000u);
            acc[2] += __builtin_bit_cast(float, v.y << 16); acc[3] += __builtin_bit_cast(float, v.y & 0xffff0000u);
            acc[4] += __builtin_bit_cast(float, v.z << 16); acc[5] += __builtin_bit_cast(float, v.z & 0xffff0000u);
            acc[6] += __builtin_bit_cast(float, v.w << 16); acc[7] += __builtin_bit_cast(float, v.w & 0xffff0000u);
        }
        float* row = C.out + (size_t)m * D;
        const float* g2 = C.mod + b * 6 * D + 5 * D + c0;
        f32x4 y0 = *(const f32x4*)(row + c0) * ALPHA + *(const f32x4*)g2 * (f32x4){acc[0], acc[1], acc[2], acc[3]};
        f32x4 y1 = *(const f32x4*)(row + c0 + 4) * ALPHA + *(const f32x4*)(g2 + 4) * (f32x4){acc[4], acc[5], acc[6], acc[7]};
        if (HF == 0) { *(f32x4*)(row + c0) = y0; *(f32x4*)(row + c0 + 4) = y1; }
        else {
            f32x4 z0 = *(const f32x4*)(row + C.lane * 8), z1 = *(const f32x4*)(row + C.lane * 8 + 4);
            float s = (y0.x + y0.y) + (y0.z + y0.w) + (y1.x + y1.y) + (y1.z + y1.w) + (z0.x + z0.y) + (z0.z + z0.w) + (z1.x + z1.y) + (z1.z + z1.w);
            const float mean = wave_sum(s) * (1.f / D);
            y0 = y0 - mean; y1 = y1 - mean; z0 = z0 - mean; z1 = z1 - mean;
            float q = (y0.x * y0.x + y0.y * y0.y) + (y0.z * y0.z + y0.w * y0.w) + (y1.x * y1.x + y1.y * y1.y) + (y1.z * y1.z + y1.w * y1.w)
                    + (z0.x * z0.x + z0.y * z0.y) + (z0.z * z0.z + z0.w * z0.w) + (z1.x * z1.x + z1.y * z1.y) + (z1.z * z1.z + z1.w * z1.w);
            const float rstd = rsqrtf(wave_sum(q) * (1.f / D) + LN_EPS);
            const int cz = C.lane * 8;
            *(f32x4*)(row + cz) = z0 * rstd * *(const f32x4*)(C.ln2_g + cz) + *(const f32x4*)(C.ln2_b + cz);
            *(f32x4*)(row + cz + 4) = z1 * rstd * *(const f32x4*)(C.ln2_g + cz + 4) + *(const f32x4*)(C.ln2_b + cz + 4);
            *(f32x4*)(row + c0) = y0 * rstd * *(const f32x4*)(C.ln2_g + c0) + *(const f32x4*)(C.ln2_b + c0);
            *(f32x4*)(row + c0 + 4) = y1 * rstd * *(const f32x4*)(C.ln2_g + c0 + 4) + *(const f32x4*)(C.ln2_b + c0 + 4);
        }
    }
}

__device__ __forceinline__ void mkctx(Ctx& C, const Args& args, LAS unsigned char* ldsp) {
    C.lds = ldsp;
    C.tid = threadIdx.x; C.lane = C.tid & 63; C.wave = __builtin_amdgcn_readfirstlane(C.tid >> 6);
    C.gtid = blockIdx.x * NTHR + C.tid; C.GT = gridDim.x * NTHR; C.gw = blockIdx.x * NWAVES + C.wave; C.NGW = gridDim.x * NWAVES;
    C.x = args.in[0]; C.c = args.in[1]; C.w_ada = args.in[2]; C.b_ada = args.in[3]; C.w_in = args.in[4]; C.b_f = args.in[5];
    C.cmp_pos_k = args.in[6]; C.cmp_w1_k = args.in[7]; C.cmp_w2_k = args.in[8]; C.cmp_pos_v = args.in[9]; C.cmp_w1_v = args.in[10]; C.cmp_w2_v = args.in[11];
    C.rel_bias = args.in[12]; C.w_out = args.in[13]; C.ln1_g = args.in[14]; C.ln1_b = args.in[15]; C.w_router = args.in[16]; C.e_bias = args.in[17];
    C.w_gate = args.in[18]; C.w_up = args.in[19]; C.w_down = args.in[20]; C.ws_gate = args.in[21]; C.ws_up = args.in[22]; C.ws_down = args.in[23];
    C.ln2_g = args.in[24]; C.ln2_b = args.in[25];
    C.out = args.out;
    unsigned char* ws = args.ws; C.wsb = ws;
    C.mod = (float*)(ws + WS_MOD); C.cum = (float*)(ws + WS_CUM); C.kvc = (float*)(ws + WS_KVC); C.hid = (float*)(ws + WS_HID);
    C.selmask = (unsigned*)(ws + WS_SELM); C.scorebuf = (float*)(ws + WS_SCB); C.scores = (float*)(ws + WS_SCORES);
    C.eidx = (int*)(ws + WS_EIDX); C.ew = (float*)(ws + WS_EW); C.fg = (float*)(ws + WS_FG);
    C.win_t = (bf16*)(ws + WS_WIN_T); C.wout_t = (bf16*)(ws + WS_WOUT_T); C.ao16 = (bf16*)(ws + WS_AO16); C.oc = (bf16*)(ws + WS_OC); C.ow = (bf16*)(ws + WS_OW);
    C.hbuf = (bf16*)(ws + WS_HBUF); C.proj = (bf16*)(ws + WS_PROJ); C.h2lo = (bf16*)(ws + WS_PROJ);
    C.pc = (float*)(ws + WS_PC);
    C.wgu = (bf16*)(ws + WS_WGU); C.wdn = (bf16*)(ws + WS_WDN); C.act16 = (bf16*)(ws + WS_ACT16); C.slot = (bf16*)(ws + WS_SLOT);
    C.lrow = (int*)(ws + WS_LROW); C.lw = (float*)(ws + WS_LW); C.ctl = (gu32*)(ws + WS_CTL);
}
constexpr int N_PHASES = 17;
__global__ void __launch_bounds__(NTHR, 2) mk_fwd(Args args) {
    extern __shared__ __attribute__((aligned(16))) unsigned char lds[];
    volatile LAS unsigned* MISC = (volatile LAS unsigned*)((LAS unsigned char*)lds + MISC_OFF);
    if (threadIdx.x < 32) MISC[threadIdx.x] = 0u;
    __syncthreads();
    gu32* ctl = (gu32*)(args.ws + WS_CTL);
    XcdBarrier bar = xcd_barrier_post((unsigned*)(ctl + CW_BAR), MISC + 8);
    const int lo = args.ph_lo, hi = args.ph_hi;
#ifndef PHASE_MASK
#define PHASE_MASK 0xffffffffu
#endif
#define IN(k) (((PHASE_MASK >> (k)) & 1u) && lo <= (k) && (k) < hi)
#define SEAM(k) do { if (IN(k) && IN((k) + 1)) xcd_barrier(bar); } while (0)
    if (IN(0)) { Ctx C; mkctx(C, args, (LAS unsigned char*)lds); ph_prologue(C); ph_mod(C); }
    SEAM(0);
    if (IN(1)) { Ctx C; mkctx(C, args, (LAS unsigned char*)lds); ph_hpass(C); }
    SEAM(1);
    if (IN(2)) { Ctx C; mkctx(C, args, (LAS unsigned char*)lds);
        pg8::Gemm g{C.hbuf, C.win_t, T, 3072, D}; pg8::StaticOrder So; So.init(T, 3072, (int)gridDim.x, (int)blockIdx.x);
        pg8::EpiProj E{C.proj, C.fg, PITCH, C2};
        pg8::gemm_phase<pg8::EpiProj, pg8::StaticOrder, true, true>(C.lds, g, So, E);
    }
    SEAM(2);
    if (IN(3)) { Ctx C; mkctx(C, args, (LAS unsigned char*)lds); ph_cum_cmp1(C); }
    SEAM(3);
    if (IN(4)) { Ctx C; mkctx(C, args, (LAS unsigned char*)lds); ph_cmp2(C); xcd_barrier(bar); for (int i = C.gtid; i < NB * 8 * S; i += C.GT) cmp_attn_item(C, i); }
    SEAM(4);
    if (IN(5)) { Ctx C; mkctx(C, args, (LAS unsigned char*)lds); ph_attn_a(C, (char*)lds); }
    SEAM(5);
    if (IN(6)) { Ctx C; mkctx(C, args, (LAS unsigned char*)lds); ph_imp_topk(C); }
    SEAM(6);
    if (IN(7)) { Ctx C; mkctx(C, args, (LAS unsigned char*)lds); ph_attn_b(C, (char*)lds); }
    SEAM(7);
    if (IN(8)) { Ctx C; mkctx(C, args, (LAS unsigned char*)lds);
        pg8::Gemm g{C.ao16, C.wout_t, T, D, D}; pg8::StaticOrder So; So.init(T, D, (int)gridDim.x, (int)blockIdx.x);
        pg8::EpiOut E{C.x, C.mod, C.out, ALPHA};
        pg8::gemm_phase<pg8::EpiOut, pg8::StaticOrder, true, true>(C.lds, g, So, E);
    }
    SEAM(8);
    if (IN(9)) { Ctx C; mkctx(C, args, (LAS unsigned char*)lds); ph_ln<1>(C); ph_convert_experts(C); }
    SEAM(9);
    if (IN(10)) { Ctx C; mkctx(C, args, (LAS unsigned char*)lds); ph_router(C); }
    SEAM(10);
    if (IN(11)) { Ctx C; mkctx(C, args, (LAS unsigned char*)lds); ph_route(C); }
    SEAM(11);
    if (IN(12)) { Ctx C; mkctx(C, args, (LAS unsigned char*)lds); ph_moe_gateup(C); }
    SEAM(12);
    if (IN(13)) { Ctx C; mkctx(C, args, (LAS unsigned char*)lds); ph_moe_down<0>(C); }
    SEAM(13);
    if (IN(14)) { Ctx C; mkctx(C, args, (LAS unsigned char*)lds); ph_combine<0>(C); }
    SEAM(14);
    if (IN(15)) { Ctx C; mkctx(C, args, (LAS unsigned char*)lds); ph_moe_down<1>(C); }
    SEAM(15);
    if (IN(16)) { Ctx C; mkctx(C, args, (LAS unsigned char*)lds); ph_combine<1>(C); }
#undef IN
#undef SEAM
}

extern "C" void kernel_launch(void* const* d_in, const int* in_sizes, int n_in, void* d_out, int out_size, void* d_ws, size_t ws_size, hipStream_t stream) {
    static int grid = 0;
    if (grid == 0) {
        if (n_in != 26 || out_size != T * D || ws_size < WS_END) { fprintf(stderr, "kernel_launch: unexpected problem (n_in %d out %d ws %zu)\n", n_in, out_size, ws_size); grid = -1; return; }
        int dev = 0, cus = 0, per_cu = 0;
        if (hipGetDevice(&dev) != hipSuccess || hipDeviceGetAttribute(&cus, hipDeviceAttributeMultiprocessorCount, dev) != hipSuccess) { grid = -1; return; }
        if (hipFuncSetAttribute((const void*)mk_fwd, hipFuncAttributeMaxDynamicSharedMemorySize, LDS_BYTES) != hipSuccess) { fprintf(stderr, "kernel_launch: hipFuncSetAttribute failed\n"); grid = -1; return; }
        if (hipOccupancyMaxActiveBlocksPerMultiprocessor(&per_cu, (const void*)mk_fwd, NTHR, LDS_BYTES) != hipSuccess || per_cu < 1) { fprintf(stderr, "kernel_launch: occupancy query says %d\n", per_cu); grid = -1; (void)hipGetLastError(); return; }
        grid = cus;
    }
    if (grid < 0) return;
    (void)hipMemsetAsync((char*)d_ws + WS_CTL, 0, CTL_ZERO_BYTES, stream);
    Args a{};
    for (int i = 0; i < 26; ++i) a.in[i] = (const float*)d_in[i];
    a.out = (float*)d_out; a.ws = (unsigned char*)d_ws; a.ph_lo = 0; a.ph_hi = N_PHASES;
    hipLaunchKernelGGL(mk_fwd, dim3(grid), dim3(NTHR), LDS_BYTES, stream, a);
}
```

```cpp
#include <hip/hip_runtime.h>
#include <cstdio>
#include <cstdint>
#include <hip/hip_bf16.h>
#include <cmath>

#define GAS __attribute__((address_space(1)))
#define LAS __attribute__((address_space(3)))
typedef unsigned short bf16;
typedef float f32x4 __attribute__((ext_vector_type(4)));
typedef unsigned u32x4 __attribute__((ext_vector_type(4)));
typedef unsigned u32x2 __attribute__((ext_vector_type(2)));
typedef GAS unsigned gu32;
#define RLX_AGENT __ATOMIC_RELAXED, __HIP_MEMORY_SCOPE_AGENT

constexpr int D = 1024, NB = 8, S = 2048, T = NB * S;
constexpr int NPROJ = 2848;
constexpr int PITCH = 2816;
constexpr int PC_FQ = 0, PC_FK = 512, PC_FV = 1024, PC_NQ = 1536, PC_KC = 2048, PC_VC = 2176, PC_KS = 2304, PC_VS = 2432, PC_KW = 2560, PC_VW = 2688;
constexpr int FGW = 32;
constexpr int NCMP = 127;
constexpr float ALPHA = 1.189207115002721f;
constexpr float LN_EPS = 1e-5f;
constexpr float LOG2E = 1.4426950408889634f;
constexpr float C2 = 0.125f * LOG2E;
constexpr int NWAVES = 8, NTHR = NWAVES * 64;

constexpr size_t MiB = 1u << 20;
constexpr size_t WS_CTL = 0, CTL_ZERO_BYTES = 1 * MiB;
constexpr size_t WS_MOD = 1 * MiB, WS_CUM = 2 * MiB, WS_KVC = 3 * MiB, WS_W1T = 4 * MiB  , WS_KVC16 = 6 * MiB  , WS_W2T = 21 * MiB  , WS_POSB = 21 * MiB + 65536  , WS_WRT = 21 * MiB + 131072  , WS_SELM = 8 * MiB, WS_SCB = 9 * MiB, WS_SCORES = 13 * MiB,
                 WS_EIDX = 17 * MiB, WS_EW = 18 * MiB, WS_FG = 19 * MiB;
constexpr size_t WS_WIN_T = 22 * MiB;
constexpr size_t WS_WOUT_T = 28 * MiB;
constexpr size_t WS_HBUF = 30 * MiB;
constexpr size_t WS_PROJ = 62 * MiB;
constexpr size_t WS_PC = 150 * MiB;
constexpr size_t WS_AO16 = 214 * MiB;
constexpr size_t WS_OC = 246 * MiB, WS_OW = 262 * MiB;
constexpr size_t WS_WGU = 94 * MiB;
constexpr size_t WS_WDN = 167 * MiB;
constexpr size_t WS_ACT16 = 200 * MiB;
constexpr size_t WS_SLOT = 22 * MiB;
constexpr size_t WS_LROW = 280 * MiB, WS_LW = 285 * MiB;
constexpr size_t WS_END = 290 * MiB;
constexpr int CW_CNT = 16384;
constexpr int CW_BAR = 4096;

constexpr int LDS_BYTES = 147456;
constexpr int MISC_OFF = 131072 + 320;
constexpr int LDS_TSTART = 131072 + 1024, LDS_CNT = 131072 + 1536, LDS_TAB = 131072 + 2048;

#define XB_TMO      128
#define XB_XCNT(j)  (256  + 64 * (j))
#define XB_XSUB(j)  (1280 + 64 * (j))
#define XB_XGEN(j)  (2304 + 64 * (j))
#define XB_TOP      3328
#define XB_TOPGEN   3392
#define XCD_BAR_WORDS 3456
#define XB_SPIN_CAP (1u << 20)
__device__ __forceinline__ unsigned xb_ld(unsigned* p)              { return __hip_atomic_load(p, __ATOMIC_RELAXED, __HIP_MEMORY_SCOPE_AGENT); }
__device__ __forceinline__ unsigned xb_add(unsigned* p, unsigned v) { return __hip_atomic_fetch_add(p, v, __ATOMIC_RELAXED, __HIP_MEMORY_SCOPE_AGENT); }
__device__ __forceinline__ unsigned xb_xcc_id() { return (unsigned)__builtin_amdgcn_s_getreg((3 << 11) | 20) & 0xFu; }
#define XB_SPIN(cond, bar) do { unsigned _sp = 0; while (cond) { __builtin_amdgcn_s_sleep(1); \
    if ((++_sp & 255u) == 0u) { if (xb_ld(&(bar)[XB_TMO])) break; if (_sp > XB_SPIN_CAP) { atomicAdd(&(bar)[XB_TMO], 1u); break; } } } } while (0)
struct XcdBarrier { unsigned* bar; unsigned x; volatile LAS unsigned* st; };
__device__ __forceinline__ XcdBarrier xcd_barrier_post(unsigned* bar, volatile LAS unsigned* st) {
    XcdBarrier b; b.bar = bar; b.x = xb_xcc_id(); b.st = st;
    if (threadIdx.x == 0) (void)xb_add(&bar[XB_XCNT(b.x)], 1u);
    return b;
}
__device__ __forceinline__ void xcd_barrier_complete(unsigned* bar, unsigned x, unsigned& nloc, unsigned& nx) {
    const unsigned G = gridDim.x * gridDim.y * gridDim.z;
    unsigned sum, cnt, mine, sp = 0u;
    for (;;) {
        sum = 0u; cnt = 0u; mine = 0u;
#pragma unroll
        for (unsigned j = 0; j < 16; ++j) { const unsigned c = xb_ld(&bar[XB_XCNT(j)]); sum += c; cnt += (c > 0u) ? 1u : 0u; mine = (j == x) ? c : mine; }
        if (sum == G) break;
        __builtin_amdgcn_s_sleep(1);
        if ((++sp & 255u) == 0u) { if (xb_ld(&bar[XB_TMO])) break; if (sp > XB_SPIN_CAP) { atomicAdd(&bar[XB_TMO], 1u); break; } }
    }
    nloc = mine > 0u ? mine : 1u; nx = cnt > 0u ? cnt : 1u;
}
__device__ __forceinline__ void xcd_barrier(const XcdBarrier& b) {
    asm volatile("s_waitcnt vmcnt(0)" ::: "memory");
    __syncthreads();
    if (threadIdx.x == 0) {
        unsigned* bar = b.bar;
        __builtin_amdgcn_s_waitcnt(0);
        unsigned nloc = b.st[0], nx = b.st[1];
        if (nloc == 0u) { xcd_barrier_complete(bar, b.x, nloc, nx); b.st[0] = nloc; b.st[1] = nx; }
        const unsigned old = xb_add(&bar[XB_XSUB(b.x)], 1u);
        const unsigned gen = old / nloc;
        if (old + 1u == (gen + 1u) * nloc) {
            __builtin_amdgcn_fence(__ATOMIC_RELEASE, "agent");
            asm volatile("s_waitcnt vmcnt(0)" ::: "memory");
            const unsigned og = xb_add(&bar[XB_TOP], 1u);
            const unsigned tg = og / nx;
            if (og + 1u == (tg + 1u) * nx) xb_add(&bar[XB_TOPGEN], 1u);
            else XB_SPIN(xb_ld(&bar[XB_TOPGEN]) == tg, bar);
            __builtin_amdgcn_fence(__ATOMIC_ACQUIRE, "agent");
            xb_add(&bar[XB_XGEN(b.x)], 1u);
            asm volatile("s_waitcnt vmcnt(0)" ::: "memory");
        } else {
            XB_SPIN(xb_ld(&bar[XB_XGEN(b.x)]) == gen, bar);
            __builtin_amdgcn_fence(__ATOMIC_ACQUIRE, "agent");
            asm volatile("s_waitcnt vmcnt(0)" ::: "memory");
        }
    }
    __syncthreads();
}

namespace pg8 {
#define PG8_LAS __attribute__((address_space(3)))
typedef unsigned short bf16_t;
typedef short bf16x8 __attribute__((ext_vector_type(8)));
typedef float f32x4 __attribute__((ext_vector_type(4)));
typedef unsigned u32x4 __attribute__((ext_vector_type(4)));
constexpr int BM = 256, BK = 64, HALF = 128, HTB = HALF * BK * 2  , STAGE_BYTES = 8 * HTB, NXCD = 8, WGM = 8;

__host__ __device__ __forceinline__ int lds_byte(int r, int c) { const int st = (r >> 4) * 2 + (c >> 5), rr = r & 15, cc = c & 31, ob = rr * 64 + cc * 2; return st * 1024 + (ob ^ (((ob >> 9) & 1) << 5)); }
__host__ __device__ __forceinline__ void stage_rc(int b, int& R, int& C) { const int st = b / 1024, sb = b % 1024, swz = sb ^ (((sb >> 9) & 1) << 5); R = (st >> 1) * 16 + swz / 64; C = (st & 1) * 32 + (swz % 64) / 2; }
__host__ __device__ __forceinline__ int perm32(int rho) { const int n = rho >> 4, i = rho & 15; return 8 * (i >> 2) + 4 * n + (i & 3); }

struct Unit { int pm, pn; };
struct Gemm { const bf16_t* A; const bf16_t* Bt; int M, N, K; };

struct StaticOrder {
    int nM, nN, nwg, G, c;
    __host__ __device__ void init(int M, int N, int G_, int c_) { nM = M / BM; nN = N / BM; nwg = nM * nN; G = G_; c = c_; }
    __host__ __device__ bool next(int i, Unit& u) const {
        const long L = (long)i * G + c; if (L >= nwg) return false;
        int wgid = (int)L; { const int q = nwg / NXCD, r = nwg % NXCD, xcd = wgid % NXCD, off = wgid / NXCD; wgid = (xcd < r ? xcd * (q + 1) : r * (q + 1) + (xcd - r) * q) + off; }
        const int nig = WGM * nN, gid = wgid / nig, fm = gid * WGM, gsz = (nM - fm) < WGM ? (nM - fm) : WGM;
        u.pm = fm + ((wgid % nig) % gsz); u.pn = (wgid % nig) / gsz; return true;
    }
    __device__ __forceinline__ void a_ready(const Unit&) const {}
    __device__ __forceinline__ void done(const Unit&) const {}
};


__device__ __forceinline__ unsigned cvt_pk_bf16(float lo, float hi) { unsigned r; asm volatile("v_cvt_pk_bf16_f32 %0, %1, %2" : "=v"(r) : "v"(lo), "v"(hi)); return r; }
struct EpiProj {
    static constexpr bool PERM = true, AFTER_DRAIN = false;
    bf16_t* proj; float* fg; int pitch; float qscale;
    __device__ __forceinline__ void operator()(const f32x4 (&acc)[2][2][4][2], const Unit& u, int wr, int wc, int fr, int fq) const {
        const int row0 = u.pm * BM + wr * 64 + fr;
        if (u.pn < 11) {
            const float sc = (u.pn < 2 || u.pn == 6 || u.pn == 7) ? qscale : 1.f;
            const int col0 = u.pn * BM + wc * 32 + 8 * fq;
#pragma unroll
            for (int ai = 0; ai < 2; ++ai)
#pragma unroll
                for (int m = 0; m < 4; ++m) { bf16_t* rowp = proj + (size_t)(row0 + ai * HALF + m * 16) * pitch + col0;
#pragma unroll
                    for (int bj = 0; bj < 2; ++bj) { const f32x4 v0 = acc[ai][bj][m][0] * sc, v1 = acc[ai][bj][m][1] * sc;
                        u32x4 w; w.x = cvt_pk_bf16(v0[0], v0[1]); w.y = cvt_pk_bf16(v0[2], v0[3]); w.z = cvt_pk_bf16(v1[0], v1[1]); w.w = cvt_pk_bf16(v1[2], v1[3]);
                        *(u32x4*)(rowp + bj * HALF) = w; } }
        } else if (wc == 0) {
#pragma unroll
            for (int ai = 0; ai < 2; ++ai)
#pragma unroll
                for (int m = 0; m < 4; ++m) { float* fp = fg + (size_t)(row0 + ai * HALF + m * 16) * 32 + 8 * fq;
                    *(f32x4*)fp = acc[ai][0][m][0]; *(f32x4*)(fp + 4) = acc[ai][0][m][1]; }
        }
    }
};
struct EpiOut {
    static constexpr bool PERM = false, AFTER_DRAIN = false;
    const float* x; const float* mod; float* out; float alpha;
    __device__ __forceinline__ void operator()(const f32x4 (&acc)[2][2][4][2], const Unit& u, int wr, int wc, int fr, int fq) const {
        const int row0 = u.pm * BM + wr * 64 + fr;
#pragma unroll
        for (int ai = 0; ai < 2; ++ai)
#pragma unroll
            for (int m = 0; m < 4; ++m) { const int r = row0 + ai * HALF + m * 16; const float* g1 = mod + (r / 2048) * 6144 + 2048;
#pragma unroll
                for (int bj = 0; bj < 2; ++bj)
#pragma unroll
                    for (int n = 0; n < 2; ++n) { const int c = u.pn * BM + bj * HALF + wc * 32 + 16 * n + 4 * fq;
                        const f32x4 xv = *(const f32x4*)(x + (size_t)r * 1024 + c), gv = *(const f32x4*)(g1 + c);
                        *(f32x4*)(out + (size_t)r * 1024 + c) = xv * alpha + gv * acc[ai][bj][m][n]; } }
    }
};
template <class Epi, class Sched, bool ALIGN_EPI = false, bool SP2 = false>
__device__ __forceinline__ void gemm_phase(PG8_LAS unsigned char* lds, const Gemm g, const Sched& S, const Epi& E) {
    const int tid = threadIdx.x, wid = __builtin_amdgcn_readfirstlane(tid >> 6), lane = tid & 63, wr = wid >> 2, wc = wid & 3, fr = lane & 15, fq = lane >> 4;
    const int K = g.K, nt = K / BK;
    unsigned voffA[2], voffB[2];
#pragma unroll
    for (int i = 0; i < 2; ++i) { int R, C; stage_rc(tid * 16 + i * 8192, R, C); const int Rb = Epi::PERM ? ((R & ~31) + perm32(R & 31)) : R;
        voffA[i] = (unsigned)(R * K + C) * 2u; voffB[i] = (unsigned)(Rb * K + C) * 2u; }
    const size_t kstep = (size_t)(BK * 2);
    const size_t hstep = (size_t)HALF * K * 2;
    const size_t tstep = 2 * hstep;
    const unsigned ldsw = (unsigned)wid * 1024u;
    const int aoff = lds_byte(wr * 64 + fr, fq * 8), boff = lds_byte(wc * 32 + fr, fq * 8);
#define PG8_SA(b, h) (((b) * 2 + (h)) * HTB)
#define PG8_SB(b, h) ((4 + (b) * 2 + (h)) * HTB)
#define PG8_STAGE(bufoff, gbase, voff) do { _Pragma("unroll") for (int _i = 0; _i < 2; ++_i) \
        __builtin_amdgcn_global_load_lds((const unsigned*)((const char*)(gbase) + (voff)[_i]), (PG8_LAS unsigned*)(lds + (bufoff) + ldsw + _i * 8192), 16, 0, 0); } while (0)
#define PG8_LDA(dst, b, h) do { _Pragma("unroll") for (int m = 0; m < 4; ++m) _Pragma("unroll") for (int k = 0; k < 2; ++k) dst[m][k] = *(const PG8_LAS bf16x8*)(lds + PG8_SA(b, h) + aoff + m * 2048 + k * 1024); } while (0)
#define PG8_LDB(dst, b, h) do { _Pragma("unroll") for (int n = 0; n < 2; ++n) _Pragma("unroll") for (int k = 0; k < 2; ++k) dst[n][k] = *(const PG8_LAS bf16x8*)(lds + PG8_SB(b, h) + boff + n * 2048 + k * 1024); } while (0)
#define PG8_MMA(ai, bj, At, Bt) do { __builtin_amdgcn_s_setprio(1); _Pragma("unroll") for (int m = 0; m < 4; ++m) _Pragma("unroll") for (int n = 0; n < 2; ++n) _Pragma("unroll") for (int k = 0; k < 2; ++k) \
        acc[ai][bj][m][n] = __builtin_amdgcn_mfma_f32_16x16x32_bf16(Bt[n][k], At[m][k], acc[ai][bj][m][n], 0, 0, 0); __builtin_amdgcn_s_setprio(0); } while (0)
#define PG8_WAIT_V(n) asm volatile("s_waitcnt vmcnt(" #n ")" ::: "memory")
#define PG8_WAIT_L(n) asm volatile("s_waitcnt lgkmcnt(" #n ")" ::: "memory")
#define PG8_BAR __builtin_amdgcn_s_barrier()
#define PG8_SCHED __builtin_amdgcn_sched_barrier(0)
    Unit cur, nxt; int ui = 0;
    if (!S.next(0, cur)) return;
    f32x4 acc[2][2][4][2];
#pragma unroll
    for (int a = 0; a < 2; ++a)
#pragma unroll
        for (int b = 0; b < 2; ++b)
#pragma unroll
            for (int m = 0; m < 4; ++m)
#pragma unroll
                for (int n = 0; n < 2; ++n) acc[a][b][m][n] = (f32x4){0.f, 0.f, 0.f, 0.f};
    bf16x8 At[4][2], B0[2][2], B1[2][2];
    const char* cA = (const char*)g.A + (size_t)cur.pm * tstep; const char* cB = (const char*)g.Bt + (size_t)cur.pn * tstep;
    S.a_ready(cur);
    if constexpr (SP2) {
        PG8_STAGE(PG8_SB(0, 0), cB, voffB); PG8_STAGE(PG8_SB(0, 1), cB + hstep, voffB); PG8_STAGE(PG8_SA(0, 0), cA, voffA); PG8_STAGE(PG8_SA(0, 1), cA + hstep, voffA);
        if (wr == 1) PG8_BAR;
        PG8_WAIT_V(2); PG8_BAR;
        PG8_STAGE(PG8_SB(1, 0), cB + kstep, voffB); PG8_STAGE(PG8_SA(1, 0), cA + kstep, voffA); PG8_STAGE(PG8_SB(1, 1), cB + hstep + kstep, voffB);
        PG8_WAIT_V(6); PG8_BAR;
    } else {
        PG8_STAGE(PG8_SB(0, 0), cB, voffB); PG8_STAGE(PG8_SA(0, 0), cA, voffA); PG8_STAGE(PG8_SB(0, 1), cB + hstep, voffB); PG8_STAGE(PG8_SA(0, 1), cA + hstep, voffA);
        if (wr == 1) PG8_BAR;
        PG8_WAIT_V(4); PG8_BAR;
        PG8_STAGE(PG8_SB(1, 0), cB + kstep, voffB); PG8_STAGE(PG8_SA(1, 0), cA + kstep, voffA); PG8_STAGE(PG8_SB(1, 1), cB + hstep + kstep, voffB);
        PG8_WAIT_V(6); PG8_BAR;
    }
    for (;;) {
        const bool has_next = S.next(ui + 1, nxt);
        const char* nA = has_next ? (const char*)g.A + (size_t)nxt.pm * tstep : cA; const char* nB = has_next ? (const char*)g.Bt + (size_t)nxt.pn * tstep : cB;
        for (int t = 0; t < nt; t += 2) {
            const bool last = (t == nt - 2);
            const char* a1 = cA + (size_t)(t + 1) * kstep;
            const char* a2 = last ? nA : cA + (size_t)(t + 2) * kstep; const char* b2 = last ? nB : cB + (size_t)(t + 2) * kstep;
            const char* a3 = a2 + kstep; const char* b3 = b2 + kstep;
            if (last && has_next) S.a_ready(nxt);
            if constexpr (SP2) {
            PG8_LDB(B0, 0, 0); PG8_LDB(B1, 0, 1); PG8_SCHED; PG8_LDA(At, 0, 0); PG8_STAGE(PG8_SA(1, 1), a1 + hstep, voffA);
            PG8_WAIT_V(8); PG8_WAIT_L(0); PG8_BAR; PG8_MMA(0, 0, At, B0); PG8_MMA(0, 1, At, B1); PG8_BAR; PG8_SCHED;
            PG8_LDA(At, 0, 1); PG8_STAGE(PG8_SB(0, 0), b2, voffB); PG8_STAGE(PG8_SB(0, 1), b2 + hstep, voffB); PG8_STAGE(PG8_SA(0, 0), a2, voffA);
            PG8_WAIT_V(8); PG8_WAIT_L(0); PG8_BAR; PG8_MMA(1, 0, At, B0); PG8_MMA(1, 1, At, B1); PG8_BAR; PG8_SCHED;
            PG8_LDB(B0, 1, 0); PG8_LDB(B1, 1, 1); PG8_SCHED; PG8_LDA(At, 1, 0); PG8_STAGE(PG8_SA(0, 1), a2 + hstep, voffA);
            PG8_WAIT_V(8); PG8_WAIT_L(0); PG8_BAR; PG8_MMA(0, 0, At, B0); PG8_MMA(0, 1, At, B1); PG8_BAR; PG8_SCHED;
            PG8_LDA(At, 1, 1); PG8_STAGE(PG8_SB(1, 0), b3, voffB); PG8_STAGE(PG8_SB(1, 1), b3 + hstep, voffB); PG8_STAGE(PG8_SA(1, 0), a3, voffA);
            PG8_WAIT_V(8); PG8_WAIT_L(0); PG8_BAR; PG8_MMA(1, 0, At, B0); PG8_MMA(1, 1, At, B1); PG8_BAR; PG8_SCHED;
            } else {
            PG8_LDB(B0, 0, 0); PG8_SCHED; PG8_LDA(At, 0, 0); PG8_STAGE(PG8_SA(1, 1), a1 + hstep, voffA);
            PG8_WAIT_L(8); PG8_BAR; PG8_WAIT_L(0); PG8_MMA(0, 0, At, B0); PG8_BAR; PG8_SCHED;
            PG8_LDB(B1, 0, 1); PG8_STAGE(PG8_SB(0, 0), b2, voffB);
            PG8_BAR; PG8_WAIT_L(0); PG8_MMA(0, 1, At, B1); PG8_BAR;
            PG8_LDA(At, 0, 1); PG8_STAGE(PG8_SA(0, 0), a2, voffA);
            PG8_BAR; PG8_WAIT_L(0); PG8_MMA(1, 0, At, B0); PG8_BAR; PG8_SCHED;
            PG8_STAGE(PG8_SB(0, 1), b2 + hstep, voffB);
            PG8_WAIT_V(6); PG8_BAR; PG8_MMA(1, 1, At, B1); PG8_BAR;
            PG8_LDB(B0, 1, 0); PG8_SCHED; PG8_LDA(At, 1, 0); PG8_STAGE(PG8_SA(0, 1), a2 + hstep, voffA);
            PG8_WAIT_L(8); PG8_BAR; PG8_WAIT_L(0); PG8_MMA(0, 0, At, B0); PG8_BAR; PG8_SCHED;
            PG8_LDB(B1, 1, 1); PG8_STAGE(PG8_SB(1, 0), b3, voffB);
            PG8_BAR; PG8_WAIT_L(0); PG8_MMA(0, 1, At, B1); PG8_BAR;
            PG8_LDA(At, 1, 1); PG8_STAGE(PG8_SA(1, 0), a3, voffA);
            PG8_BAR; PG8_WAIT_L(0); PG8_MMA(1, 0, At, B0); PG8_BAR; PG8_SCHED;
            PG8_STAGE(PG8_SB(1, 1), b3 + hstep, voffB);
            PG8_WAIT_V(6); PG8_BAR; PG8_MMA(1, 1, At, B1); PG8_BAR;
            }
        }
        if constexpr (ALIGN_EPI) { if (wr == 0) PG8_BAR; }
        if constexpr (!Epi::AFTER_DRAIN) { E(acc, cur, wr, wc, fr, fq); S.done(cur); }
        if (!has_next) break;
#pragma unroll
        for (int a = 0; a < 2; ++a)
#pragma unroll
            for (int b = 0; b < 2; ++b)
#pragma unroll
                for (int m = 0; m < 4; ++m)
#pragma unroll
                    for (int n = 0; n < 2; ++n) acc[a][b][m][n] = (f32x4){0.f, 0.f, 0.f, 0.f};
        cur = nxt; cA = nA; cB = nB; ++ui;
        if constexpr (ALIGN_EPI) { if (wr == 1) PG8_BAR; }
    }
    PG8_WAIT_V(0);
    if constexpr (!ALIGN_EPI) { if (wr == 0) PG8_BAR; }
    PG8_BAR;
    if constexpr (Epi::AFTER_DRAIN) { E.fused(acc, cur, wr, wc, fr, fq, lds, wid, lane); S.done(cur); }
#undef PG8_SA
#undef PG8_SB
#undef PG8_STAGE
#undef PG8_LDA
#undef PG8_LDB
#undef PG8_MMA
#undef PG8_WAIT_V
#undef PG8_WAIT_L
#undef PG8_BAR
#undef PG8_SCHED
}
struct UnitM { int e, mt, pn, arow0, nvalid; };
constexpr int TAB_SLOT_BYTES = 2048;
template <class Epi, class Sched, bool GATHER>
__device__ __forceinline__ void gemm_phase_g(PG8_LAS unsigned char* lds, PG8_LAS unsigned char* tab, const bf16_t* A, const int K, const Sched& S, const Epi& E) {
    const int tid = threadIdx.x, wid = __builtin_amdgcn_readfirstlane(tid >> 6), lane = tid & 63, wr = wid >> 2, wc = wid & 3, fr = lane & 15, fq = lane >> 4;
    const int nt = K / BK;
    unsigned voffB[2];
#pragma unroll
    for (int i = 0; i < 2; ++i) { int R, C; stage_rc(tid * 16 + i * 8192, R, C); const int Rb = Epi::PERM ? ((R & ~31) + perm32(R & 31)) : R;
        voffB[i] = (unsigned)(Rb * K + C) * 2u; }
    const size_t kstep = (size_t)(BK * 2);
    const size_t hstep = (size_t)HALF * K * 2;
    const unsigned ldsw = (unsigned)wid * 1024u;
    const int aoff = lds_byte(wr * 64 + fr, fq * 8), boff = lds_byte(wc * 32 + fr, fq * 8);
#define PG8_SA(b, h) (((b) * 2 + (h)) * HTB)
#define PG8_SB(b, h) ((4 + (b) * 2 + (h)) * HTB)
#define PG8_STAGE(bufoff, gbase, voff) do { _Pragma("unroll") for (int _i = 0; _i < 2; ++_i) \
        __builtin_amdgcn_global_load_lds((const unsigned*)((const char*)(gbase) + (voff)[_i]), (PG8_LAS unsigned*)(lds + (bufoff) + ldsw + _i * 8192), 16, 0, 0); } while (0)
#define PG8_STAGEA(bufoff, gbase, o0, o1) do { \
        __builtin_amdgcn_global_load_lds((const unsigned*)((const char*)(gbase) + (o0)), (PG8_LAS unsigned*)(lds + (bufoff) + ldsw), 16, 0, 0); \
        __builtin_amdgcn_global_load_lds((const unsigned*)((const char*)(gbase) + (o1)), (PG8_LAS unsigned*)(lds + (bufoff) + ldsw + 8192), 16, 0, 0); } while (0)
#define PG8_LDA(dst, b, h) do { _Pragma("unroll") for (int m = 0; m < 4; ++m) _Pragma("unroll") for (int k = 0; k < 2; ++k) dst[m][k] = *(const PG8_LAS bf16x8*)(lds + PG8_SA(b, h) + aoff + m * 2048 + k * 1024); } while (0)
#define PG8_LDB(dst, b, h) do { _Pragma("unroll") for (int n = 0; n < 2; ++n) _Pragma("unroll") for (int k = 0; k < 2; ++k) dst[n][k] = *(const PG8_LAS bf16x8*)(lds + PG8_SB(b, h) + boff + n * 2048 + k * 1024); } while (0)
#define PG8_MMA(ai, bj, At, Bt) do { __builtin_amdgcn_s_setprio(1); _Pragma("unroll") for (int m = 0; m < 4; ++m) _Pragma("unroll") for (int n = 0; n < 2; ++n) _Pragma("unroll") for (int k = 0; k < 2; ++k) \
        acc[ai][bj][m][n] = __builtin_amdgcn_mfma_f32_16x16x32_bf16(Bt[n][k], At[m][k], acc[ai][bj][m][n], 0, 0, 0); __builtin_amdgcn_s_setprio(0); } while (0)
#define PG8_WAIT_V(n) asm volatile("s_waitcnt vmcnt(" #n ")" ::: "memory")
#define PG8_WAIT_L(n) asm volatile("s_waitcnt lgkmcnt(" #n ")" ::: "memory")
#define PG8_BAR __builtin_amdgcn_s_barrier()
#define PG8_SCHED __builtin_amdgcn_sched_barrier(0)
#define PG8_AOFFS(dst, u, tslot) do { _Pragma("unroll") for (int h = 0; h < 2; ++h) _Pragma("unroll") for (int i = 0; i < 2; ++i) { int RA_, CA_; stage_rc(tid * 16 + i * 8192, RA_, CA_); const int R_ = h * HALF + RA_; int row_; \
        if (GATHER) { const int inf_ = *(const PG8_LAS int*)(tab + (tslot) * TAB_SLOT_BYTES + R_ * 4); row_ = R_ < (u).nvalid ? (inf_ >> 4) : 0; } else row_ = (u).arow0 + R_; \
        dst[h][i] = (unsigned)(row_ * K + CA_) * 2u; } } while (0)
    UnitM cur, nxt; int ui = 0;
    if (!S.next(0, cur)) return;
    if (wid == 0) S.load_tab(cur, tab, lane);
    asm volatile("s_waitcnt vmcnt(0)" ::: "memory"); __builtin_amdgcn_s_barrier(); asm volatile("" ::: "memory");
    f32x4 acc[2][2][4][2];
#pragma unroll
    for (int a = 0; a < 2; ++a)
#pragma unroll
        for (int b = 0; b < 2; ++b)
#pragma unroll
            for (int m = 0; m < 4; ++m)
#pragma unroll
                for (int n = 0; n < 2; ++n) acc[a][b][m][n] = (f32x4){0.f, 0.f, 0.f, 0.f};
    bf16x8 At[4][2], B0[2][2], B1[2][2];
    unsigned cao[2][2];
    PG8_AOFFS(cao, cur, 0);
    const char* cB = S.b_base(cur);
    const char* Ab = (const char*)A;
    PG8_STAGE(PG8_SB(0, 0), cB, voffB); PG8_STAGE(PG8_SB(0, 1), cB + hstep, voffB); PG8_STAGEA(PG8_SA(0, 0), Ab, cao[0][0], cao[0][1]); PG8_STAGEA(PG8_SA(0, 1), Ab, cao[1][0], cao[1][1]);
    if (wr == 1) PG8_BAR;
    PG8_WAIT_V(2); PG8_BAR;
    PG8_STAGE(PG8_SB(1, 0), cB + kstep, voffB); PG8_STAGEA(PG8_SA(1, 0), Ab + kstep, cao[0][0], cao[0][1]); PG8_STAGE(PG8_SB(1, 1), cB + hstep + kstep, voffB);
    PG8_WAIT_V(6); PG8_BAR;
    for (;;) {
        const bool has_next = S.next(ui + 1, nxt);
        const int tslot_n = (ui + 1) % 3;
        if (has_next && wid == 0) S.load_tab(nxt, tab + tslot_n * TAB_SLOT_BYTES, lane);
        const char* nB = has_next ? S.b_base(nxt) : cB;
#pragma unroll 1
        for (int t = 0; t < nt; t += 2) {
            const bool last = (t == nt - 2);
            const char* a1 = Ab + (size_t)(t + 1) * kstep;
            const char* a2 = last ? Ab : Ab + (size_t)(t + 2) * kstep; const char* b2 = last ? nB : cB + (size_t)(t + 2) * kstep;
            const char* a3 = a2 + kstep; const char* b3 = b2 + kstep;
            PG8_LDB(B0, 0, 0); PG8_LDB(B1, 0, 1); PG8_SCHED; PG8_LDA(At, 0, 0); PG8_STAGEA(PG8_SA(1, 1), a1, cao[1][0], cao[1][1]);
            PG8_WAIT_V(8); PG8_WAIT_L(0); PG8_BAR; PG8_MMA(0, 0, At, B0); PG8_MMA(0, 1, At, B1); PG8_BAR; PG8_SCHED;
            if (last && has_next) { PG8_AOFFS(cao, nxt, tslot_n); }
            PG8_LDA(At, 0, 1); PG8_STAGE(PG8_SB(0, 0), b2, voffB); PG8_STAGE(PG8_SB(0, 1), b2 + hstep, voffB); PG8_STAGEA(PG8_SA(0, 0), a2, cao[0][0], cao[0][1]);
            PG8_WAIT_V(8); PG8_WAIT_L(0); PG8_BAR; PG8_MMA(1, 0, At, B0); PG8_MMA(1, 1, At, B1); PG8_BAR; PG8_SCHED;
            PG8_LDB(B0, 1, 0); PG8_LDB(B1, 1, 1); PG8_SCHED; PG8_LDA(At, 1, 0); PG8_STAGEA(PG8_SA(0, 1), a2, cao[1][0], cao[1][1]);
            PG8_WAIT_V(8); PG8_WAIT_L(0); PG8_BAR; PG8_MMA(0, 0, At, B0); PG8_MMA(0, 1, At, B1); PG8_BAR; PG8_SCHED;
            PG8_LDA(At, 1, 1); PG8_STAGE(PG8_SB(1, 0), b3, voffB); PG8_STAGE(PG8_SB(1, 1), b3 + hstep, voffB); PG8_STAGEA(PG8_SA(1, 0), a3, cao[0][0], cao[0][1]);
            PG8_WAIT_V(8); PG8_WAIT_L(0); PG8_BAR; PG8_MMA(1, 0, At, B0); PG8_MMA(1, 1, At, B1); PG8_BAR; PG8_SCHED;
        }
        if (wr == 0) PG8_BAR;
        E(acc, cur, wr, wc, fr, fq, tab + (ui % 3) * TAB_SLOT_BYTES);
        if (!has_next) break;
#pragma unroll
        for (int a = 0; a < 2; ++a)
#pragma unroll
            for (int b = 0; b < 2; ++b)
#pragma unroll
                for (int m = 0; m < 4; ++m)
#pragma unroll
                    for (int n = 0; n < 2; ++n) acc[a][b][m][n] = (f32x4){0.f, 0.f, 0.f, 0.f};
        cur = nxt; cB = nB; ++ui;
        if (wr == 1) PG8_BAR;
    }
    PG8_WAIT_V(0);
    PG8_BAR;
#undef PG8_SA
#undef PG8_SB
#undef PG8_STAGE
#undef PG8_STAGEA
#undef PG8_LDA
#undef PG8_LDB
#undef PG8_MMA
#undef PG8_WAIT_V
#undef PG8_WAIT_L
#undef PG8_BAR
#undef PG8_SCHED
#undef PG8_AOFFS
}
struct MoeSched {
    const PG8_LAS int* tstart; const PG8_LAS int* cnt;
    const int* lrow; const float* lw;
    const char* Bt; size_t e_stride, pn_stride;
    int MT, NP, pn0, G, c;
    __device__ __forceinline__ bool next(int i, UnitM& u) const {
        const int L = i * G + c; if (L >= MT * NP) return false;
        const int mtg = L / NP; u.pn = pn0 + L % NP;
        int e = 0;
        for (int k = 1; k < 65; ++k) e += (tstart[k] <= mtg) ? 1 : 0;
        u.e = e; u.mt = mtg - tstart[e]; u.arow0 = mtg * 256; const int rem = cnt[e] - u.mt * 256; u.nvalid = rem < 256 ? rem : 256;
        return true;
    }
    __device__ __forceinline__ const char* b_base(const UnitM& u) const { return Bt + (size_t)u.e * e_stride + (size_t)u.pn * pn_stride; }
    __device__ __forceinline__ void load_tab(const UnitM& u, PG8_LAS unsigned char* dst, int lane) const {
        const size_t off = (size_t)u.e * 16384 + u.mt * 256 + lane * 4;
        __builtin_amdgcn_global_load_lds((const unsigned*)(lrow + off), (PG8_LAS unsigned*)dst, 16, 0, 0);
        __builtin_amdgcn_global_load_lds((const unsigned*)(lw + off), (PG8_LAS unsigned*)(dst + 1024), 16, 0, 0);
    }
};
struct EpiAct {
    static constexpr bool PERM = true;
    bf16_t* act;
    __device__ __forceinline__ void operator()(const f32x4 (&acc)[2][2][4][2], const UnitM& u, int wr, int wc, int fr, int fq, const PG8_LAS unsigned char* tab) const {
#pragma unroll
        for (int ai = 0; ai < 2; ++ai)
#pragma unroll
            for (int m = 0; m < 4; ++m) { const int r = ai * HALF + wr * 64 + m * 16 + fr;
                float w = *(const PG8_LAS float*)(tab + 1024 + r * 4); w = r < u.nvalid ? w : 0.f;
                float v[8];
#pragma unroll
                for (int n = 0; n < 2; ++n)
#pragma unroll
                    for (int i = 0; i < 4; ++i) { const float g = acc[ai][0][m][n][i], up = acc[ai][1][m][n][i];
                        v[n * 4 + i] = g * __builtin_amdgcn_rcpf(1.f + __builtin_amdgcn_exp2f(-1.4426950408889634f * g)) * up * w; }
                u32x4 o; o.x = cvt_pk_bf16(v[0], v[1]); o.y = cvt_pk_bf16(v[2], v[3]); o.z = cvt_pk_bf16(v[4], v[5]); o.w = cvt_pk_bf16(v[6], v[7]);
                *(u32x4*)(act + (size_t)(u.arow0 + r) * 256 + u.pn * 128 + wc * 32 + 8 * fq) = o; }
    }
};
struct EpiSlot {
    static constexpr bool PERM = true;
    bf16_t* slot; int pn_half0; unsigned dump_row;
    __device__ __forceinline__ void operator()(const f32x4 (&acc)[2][2][4][2], const UnitM& u, int wr, int wc, int fr, int fq, const PG8_LAS unsigned char* tab) const {
#pragma unroll
        for (int ai = 0; ai < 2; ++ai)
#pragma unroll
            for (int m = 0; m < 4; ++m) { const int r = ai * HALF + wr * 64 + m * 16 + fr;
                const int inf = *(const PG8_LAS int*)(tab + r * 4);
                const unsigned srow = r < u.nvalid ? (unsigned)(inf >> 4) * 9u + (unsigned)(inf & 15) : dump_row;
                bf16_t* dst = slot + (size_t)srow * 512 + (u.pn - pn_half0) * 256 + wc * 32 + 8 * fq;
#pragma unroll
                for (int bj = 0; bj < 2; ++bj) { const f32x4 v0 = acc[ai][bj][m][0], v1 = acc[ai][bj][m][1];
                    u32x4 o; o.x = cvt_pk_bf16(v0[0], v0[1]); o.y = cvt_pk_bf16(v0[2], v0[3]); o.z = cvt_pk_bf16(v1[0], v1[1]); o.w = cvt_pk_bf16(v1[2], v1[3]);
                    *(u32x4*)(dst + bj * HALF) = o; }
                asm volatile("" ::: "memory"); }
    }
};
}

namespace attn_body {
using bf16=__hip_bfloat16;
using bf16x8=__attribute__((ext_vector_type(8)))short;
using s16x4=__attribute__((ext_vector_type(4)))short;
using f32x16=__attribute__((ext_vector_type(16)))float;
using u32x4=__attribute__((ext_vector_type(4)))unsigned;
using f32x4_t=__attribute__((ext_vector_type(4)))float;
constexpr int SEQ=2048,D=64,DM=2816;
constexpr int NW=8,QBLK=32,QB=QBLK*NW,KVBLK=64,NQB=SEQ/QB;
__device__ __forceinline__ int crow(int r,int hi){return (r&3)+8*(r>>2)+4*hi;}
#define SBAR() __builtin_amdgcn_sched_barrier(0)
__device__ __forceinline__ void cmask(f32x16&p0,f32x16&p1,int jb,int qrel,int hi){
  const float NEG=-INFINITY; int lim=qrel-64*jb-4*hi; asm volatile("":"+v"(lim));
  #pragma unroll
  for(int r=0;r<16;++r){const int c=(r&3)+8*(r>>2); if(c>lim)p0[r]=NEG; if(c+32>lim)p1[r]=NEG;}
}

typedef __attribute__((address_space(3))) const float* lds_fptr;
template<int MODE> __device__ __forceinline__ void tilefix(f32x16&p0,f32x16&p1,int t,int NT,int ta,int qrel,int hi,lds_fptr cl,lds_fptr dt,unsigned maskq,float mhat){
  const float NEG=-INFINITY;
  if(MODE==0){
  } else {
    #pragma unroll
    for(int r=0;r<16;++r){p0[r]-=mhat;p1[r]-=mhat;}
  }
  if(MODE==1){ if(__any(((maskq>>ta)&1u)==0u)){ const bool off=((maskq>>ta)&1u)==0u;
      #pragma unroll
      for(int r=0;r<16;++r){p0[r]=off?NEG:p0[r];p1[r]=off?NEG:p1[r];} } }
  if(MODE!=0){
    int dbase=qrel+64*(NT-4-t)-4*hi; asm volatile("":"+v"(dbase));
    if(MODE==2 && t<4){
      { int e511=dbase-511; asm volatile("":"+v"(e511));
      #pragma unroll
      for(int r=0;r<16;++r){ if(e511>((r&3)+8*(r>>2)))p0[r]=NEG; if(e511>((r&3)+8*(r>>2)+32))p1[r]=NEG; } } }
    if(t>=NT-6){
      #pragma unroll
      for(int g=0;g<4;++g){
        #pragma unroll
        for(int i=0;i<4;++i){const int r=4*g+i; const int d=dbase-((r&3)+8*(r>>2)); const int i0=min(max(d,0),127),i1=min(max(d-32,0),127); p0[r]+=dt[i0]; p1[r]+=dt[i1];}
        __builtin_amdgcn_sched_barrier(0); } }
  }
  { const int jb=t-(NT-4); if(jb>=0)cmask(p0,p1,jb,qrel,hi); }
}

constexpr int NSLOT=3, SLOTB=8192;
constexpr int LDS_K=0, LDS_V=NSLOT*SLOTB, LDS_WS=2*NSLOT*SLOTB, LDS_OST=LDS_WS+NW*64*4, LDS_CUM=LDS_OST+NW*4096, LDS_DT=LDS_CUM+8192, LDS_BYTES=LDS_DT+4096;
constexpr float C2=0.125f*1.4426950408889634f;
__device__ __forceinline__ void glds16(const void*gsrc,unsigned lds_dst){unsigned keep;
  asm volatile("s_mov_b32 %0, m0\n\ts_mov_b32 m0, %2\n\ts_nop 0\n\tglobal_load_lds_dwordx4 %1, off\n\ts_mov_b32 m0, %0":"=&s"(keep):"v"(gsrc),"s"(lds_dst):"memory");}
__device__ __forceinline__ float max3f(float a,float b,float c){float r;asm("v_max3_f32 %0, %1, %2, %3":"=v"(r):"v"(a),"v"(b),"v"(c));return r;}
__device__ __forceinline__ float max2f(float a,float b){float r;asm("v_max_f32_e32 %0, %1, %2":"=v"(r):"v"(a),"v"(b));return r;}
__device__ __forceinline__ float fadd_s(float a,float b){float r;asm("v_add_f32_e32 %0, %1, %2":"=v"(r):"v"(a),"v"(b));return r;}
__device__ __forceinline__ float fsub_s(float a,float b){float r;asm("v_sub_f32_e32 %0, %1, %2":"=v"(r):"v"(a),"v"(b));return r;}
typedef float f32x2_t __attribute__((ext_vector_type(2))); typedef __bf16 bf16x2_t __attribute__((ext_vector_type(2)));
__device__ __forceinline__ unsigned cvtpk_s(float lo,float hi){f32x2_t v={lo,hi};bf16x2_t b=__builtin_convertvector(v,bf16x2_t);return __builtin_bit_cast(unsigned,b);}
#define WAIT_BAR(N) asm volatile("s_waitcnt vmcnt(" #N ") lgkmcnt(0)\n\ts_barrier":::"memory")

__device__ __forceinline__ void qkt(f32x16&p0,f32x16&p1,const char*Kslot,const bf16x8*qr,const f32x16&ci0,const f32x16&ci1,int r32,int hi){
  const char*kb=Kslot+hi*1024+r32*16;
  #pragma unroll
  for(int d0=0;d0<4;++d0){
    const bf16x8 b0=*reinterpret_cast<const bf16x8*>(kb+d0*2048);
    const bf16x8 b1=*reinterpret_cast<const bf16x8*>(kb+d0*2048+512);
    if(d0==0){p0=__builtin_amdgcn_mfma_f32_32x32x16_bf16(b0,qr[0],ci0,0,0,0);p1=__builtin_amdgcn_mfma_f32_32x32x16_bf16(b1,qr[0],ci1,0,0,0);}
    else{p0=__builtin_amdgcn_mfma_f32_32x32x16_bf16(b0,qr[d0],p0,0,0,0);p1=__builtin_amdgcn_mfma_f32_32x32x16_bf16(b1,qr[d0],p1,0,0,0);}}
}
typedef __attribute__((address_space(3))) const char* lds_cptr;
typedef short v4i16_t __attribute__((ext_vector_type(4)));
__device__ __forceinline__ void kload8(bf16x8*kf,lds_cptr kp){
  kf[0]=*(const __attribute__((address_space(3))) bf16x8*)(kp);      kf[1]=*(const __attribute__((address_space(3))) bf16x8*)(kp+512);
  kf[2]=*(const __attribute__((address_space(3))) bf16x8*)(kp+2048); kf[3]=*(const __attribute__((address_space(3))) bf16x8*)(kp+2560);
  kf[4]=*(const __attribute__((address_space(3))) bf16x8*)(kp+4096); kf[5]=*(const __attribute__((address_space(3))) bf16x8*)(kp+4608);
  kf[6]=*(const __attribute__((address_space(3))) bf16x8*)(kp+6144); kf[7]=*(const __attribute__((address_space(3))) bf16x8*)(kp+6656);
}
__device__ __forceinline__ void kload2(bf16x8*kf,lds_cptr kp,int j){ kf[2*j]=*(const __attribute__((address_space(3))) bf16x8*)(kp+j*2048); kf[2*j+1]=*(const __attribute__((address_space(3))) bf16x8*)(kp+j*2048+512); }
__device__ __forceinline__ s16x4 vtr(lds_cptr p){ return __builtin_bit_cast(s16x4,__builtin_amdgcn_ds_read_tr16_b64_v4i16((__attribute__((address_space(3))) v4i16_t*)p)); }
__device__ __forceinline__ float rowmax(const f32x16&p0,const f32x16&p1){
  float a=max3f(p0[0],p0[1],p1[0]),b=max3f(p0[2],p0[3],p1[1]);a=max3f(a,p1[2],p1[3]);
  #pragma unroll
  for(int r=4;r<16;r+=4){a=max3f(a,p0[r],p0[r+1]);b=max3f(b,p0[r+2],p0[r+3]);a=max3f(a,p1[r],p1[r+1]);b=max3f(b,p1[r+2],p1[r+3]);}
  const float m=max2f(a,b);
  auto rr=__builtin_amdgcn_permlane32_swap(__float_as_uint(m),__float_as_uint(m),false,false);
  return max2f(__uint_as_float(rr[0]),__uint_as_float(rr[1]));
}
__device__ __forceinline__ void pv(f32x16*o,int vb,bf16x8 pa0,bf16x8 pa1,bf16x8 pa2,bf16x8 pa3){
  #pragma unroll
  for(int d0=0;d0<2;++d0){s16x4 lo[4],hi[4];
    #pragma unroll
    for(int ks=0;ks<4;++ks){
      asm volatile("ds_read_b64_tr_b16 %0,%1 offset:%c2":"=&v"(lo[ks]):"v"(vb),"i"(d0*4096+ks*1024):"memory");
      asm volatile("ds_read_b64_tr_b16 %0,%1 offset:%c2":"=&v"(hi[ks]):"v"(vb),"i"(d0*4096+ks*1024+512):"memory");}
    asm volatile("s_waitcnt lgkmcnt(0)":::"memory");SBAR();
    #define PK(k) (bf16x8){lo[k][0],lo[k][1],lo[k][2],lo[k][3],hi[k][0],hi[k][1],hi[k][2],hi[k][3]}
    o[d0]=__builtin_amdgcn_mfma_f32_32x32x16_bf16(pa0,PK(0),o[d0],0,0,0);
    o[d0]=__builtin_amdgcn_mfma_f32_32x32x16_bf16(pa1,PK(1),o[d0],0,0,0);
    o[d0]=__builtin_amdgcn_mfma_f32_32x32x16_bf16(pa2,PK(2),o[d0],0,0,0);
    o[d0]=__builtin_amdgcn_mfma_f32_32x32x16_bf16(pa3,PK(3),o[d0],0,0,0);
    #undef PK
  }
}

__device__ __forceinline__ void attn_fill_dt(char*shm,const float*rel_bias){
  const int tid=threadIdx.x;
  #pragma unroll
  for(int k=0;k<2;++k){ const int e=tid+512*k, hh=e>>7, n=e&127;
    const int bk=n<16?n:16+(n>=19)+(n>=21)+(n>=24)+(n>=27)+(n>=31)+(n>=35)+(n>=40)+(n>=46)+(n>=52)+(n>=59)+(n>=67)+(n>=77)+(n>=87)+(n>=99)+(n>=113);
    ((float*)(shm+LDS_DT))[e]=(rel_bias[bk*8+hh]-rel_bias[31*8+hh])*1.4426950408889634f; }
  __syncthreads();
}
#ifndef ATTN_STORE16
#define ATTN_STORE16(p,v) (*(u32x4*)(p)=(v))
#endif
struct AttnIO { unsigned char* ws; };
#define IO_PROJ ((const bf16*)(io.ws+WS_PROJ))
#define IO_CUM ((const float*)(io.ws+WS_CUM))
#define IO_SELM ((const unsigned*)(io.ws+WS_SELM))
#define IO_FG ((const float*)(io.ws+WS_FG))
#define IO_OC ((const bf16*)(io.ws+WS_OC))
#define IO_OW ((bf16*)(io.ws+WS_OW))
#define IO_AO16 ((bf16*)(io.ws+WS_AO16))

template<int MODE,int THRL> __device__ __forceinline__ void attn_unit(int b,int h,int qb,const AttnIO&io,char*shm,const int tidv){
  const int tid=tidv,lane=tid&63,r32=lane&31,hi=lane>>5; const int wid=__builtin_amdgcn_readfirstlane(tid>>6);
  const long rowbase=(long)b*SEQ; const int q0=qb*QB; const int g=h>>2;
  const int NT=(MODE==2)?((4*qb+4)<12?(4*qb+4):12):(4*qb+4);
  const int t0=4*qb+4-NT;
  const int qcol=(MODE==0?0:1536)+h*D, kcol=(MODE==0?512+h*D:(MODE==1?2304:2560)+g*D), vcol=(MODE==0?1024+h*D:(MODE==1?2432:2688)+g*D);
  const bf16*Qw=IO_PROJ+(rowbase+q0+wid*QBLK)*DM+qcol;
  const bf16*Kh=IO_PROJ+(rowbase+(long)t0*KVBLK)*DM+kcol,*Vh=IO_PROJ+(rowbase+(long)t0*KVBLK)*DM+vcol;
  const unsigned lds0=(unsigned)(uintptr_t)shm;
  float*wsf=(float*)(shm+LDS_WS)+wid*64;
  const bf16*ksrc=Kh+(long)lane*DM+wid*8;
  const bf16*vsrc=Vh+(long)(16*(wid&3)+(lane>>2))*DM+(wid>>2)*32+(lane&3)*8;
  const unsigned kdst=lds0+LDS_K+wid*1024, vdst=lds0+LDS_V+wid*1024;
  #define DMA_K(t,slot) glds16(ksrc+(long)(t)*KVBLK*DM,(unsigned)__builtin_amdgcn_readfirstlane(kdst+(slot)))
  #define DMA_V(t,slot) glds16(vsrc+(long)(t)*KVBLK*DM,(unsigned)__builtin_amdgcn_readfirstlane(vdst+(slot)))
  const int vb0=(int)(lds0+LDS_V)+((lane>>4)&1)*32+(lane&3)*8+(4*hi+((lane&15)>>2))*64;
  const char*Kbase=shm+LDS_K; bf16x8 kf[8];
  const lds_cptr shm3=(lds_cptr)shm; const lds_cptr kp0=shm3+LDS_K+hi*1024+r32*16; const lds_cptr vp0=shm3+LDS_V+((lane>>4)&1)*32+(lane&3)*8+(4*hi+((lane&15)>>2))*64;
  DMA_K(0,0);DMA_V(0,0);DMA_K(1,SLOTB);
  bf16x8 qr[4];
  #pragma unroll
  for(int d0=0;d0<4;++d0)qr[d0]=*reinterpret_cast<const bf16x8*>(&Qw[(long)r32*DM+d0*16+hi*8]);
  const lds_cptr qst=(lds_cptr)shm+LDS_OST+wid*4096+lane*16;
  #pragma unroll
  for(int d0=0;d0<4;++d0)*(__attribute__((address_space(3))) bf16x8*)((__attribute__((address_space(3))) char*)qst+d0*1024)=qr[d0];
  const lds_fptr cl=(lds_fptr)(shm+LDS_CUM), dt=(lds_fptr)(shm+LDS_DT)+h*128;
  unsigned maskq=0xffffffffu;
  if(MODE==0){ const f32x4_t c4=*(const f32x4_t*)(IO_CUM+((long)(b*8+h))*SEQ+tid*4); *(f32x4_t*)(shm+LDS_CUM+tid*16)=c4*1.4426950408889634f; }
  else {
    if(MODE==1) maskq=IO_SELM[((long)(b*2+g))*SEQ+q0+wid*QBLK+r32]; }
  float mhat=0.f,l_reg=0.f;f32x16 o[2];o[0]=f32x16{};o[1]=f32x16{};const f32x16 negm=f32x16{};
  #define SPLIT3(v,hb,lb,l2) const unsigned hb=cvtpk_s(v,0.f)&0xffffu; const float r1_=(v)-__uint_as_float(hb<<16); const unsigned lb=cvtpk_s(r1_,0.f)&0xffffu; const float r2_=r1_-__uint_as_float(lb<<16); const unsigned l2=cvtpk_s(r2_,0.f)&0xffffu
  #define KAUG(dst,cval) do{ const float v_=-(cval); SPLIT3(v_,hb_,lb_,l2_); u32x4 w_; w_[0]=hi?0u:(hb_|(lb_<<16)); w_[1]=hi?0u:(l2_|0x3f800000u); w_[2]=hi?0u:0x3f803f80u; w_[3]=0u; dst=__builtin_bit_cast(bf16x8,w_); }while(0)
  #define QAUG(dst,mval) do{ const float v_=-(mval); SPLIT3(v_,hb_,lb_,l2_); u32x4 w_; w_[0]=0x3f803f80u; w_[1]=0x3f80u|(hb_<<16); w_[2]=lb_|(l2_<<16); w_[3]=0u; dst=__builtin_bit_cast(bf16x8,w_); }while(0)
  bf16x8 qa; QAUG(qa,0.f);
  const int qrel=wid*QBLK+r32;
  #define CMASK(P0,P1,t) tilefix<MODE>(P0,P1,(t),NT,t0+(t),qrel,hi,cl,dt,maskq,mhat)
  bool resc=false;
  #define START(P0,P1) do{ const float rm=rowmax(P0,P1); resc=false; \
    { const float dl=(rm==-INFINITY)?0.f:rm; mhat=fadd_s(mhat,dl); if(MODE==0){QAUG(qa,mhat);} \
      _Pragma("unroll") for(int r=0;r<16;++r){P0[r]=fsub_s(P0[r],dl);P1[r]=fsub_s(P1[r],dl);} \
      } \
    _Pragma("unroll") for(int r=0;r<16;++r)P0[r]=__builtin_amdgcn_exp2f(P0[r]); }while(0)
  #define RESC() do{ if(resc){ asm volatile("s_waitcnt lgkmcnt(0)":::"memory"); \
      _Pragma("unroll") for(int d_=0;d_<2;++d_) _Pragma("unroll") for(int r=0;r<16;++r)o[d_][r]*=wsf[crow(r,hi)]; } }while(0)
  f32x16 pA0,pA1,pB0,pB1;
  int sl_prev=0,sl_cur=0,sl_next=SLOTB;
  #define ROT() do{sl_prev=sl_cur;sl_cur=sl_next;sl_next=(sl_next==(NSLOT-1)*SLOTB)?0:sl_next+SLOTB;}while(0)
  DMA_K(2,2*SLOTB);
  WAIT_BAR(3);
  if(MODE==0){ bf16x8 ka0,ka1; KAUG(ka0,cl[64*t0+r32]); KAUG(ka1,cl[64*t0+32+r32]);
    pA0=__builtin_amdgcn_mfma_f32_32x32x16_bf16(ka0,qa,negm,0,0,0); pA1=__builtin_amdgcn_mfma_f32_32x32x16_bf16(ka1,qa,negm,0,0,0); qkt(pA0,pA1,Kbase,qr,pA0,pA1,r32,hi); }
  else qkt(pA0,pA1,Kbase,qr,negm,negm,r32,hi);
  asm volatile("s_nop 15\n\ts_nop 7":"+v"(pA0),"+v"(pA1));CMASK(pA0,pA1,0);
  START(pA0,pA1);
  _Pragma("unroll") for(int r=0;r<16;++r)pA1[r]=__builtin_amdgcn_exp2f(pA1[r]);
  WAIT_BAR(0);
  DMA_K(3,0);DMA_V(1,SLOTB);
  ROT();
  kload8(kf,kp0+sl_cur);
  WAIT_BAR(2);
  s16x4 vlo[8],vhi[8]; u32x4 pw0,pw1,pw2,pw3;
  #define PKW(P,B) cvtpk_s(P[B],P[B+1])
  #define PAF(k) __builtin_bit_cast(bf16x8,pw##k)
  #define VFR(i) (bf16x8){vlo[i][0],vlo[i][1],vlo[i][2],vlo[i][3],vhi[i][0],vhi[i][1],vhi[i][2],vhi[i][3]}
  #define PIN(x) asm volatile("":"+v"(x))
  #define MX3(a,b,c) __builtin_fmaxf(__builtin_fmaxf((a),(b)),(c))
  #define GAPA(MF,A0,A1,A2,A3,W0,W1,PW) do{ MF; sacc+=A0; sacc+=A1; sacc+=A2; sacc+=A3; PIN(sacc); W0; W1; PIN(PW); SBAR(); }while(0)
  #define EX(v) __builtin_amdgcn_exp2f(v)
  #define GAPB(MF,X,B) do{ MF; X[B]=EX(X[B]); X[B+1]=EX(X[B+1]); X[B+2]=EX(X[B+2]); X[B+3]=EX(X[B+3]); PIN(X); SBAR(); }while(0)
  #define VRD(i) do{ vlo[i]=vtr(vp_+(((i)>>2)*4096+((i)&3)*1024)); vhi[i]=vtr(vp_+(((i)>>2)*4096+((i)&3)*1024+512)); }while(0)
  #define KRD(G,j) do{ if(G){ kload2(kf,kp0+sl_next,j); SBAR(); } }while(0)
  #define STEP(C0,C1,P0,P1,t,GK,GV,GL) do{ SBAR(); \
    if(MODE==0){ bf16x8 ka0_,ka1_; KAUG(ka0_,cl[64*(t0+(t))+r32]); KAUG(ka1_,cl[64*(t0+(t))+32+r32]); \
      C0=__builtin_amdgcn_mfma_f32_32x32x16_bf16(ka0_,qa,negm,0,0,0); C1=__builtin_amdgcn_mfma_f32_32x32x16_bf16(ka1_,qa,negm,0,0,0); SBAR(); } \
    const lds_cptr vp_=vp0+sl_prev; \
    const bf16x8 qq0=*(const __attribute__((address_space(3))) bf16x8*)(qst),qq1=*(const __attribute__((address_space(3))) bf16x8*)(qst+1024),qq2=*(const __attribute__((address_space(3))) bf16x8*)(qst+2048),qq3=*(const __attribute__((address_space(3))) bf16x8*)(qst+3072); \
    VRD(0); SBAR(); float sacc=(P0[0]+P0[1]); \
    GAPA(C0=__builtin_amdgcn_mfma_f32_32x32x16_bf16(kf[0],qq0,(MODE==0?C0:negm),0,0,0), P0[2],P0[3],P0[4],P0[5],     pw0[0]=PKW(P0,0), pw0[1]=PKW(P0,2), pw0); \
    VRD(4); SBAR(); GAPA(C1=__builtin_amdgcn_mfma_f32_32x32x16_bf16(kf[1],qq0,(MODE==0?C1:negm),0,0,0), P0[6],P0[7],P0[8],P0[9],     pw0[2]=PKW(P0,4), pw0[3]=PKW(P0,6), pw0); \
    VRD(1); SBAR(); GAPA(C0=__builtin_amdgcn_mfma_f32_32x32x16_bf16(kf[2],qq1,C0,0,0,0),   P0[10],P0[11],P0[12],P0[13], pw1[0]=PKW(P0,8), pw1[1]=PKW(P0,10), pw1); \
    VRD(5); SBAR(); GAPA(C1=__builtin_amdgcn_mfma_f32_32x32x16_bf16(kf[3],qq1,C1,0,0,0),   P0[14],P0[15],P1[0],P1[1],   pw1[2]=PKW(P0,12),pw1[3]=PKW(P0,14), pw1); \
    VRD(2); SBAR(); GAPA(C0=__builtin_amdgcn_mfma_f32_32x32x16_bf16(kf[4],qq2,C0,0,0,0),   P1[2],P1[3],P1[4],P1[5],     pw2[0]=PKW(P1,0), pw2[1]=PKW(P1,2), pw2); \
    VRD(6); SBAR(); GAPA(C1=__builtin_amdgcn_mfma_f32_32x32x16_bf16(kf[5],qq2,C1,0,0,0),   P1[6],P1[7],P1[8],P1[9],     pw2[2]=PKW(P1,4), pw2[3]=PKW(P1,6), pw2); \
    VRD(3); SBAR(); GAPA(C0=__builtin_amdgcn_mfma_f32_32x32x16_bf16(kf[6],qq3,C0,0,0,0),   P1[10],P1[11],P1[12],P1[13], pw3[0]=PKW(P1,8), pw3[1]=PKW(P1,10), pw3); \
    VRD(7); SBAR(); GAPA(C1=__builtin_amdgcn_mfma_f32_32x32x16_bf16(kf[7],qq3,C1,0,0,0),   P1[14],P1[15],0.f,0.f,       pw3[2]=PKW(P1,12),pw3[3]=PKW(P1,14), pw3); \
    l_reg+=sacc; \
    if(GK){DMA_K((t)+3,sl_cur);} if(GV){DMA_V((t)+1,sl_next);} \
    CMASK(C0,C1,t); \
    { float a=MX3(C0[0],C0[1],C1[0]),b=MX3(C0[2],C0[3],C1[1]); a=MX3(a,C1[2],C1[3]); \
      _Pragma("unroll") for(int r=4;r<16;r+=4){a=MX3(a,C0[r],C0[r+1]);b=MX3(b,C0[r+2],C0[r+3]);a=MX3(a,C1[r],C1[r+1]);b=MX3(b,C1[r+2],C1[r+3]);} \
      float rm=__builtin_fmaxf(a,b); { auto rr=__builtin_amdgcn_permlane32_swap(__float_as_uint(rm),__float_as_uint(rm),false,false); rm=__builtin_fmaxf(__uint_as_float(rr[0]),__uint_as_float(rr[1])); } \
      resc=false; \
      if(__builtin_expect(__any(rm>(float)THRL),0)){ const float dl=__builtin_fmaxf(rm,0.f); mhat+=dl; if(MODE==0){QAUG(qa,mhat);} \
        _Pragma("unroll") for(int r=0;r<16;++r){C0[r]-=dl;C1[r]-=dl;} \
        const float f=__builtin_amdgcn_exp2f(-dl); l_reg*=f; if(hi==0)wsf[r32]=f; resc=true; } } \
    SBAR(); \
    GAPB(o[0]=__builtin_amdgcn_mfma_f32_32x32x16_bf16(PAF(0),VFR(0),o[0],0,0,0), C0,0); \
    GAPB(o[1]=__builtin_amdgcn_mfma_f32_32x32x16_bf16(PAF(0),VFR(4),o[1],0,0,0), C0,4); \
    KRD(GL,0); GAPB(o[0]=__builtin_amdgcn_mfma_f32_32x32x16_bf16(PAF(1),VFR(1),o[0],0,0,0), C0,8); \
    KRD(GL,1); GAPB(o[1]=__builtin_amdgcn_mfma_f32_32x32x16_bf16(PAF(1),VFR(5),o[1],0,0,0), C0,12); \
    KRD(GL,2); GAPB(o[0]=__builtin_amdgcn_mfma_f32_32x32x16_bf16(PAF(2),VFR(2),o[0],0,0,0), C1,0); \
    KRD(GL,3); GAPB(o[1]=__builtin_amdgcn_mfma_f32_32x32x16_bf16(PAF(2),VFR(6),o[1],0,0,0), C1,4); \
    GAPB(o[0]=__builtin_amdgcn_mfma_f32_32x32x16_bf16(PAF(3),VFR(3),o[0],0,0,0), C1,8); \
    GAPB(o[1]=__builtin_amdgcn_mfma_f32_32x32x16_bf16(PAF(3),VFR(7),o[1],0,0,0), C1,12); \
    }while(0)
  int t=1;
  for(;t+5<NT;t+=2){
    STEP(pB0,pB1,pA0,pA1,t,true,true,true);     WAIT_BAR(2); RESC(); ROT();
    STEP(pA0,pA1,pB0,pB1,t+1,true,true,true);   WAIT_BAR(2); RESC(); ROT();
  }
  #define ENDW(tt) do{ if((tt)+3<NT){WAIT_BAR(2);} else if((tt)+2<NT){WAIT_BAR(1);} else {WAIT_BAR(0);} }while(0)
  for(;t+1<NT;t+=2){
    STEP(pB0,pB1,pA0,pA1,t,(t+3<NT),(t+1<NT),(t+1<NT));       ENDW(t);   RESC(); ROT();
    STEP(pA0,pA1,pB0,pB1,t+1,(t+4<NT),(t+2<NT),(t+2<NT));     ENDW(t+1); RESC(); ROT();
  }
  STEP(pB0,pB1,pA0,pA1,NT-1,false,false,false); RESC();
  { float sacc=pB0[0]+pB0[1]; _Pragma("unroll") for(int r=2;r<16;++r)sacc+=pB0[r]; _Pragma("unroll") for(int r=0;r<16;++r)sacc+=pB1[r]; l_reg+=sacc;
    pw0=(u32x4){PKW(pB0,0),PKW(pB0,2),PKW(pB0,4),PKW(pB0,6)};pw1=(u32x4){PKW(pB0,8),PKW(pB0,10),PKW(pB0,12),PKW(pB0,14)};pw2=(u32x4){PKW(pB1,0),PKW(pB1,2),PKW(pB1,4),PKW(pB1,6)};pw3=(u32x4){PKW(pB1,8),PKW(pB1,10),PKW(pB1,12),PKW(pB1,14)};
    SBAR(); pv(o,vb0+sl_cur,PAF(0),PAF(1),PAF(2),PAF(3)); }
  #undef PKW
  #undef PAF
  #undef VFR
  #undef PIN
  #undef MX3
  #undef GAPA
  #undef GAPB
  #undef EX
  #undef VRD
  #undef KRD
  #undef STEP
  #undef ENDW
  {auto rr=__builtin_amdgcn_permlane32_swap(__float_as_uint(l_reg),__float_as_uint(l_reg),false,false);l_reg=__uint_as_float(rr[0])+__uint_as_float(rr[1]);}
  if(hi==0)wsf[32+r32]=l_reg;asm volatile("s_waitcnt lgkmcnt(0)":::"memory");
  float rli[16];
  #pragma unroll
  for(int r=0;r<16;++r)rli[r]=__builtin_amdgcn_rcpf(wsf[32+crow(r,hi)]);
  { bf16*stg=(bf16*)(shm+LDS_OST)+wid*2048;
    #pragma unroll
    for(int r=0;r<16;++r){const int orow=crow(r,hi);
      #pragma unroll
      for(int d0=0;d0<2;++d0)stg[orow*64+d0*32+r32]=__float2bfloat16(o[d0][r]*rli[r]);}
    asm volatile("s_waitcnt lgkmcnt(0)":::"memory");
    const long tok0=rowbase+q0+wid*QBLK;
    #pragma unroll
    for(int i=0;i<4;++i){const int row=i*8+(lane>>3),ch=lane&7; const u32x4 v=*(const u32x4*)(stg+row*64+ch*8);
      if(MODE==0){ *(u32x4*)(IO_AO16+(tok0+row)*1024+h*D+ch*8)=v; }
      else if(MODE==2){ *(u32x4*)(IO_OW+(tok0+row)*512+h*D+ch*8)=v; }
      else { const u32x4 c=*(const u32x4*)(IO_OC+(tok0+row)*512+h*D+ch*8), w=*(const u32x4*)(IO_OW+(tok0+row)*512+h*D+ch*8);
        const float*gp=IO_FG+(tok0+row)*32+8+h*3;
        const float g0=1.f/(1.f+__expf(-gp[0])),g1=1.f/(1.f+__expf(-gp[1])),g2=1.f/(1.f+__expf(-gp[2]));
        u32x4 o4;
        #pragma unroll
        for(int k=0;k<4;++k){ const float c_lo=__uint_as_float(c[k]<<16),c_hi=__uint_as_float(c[k]&0xffff0000u),s_lo=__uint_as_float(v[k]<<16),s_hi=__uint_as_float(v[k]&0xffff0000u),w_lo=__uint_as_float(w[k]<<16),w_hi=__uint_as_float(w[k]&0xffff0000u);
          o4[k]=cvtpk_s(g0*c_lo+g1*s_lo+g2*w_lo,g0*c_hi+g1*s_hi+g2*w_hi); }
        *(u32x4*)(IO_AO16+(tok0+row)*1024+512+h*D+ch*8)=o4; } } }
  asm volatile("s_waitcnt lgkmcnt(0)\n\ts_barrier":::"memory");
  #undef DMA_K
  #undef DMA_V
  #undef CMASK
  #undef START
  #undef RESC
  #undef ROT
}
constexpr int ATTN_LDS_BYTES=LDS_BYTES;
#undef SBAR
#undef WAIT_BAR
}

__device__ __forceinline__ float silu_f(float x) { return x / (1.f + expf(-x)); }
__device__ __forceinline__ float sigmoid_f(float x) { return 1.f / (1.f + expf(-x)); }
__device__ __forceinline__ unsigned f2bf(float f) { unsigned u = __builtin_bit_cast(unsigned, f); return (u + 0x7fffu + ((u >> 16) & 1u)) >> 16; }
__device__ __forceinline__ unsigned pk2(float lo, float hi) { return f2bf(lo) | (f2bf(hi) << 16); }
__device__ __forceinline__ float bf2f(bf16 v) { return __builtin_bit_cast(float, (unsigned)v << 16); }
__device__ __forceinline__ float wave_sum(float v) {
#pragma unroll
    for (int o = 1; o < 64; o <<= 1) v += __shfl_xor(v, o);
    return v;
}
__device__ __forceinline__ int t5_bucket(int dist) {
    const int n = dist < 0 ? 0 : dist;
    if (n < 16) return n;
    int b = 16;
    b += (n >= 19) + (n >= 21) + (n >= 24) + (n >= 27) + (n >= 31) + (n >= 35) + (n >= 40) + (n >= 46) + (n >= 52) + (n >= 59) +
         (n >= 67) + (n >= 77) + (n >= 87) + (n >= 99) + (n >= 113);
    return b;
}

struct Args {
    const float* in[26];
    float* out; unsigned char* ws;
    int ph_lo, ph_hi, li, pad;
};

struct Ctx {
    LAS unsigned char* lds;
    int tid, lane, wave, gtid, GT, gw, NGW;
    const float *x, *c, *w_ada, *b_ada, *w_in, *b_f, *cmp_pos_k, *cmp_w1_k, *cmp_w2_k, *cmp_pos_v, *cmp_w1_v, *cmp_w2_v, *rel_bias, *w_out, *ln1_g, *ln1_b,
        *w_router, *e_bias, *w_gate, *w_up, *w_down, *ws_gate, *ws_up, *ws_down, *ln2_g, *ln2_b;
    float* out;
    float *mod, *cum, *kvc, *posb, *scorebuf, *scores, *ew, *fg, *pc, *lw;
    int* lrow; gu32* ctl; unsigned char* wsb;
    unsigned* selmask; int* eidx;
    bf16 *hbuf, *proj, *h2lo, *win_t, *wout_t, *ao16, *oc, *ow, *wgu, *wdn, *act16, *slot, *w1t, *w2t, *kvc16, *wrt;
};


__device__ __forceinline__ int map_inproj(int n) { return n < 1536 ? n : (n < 1544 ? 2816 + (n - 1536) : (n < 2824 ? n - 8 : n)); }
template <int MAP>
__device__ __forceinline__ void transpose_item(const float* W, int K, int N, bf16* WT, LAS float* scr, int item, int lane) {
    const int nblk = N / 32, kb = item / nblk, nb = item % nblk, k0 = 64 * kb, n0 = 32 * nb;
#pragma unroll 8
    for (int i = 0; i < 32; ++i) { const int kk = 2 * i + (lane >> 5); scr[kk * 33 + (lane & 31)] = W[(size_t)(k0 + kk) * N + n0 + (lane & 31)]; }
    asm volatile("s_waitcnt lgkmcnt(0)" ::: "memory");
    const int c = lane & 7;
#pragma unroll
    for (int j = 0; j < 4; ++j) { const int n = (lane >> 3) + 8 * j; const LAS float* s = scr + (8 * c) * 33 + n;
        u32x4 o; o.x = pk2(s[0 * 33], s[1 * 33]); o.y = pk2(s[2 * 33], s[3 * 33]); o.z = pk2(s[4 * 33], s[5 * 33]); o.w = pk2(s[6 * 33], s[7 * 33]);
        const int dr = MAP == 1 ? map_inproj(n0 + n) : n0 + n;
        *(u32x4*)(WT + (size_t)dr * K + k0 + 8 * c) = o; }
    asm volatile("s_waitcnt lgkmcnt(0)" ::: "memory");
}
__device__ __forceinline__ void ph_prologue(Ctx& C) {
    LAS float* scr = (LAS float*)(C.lds + C.wave * 8704);
    constexpr int I_IN = (D / 64) * (NPROJ / 32), I_OUT = (D / 64) * (D / 32);
    for (int it = C.gw; it < I_IN + I_OUT; it += C.NGW) {
        if (it < I_IN) transpose_item<1>(C.w_in, D, NPROJ, C.win_t, scr, it, C.lane);
        else transpose_item<0>(C.w_out, D, D, C.wout_t, scr, it - I_IN, C.lane);
    }
    constexpr int I_W1 = (2048 / 64) * (256 / 32), I_W2 = (256 / 64) * (64 / 32);
    for (int it = C.gw; it < 2 * (I_W1 + I_W2); it += C.NGW) {
        const int which = it / (I_W1 + I_W2), r = it % (I_W1 + I_W2);
        if (r < I_W1) transpose_item<0>(which ? C.cmp_w1_v : C.cmp_w1_k, 2048, 256, C.w1t + (size_t)which * 256 * 2048, scr, r, C.lane);
        else transpose_item<0>(which ? C.cmp_w2_v : C.cmp_w2_k, 256, 64, C.w2t + (size_t)which * 64 * 256, scr, r - I_W1, C.lane);
    }
    if (blockIdx.x == gridDim.x - 1) {
        const int which = C.tid >> 8, j = C.tid & 255;
        const float* pos = which ? C.cmp_pos_v : C.cmp_pos_k; const float* w1 = which ? C.cmp_w1_v : C.cmp_w1_k;
        float acc = 0.f;
        for (int k = 0; k < 2048; ++k) acc += pos[k] * w1[(size_t)k * 256 + j];
        C.posb[C.tid] = acc;
    }
    for (int i = C.gtid; i < 64 * 128; i += C.GT) {
        const int e = i & 63, k0 = (i >> 6) * 8;
        u32x4 oh, ol;
#pragma unroll
        for (int p = 0; p < 4; ++p) {
            const float a = C.w_router[(size_t)(k0 + 2 * p) * 64 + e], b = C.w_router[(size_t)(k0 + 2 * p + 1) * 64 + e];
            const unsigned h = pk2(a, b);
            oh[p] = h; ol[p] = pk2(a - __builtin_bit_cast(float, h << 16), b - __builtin_bit_cast(float, h & 0xffff0000u));
        }
        *(u32x4*)(C.wrt + (size_t)e * 1024 + k0) = oh; *(u32x4*)(C.wrt + 65536 + (size_t)e * 1024 + k0) = ol;
    }
    for (int i = C.gtid; i < 2 * 8 * 2 * 64; i += C.GT) C.kvc16[((size_t)(i >> 6) * 128 + 127) * 64 + (i & 63)] = 0;
    for (int i = C.gtid; i < (3072 - NPROJ) * D / 8; i += C.GT) *(u32x4*)(C.win_t + (size_t)NPROJ * D + (size_t)i * 8) = (u32x4){0u, 0u, 0u, 0u};
}
__device__ __forceinline__ void ph_mod(Ctx& C) {
    for (int i = C.gtid; i < NB * 6 * D; i += C.GT) {
        const int b = i / (6 * D), e = i % (6 * D);
        float acc = C.b_ada[e];
        for (int d = 0; d < D; ++d) acc += silu_f(C.c[b * D + d]) * C.w_ada[(size_t)d * 6 * D + e];
        C.mod[i] = acc;
    }
}
__device__ __forceinline__ void ph_hpass(Ctx& C) {
    for (int m = C.gw; m < T; m += C.NGW) {
        const int b = m / S;
        const float* md = C.mod + b * 6 * D;
#pragma unroll
        for (int j = 0; j < 4; ++j) {
            const int c0 = (C.lane + 64 * j) * 4;
            const f32x4 xv = *(const f32x4*)(C.x + (size_t)m * D + c0);
            const f32x4 sh = *(const f32x4*)(md + c0), sc = *(const f32x4*)(md + D + c0);
            const f32x4 h = xv * (1.f + sc) + sh;
            u32x2 o; o.x = pk2(h.x, h.y); o.y = pk2(h.z, h.w);
            *(u32x2*)(C.hbuf + (size_t)m * D + c0) = o;
        }
    }
}
__device__ __forceinline__ void ph_cum_cmp1(Ctx& C) {
    for (int w = C.gw; w < NB * 8; w += C.NGW) {
        const int b = w / 8, h = w % 8;
        float carry = 0.f;
        for (int c0 = 0; c0 < S; c0 += 64) {
            const int t = c0 + C.lane;
            const float xx = C.fg[((size_t)b * S + t) * FGW + h] + C.b_f[h];
            float v = fminf(xx, 0.f) - log1pf(expf(-fabsf(xx)));
#pragma unroll
            for (int o = 1; o < 64; o <<= 1) { const float u = __shfl_up(v, o); if (C.lane >= o) v += u; }
            v += carry;
            C.cum[(size_t)w * S + t] = v;
            carry = __shfl(v, 63);
        }
    }
}
typedef short bf16x8_t __attribute__((ext_vector_type(8)));
__device__ __forceinline__ void ph_compress(Ctx& C) {
    LAS bf16* hidL = (LAS bf16*)C.lds;
    const int row = C.lane & 15, kq = C.lane >> 4;
    for (int u = blockIdx.x; u < 2 * NCMP; u += gridDim.x) {
        const int which = u / NCMP, tile = u % NCMP;
        { const int R = tile * 16 + row, b = R / 254, n = (R % 254) >> 1, g = R & 1;
          const bf16* abase = C.proj + ((size_t)b * S + 16 * n) * PITCH + (which ? PC_VC : PC_KC) + g * 64 + 8 * kq;
          const bf16* wb = C.w1t + ((size_t)which * 256 + 32 * C.wave + row) * 2048 + 8 * kq;
          f32x4 acc0 = {0.f, 0.f, 0.f, 0.f}, acc1 = {0.f, 0.f, 0.f, 0.f};
#pragma unroll 4
          for (int k0 = 0; k0 < 2048; k0 += 32) {
              const bf16x8_t a = *(const bf16x8_t*)(abase + (size_t)(k0 >> 6) * PITCH + (k0 & 63));
              const bf16x8_t b0 = *(const bf16x8_t*)(wb + k0), b1 = *(const bf16x8_t*)(wb + 16 * 2048 + k0);
              acc0 = __builtin_amdgcn_mfma_f32_16x16x32_bf16(a, b0, acc0, 0, 0, 0);
              acc1 = __builtin_amdgcn_mfma_f32_16x16x32_bf16(a, b1, acc1, 0, 0, 0);
          }
          const float pb0 = C.posb[which * 256 + 32 * C.wave + row], pb1 = C.posb[which * 256 + 32 * C.wave + 16 + row];
#pragma unroll
          for (int r = 0; r < 4; ++r) {
              hidL[(kq * 4 + r) * 256 + 32 * C.wave + row] = (bf16)f2bf(silu_f(acc0[r] + pb0));
              hidL[(kq * 4 + r) * 256 + 32 * C.wave + 16 + row] = (bf16)f2bf(silu_f(acc1[r] + pb1));
          } }
        __syncthreads();
        if (C.wave < 4) {
            const bf16* w2 = C.w2t + ((size_t)which * 64 + 16 * C.wave + row) * 256 + 8 * kq;
            f32x4 acc = {0.f, 0.f, 0.f, 0.f};
#pragma unroll
            for (int k0 = 0; k0 < 256; k0 += 32) {
                const bf16x8_t a = *(const LAS bf16x8_t*)(hidL + row * 256 + k0 + 8 * kq);
                const bf16x8_t b = *(const bf16x8_t*)(w2 + k0);
                acc = __builtin_amdgcn_mfma_f32_16x16x32_bf16(a, b, acc, 0, 0, 0);
            }
#pragma unroll
            for (int r = 0; r < 4; ++r) {
                const int R = tile * 16 + kq * 4 + r, b = R / 254, n = (R % 254) >> 1, g = R & 1, col = 16 * C.wave + row;
                C.kvc[((size_t)which * (NB * NCMP * 2) + R) * 64 + col] = acc[r];
                C.kvc16[((((size_t)which * 8 + b) * 2 + g) * 128 + n) * 64 + col] = (bf16)f2bf(acc[r]);
            }
        }
        __syncthreads();
    }
}
__device__ __forceinline__ void cmp_attn_item(Ctx& C, int i) {
    const int t = i % S, h = (i / S) % 8, b = i / (S * 8), g = h / 4;
    const size_t tok = (size_t)b * S + t;
    const int NR = NB * NCMP * 2;
    const float* kc = C.kvc;
    const float* vc = C.kvc + (size_t)NR * 64;
    float q[64], o[64];
#pragma unroll
    for (int d = 0; d < 64; ++d) { q[d] = bf2f(C.proj[tok * PITCH + PC_NQ + h * 64 + d]); o[d] = 0.f; }
    float* prow = C.pc + ((size_t)(b * 8 + h) * S + t) * 128;
    const int nvalid = t >= 31 ? min(NCMP, (t - 31) / 16 + 1) : 0;
    float m = -1e30f;
    for (int n = 0; n < nvalid; ++n) {
        const float* kr = kc + ((size_t)(b * NCMP + n) * 2 + g) * 64;
        float dot = 0.f;
#pragma unroll
        for (int d = 0; d < 64; ++d) dot += q[d] * kr[d];
        const float lg = dot + C.rel_bias[t5_bucket(t - (16 * n + 31)) * 8 + h] * LOG2E;
        prow[n] = lg;
        m = fmaxf(m, lg);
    }
    float l = 0.f;
    for (int n = 0; n < nvalid; ++n) l += exp2f(prow[n] - m);
    const float il = nvalid ? 1.f / l : 0.f;
    for (int n = 0; n < 128; ++n) {
        float p = 0.f;
        if (n < nvalid) {
            p = exp2f(prow[n] - m) * il;
            const float* vr = vc + ((size_t)(b * NCMP + n) * 2 + g) * 64;
#pragma unroll
            for (int d = 0; d < 64; ++d) o[d] += p * vr[d];
        }
        prow[n] = p;
    }
#pragma unroll
    for (int d = 0; d < 64; ++d) C.oc[tok * 512 + h * 64 + d] = (bf16)f2bf(o[d]);
}
__device__ __forceinline__ void ph_imp_topk(Ctx& C) {
    for (int i = C.gtid; i < NB * 2 * S; i += C.GT) {
        const int t = i % S, g = (i / S) % 2, b = i / (S * 2);
        const int qb = t >> 6;
        float* sc = C.scorebuf + (size_t)i * 32;
        for (int j = 0; j < 32; ++j) {
            float imp = 0.f;
            for (int r = 0; r < 4; ++r) {
                const float* prow = C.pc + ((size_t)(b * 8 + g * 4 + r) * S + t) * 128;
                for (int n = 4 * j - 1; n <= 4 * j + 3; ++n)
                    if (n >= 0 && n < NCMP) imp += prow[n];
            }
            const bool causal = j <= qb, forced = (j == 0) || (j == qb) || (j == qb - 1);
            sc[j] = causal ? imp + (forced ? 1e4f : 0.f) : -1e4f;
        }
        unsigned taken = 0u;
        for (int k = 0; k < 16; ++k) {
            float best = -3e38f; int bi = 0;
            for (int j = 0; j < 32; ++j)
                if (!((taken >> j) & 1u)) { const float v = sc[j]; if (v > best) { best = v; bi = j; } }
            taken |= 1u << bi;
        }
        C.selmask[i] = taken;
    }
}
#define ATTN_IO(C) attn_body::AttnIO{C.wsb}
__device__ __forceinline__ unsigned pick4(unsigned a, unsigned b, unsigned c, unsigned d, int k) { return k == 0 ? a : (k == 1 ? b : (k == 2 ? c : d)); }
__device__ __forceinline__ void ph_attn_a(Ctx& C, char* shm) {
    const attn_body::AttnIO io = ATTN_IO(C);
    const int c = blockIdx.x, k = c >> 6, j = c & 63, b = j >> 3, h = j & 7;
    if (c >= 256) return;
    attn_body::attn_fill_dt(shm, C.rel_bias);
    { int tv = threadIdx.x; asm volatile("" : "+v"(tv));
    for (unsigned l = pick4(0xF07u, 0xF16u, 0xF25u, 0xF34u, k); (l & 15u) != 15u; l >>= 4) attn_body::attn_unit<0, 8>(b, h, (int)(l & 15u), io, shm, tv); }
    { int tv = threadIdx.x; asm volatile("" : "+v"(tv));
    for (unsigned l = pick4(0xF07u, 0xF16u, 0xF25u, 0xF34u, k); (l & 15u) != 15u; l >>= 4) attn_body::attn_unit<2, 8>(b, h, (int)(l & 15u), io, shm, tv); }
}
__device__ __forceinline__ void ph_attn_b(Ctx& C, char* shm) {
    const attn_body::AttnIO io = ATTN_IO(C);
    const int c = blockIdx.x, k = c >> 6, j = c & 63, b = j >> 3, h = j & 7;
    if (c >= 256) return;
    attn_body::attn_fill_dt(shm, C.rel_bias);
    { int tv = threadIdx.x; asm volatile("" : "+v"(tv));
    for (unsigned l = pick4(0xF07u, 0xF16u, 0xF25u, 0xF34u, k); (l & 15u) != 15u; l >>= 4) attn_body::attn_unit<1, 8>(b, h, (int)(l & 15u), io, shm, tv); }
}

#ifdef ORACLE
constexpr int CW_ORA = 24576;
template <int MODE>
__device__ __forceinline__ void oracle_attn(Ctx& C) {
    float sd = 0.f, sr = 0.f;
    for (int i = C.gtid; i < NB * 8 * S; i += C.GT) {
        const int t = i % S, h = (i / S) % 8, b = i / (S * 8), g = h / 4;
        const size_t tok = (size_t)b * S + t;
        const int qoff = (MODE == 0 ? PC_FQ : PC_NQ) + h * 64;
        const int koff = MODE == 0 ? PC_FK + h * 64 : (MODE == 1 ? PC_KS : PC_KW) + g * 64;
        const int voff = MODE == 0 ? PC_FV + h * 64 : (MODE == 1 ? PC_VS : PC_VW) + g * 64;
        float q[64], o[64];
#pragma unroll
        for (int d = 0; d < 64; ++d) { q[d] = bf2f(C.proj[tok * PITCH + qoff + d]); o[d] = 0.f; }
        float m = -INFINITY, l = 0.f;
        const int s_lo = MODE == 2 ? max(0, t - 511) : 0;
        const unsigned mask = MODE == 1 ? C.selmask[(b * 2 + g) * S + t] : 0xffffffffu;
        const float* cr = C.cum + (size_t)(b * 8 + h) * S;
        const float cumt = MODE == 0 ? cr[t] : 0.f;
        for (int s = s_lo; s <= t; ++s) {
            if (MODE == 1 && !((mask >> (s >> 6)) & 1u)) continue;
            const bf16* kr = C.proj + ((size_t)b * S + s) * PITCH + koff;
            const bf16* vr = C.proj + ((size_t)b * S + s) * PITCH + voff;
            float dot = 0.f;
#pragma unroll
            for (int d = 0; d < 64; ++d) dot += q[d] * bf2f(kr[d]);
            const float bias = MODE == 0 ? cumt - cr[s] : C.rel_bias[t5_bucket(t - s) * 8 + h];
            const float lg = dot + bias * LOG2E;
            const float mn = fmaxf(m, lg), corr = exp2f(m - mn), p = exp2f(lg - mn);
            l = l * corr + p;
#pragma unroll
            for (int d = 0; d < 64; ++d) o[d] = o[d] * corr + p * bf2f(vr[d]);
            m = mn;
        }
        const float il = 1.f / l;
        float g0 = 0.f, g1 = 1.f, g2 = 0.f;
        if (MODE == 1) { g0 = sigmoid_f(C.fg[tok * FGW + 8 + h * 3 + 0]); g1 = sigmoid_f(C.fg[tok * FGW + 8 + h * 3 + 1]); g2 = sigmoid_f(C.fg[tok * FGW + 8 + h * 3 + 2]); }
#pragma unroll
        for (int d = 0; d < 64; ++d) {
            float ref = o[d] * il, got;
            if (MODE == 0) got = bf2f(C.ao16[tok * D + h * 64 + d]);
            else if (MODE == 2) got = bf2f(C.ow[tok * 512 + h * 64 + d]);
            else { ref = g0 * bf2f(C.oc[tok * 512 + h * 64 + d]) + g1 * ref + g2 * bf2f(C.ow[tok * 512 + h * 64 + d]); got = bf2f(C.ao16[tok * D + 512 + h * 64 + d]); }
            sd += (got - ref) * (got - ref); sr += ref * ref;
        }
    }
    sd = wave_sum(sd); sr = wave_sum(sr);
    if (C.lane == 0) { atomicAdd((float*)(C.ctl + CW_ORA), sd); atomicAdd((float*)(C.ctl + CW_ORA + 64), sr); }
}
#endif
template <int WHICH>
__device__ __forceinline__ void ph_ln(Ctx& C) {
    const float* gam = WHICH == 1 ? C.ln1_g : C.ln2_g;
    const float* bet = WHICH == 1 ? C.ln1_b : C.ln2_b;
    for (int m = C.gw; m < T; m += C.NGW) {
        const int b = m / S;
        float* row = C.out + (size_t)m * D;
        f32x4 v[4]; float s = 0.f;
#pragma unroll
        for (int j = 0; j < 4; ++j) { v[j] = *(const f32x4*)(row + (C.lane + 64 * j) * 4); s += (v[j].x + v[j].y) + (v[j].z + v[j].w); }
        const float mean = wave_sum(s) * (1.f / D); float s2 = 0.f;
#pragma unroll
        for (int j = 0; j < 4; ++j) { v[j] = v[j] - mean; s2 += (v[j].x * v[j].x + v[j].y * v[j].y) + (v[j].z * v[j].z + v[j].w * v[j].w); }
        const float rstd = rsqrtf(wave_sum(s2) * (1.f / D) + LN_EPS);
#pragma unroll
        for (int j = 0; j < 4; ++j) {
            const int c0 = (C.lane + 64 * j) * 4;
            const f32x4 y = v[j] * rstd * *(const f32x4*)(gam + c0) + *(const f32x4*)(bet + c0);
            *(f32x4*)(row + c0) = y;
            if (WHICH == 1) {
                const float* md = C.mod + b * 6 * D;
                const f32x4 h2 = y * (1.f + *(const f32x4*)(md + 4 * D + c0)) + *(const f32x4*)(md + 3 * D + c0);
                u32x2 hi; hi.x = pk2(h2.x, h2.y); hi.y = pk2(h2.z, h2.w);
                const float r0 = h2.x - __builtin_bit_cast(float, hi.x << 16), r1 = h2.y - __builtin_bit_cast(float, hi.x & 0xffff0000u);
                const float r2 = h2.z - __builtin_bit_cast(float, hi.y << 16), r3 = h2.w - __builtin_bit_cast(float, hi.y & 0xffff0000u);
                u32x2 lo; lo.x = pk2(r0, r1); lo.y = pk2(r2, r3);
                *(u32x2*)(C.hbuf + (size_t)m * D + c0) = hi;
                *(u32x2*)(C.h2lo + (size_t)m * D + c0) = lo;
            }
        }
    }
}
__device__ __forceinline__ void ph_router_route(Ctx& C) {
    LAS float* scr = (LAS float*)(C.lds + C.wave * 4096);
    const int row = C.lane & 15, kq = C.lane >> 4;
    for (int tile = C.gw; tile < T / 16; tile += C.NGW) {
        const int tok0 = tile * 16;
        const bf16* ah = C.hbuf + (size_t)(tok0 + row) * D + 8 * kq;
        const bf16* al = C.h2lo + (size_t)(tok0 + row) * D + 8 * kq;
        const bf16* wh = C.wrt + (size_t)row * 1024 + 8 * kq;
        f32x4 acc[4];
#pragma unroll
        for (int n = 0; n < 4; ++n) acc[n] = (f32x4){0.f, 0.f, 0.f, 0.f};
#pragma unroll 2
        for (int k0 = 0; k0 < D; k0 += 32) {
            const bf16x8_t a_h = *(const bf16x8_t*)(ah + k0), a_l = *(const bf16x8_t*)(al + k0);
#pragma unroll
            for (int n = 0; n < 4; ++n) {
                const bf16x8_t b_h = *(const bf16x8_t*)(wh + (size_t)n * 16 * 1024 + k0), b_l = *(const bf16x8_t*)(wh + 65536 + (size_t)n * 16 * 1024 + k0);
                acc[n] = __builtin_amdgcn_mfma_f32_16x16x32_bf16(a_l, b_l, acc[n], 0, 0, 0);
                acc[n] = __builtin_amdgcn_mfma_f32_16x16x32_bf16(a_l, b_h, acc[n], 0, 0, 0);
                acc[n] = __builtin_amdgcn_mfma_f32_16x16x32_bf16(a_h, b_l, acc[n], 0, 0, 0);
                acc[n] = __builtin_amdgcn_mfma_f32_16x16x32_bf16(a_h, b_h, acc[n], 0, 0, 0);
            }
        }
#pragma unroll
        for (int n = 0; n < 4; ++n)
#pragma unroll
            for (int r = 0; r < 4; ++r) scr[(kq * 4 + r) * 64 + n * 16 + row] = acc[n][r];
        asm volatile("s_waitcnt lgkmcnt(0)" ::: "memory");
        const int e = C.lane, g = e >> 3;
        const float eb = C.e_bias[e];
        for (int tl = 0; tl < 16; ++tl) {
            const int tok = tok0 + tl;
            const float sc = sigmoid_f(scr[tl * 64 + e]);
            const float bsc = sc + eb;
            float m1 = bsc;
            m1 = fmaxf(m1, __shfl_xor(m1, 1)); m1 = fmaxf(m1, __shfl_xor(m1, 2)); m1 = fmaxf(m1, __shfl_xor(m1, 4));
            const unsigned long long eq = __ballot(bsc == m1) & (0xFFull << (8 * g));
            const int first = __ffsll((long long)eq) - 1;
            float m2 = (e == first) ? -INFINITY : bsc;
            m2 = fmaxf(m2, __shfl_xor(m2, 1)); m2 = fmaxf(m2, __shfl_xor(m2, 2)); m2 = fmaxf(m2, __shfl_xor(m2, 4));
            const float gs = m1 + m2;
            int grank = 0;
#pragma unroll
            for (int gg = 0; gg < 8; ++gg) { const float o = __shfl(gs, gg * 8); grank += (o > gs || (o == gs && gg < g)) ? 1 : 0; }
            const float mv = grank < 4 ? bsc : -INFINITY;
            int rank = 0;
#pragma unroll
            for (int e2 = 0; e2 < 64; ++e2) { const float o = __shfl(mv, e2); rank += (o > mv || (o == mv && e2 < e)) ? 1 : 0; }
            const bool sel = rank < 8;
            const float wsum = wave_sum(sel ? sc : 0.f);
            if (sel) {
                const float w = sc / wsum * 2.5f;
                const unsigned pos = __hip_atomic_fetch_add(C.ctl + CW_CNT + 64 * e, 1u, RLX_AGENT);
                C.lrow[(size_t)e * 16384 + pos] = tok * 16 + rank; C.lw[(size_t)e * 16384 + pos] = w;
            }
            if (e == 0) { C.lrow[(size_t)64 * 16384 + tok] = tok * 16 + 8; C.lw[(size_t)64 * 16384 + tok] = 1.f; }
        }
    }
}
__device__ __forceinline__ void ph_convert_experts(Ctx& C) {
    LAS float* scr = (LAS float*)(C.lds + C.wave * 8704);
    for (int it = C.gw; it < 65 * 384; it += C.NGW) {
        const int e = it / 384, r = it % 384, kind = r / 128, item = r % 128;
        if (kind < 2) {
            const float* W = e < 64 ? (kind == 0 ? C.w_gate : C.w_up) + (size_t)e * D * 256 : (kind == 0 ? C.ws_gate : C.ws_up);
            const int n0 = 32 * (item % 8);
            bf16* WT = C.wgu + ((size_t)e * 512 + (n0 / 128) * 128 + kind * 128) * D;
            transpose_item<0>(W, D, 256, WT, scr, item, C.lane);
        } else {
            const float* W = e < 64 ? C.w_down + (size_t)e * 256 * D : C.ws_down;
            transpose_item<0>(W, 256, D, C.wdn + (size_t)e * D * 256, scr, item, C.lane);
        }
    }
}
__device__ __forceinline__ int moe_tables(Ctx& C) {
    LAS int* tstart = (LAS int*)(C.lds + LDS_TSTART); LAS int* cntl = (LAS int*)(C.lds + LDS_CNT);
    if (C.tid < 64) cntl[C.tid] = (int)__hip_atomic_load(C.ctl + CW_CNT + 64 * C.tid, RLX_AGENT);
    if (C.tid == 64) cntl[64] = T;
    __syncthreads();
    if (C.tid == 0) { int s = 0; for (int e = 0; e < 65; ++e) { tstart[e] = s; s += (cntl[e] + 255) >> 8; } tstart[65] = s; }
    __syncthreads();
    return tstart[65];
}
__device__ __forceinline__ void ph_moe_gateup(Ctx& C) {
    const int MT = moe_tables(C);
    pg8::MoeSched So{(const LAS int*)(C.lds + LDS_TSTART), (const LAS int*)(C.lds + LDS_CNT), C.lrow, C.lw, (const char*)C.wgu, (size_t)512 * D * 2, (size_t)256 * D * 2, MT, 2, 0, (int)gridDim.x, (int)blockIdx.x};
    pg8::EpiAct E{C.act16};
    pg8::gemm_phase_g<pg8::EpiAct, pg8::MoeSched, true>(C.lds, C.lds + LDS_TAB, C.hbuf, D, So, E);
}
template <int HF>
__device__ __forceinline__ void ph_moe_down(Ctx& C) {
    const int MT = moe_tables(C);
    pg8::MoeSched So{(const LAS int*)(C.lds + LDS_TSTART), (const LAS int*)(C.lds + LDS_CNT), C.lrow, C.lw, (const char*)C.wdn, (size_t)D * 256 * 2, (size_t)256 * 256 * 2, MT, 2, 2 * HF, (int)gridDim.x, (int)blockIdx.x};
    pg8::EpiSlot E{C.slot, 2 * HF, (unsigned)T * 9u};
    pg8::gemm_phase_g<pg8::EpiSlot, pg8::MoeSched, false>(C.lds, C.lds + LDS_TAB, C.act16, 256, So, E);
}
template <int HF>
__device__ __forceinline__ void ph_combine(Ctx& C) {
    for (int m = C.gw; m < T; m += C.NGW) {
        const int b = m / S, c0 = HF * 512 + C.lane * 8;
        float acc[8];
#pragma unroll
        for (int i = 0; i < 8; ++i) acc[i] = 0.f;
#pragma unroll
        for (int s = 0; s < 9; ++s) {
            const u32x4 v = *(const u32x4*)(C.slot + ((size_t)m * 9 + s) * 512 + C.lane * 8);
            acc[0] += __builtin_bit_cast(float, v.x << 16); acc[1] += __builtin_bit_cast(float, v.x & 0xffff0000u);
            acc[2] += __builtin_bit_cast(float, v.y << 16); acc[3] += __builtin_bit_cast(float, v.y & 0xffff0000u);
            acc[4] += __builtin_bit_cast(float, v.z << 16); acc[5] += __builtin_bit_cast(float, v.z & 0xffff0000u);
            acc[6] += __builtin_bit_cast(float, v.w << 16); acc[7] += __builtin_bit_cast(float, v.w & 0xffff0000u);
        }
        float* row = C.out + (size_t)m * D;
        const float* g2 = C.mod + b * 6 * D + 5 * D + c0;
        f32x4 y0 = *(const f32x4*)(row + c0) * ALPHA + *(const f32x4*)g2 * (f32x4){acc[0], acc[1], acc[2], acc[3]};
        f32x4 y1 = *(const f32x4*)(row + c0 + 4) * ALPHA + *(const f32x4*)(g2 + 4) * (f32x4){acc[4], acc[5], acc[6], acc[7]};
        if (HF == 0) { *(f32x4*)(row + c0) = y0; *(f32x4*)(row + c0 + 4) = y1; }
        else {
            f32x4 z0 = *(const f32x4*)(row + C.lane * 8), z1 = *(const f32x4*)(row + C.lane * 8 + 4);
            float s = (y0.x + y0.y) + (y0.z + y0.w) + (y1.x + y1.y) + (y1.z + y1.w) + (z0.x + z0.y) + (z0.z + z0.w) + (z1.x + z1.y) + (z1.z + z1.w);
            const float mean = wave_sum(s) * (1.f / D);
            y0 = y0 - mean; y1 = y1 - mean; z0 = z0 - mean; z1 = z1 - mean;
            float q = (y0.x * y0.x + y0.y * y0.y) + (y0.z * y0.z + y0.w * y0.w) + (y1.x * y1.x + y1.y * y1.y) + (y1.z * y1.z + y1.w * y1.w)
                    + (z0.x * z0.x + z0.y * z0.y) + (z0.z * z0.z + z0.w * z0.w) + (z1.x * z1.x + z1.y * z1.y) + (z1.z * z1.z + z1.w * z1.w);
            float rstd = rsqrtf(wave_sum(q) * (1.f / D) + LN_EPS);
            const int cz = C.lane * 8;
#ifdef ORACLE
            { const float sd_ = __uint_as_float(__hip_atomic_load(C.ctl + CW_ORA, RLX_AGENT)), sr_ = __uint_as_float(__hip_atomic_load(C.ctl + CW_ORA + 64, RLX_AGENT)); rstd *= 1.f + 10.f * sqrtf(sd_ / sr_); }
#endif
            *(f32x4*)(row + cz) = z0 * rstd * *(const f32x4*)(C.ln2_g + cz) + *(const f32x4*)(C.ln2_b + cz);
            *(f32x4*)(row + cz + 4) = z1 * rstd * *(const f32x4*)(C.ln2_g + cz + 4) + *(const f32x4*)(C.ln2_b + cz + 4);
            *(f32x4*)(row + c0) = y0 * rstd * *(const f32x4*)(C.ln2_g + c0) + *(const f32x4*)(C.ln2_b + c0);
            *(f32x4*)(row + c0 + 4) = y1 * rstd * *(const f32x4*)(C.ln2_g + c0 + 4) + *(const f32x4*)(C.ln2_b + c0 + 4);
        }
    }
}

__device__ __forceinline__ void mkctx(Ctx& C, const Args& args_unused, LAS unsigned char* ldsp) {
    typedef const __attribute__((address_space(4))) Args* kargp; kargp ap = (kargp)__builtin_amdgcn_kernarg_segment_ptr(); asm volatile("" : "+s"(ap));
#define args (*ap)
    C.lds = ldsp;
    C.tid = threadIdx.x; C.lane = C.tid & 63; C.wave = __builtin_amdgcn_readfirstlane(C.tid >> 6);
    C.gtid = blockIdx.x * NTHR + C.tid; C.GT = gridDim.x * NTHR; C.gw = blockIdx.x * NWAVES + C.wave; C.NGW = gridDim.x * NWAVES;
    C.x = args.in[0]; C.c = args.in[1]; C.w_ada = args.in[2]; C.b_ada = args.in[3]; C.w_in = args.in[4]; C.b_f = args.in[5];
    C.cmp_pos_k = args.in[6]; C.cmp_w1_k = args.in[7]; C.cmp_w2_k = args.in[8]; C.cmp_pos_v = args.in[9]; C.cmp_w1_v = args.in[10]; C.cmp_w2_v = args.in[11];
    C.rel_bias = args.in[12]; C.w_out = args.in[13]; C.ln1_g = args.in[14]; C.ln1_b = args.in[15]; C.w_router = args.in[16]; C.e_bias = args.in[17];
    C.w_gate = args.in[18]; C.w_up = args.in[19]; C.w_down = args.in[20]; C.ws_gate = args.in[21]; C.ws_up = args.in[22]; C.ws_down = args.in[23];
    C.ln2_g = args.in[24]; C.ln2_b = args.in[25];
    C.out = args.out;
    unsigned char* ws = args.ws; C.wsb = ws;
    C.mod = (float*)(ws + WS_MOD); C.cum = (float*)(ws + WS_CUM); C.kvc = (float*)(ws + WS_KVC); C.posb = (float*)(ws + WS_POSB); C.w1t = (bf16*)(ws + WS_W1T); C.w2t = (bf16*)(ws + WS_W2T); C.kvc16 = (bf16*)(ws + WS_KVC16); C.wrt = (bf16*)(ws + WS_WRT);
    C.selmask = (unsigned*)(ws + WS_SELM); C.scorebuf = (float*)(ws + WS_SCB); C.scores = (float*)(ws + WS_SCORES);
    C.eidx = (int*)(ws + WS_EIDX); C.ew = (float*)(ws + WS_EW); C.fg = (float*)(ws + WS_FG);
    C.win_t = (bf16*)(ws + WS_WIN_T); C.wout_t = (bf16*)(ws + WS_WOUT_T); C.ao16 = (bf16*)(ws + WS_AO16); C.oc = (bf16*)(ws + WS_OC); C.ow = (bf16*)(ws + WS_OW);
    C.hbuf = (bf16*)(ws + WS_HBUF); C.proj = (bf16*)(ws + WS_PROJ); C.h2lo = (bf16*)(ws + WS_PROJ);
    C.pc = (float*)(ws + WS_PC);
    C.wgu = (bf16*)(ws + WS_WGU); C.wdn = (bf16*)(ws + WS_WDN); C.act16 = (bf16*)(ws + WS_ACT16); C.slot = (bf16*)(ws + WS_SLOT);
    C.lrow = (int*)(ws + WS_LROW); C.lw = (float*)(ws + WS_LW); C.ctl = (gu32*)(ws + WS_CTL);
#undef args
}
#if defined(ORACLE) && ORACLE == 3
__global__ void __launch_bounds__(256) k_oracle3a(Args args) {
    Ctx C; mkctx(C, args, (LAS unsigned char*)nullptr);
    const int NR = NB * NCMP * 2;
    for (int i = blockIdx.x * 256 + threadIdx.x; i < 2 * NR * 256; i += gridDim.x * 256) {
        const int j = i % 256, row = (i / 256) % NR, which = i / (256 * NR);
        const int g = row % 2, n = (row / 2) % NCMP, b = row / (2 * NCMP);
        const float* pos = which ? C.cmp_pos_v : C.cmp_pos_k; const float* w1 = which ? C.cmp_w1_v : C.cmp_w1_k;
        const int off = (which ? PC_VC : PC_KC) + g * 64;
        float acc = 0.f;
        for (int l = 0; l < 32; ++l) { const bf16* xr = C.proj + ((size_t)b * S + 16 * n + l) * PITCH + off;
            for (int d = 0; d < 64; ++d) acc += (bf2f(xr[d]) + pos[l * 64 + d]) * w1[(size_t)(l * 64 + d) * 256 + j]; }
        C.scorebuf[i] = silu_f(acc);
    }
}
__global__ void __launch_bounds__(256) k_oracle3b(Args args) {
    Ctx C; mkctx(C, args, (LAS unsigned char*)nullptr);
    const int NR = NB * NCMP * 2; float sd = 0.f, sr = 0.f;
    for (int i = blockIdx.x * 256 + threadIdx.x; i < 2 * NR * 64; i += gridDim.x * 256) {
        const int d = i % 64, row = (i / 64) % NR, which = i / (64 * NR);
        const float* w2 = which ? C.cmp_w2_v : C.cmp_w2_k; const float* hr = C.scorebuf + ((size_t)which * NR + row) * 256;
        float acc = 0.f; for (int j = 0; j < 256; ++j) acc += hr[j] * w2[j * 64 + d];
        const int g = row % 2, n = (row / 2) % NCMP, b = row / (2 * NCMP);
        const float got = bf2f(C.kvc16[((((size_t)which * 8 + b) * 2 + g) * 128 + n) * 64 + d]);
        const float got2 = C.kvc[i];
        sd += (got - acc) * (got - acc) + (got2 - acc) * (got2 - acc); sr += 2.f * acc * acc;
    }
    sd = wave_sum(sd); sr = wave_sum(sr);
    if ((threadIdx.x & 63) == 0) { atomicAdd((float*)(C.ctl + CW_ORA), sd); atomicAdd((float*)(C.ctl + CW_ORA + 64), sr); }
}
#endif
#if defined(ORACLE) && ORACLE < 3
__global__ void __launch_bounds__(256) k_oracle(Args args) {
    Ctx C; mkctx(C, args, (LAS unsigned char*)nullptr);
    C.gtid = blockIdx.x * 256 + threadIdx.x; C.GT = gridDim.x * 256;
    oracle_attn<ORACLE>(C);
}
#endif
constexpr int N_PHASES = 17;
__global__ void __launch_bounds__(NTHR, 2) mk_fwd(Args args) {
    extern __shared__ __attribute__((aligned(16))) unsigned char lds[];
    volatile LAS unsigned* MISC = (volatile LAS unsigned*)((LAS unsigned char*)lds + MISC_OFF);
    if (threadIdx.x < 32) MISC[threadIdx.x] = 0u;
    __syncthreads();
    (void)xcd_barrier_post((unsigned*)((gu32*)(args.ws + WS_CTL) + CW_BAR) + args.li * XCD_BAR_WORDS, MISC + 8);
#define bar (XcdBarrier{(unsigned*)((gu32*)(args.ws + WS_CTL) + CW_BAR) + args.li * XCD_BAR_WORDS, xb_xcc_id(), (volatile LAS unsigned*)((LAS unsigned char*)lds + MISC_OFF) + 8})
    const int lo = args.ph_lo, hi = args.ph_hi;
#ifndef PHASE_MASK
#define PHASE_MASK 0xffffffffu
#endif
#define IN(k) (((PHASE_MASK >> (k)) & 1u) && lo <= (k) && (k) < hi)
#define SEAM(k) do { if (IN(k) && IN((k) + 1)) xcd_barrier(bar); } while (0)
#ifndef DUP_MASK
#define DUP_MASK 0u
#endif
#define DUP(k) (((DUP_MASK >> (k)) & 1u) != 0u)
    if (IN(0)) { Ctx C; mkctx(C, args, (LAS unsigned char*)lds); for (int rep = 0; rep < (DUP(0) ? 2 : 1); ++rep) { if (rep) xcd_barrier(bar); if (!rep) ph_prologue(C); ph_mod(C); } }
    SEAM(0);
    if (IN(1)) { Ctx C; mkctx(C, args, (LAS unsigned char*)lds); ph_hpass(C); }
    SEAM(1);
    if (IN(2)) { Ctx C; mkctx(C, args, (LAS unsigned char*)lds);
        pg8::Gemm g{C.hbuf, C.win_t, T, 3072, D}; pg8::StaticOrder So; So.init(T, 3072, (int)gridDim.x, (int)blockIdx.x);
        pg8::EpiProj E{C.proj, C.fg, PITCH, C2};
        pg8::gemm_phase<pg8::EpiProj, pg8::StaticOrder, true, true>(C.lds, g, So, E);
    }
    SEAM(2);
    if (IN(3)) { Ctx C; mkctx(C, args, (LAS unsigned char*)lds); ph_cum_cmp1(C); ph_compress(C); }
    SEAM(3);
    if (IN(4)) { Ctx C; mkctx(C, args, (LAS unsigned char*)lds); for (int i = C.gtid; i < NB * 8 * S; i += C.GT) cmp_attn_item(C, i); }
    SEAM(4);
    if (IN(5)) { Ctx C; mkctx(C, args, (LAS unsigned char*)lds); ph_attn_a(C, (char*)lds); }
    SEAM(5);
    if (IN(6)) { Ctx C; mkctx(C, args, (LAS unsigned char*)lds); for (int rep = 0; rep < (DUP(6) ? 2 : 1); ++rep) { if (rep) xcd_barrier(bar); ph_imp_topk(C); } }
    SEAM(6);
    if (IN(7)) { Ctx C; mkctx(C, args, (LAS unsigned char*)lds); ph_attn_b(C, (char*)lds); }
    SEAM(7);
    if (IN(8)) { Ctx C; mkctx(C, args, (LAS unsigned char*)lds);
        pg8::Gemm g{C.ao16, C.wout_t, T, D, D}; pg8::StaticOrder So; So.init(T, D, (int)gridDim.x, (int)blockIdx.x);
        pg8::EpiOut E{C.x, C.mod, C.out, ALPHA};
        pg8::gemm_phase<pg8::EpiOut, pg8::StaticOrder, true, true>(C.lds, g, So, E);
    }
    SEAM(8);
    if (IN(9)) { Ctx C; mkctx(C, args, (LAS unsigned char*)lds); ph_ln<1>(C); ph_convert_experts(C); }
    SEAM(9);
    if (IN(10)) { Ctx C; mkctx(C, args, (LAS unsigned char*)lds); ph_router_route(C); }
    if (IN(10) && IN(12)) xcd_barrier(bar);
    if (IN(12)) { Ctx C; mkctx(C, args, (LAS unsigned char*)lds); ph_moe_gateup(C); }
    SEAM(12);
    if (IN(13)) { Ctx C; mkctx(C, args, (LAS unsigned char*)lds); ph_moe_down<0>(C); }
    SEAM(13);
    if (IN(14)) { Ctx C; mkctx(C, args, (LAS unsigned char*)lds); ph_combine<0>(C); }
    SEAM(14);
    if (IN(15)) { Ctx C; mkctx(C, args, (LAS unsigned char*)lds); ph_moe_down<1>(C); }
    SEAM(15);
    if (IN(16)) { Ctx C; mkctx(C, args, (LAS unsigned char*)lds); ph_combine<1>(C); }
#undef IN
#undef SEAM
#undef bar
}

extern "C" void kernel_launch(void* const* d_in, const int* in_sizes, int n_in, void* d_out, int out_size, void* d_ws, size_t ws_size, hipStream_t stream) {
    static int grid = 0;
    if (grid == 0) {
        if (n_in != 26 || out_size != T * D || ws_size < WS_END) { fprintf(stderr, "kernel_launch: unexpected problem (n_in %d out %d ws %zu)\n", n_in, out_size, ws_size); grid = -1; return; }
        int dev = 0, cus = 0, per_cu = 0;
        if (hipGetDevice(&dev) != hipSuccess || hipDeviceGetAttribute(&cus, hipDeviceAttributeMultiprocessorCount, dev) != hipSuccess) { grid = -1; return; }
        if (hipFuncSetAttribute((const void*)mk_fwd, hipFuncAttributeMaxDynamicSharedMemorySize, LDS_BYTES) != hipSuccess) { fprintf(stderr, "kernel_launch: hipFuncSetAttribute failed\n"); grid = -1; return; }
        if (hipOccupancyMaxActiveBlocksPerMultiprocessor(&per_cu, (const void*)mk_fwd, NTHR, LDS_BYTES) != hipSuccess || per_cu < 1) { fprintf(stderr, "kernel_launch: occupancy query says %d\n", per_cu); grid = -1; (void)hipGetLastError(); return; }
        grid = cus;
    }
    if (grid < 0) return;
    (void)hipMemsetAsync((char*)d_ws + WS_CTL, 0, CTL_ZERO_BYTES, stream);
    Args a{};
    for (int i = 0; i < 26; ++i) a.in[i] = (const float*)d_in[i];
    a.out = (float*)d_out; a.ws = (unsigned char*)d_ws; a.ph_lo = 0; a.ph_hi = N_PHASES;
#ifdef ORACLE
    a.ph_hi = 8; hipLaunchKernelGGL(mk_fwd, dim3(grid), dim3(NTHR), LDS_BYTES, stream, a);
#if ORACLE == 3
    hipLaunchKernelGGL(k_oracle3a, dim3(2048), dim3(256), 0, stream, a); hipLaunchKernelGGL(k_oracle3b, dim3(512), dim3(256), 0, stream, a);
#else
    hipLaunchKernelGGL(k_oracle, dim3(NB * 8 * S / 256), dim3(256), 0, stream, a);
#endif
    a.ph_lo = 8; a.ph_hi = N_PHASES; a.li = 1;
#endif
    hipLaunchKernelGGL(mk_fwd, dim3(grid), dim3(NTHR), LDS_BYTES, stream, a);
}
```

```cpp
#include <hip/hip_runtime.h>
#include <cstdio>
#include <cstdint>
#include <hip/hip_bf16.h>
#include <cmath>

#define GAS __attribute__((address_space(1)))
#define LAS __attribute__((address_space(3)))
typedef unsigned short bf16;
typedef float f32x4 __attribute__((ext_vector_type(4)));
typedef unsigned u32x4 __attribute__((ext_vector_type(4)));
typedef unsigned u32x2 __attribute__((ext_vector_type(2)));
typedef GAS unsigned gu32;
#define RLX_AGENT __ATOMIC_RELAXED, __HIP_MEMORY_SCOPE_AGENT

constexpr int D = 1024, NB = 8, S = 2048, T = NB * S;
constexpr int NPROJ = 2848;
constexpr int PITCH = 2816;
constexpr int PC_FQ = 0, PC_FK = 512, PC_FV = 1024, PC_NQ = 1536, PC_KC = 2048, PC_VC = 2176, PC_KS = 2304, PC_VS = 2432, PC_KW = 2560, PC_VW = 2688;
constexpr int FGW = 32;
constexpr int NCMP = 127;
constexpr float ALPHA = 1.189207115002721f;
constexpr float LN_EPS = 1e-5f;
constexpr float LOG2E = 1.4426950408889634f;
constexpr float C2 = 0.125f * LOG2E;
constexpr int NWAVES = 8, NTHR = NWAVES * 64;

constexpr size_t MiB = 1u << 20;
constexpr size_t WS_CTL = 0, CTL_ZERO_BYTES = 1 * MiB;
constexpr size_t WS_MOD = 1 * MiB, WS_CUM = 2 * MiB, WS_KVC = 3 * MiB, WS_W1T = 4 * MiB  , WS_KVC16 = 6 * MiB  , WS_W2T = 21 * MiB  , WS_POSB = 21 * MiB + 65536  , WS_WRT = 21 * MiB + 131072  , WS_SELM = 8 * MiB, WS_SCB = 9 * MiB, WS_SCORES = 13 * MiB,
                 WS_EIDX = 17 * MiB, WS_EW = 18 * MiB, WS_FG = 19 * MiB;
constexpr size_t WS_WIN_T = 22 * MiB;
constexpr size_t WS_WOUT_T = 28 * MiB;
constexpr size_t WS_HBUF = 30 * MiB;
constexpr size_t WS_PROJ = 62 * MiB;
constexpr size_t WS_PC = 150 * MiB;
constexpr size_t WS_AO16 = 214 * MiB;
constexpr size_t WS_OC = 246 * MiB, WS_OW = 262 * MiB;
constexpr size_t WS_WGU = 94 * MiB;
constexpr size_t WS_WDN = 167 * MiB;
constexpr size_t WS_ACT16 = 200 * MiB;
constexpr size_t WS_SLOT = 22 * MiB;
constexpr size_t WS_LROW = 280 * MiB, WS_LW = 285 * MiB;
constexpr size_t WS_END = 290 * MiB;
constexpr int CW_CNT = 16384;
constexpr int CW_BAR = 4096;

constexpr int LDS_BYTES = 147456;
constexpr int MISC_OFF = 131072 + 320;
constexpr int LDS_TSTART = 131072 + 1024, LDS_CNT = 131072 + 1536, LDS_TAB = 131072 + 2048;

#define XB_TMO      128
#define XB_XCNT(j)  (256  + 64 * (j))
#define XB_XSUB(j)  (1280 + 64 * (j))
#define XB_XGEN(j)  (2304 + 64 * (j))
#define XB_TOP      3328
#define XB_TOPGEN   3392
#define XCD_BAR_WORDS 3456
#define XB_SPIN_CAP (1u << 20)
__device__ __forceinline__ unsigned xb_ld(unsigned* p)              { return __hip_atomic_load(p, __ATOMIC_RELAXED, __HIP_MEMORY_SCOPE_AGENT); }
__device__ __forceinline__ unsigned xb_add(unsigned* p, unsigned v) { return __hip_atomic_fetch_add(p, v, __ATOMIC_RELAXED, __HIP_MEMORY_SCOPE_AGENT); }
__device__ __forceinline__ unsigned xb_xcc_id() { return (unsigned)__builtin_amdgcn_s_getreg((3 << 11) | 20) & 0xFu; }
#define XB_SPIN(cond, bar) do { unsigned _sp = 0; while (cond) { __builtin_amdgcn_s_sleep(1); \
    if ((++_sp & 255u) == 0u) { if (xb_ld(&(bar)[XB_TMO])) break; if (_sp > XB_SPIN_CAP) { atomicAdd(&(bar)[XB_TMO], 1u); break; } } } } while (0)
struct XcdBarrier { unsigned* bar; unsigned x; volatile LAS unsigned* st; };
__device__ __forceinline__ XcdBarrier xcd_barrier_post(unsigned* bar, volatile LAS unsigned* st) {
    XcdBarrier b; b.bar = bar; b.x = xb_xcc_id(); b.st = st;
    if (threadIdx.x == 0) (void)xb_add(&bar[XB_XCNT(b.x)], 1u);
    return b;
}
__device__ __forceinline__ void xcd_barrier_complete(unsigned* bar, unsigned x, unsigned& nloc, unsigned& nx) {
    const unsigned G = gridDim.x * gridDim.y * gridDim.z;
    unsigned sum, cnt, mine, sp = 0u;
    for (;;) {
        sum = 0u; cnt = 0u; mine = 0u;
#pragma unroll
        for (unsigned j = 0; j < 16; ++j) { const unsigned c = xb_ld(&bar[XB_XCNT(j)]); sum += c; cnt += (c > 0u) ? 1u : 0u; mine = (j == x) ? c : mine; }
        if (sum == G) break;
        __builtin_amdgcn_s_sleep(1);
        if ((++sp & 255u) == 0u) { if (xb_ld(&bar[XB_TMO])) break; if (sp > XB_SPIN_CAP) { atomicAdd(&bar[XB_TMO], 1u); break; } }
    }
    nloc = mine > 0u ? mine : 1u; nx = cnt > 0u ? cnt : 1u;
}
__device__ __forceinline__ void xcd_barrier(const XcdBarrier& b) {
    asm volatile("s_waitcnt vmcnt(0)" ::: "memory");
    __syncthreads();
    if (threadIdx.x == 0) {
        unsigned* bar = b.bar;
        __builtin_amdgcn_s_waitcnt(0);
        unsigned nloc = b.st[0], nx = b.st[1];
        if (nloc == 0u) { xcd_barrier_complete(bar, b.x, nloc, nx); b.st[0] = nloc; b.st[1] = nx; }
        const unsigned old = xb_add(&bar[XB_XSUB(b.x)], 1u);
        const unsigned gen = old / nloc;
        if (old + 1u == (gen + 1u) * nloc) {
            __builtin_amdgcn_fence(__ATOMIC_RELEASE, "agent");
            asm volatile("s_waitcnt vmcnt(0)" ::: "memory");
            const unsigned og = xb_add(&bar[XB_TOP], 1u);
            const unsigned tg = og / nx;
            if (og + 1u == (tg + 1u) * nx) xb_add(&bar[XB_TOPGEN], 1u);
            else XB_SPIN(xb_ld(&bar[XB_TOPGEN]) == tg, bar);
            __builtin_amdgcn_fence(__ATOMIC_ACQUIRE, "agent");
            xb_add(&bar[XB_XGEN(b.x)], 1u);
            asm volatile("s_waitcnt vmcnt(0)" ::: "memory");
        } else {
            XB_SPIN(xb_ld(&bar[XB_XGEN(b.x)]) == gen, bar);
            __builtin_amdgcn_fence(__ATOMIC_ACQUIRE, "agent");
            asm volatile("s_waitcnt vmcnt(0)" ::: "memory");
        }
    }
    __syncthreads();
}

namespace pg8 {
#define PG8_LAS __attribute__((address_space(3)))
typedef unsigned short bf16_t;
typedef short bf16x8 __attribute__((ext_vector_type(8)));
typedef float f32x4 __attribute__((ext_vector_type(4)));
typedef unsigned u32x4 __attribute__((ext_vector_type(4)));
constexpr int BM = 256, BK = 64, HALF = 128, HTB = HALF * BK * 2  , STAGE_BYTES = 8 * HTB, NXCD = 8, WGM = 8;

__host__ __device__ __forceinline__ int lds_byte(int r, int c) { const int st = (r >> 4) * 2 + (c >> 5), rr = r & 15, cc = c & 31, ob = rr * 64 + cc * 2; return st * 1024 + (ob ^ (((ob >> 9) & 1) << 5)); }
__host__ __device__ __forceinline__ void stage_rc(int b, int& R, int& C) { const int st = b / 1024, sb = b % 1024, swz = sb ^ (((sb >> 9) & 1) << 5); R = (st >> 1) * 16 + swz / 64; C = (st & 1) * 32 + (swz % 64) / 2; }
__host__ __device__ __forceinline__ int perm32(int rho) { const int n = rho >> 4, i = rho & 15; return 8 * (i >> 2) + 4 * n + (i & 3); }

struct Unit { int pm, pn; };
struct Gemm { const bf16_t* A; const bf16_t* Bt; int M, N, K; };

struct StaticOrder {
    int nM, nN, nwg, G, c;
    __host__ __device__ void init(int M, int N, int G_, int c_) { nM = M / BM; nN = N / BM; nwg = nM * nN; G = G_; c = c_; }
    __host__ __device__ bool next(int i, Unit& u) const {
        const long L = (long)i * G + c; if (L >= nwg) return false;
        int wgid = (int)L; { const int q = nwg / NXCD, r = nwg % NXCD, xcd = wgid % NXCD, off = wgid / NXCD; wgid = (xcd < r ? xcd * (q + 1) : r * (q + 1) + (xcd - r) * q) + off; }
        const int nig = WGM * nN, gid = wgid / nig, fm = gid * WGM, gsz = (nM - fm) < WGM ? (nM - fm) : WGM;
        u.pm = fm + ((wgid % nig) % gsz); u.pn = (wgid % nig) / gsz; return true;
    }
    __device__ __forceinline__ void a_ready(const Unit&) const {}
    __device__ __forceinline__ void done(const Unit&) const {}
};


__device__ __forceinline__ unsigned cvt_pk_bf16(float lo, float hi) { unsigned r; asm volatile("v_cvt_pk_bf16_f32 %0, %1, %2" : "=v"(r) : "v"(lo), "v"(hi)); return r; }
struct EpiProj {
    static constexpr bool PERM = true, AFTER_DRAIN = false;
    bf16_t* proj; float* fg; int pitch; float qscale;
    __device__ __forceinline__ void operator()(const f32x4 (&acc)[2][2][4][2], const Unit& u, int wr, int wc, int fr, int fq) const {
        const int row0 = u.pm * BM + wr * 64 + fr;
        if (u.pn < 11) {
            const float sc = (u.pn < 2 || u.pn == 6 || u.pn == 7) ? qscale : 1.f;
            const int col0 = u.pn * BM + wc * 32 + 8 * fq;
#pragma unroll
            for (int ai = 0; ai < 2; ++ai)
#pragma unroll
                for (int m = 0; m < 4; ++m) { bf16_t* rowp = proj + (size_t)(row0 + ai * HALF + m * 16) * pitch + col0;
#pragma unroll
                    for (int bj = 0; bj < 2; ++bj) { const f32x4 v0 = acc[ai][bj][m][0] * sc, v1 = acc[ai][bj][m][1] * sc;
                        u32x4 w; w.x = cvt_pk_bf16(v0[0], v0[1]); w.y = cvt_pk_bf16(v0[2], v0[3]); w.z = cvt_pk_bf16(v1[0], v1[1]); w.w = cvt_pk_bf16(v1[2], v1[3]);
                        *(u32x4*)(rowp + bj * HALF) = w; } }
        } else if (wc == 0) {
#pragma unroll
            for (int ai = 0; ai < 2; ++ai)
#pragma unroll
                for (int m = 0; m < 4; ++m) { float* fp = fg + (size_t)(row0 + ai * HALF + m * 16) * 32 + 8 * fq;
                    *(f32x4*)fp = acc[ai][0][m][0]; *(f32x4*)(fp + 4) = acc[ai][0][m][1]; }
        }
    }
};
struct EpiOut {
    static constexpr bool PERM = false, AFTER_DRAIN = false;
    const float* x; const float* mod; float* out; float alpha;
    __device__ __forceinline__ void operator()(const f32x4 (&acc)[2][2][4][2], const Unit& u, int wr, int wc, int fr, int fq) const {
        const int row0 = u.pm * BM + wr * 64 + fr;
#pragma unroll
        for (int ai = 0; ai < 2; ++ai)
#pragma unroll
            for (int m = 0; m < 4; ++m) { const int r = row0 + ai * HALF + m * 16; const float* g1 = mod + (r / 2048) * 6144 + 2048;
#pragma unroll
                for (int bj = 0; bj < 2; ++bj)
#pragma unroll
                    for (int n = 0; n < 2; ++n) { const int c = u.pn * BM + bj * HALF + wc * 32 + 16 * n + 4 * fq;
                        const f32x4 xv = *(const f32x4*)(x + (size_t)r * 1024 + c), gv = *(const f32x4*)(g1 + c);
                        *(f32x4*)(out + (size_t)r * 1024 + c) = xv * alpha + gv * acc[ai][bj][m][n]; } }
    }
};
template <class Epi, class Sched, bool ALIGN_EPI = false, bool SP2 = false>
__device__ __forceinline__ void gemm_phase(PG8_LAS unsigned char* lds, const Gemm g, const Sched& S, const Epi& E) {
    const int tid = threadIdx.x, wid = __builtin_amdgcn_readfirstlane(tid >> 6), lane = tid & 63, wr = wid >> 2, wc = wid & 3, fr = lane & 15, fq = lane >> 4;
    const int K = g.K, nt = K / BK;
    unsigned voffA[2], voffB[2];
#pragma unroll
    for (int i = 0; i < 2; ++i) { int R, C; stage_rc(tid * 16 + i * 8192, R, C); const int Rb = Epi::PERM ? ((R & ~31) + perm32(R & 31)) : R;
        voffA[i] = (unsigned)(R * K + C) * 2u; voffB[i] = (unsigned)(Rb * K + C) * 2u; }
    const size_t kstep = (size_t)(BK * 2);
    const size_t hstep = (size_t)HALF * K * 2;
    const size_t tstep = 2 * hstep;
    const unsigned ldsw = (unsigned)wid * 1024u;
    const int aoff = lds_byte(wr * 64 + fr, fq * 8), boff = lds_byte(wc * 32 + fr, fq * 8);
#define PG8_SA(b, h) (((b) * 2 + (h)) * HTB)
#define PG8_SB(b, h) ((4 + (b) * 2 + (h)) * HTB)
#define PG8_STAGE(bufoff, gbase, voff) do { _Pragma("unroll") for (int _i = 0; _i < 2; ++_i) \
        __builtin_amdgcn_global_load_lds((const unsigned*)((const char*)(gbase) + (voff)[_i]), (PG8_LAS unsigned*)(lds + (bufoff) + ldsw + _i * 8192), 16, 0, 0); } while (0)
#define PG8_LDA(dst, b, h) do { _Pragma("unroll") for (int m = 0; m < 4; ++m) _Pragma("unroll") for (int k = 0; k < 2; ++k) dst[m][k] = *(const PG8_LAS bf16x8*)(lds + PG8_SA(b, h) + aoff + m * 2048 + k * 1024); } while (0)
#define PG8_LDB(dst, b, h) do { _Pragma("unroll") for (int n = 0; n < 2; ++n) _Pragma("unroll") for (int k = 0; k < 2; ++k) dst[n][k] = *(const PG8_LAS bf16x8*)(lds + PG8_SB(b, h) + boff + n * 2048 + k * 1024); } while (0)
#define PG8_MMA(ai, bj, At, Bt) do { __builtin_amdgcn_s_setprio(1); _Pragma("unroll") for (int m = 0; m < 4; ++m) _Pragma("unroll") for (int n = 0; n < 2; ++n) _Pragma("unroll") for (int k = 0; k < 2; ++k) \
        acc[ai][bj][m][n] = __builtin_amdgcn_mfma_f32_16x16x32_bf16(Bt[n][k], At[m][k], acc[ai][bj][m][n], 0, 0, 0); __builtin_amdgcn_s_setprio(0); } while (0)
#define PG8_WAIT_V(n) asm volatile("s_waitcnt vmcnt(" #n ")" ::: "memory")
#define PG8_WAIT_L(n) asm volatile("s_waitcnt lgkmcnt(" #n ")" ::: "memory")
#define PG8_BAR __builtin_amdgcn_s_barrier()
#define PG8_SCHED __builtin_amdgcn_sched_barrier(0)
    Unit cur, nxt; int ui = 0;
    if (!S.next(0, cur)) return;
    f32x4 acc[2][2][4][2];
#pragma unroll
    for (int a = 0; a < 2; ++a)
#pragma unroll
        for (int b = 0; b < 2; ++b)
#pragma unroll
            for (int m = 0; m < 4; ++m)
#pragma unroll
                for (int n = 0; n < 2; ++n) acc[a][b][m][n] = (f32x4){0.f, 0.f, 0.f, 0.f};
    bf16x8 At[4][2], B0[2][2], B1[2][2];
    const char* cA = (const char*)g.A + (size_t)cur.pm * tstep; const char* cB = (const char*)g.Bt + (size_t)cur.pn * tstep;
    S.a_ready(cur);
    if constexpr (SP2) {
        PG8_STAGE(PG8_SB(0, 0), cB, voffB); PG8_STAGE(PG8_SB(0, 1), cB + hstep, voffB); PG8_STAGE(PG8_SA(0, 0), cA, voffA); PG8_STAGE(PG8_SA(0, 1), cA + hstep, voffA);
        if (wr == 1) PG8_BAR;
        PG8_WAIT_V(2); PG8_BAR;
        PG8_STAGE(PG8_SB(1, 0), cB + kstep, voffB); PG8_STAGE(PG8_SA(1, 0), cA + kstep, voffA); PG8_STAGE(PG8_SB(1, 1), cB + hstep + kstep, voffB);
        PG8_WAIT_V(6); PG8_BAR;
    } else {
        PG8_STAGE(PG8_SB(0, 0), cB, voffB); PG8_STAGE(PG8_SA(0, 0), cA, voffA); PG8_STAGE(PG8_SB(0, 1), cB + hstep, voffB); PG8_STAGE(PG8_SA(0, 1), cA + hstep, voffA);
        if (wr == 1) PG8_BAR;
        PG8_WAIT_V(4); PG8_BAR;
        PG8_STAGE(PG8_SB(1, 0), cB + kstep, voffB); PG8_STAGE(PG8_SA(1, 0), cA + kstep, voffA); PG8_STAGE(PG8_SB(1, 1), cB + hstep + kstep, voffB);
        PG8_WAIT_V(6); PG8_BAR;
    }
    for (;;) {
        const bool has_next = S.next(ui + 1, nxt);
        const char* nA = has_next ? (const char*)g.A + (size_t)nxt.pm * tstep : cA; const char* nB = has_next ? (const char*)g.Bt + (size_t)nxt.pn * tstep : cB;
        for (int t = 0; t < nt; t += 2) {
            const bool last = (t == nt - 2);
            const char* a1 = cA + (size_t)(t + 1) * kstep;
            const char* a2 = last ? nA : cA + (size_t)(t + 2) * kstep; const char* b2 = last ? nB : cB + (size_t)(t + 2) * kstep;
            const char* a3 = a2 + kstep; const char* b3 = b2 + kstep;
            if (last && has_next) S.a_ready(nxt);
            if constexpr (SP2) {
            PG8_LDB(B0, 0, 0); PG8_LDB(B1, 0, 1); PG8_SCHED; PG8_LDA(At, 0, 0); PG8_STAGE(PG8_SA(1, 1), a1 + hstep, voffA);
            PG8_WAIT_V(8); PG8_WAIT_L(0); PG8_BAR; PG8_MMA(0, 0, At, B0); PG8_MMA(0, 1, At, B1); PG8_BAR; PG8_SCHED;
            PG8_LDA(At, 0, 1); PG8_STAGE(PG8_SB(0, 0), b2, voffB); PG8_STAGE(PG8_SB(0, 1), b2 + hstep, voffB); PG8_STAGE(PG8_SA(0, 0), a2, voffA);
            PG8_WAIT_V(8); PG8_WAIT_L(0); PG8_BAR; PG8_MMA(1, 0, At, B0); PG8_MMA(1, 1, At, B1); PG8_BAR; PG8_SCHED;
            PG8_LDB(B0, 1, 0); PG8_LDB(B1, 1, 1); PG8_SCHED; PG8_LDA(At, 1, 0); PG8_STAGE(PG8_SA(0, 1), a2 + hstep, voffA);
            PG8_WAIT_V(8); PG8_WAIT_L(0); PG8_BAR; PG8_MMA(0, 0, At, B0); PG8_MMA(0, 1, At, B1); PG8_BAR; PG8_SCHED;
            PG8_LDA(At, 1, 1); PG8_STAGE(PG8_SB(1, 0), b3, voffB); PG8_STAGE(PG8_SB(1, 1), b3 + hstep, voffB); PG8_STAGE(PG8_SA(1, 0), a3, voffA);
            PG8_WAIT_V(8); PG8_WAIT_L(0); PG8_BAR; PG8_MMA(1, 0, At, B0); PG8_MMA(1, 1, At, B1); PG8_BAR; PG8_SCHED;
            } else {
            PG8_LDB(B0, 0, 0); PG8_SCHED; PG8_LDA(At, 0, 0); PG8_STAGE(PG8_SA(1, 1), a1 + hstep, voffA);
            PG8_WAIT_L(8); PG8_BAR; PG8_WAIT_L(0); PG8_MMA(0, 0, At, B0); PG8_BAR; PG8_SCHED;
            PG8_LDB(B1, 0, 1); PG8_STAGE(PG8_SB(0, 0), b2, voffB);
            PG8_BAR; PG8_WAIT_L(0); PG8_MMA(0, 1, At, B1); PG8_BAR;
            PG8_LDA(At, 0, 1); PG8_STAGE(PG8_SA(0, 0), a2, voffA);
            PG8_BAR; PG8_WAIT_L(0); PG8_MMA(1, 0, At, B0); PG8_BAR; PG8_SCHED;
            PG8_STAGE(PG8_SB(0, 1), b2 + hstep, voffB);
            PG8_WAIT_V(6); PG8_BAR; PG8_MMA(1, 1, At, B1); PG8_BAR;
            PG8_LDB(B0, 1, 0); PG8_SCHED; PG8_LDA(At, 1, 0); PG8_STAGE(PG8_SA(0, 1), a2 + hstep, voffA);
            PG8_WAIT_L(8); PG8_BAR; PG8_WAIT_L(0); PG8_MMA(0, 0, At, B0); PG8_BAR; PG8_SCHED;
            PG8_LDB(B1, 1, 1); PG8_STAGE(PG8_SB(1, 0), b3, voffB);
            PG8_BAR; PG8_WAIT_L(0); PG8_MMA(0, 1, At, B1); PG8_BAR;
            PG8_LDA(At, 1, 1); PG8_STAGE(PG8_SA(1, 0), a3, voffA);
            PG8_BAR; PG8_WAIT_L(0); PG8_MMA(1, 0, At, B0); PG8_BAR; PG8_SCHED;
            PG8_STAGE(PG8_SB(1, 1), b3 + hstep, voffB);
            PG8_WAIT_V(6); PG8_BAR; PG8_MMA(1, 1, At, B1); PG8_BAR;
            }
        }
        if constexpr (ALIGN_EPI) { if (wr == 0) PG8_BAR; }
        if constexpr (!Epi::AFTER_DRAIN) { E(acc, cur, wr, wc, fr, fq); S.done(cur); }
        if (!has_next) break;
#pragma unroll
        for (int a = 0; a < 2; ++a)
#pragma unroll
            for (int b = 0; b < 2; ++b)
#pragma unroll
                for (int m = 0; m < 4; ++m)
#pragma unroll
                    for (int n = 0; n < 2; ++n) acc[a][b][m][n] = (f32x4){0.f, 0.f, 0.f, 0.f};
        cur = nxt; cA = nA; cB = nB; ++ui;
        if constexpr (ALIGN_EPI) { if (wr == 1) PG8_BAR; }
    }
    PG8_WAIT_V(0);
    if constexpr (!ALIGN_EPI) { if (wr == 0) PG8_BAR; }
    PG8_BAR;
    if constexpr (Epi::AFTER_DRAIN) { E.fused(acc, cur, wr, wc, fr, fq, lds, wid, lane); S.done(cur); }
#undef PG8_SA
#undef PG8_SB
#undef PG8_STAGE
#undef PG8_LDA
#undef PG8_LDB
#undef PG8_MMA
#undef PG8_WAIT_V
#undef PG8_WAIT_L
#undef PG8_BAR
#undef PG8_SCHED
}
struct UnitM { int e, mt, pn, arow0, nvalid; };
constexpr int TAB_SLOT_BYTES = 2048;
template <class Epi, class Sched, bool GATHER>
__device__ __forceinline__ void gemm_phase_g(PG8_LAS unsigned char* lds, PG8_LAS unsigned char* tab, const bf16_t* A, const int K, const Sched& S, const Epi& E) {
    const int tid = threadIdx.x, wid = __builtin_amdgcn_readfirstlane(tid >> 6), lane = tid & 63, wr = wid >> 2, wc = wid & 3, fr = lane & 15, fq = lane >> 4;
    const int nt = K / BK;
    unsigned voffB[2];
#pragma unroll
    for (int i = 0; i < 2; ++i) { int R, C; stage_rc(tid * 16 + i * 8192, R, C); const int Rb = Epi::PERM ? ((R & ~31) + perm32(R & 31)) : R;
        voffB[i] = (unsigned)(Rb * K + C) * 2u; }
    const size_t kstep = (size_t)(BK * 2);
    const size_t hstep = (size_t)HALF * K * 2;
    const unsigned ldsw = (unsigned)wid * 1024u;
    const int aoff = lds_byte(wr * 64 + fr, fq * 8), boff = lds_byte(wc * 32 + fr, fq * 8);
#define PG8_SA(b, h) (((b) * 2 + (h)) * HTB)
#define PG8_SB(b, h) ((4 + (b) * 2 + (h)) * HTB)
#define PG8_STAGE(bufoff, gbase, voff) do { _Pragma("unroll") for (int _i = 0; _i < 2; ++_i) \
        __builtin_amdgcn_global_load_lds((const unsigned*)((const char*)(gbase) + (voff)[_i]), (PG8_LAS unsigned*)(lds + (bufoff) + ldsw + _i * 8192), 16, 0, 0); } while (0)
#define PG8_STAGEA(bufoff, gbase, o0, o1) do { \
        __builtin_amdgcn_global_load_lds((const unsigned*)((const char*)(gbase) + (o0)), (PG8_LAS unsigned*)(lds + (bufoff) + ldsw), 16, 0, 0); \
        __builtin_amdgcn_global_load_lds((const unsigned*)((const char*)(gbase) + (o1)), (PG8_LAS unsigned*)(lds + (bufoff) + ldsw + 8192), 16, 0, 0); } while (0)
#define PG8_LDA(dst, b, h) do { _Pragma("unroll") for (int m = 0; m < 4; ++m) _Pragma("unroll") for (int k = 0; k < 2; ++k) dst[m][k] = *(const PG8_LAS bf16x8*)(lds + PG8_SA(b, h) + aoff + m * 2048 + k * 1024); } while (0)
#define PG8_LDB(dst, b, h) do { _Pragma("unroll") for (int n = 0; n < 2; ++n) _Pragma("unroll") for (int k = 0; k < 2; ++k) dst[n][k] = *(const PG8_LAS bf16x8*)(lds + PG8_SB(b, h) + boff + n * 2048 + k * 1024); } while (0)
#define PG8_MMA(ai, bj, At, Bt) do { __builtin_amdgcn_s_setprio(1); _Pragma("unroll") for (int m = 0; m < 4; ++m) _Pragma("unroll") for (int n = 0; n < 2; ++n) _Pragma("unroll") for (int k = 0; k < 2; ++k) \
        acc[ai][bj][m][n] = __builtin_amdgcn_mfma_f32_16x16x32_bf16(Bt[n][k], At[m][k], acc[ai][bj][m][n], 0, 0, 0); __builtin_amdgcn_s_setprio(0); } while (0)
#define PG8_WAIT_V(n) asm volatile("s_waitcnt vmcnt(" #n ")" ::: "memory")
#define PG8_WAIT_L(n) asm volatile("s_waitcnt lgkmcnt(" #n ")" ::: "memory")
#define PG8_BAR __builtin_amdgcn_s_barrier()
#define PG8_SCHED __builtin_amdgcn_sched_barrier(0)
#define PG8_AOFFS(dst, u, tslot) do { _Pragma("unroll") for (int h = 0; h < 2; ++h) _Pragma("unroll") for (int i = 0; i < 2; ++i) { int RA_, CA_; stage_rc(tid * 16 + i * 8192, RA_, CA_); const int R_ = h * HALF + RA_; int row_; \
        if (GATHER) { const int inf_ = *(const PG8_LAS int*)(tab + (tslot) * TAB_SLOT_BYTES + R_ * 4); row_ = R_ < (u).nvalid ? (inf_ >> 4) : 0; } else row_ = (u).arow0 + R_; \
        dst[h][i] = (unsigned)(row_ * K + CA_) * 2u; } } while (0)
    UnitM cur, nxt; int ui = 0;
    if (!S.next(0, cur)) return;
    if (wid == 0) S.load_tab(cur, tab, lane);
    asm volatile("s_waitcnt vmcnt(0)" ::: "memory"); __builtin_amdgcn_s_barrier(); asm volatile("" ::: "memory");
    f32x4 acc[2][2][4][2];
#pragma unroll
    for (int a = 0; a < 2; ++a)
#pragma unroll
        for (int b = 0; b < 2; ++b)
#pragma unroll
            for (int m = 0; m < 4; ++m)
#pragma unroll
                for (int n = 0; n < 2; ++n) acc[a][b][m][n] = (f32x4){0.f, 0.f, 0.f, 0.f};
    bf16x8 At[4][2], B0[2][2], B1[2][2];
    unsigned cao[2][2];
    PG8_AOFFS(cao, cur, 0);
    const char* cB = S.b_base(cur);
    const char* Ab = (const char*)A;
    PG8_STAGE(PG8_SB(0, 0), cB, voffB); PG8_STAGE(PG8_SB(0, 1), cB + hstep, voffB); PG8_STAGEA(PG8_SA(0, 0), Ab, cao[0][0], cao[0][1]); PG8_STAGEA(PG8_SA(0, 1), Ab, cao[1][0], cao[1][1]);
    if (wr == 1) PG8_BAR;
    PG8_WAIT_V(2); PG8_BAR;
    PG8_STAGE(PG8_SB(1, 0), cB + kstep, voffB); PG8_STAGEA(PG8_SA(1, 0), Ab + kstep, cao[0][0], cao[0][1]); PG8_STAGE(PG8_SB(1, 1), cB + hstep + kstep, voffB);
    PG8_WAIT_V(6); PG8_BAR;
    for (;;) {
        const bool has_next = S.next(ui + 1, nxt);
        const int tslot_n = (ui + 1) % 3;
        if (has_next && wid == 0) S.load_tab(nxt, tab + tslot_n * TAB_SLOT_BYTES, lane);
        const char* nB = has_next ? S.b_base(nxt) : cB;
#pragma unroll 1
        for (int t = 0; t < nt; t += 2) {
            const bool last = (t == nt - 2);
            const char* a1 = Ab + (size_t)(t + 1) * kstep;
            const char* a2 = last ? Ab : Ab + (size_t)(t + 2) * kstep; const char* b2 = last ? nB : cB + (size_t)(t + 2) * kstep;
            const char* a3 = a2 + kstep; const char* b3 = b2 + kstep;
            PG8_LDB(B0, 0, 0); PG8_LDB(B1, 0, 1); PG8_SCHED; PG8_LDA(At, 0, 0); PG8_STAGEA(PG8_SA(1, 1), a1, cao[1][0], cao[1][1]);
            PG8_WAIT_V(8); PG8_WAIT_L(0); PG8_BAR; PG8_MMA(0, 0, At, B0); PG8_MMA(0, 1, At, B1); PG8_BAR; PG8_SCHED;
            if (last && has_next) { PG8_AOFFS(cao, nxt, tslot_n); }
            PG8_LDA(At, 0, 1); PG8_STAGE(PG8_SB(0, 0), b2, voffB); PG8_STAGE(PG8_SB(0, 1), b2 + hstep, voffB); PG8_STAGEA(PG8_SA(0, 0), a2, cao[0][0], cao[0][1]);
            PG8_WAIT_V(8); PG8_WAIT_L(0); PG8_BAR; PG8_MMA(1, 0, At, B0); PG8_MMA(1, 1, At, B1); PG8_BAR; PG8_SCHED;
            PG8_LDB(B0, 1, 0); PG8_LDB(B1, 1, 1); PG8_SCHED; PG8_LDA(At, 1, 0); PG8_STAGEA(PG8_SA(0, 1), a2, cao[1][0], cao[1][1]);
            PG8_WAIT_V(8); PG8_WAIT_L(0); PG8_BAR; PG8_MMA(0, 0, At, B0); PG8_MMA(0, 1, At, B1); PG8_BAR; PG8_SCHED;
            PG8_LDA(At, 1, 1); PG8_STAGE(PG8_SB(1, 0), b3, voffB); PG8_STAGE(PG8_SB(1, 1), b3 + hstep, voffB); PG8_STAGEA(PG8_SA(1, 0), a3, cao[0][0], cao[0][1]);
            PG8_WAIT_V(8); PG8_WAIT_L(0); PG8_BAR; PG8_MMA(1, 0, At, B0); PG8_MMA(1, 1, At, B1); PG8_BAR; PG8_SCHED;
        }
        if (wr == 0) PG8_BAR;
        E(acc, cur, wr, wc, fr, fq, tab + (ui % 3) * TAB_SLOT_BYTES);
        if (!has_next) break;
#pragma unroll
        for (int a = 0; a < 2; ++a)
#pragma unroll
            for (int b = 0; b < 2; ++b)
#pragma unroll
                for (int m = 0; m < 4; ++m)
#pragma unroll
                    for (int n = 0; n < 2; ++n) acc[a][b][m][n] = (f32x4){0.f, 0.f, 0.f, 0.f};
        cur = nxt; cB = nB; ++ui;
        if (wr == 1) PG8_BAR;
    }
    PG8_WAIT_V(0);
    PG8_BAR;
#undef PG8_SA
#undef PG8_SB
#undef PG8_STAGE
#undef PG8_STAGEA
#undef PG8_LDA
#undef PG8_LDB
#undef PG8_MMA
#undef PG8_WAIT_V
#undef PG8_WAIT_L
#undef PG8_BAR
#undef PG8_SCHED
#undef PG8_AOFFS
}
struct MoeSched {
    const PG8_LAS int* tstart; const PG8_LAS int* cnt;
    const int* lrow; const float* lw;
    const char* Bt; size_t e_stride, pn_stride;
    int MT, NP, pn0, G, c;
    __device__ __forceinline__ bool next(int i, UnitM& u) const {
        const int L = i * G + c; if (L >= MT * NP) return false;
        const int mtg = L / NP; u.pn = pn0 + L % NP;
        int e = 0;
        for (int k = 1; k < 65; ++k) e += (tstart[k] <= mtg) ? 1 : 0;
        u.e = e; u.mt = mtg - tstart[e]; u.arow0 = mtg * 256; const int rem = cnt[e] - u.mt * 256; u.nvalid = rem < 256 ? rem : 256;
        return true;
    }
    __device__ __forceinline__ const char* b_base(const UnitM& u) const { return Bt + (size_t)u.e * e_stride + (size_t)u.pn * pn_stride; }
    __device__ __forceinline__ void load_tab(const UnitM& u, PG8_LAS unsigned char* dst, int lane) const {
        const size_t off = (size_t)u.e * 16384 + u.mt * 256 + lane * 4;
        __builtin_amdgcn_global_load_lds((const unsigned*)(lrow + off), (PG8_LAS unsigned*)dst, 16, 0, 0);
        __builtin_amdgcn_global_load_lds((const unsigned*)(lw + off), (PG8_LAS unsigned*)(dst + 1024), 16, 0, 0);
    }
};
struct EpiAct {
    static constexpr bool PERM = true;
    bf16_t* act;
    __device__ __forceinline__ void operator()(const f32x4 (&acc)[2][2][4][2], const UnitM& u, int wr, int wc, int fr, int fq, const PG8_LAS unsigned char* tab) const {
#pragma unroll
        for (int ai = 0; ai < 2; ++ai)
#pragma unroll
            for (int m = 0; m < 4; ++m) { const int r = ai * HALF + wr * 64 + m * 16 + fr;
                float w = *(const PG8_LAS float*)(tab + 1024 + r * 4); w = r < u.nvalid ? w : 0.f;
                float v[8];
#pragma unroll
                for (int n = 0; n < 2; ++n)
#pragma unroll
                    for (int i = 0; i < 4; ++i) { const float g = acc[ai][0][m][n][i], up = acc[ai][1][m][n][i];
                        v[n * 4 + i] = g * __builtin_amdgcn_rcpf(1.f + __builtin_amdgcn_exp2f(-1.4426950408889634f * g)) * up * w; }
                u32x4 o; o.x = cvt_pk_bf16(v[0], v[1]); o.y = cvt_pk_bf16(v[2], v[3]); o.z = cvt_pk_bf16(v[4], v[5]); o.w = cvt_pk_bf16(v[6], v[7]);
                *(u32x4*)(act + (size_t)(u.arow0 + r) * 256 + u.pn * 128 + wc * 32 + 8 * fq) = o; }
    }
};
struct EpiSlot {
    static constexpr bool PERM = true;
    bf16_t* slot; int pn_half0; unsigned dump_row;
    __device__ __forceinline__ void operator()(const f32x4 (&acc)[2][2][4][2], const UnitM& u, int wr, int wc, int fr, int fq, const PG8_LAS unsigned char* tab) const {
#pragma unroll
        for (int ai = 0; ai < 2; ++ai)
#pragma unroll
            for (int m = 0; m < 4; ++m) { const int r = ai * HALF + wr * 64 + m * 16 + fr;
                const int inf = *(const PG8_LAS int*)(tab + r * 4);
                const unsigned srow = r < u.nvalid ? (unsigned)(inf >> 4) * 9u + (unsigned)(inf & 15) : dump_row;
                bf16_t* dst = slot + (size_t)srow * 512 + (u.pn - pn_half0) * 256 + wc * 32 + 8 * fq;
#pragma unroll
                for (int bj = 0; bj < 2; ++bj) { const f32x4 v0 = acc[ai][bj][m][0], v1 = acc[ai][bj][m][1];
                    u32x4 o; o.x = cvt_pk_bf16(v0[0], v0[1]); o.y = cvt_pk_bf16(v0[2], v0[3]); o.z = cvt_pk_bf16(v1[0], v1[1]); o.w = cvt_pk_bf16(v1[2], v1[3]);
                    *(u32x4*)(dst + bj * HALF) = o; }
                asm volatile("" ::: "memory"); }
    }
};
}

namespace attn_body {
using bf16=__hip_bfloat16;
using bf16x8=__attribute__((ext_vector_type(8)))short;
using s16x4=__attribute__((ext_vector_type(4)))short;
using f32x16=__attribute__((ext_vector_type(16)))float;
using u32x4=__attribute__((ext_vector_type(4)))unsigned;
using f32x4_t=__attribute__((ext_vector_type(4)))float;
constexpr int SEQ=2048,D=64,DM=2816;
constexpr int NW=8,QBLK=32,QB=QBLK*NW,KVBLK=64,NQB=SEQ/QB;
__device__ __forceinline__ int crow(int r,int hi){return (r&3)+8*(r>>2)+4*hi;}
#define SBAR() __builtin_amdgcn_sched_barrier(0)
__device__ __forceinline__ void cmask(f32x16&p0,f32x16&p1,int jb,int qrel,int hi){
  const float NEG=-INFINITY; int lim=qrel-64*jb-4*hi; asm volatile("":"+v"(lim));
  #pragma unroll
  for(int r=0;r<16;++r){const int c=(r&3)+8*(r>>2); if(c>lim)p0[r]=NEG; if(c+32>lim)p1[r]=NEG;}
}

typedef __attribute__((address_space(3))) const float* lds_fptr;
template<int MODE> __device__ __forceinline__ void tilefix(f32x16&p0,f32x16&p1,int t,int NT,int ta,int qrel,int hi,lds_fptr cl,lds_fptr dt,unsigned maskq,float mhat){
  const float NEG=-INFINITY;
  if(MODE==0){
  } else {
    #pragma unroll
    for(int r=0;r<16;++r){p0[r]-=mhat;p1[r]-=mhat;}
  }
  if(MODE==1){ if(__any(((maskq>>ta)&1u)==0u)){ const bool off=((maskq>>ta)&1u)==0u;
      #pragma unroll
      for(int r=0;r<16;++r){p0[r]=off?NEG:p0[r];p1[r]=off?NEG:p1[r];} } }
  if(MODE!=0){
    int dbase=qrel+64*(NT-4-t)-4*hi; asm volatile("":"+v"(dbase));
    if(MODE==2 && t<4){
      { int e511=dbase-511; asm volatile("":"+v"(e511));
      #pragma unroll
      for(int r=0;r<16;++r){ if(e511>((r&3)+8*(r>>2)))p0[r]=NEG; if(e511>((r&3)+8*(r>>2)+32))p1[r]=NEG; } } }
    if(t>=NT-6){
      #pragma unroll
      for(int g=0;g<4;++g){
        #pragma unroll
        for(int i=0;i<4;++i){const int r=4*g+i; const int d=dbase-((r&3)+8*(r>>2)); const int i0=min(max(d,0),127),i1=min(max(d-32,0),127); p0[r]+=dt[i0]; p1[r]+=dt[i1];}
        __builtin_amdgcn_sched_barrier(0); } }
  }
  { const int jb=t-(NT-4); if(jb>=0)cmask(p0,p1,jb,qrel,hi); }
}

constexpr int NSLOT=3, SLOTB=8192;
constexpr int LDS_K=0, LDS_V=NSLOT*SLOTB, LDS_WS=2*NSLOT*SLOTB, LDS_OST=LDS_WS+NW*64*4, LDS_CUM=LDS_OST+NW*4096, LDS_DT=LDS_CUM+8192, LDS_BYTES=LDS_DT+4096;
constexpr float C2=0.125f*1.4426950408889634f;
__device__ __forceinline__ void glds16(const void*gsrc,unsigned lds_dst){unsigned keep;
  asm volatile("s_mov_b32 %0, m0\n\ts_mov_b32 m0, %2\n\ts_nop 0\n\tglobal_load_lds_dwordx4 %1, off\n\ts_mov_b32 m0, %0":"=&s"(keep):"v"(gsrc),"s"(lds_dst):"memory");}
__device__ __forceinline__ float max3f(float a,float b,float c){float r;asm("v_max3_f32 %0, %1, %2, %3":"=v"(r):"v"(a),"v"(b),"v"(c));return r;}
__device__ __forceinline__ float max2f(float a,float b){float r;asm("v_max_f32_e32 %0, %1, %2":"=v"(r):"v"(a),"v"(b));return r;}
__device__ __forceinline__ float fadd_s(float a,float b){float r;asm("v_add_f32_e32 %0, %1, %2":"=v"(r):"v"(a),"v"(b));return r;}
__device__ __forceinline__ float fsub_s(float a,float b){float r;asm("v_sub_f32_e32 %0, %1, %2":"=v"(r):"v"(a),"v"(b));return r;}
typedef float f32x2_t __attribute__((ext_vector_type(2))); typedef __bf16 bf16x2_t __attribute__((ext_vector_type(2)));
__device__ __forceinline__ unsigned cvtpk_s(float lo,float hi){f32x2_t v={lo,hi};bf16x2_t b=__builtin_convertvector(v,bf16x2_t);return __builtin_bit_cast(unsigned,b);}
#define WAIT_BAR(N) asm volatile("s_waitcnt vmcnt(" #N ") lgkmcnt(0)\n\ts_barrier":::"memory")

__device__ __forceinline__ void qkt(f32x16&p0,f32x16&p1,const char*Kslot,const bf16x8*qr,const f32x16&ci0,const f32x16&ci1,int r32,int hi){
  const char*kb=Kslot+hi*1024+r32*16;
  #pragma unroll
  for(int d0=0;d0<4;++d0){
    const bf16x8 b0=*reinterpret_cast<const bf16x8*>(kb+d0*2048);
    const bf16x8 b1=*reinterpret_cast<const bf16x8*>(kb+d0*2048+512);
    if(d0==0){p0=__builtin_amdgcn_mfma_f32_32x32x16_bf16(b0,qr[0],ci0,0,0,0);p1=__builtin_amdgcn_mfma_f32_32x32x16_bf16(b1,qr[0],ci1,0,0,0);}
    else{p0=__builtin_amdgcn_mfma_f32_32x32x16_bf16(b0,qr[d0],p0,0,0,0);p1=__builtin_amdgcn_mfma_f32_32x32x16_bf16(b1,qr[d0],p1,0,0,0);}}
}
typedef __attribute__((address_space(3))) const char* lds_cptr;
typedef short v4i16_t __attribute__((ext_vector_type(4)));
__device__ __forceinline__ void kload8(bf16x8*kf,lds_cptr kp){
  kf[0]=*(const __attribute__((address_space(3))) bf16x8*)(kp);      kf[1]=*(const __attribute__((address_space(3))) bf16x8*)(kp+512);
  kf[2]=*(const __attribute__((address_space(3))) bf16x8*)(kp+2048); kf[3]=*(const __attribute__((address_space(3))) bf16x8*)(kp+2560);
  kf[4]=*(const __attribute__((address_space(3))) bf16x8*)(kp+4096); kf[5]=*(const __attribute__((address_space(3))) bf16x8*)(kp+4608);
  kf[6]=*(const __attribute__((address_space(3))) bf16x8*)(kp+6144); kf[7]=*(const __attribute__((address_space(3))) bf16x8*)(kp+6656);
}
__device__ __forceinline__ void kload2(bf16x8*kf,lds_cptr kp,int j){ kf[2*j]=*(const __attribute__((address_space(3))) bf16x8*)(kp+j*2048); kf[2*j+1]=*(const __attribute__((address_space(3))) bf16x8*)(kp+j*2048+512); }
__device__ __forceinline__ s16x4 vtr(lds_cptr p){ return __builtin_bit_cast(s16x4,__builtin_amdgcn_ds_read_tr16_b64_v4i16((__attribute__((address_space(3))) v4i16_t*)p)); }
__device__ __forceinline__ float rowmax(const f32x16&p0,const f32x16&p1){
  float a=max3f(p0[0],p0[1],p1[0]),b=max3f(p0[2],p0[3],p1[1]);a=max3f(a,p1[2],p1[3]);
  #pragma unroll
  for(int r=4;r<16;r+=4){a=max3f(a,p0[r],p0[r+1]);b=max3f(b,p0[r+2],p0[r+3]);a=max3f(a,p1[r],p1[r+1]);b=max3f(b,p1[r+2],p1[r+3]);}
  const float m=max2f(a,b);
  auto rr=__builtin_amdgcn_permlane32_swap(__float_as_uint(m),__float_as_uint(m),false,false);
  return max2f(__uint_as_float(rr[0]),__uint_as_float(rr[1]));
}
__device__ __forceinline__ void pv(f32x16*o,int vb,bf16x8 pa0,bf16x8 pa1,bf16x8 pa2,bf16x8 pa3){
  #pragma unroll
  for(int d0=0;d0<2;++d0){s16x4 lo[4],hi[4];
    #pragma unroll
    for(int ks=0;ks<4;++ks){
      asm volatile("ds_read_b64_tr_b16 %0,%1 offset:%c2":"=&v"(lo[ks]):"v"(vb),"i"(d0*4096+ks*1024):"memory");
      asm volatile("ds_read_b64_tr_b16 %0,%1 offset:%c2":"=&v"(hi[ks]):"v"(vb),"i"(d0*4096+ks*1024+512):"memory");}
    asm volatile("s_waitcnt lgkmcnt(0)":::"memory");SBAR();
    #define PK(k) (bf16x8){lo[k][0],lo[k][1],lo[k][2],lo[k][3],hi[k][0],hi[k][1],hi[k][2],hi[k][3]}
    o[d0]=__builtin_amdgcn_mfma_f32_32x32x16_bf16(pa0,PK(0),o[d0],0,0,0);
    o[d0]=__builtin_amdgcn_mfma_f32_32x32x16_bf16(pa1,PK(1),o[d0],0,0,0);
    o[d0]=__builtin_amdgcn_mfma_f32_32x32x16_bf16(pa2,PK(2),o[d0],0,0,0);
    o[d0]=__builtin_amdgcn_mfma_f32_32x32x16_bf16(pa3,PK(3),o[d0],0,0,0);
    #undef PK
  }
}

__device__ __forceinline__ void attn_fill_dt(char*shm,const float*rel_bias,int off=LDS_DT){
  const int tid=threadIdx.x;
  #pragma unroll
  for(int k=0;k<2;++k){ const int e=tid+512*k, hh=e>>7, n=e&127;
    const int bk=n<16?n:16+(n>=19)+(n>=21)+(n>=24)+(n>=27)+(n>=31)+(n>=35)+(n>=40)+(n>=46)+(n>=52)+(n>=59)+(n>=67)+(n>=77)+(n>=87)+(n>=99)+(n>=113);
    ((float*)(shm+off))[e]=(rel_bias[bk*8+hh]-rel_bias[31*8+hh])*1.4426950408889634f; }
  __syncthreads();
}
#ifndef ATTN_STORE16
#define ATTN_STORE16(p,v) (*(u32x4*)(p)=(v))
#endif
struct AttnIO { unsigned char* ws; };
#define IO_PROJ ((const bf16*)(io.ws+WS_PROJ))
#define IO_CUM ((const float*)(io.ws+WS_CUM))
#define IO_SELM ((const unsigned*)(io.ws+WS_SELM))
#define IO_FG ((const float*)(io.ws+WS_FG))
#define IO_OC ((const bf16*)(io.ws+WS_OC))
#define IO_OW ((bf16*)(io.ws+WS_OW))
#define IO_AO16 ((bf16*)(io.ws+WS_AO16))

template<int MODE,int THRL> __device__ __forceinline__ void attn_unit(int b,int h,int qb,const AttnIO&io,char*shm,const int tidv){
  const int tid=tidv,lane=tid&63,r32=lane&31,hi=lane>>5; const int wid=__builtin_amdgcn_readfirstlane(tid>>6);
  const long rowbase=(long)b*SEQ; const int q0=qb*QB; const int g=h>>2;
  const int NT=(MODE==2)?((4*qb+4)<12?(4*qb+4):12):(4*qb+4);
  const int t0=4*qb+4-NT;
  const int qcol=(MODE==0?0:1536)+h*D, kcol=(MODE==0?512+h*D:(MODE==1?2304:2560)+g*D), vcol=(MODE==0?1024+h*D:(MODE==1?2432:2688)+g*D);
  const bf16*Qw=IO_PROJ+(rowbase+q0+wid*QBLK)*DM+qcol;
  const bf16*Kh=IO_PROJ+(rowbase+(long)t0*KVBLK)*DM+kcol,*Vh=IO_PROJ+(rowbase+(long)t0*KVBLK)*DM+vcol;
  const unsigned lds0=(unsigned)(uintptr_t)shm;
  float*wsf=(float*)(shm+LDS_WS)+wid*64;
  const bf16*ksrc=Kh+(long)lane*DM+wid*8;
  const bf16*vsrc=Vh+(long)(16*(wid&3)+(lane>>2))*DM+(wid>>2)*32+(lane&3)*8;
  const unsigned kdst=lds0+LDS_K+wid*1024, vdst=lds0+LDS_V+wid*1024;
  #define DMA_K(t,slot) glds16(ksrc+(long)(t)*KVBLK*DM,(unsigned)__builtin_amdgcn_readfirstlane(kdst+(slot)))
  #define DMA_V(t,slot) glds16(vsrc+(long)(t)*KVBLK*DM,(unsigned)__builtin_amdgcn_readfirstlane(vdst+(slot)))
  const int vb0=(int)(lds0+LDS_V)+((lane>>4)&1)*32+(lane&3)*8+(4*hi+((lane&15)>>2))*64;
  const char*Kbase=shm+LDS_K; bf16x8 kf[8];
  const lds_cptr shm3=(lds_cptr)shm; const lds_cptr kp0=shm3+LDS_K+hi*1024+r32*16; const lds_cptr vp0=shm3+LDS_V+((lane>>4)&1)*32+(lane&3)*8+(4*hi+((lane&15)>>2))*64;
  DMA_K(0,0);DMA_V(0,0);DMA_K(1,SLOTB);
  bf16x8 qr[4];
  #pragma unroll
  for(int d0=0;d0<4;++d0)qr[d0]=*reinterpret_cast<const bf16x8*>(&Qw[(long)r32*DM+d0*16+hi*8]);
  const lds_cptr qst=(lds_cptr)shm+LDS_OST+wid*4096+lane*16;
  #pragma unroll
  for(int d0=0;d0<4;++d0)*(__attribute__((address_space(3))) bf16x8*)((__attribute__((address_space(3))) char*)qst+d0*1024)=qr[d0];
  const lds_fptr cl=(lds_fptr)(shm+LDS_CUM), dt=(lds_fptr)(shm+LDS_DT)+h*128;
  unsigned maskq=0xffffffffu;
  if(MODE==0){ const f32x4_t c4=*(const f32x4_t*)(IO_CUM+((long)(b*8+h))*SEQ+tid*4); *(f32x4_t*)(shm+LDS_CUM+tid*16)=c4*1.4426950408889634f; }
  else {
    if(MODE==1) maskq=IO_SELM[((long)(b*2+g))*SEQ+q0+wid*QBLK+r32]; }
  float mhat=0.f,l_reg=0.f;f32x16 o[2];o[0]=f32x16{};o[1]=f32x16{};const f32x16 negm=f32x16{};
  #define SPLIT3(v,hb,lb,l2) const unsigned hb=cvtpk_s(v,0.f)&0xffffu; const float r1_=(v)-__uint_as_float(hb<<16); const unsigned lb=cvtpk_s(r1_,0.f)&0xffffu; const float r2_=r1_-__uint_as_float(lb<<16); const unsigned l2=cvtpk_s(r2_,0.f)&0xffffu
  #define KAUG(dst,cval) do{ const float v_=-(cval); SPLIT3(v_,hb_,lb_,l2_); u32x4 w_; w_[0]=hi?0u:(hb_|(lb_<<16)); w_[1]=hi?0u:(l2_|0x3f800000u); w_[2]=hi?0u:0x3f803f80u; w_[3]=0u; dst=__builtin_bit_cast(bf16x8,w_); }while(0)
  #define QAUG(dst,mval) do{ const float v_=-(mval); SPLIT3(v_,hb_,lb_,l2_); u32x4 w_; w_[0]=0x3f803f80u; w_[1]=0x3f80u|(hb_<<16); w_[2]=lb_|(l2_<<16); w_[3]=0u; dst=__builtin_bit_cast(bf16x8,w_); }while(0)
  bf16x8 qa; QAUG(qa,0.f);
  const int qrel=wid*QBLK+r32;
  #define CMASK(P0,P1,t) tilefix<MODE>(P0,P1,(t),NT,t0+(t),qrel,hi,cl,dt,maskq,mhat)
  bool resc=false;
  #define START(P0,P1) do{ const float rm=rowmax(P0,P1); resc=false; \
    { const float dl=(rm==-INFINITY)?0.f:rm; mhat=fadd_s(mhat,dl); if(MODE==0){QAUG(qa,mhat);} \
      _Pragma("unroll") for(int r=0;r<16;++r){P0[r]=fsub_s(P0[r],dl);P1[r]=fsub_s(P1[r],dl);} \
      } \
    _Pragma("unroll") for(int r=0;r<16;++r)P0[r]=__builtin_amdgcn_exp2f(P0[r]); }while(0)
  #define RESC() do{ if(resc){ asm volatile("s_waitcnt lgkmcnt(0)":::"memory"); \
      _Pragma("unroll") for(int d_=0;d_<2;++d_) _Pragma("unroll") for(int r=0;r<16;++r)o[d_][r]*=wsf[crow(r,hi)]; } }while(0)
  f32x16 pA0,pA1,pB0,pB1;
  int sl_prev=0,sl_cur=0,sl_next=SLOTB;
  #define ROT() do{sl_prev=sl_cur;sl_cur=sl_next;sl_next=(sl_next==(NSLOT-1)*SLOTB)?0:sl_next+SLOTB;}while(0)
  DMA_K(2,2*SLOTB);
  WAIT_BAR(3);
  if(MODE==0){ bf16x8 ka0,ka1; KAUG(ka0,cl[64*t0+r32]); KAUG(ka1,cl[64*t0+32+r32]);
    pA0=__builtin_amdgcn_mfma_f32_32x32x16_bf16(ka0,qa,negm,0,0,0); pA1=__builtin_amdgcn_mfma_f32_32x32x16_bf16(ka1,qa,negm,0,0,0); qkt(pA0,pA1,Kbase,qr,pA0,pA1,r32,hi); }
  else qkt(pA0,pA1,Kbase,qr,negm,negm,r32,hi);
  asm volatile("s_nop 15\n\ts_nop 7":"+v"(pA0),"+v"(pA1));CMASK(pA0,pA1,0);
  START(pA0,pA1);
  _Pragma("unroll") for(int r=0;r<16;++r)pA1[r]=__builtin_amdgcn_exp2f(pA1[r]);
  WAIT_BAR(0);
  DMA_K(3,0);DMA_V(1,SLOTB);
  ROT();
  kload8(kf,kp0+sl_cur);
  WAIT_BAR(2);
  s16x4 vlo[8],vhi[8]; u32x4 pw0,pw1,pw2,pw3;
  #define PKW(P,B) cvtpk_s(P[B],P[B+1])
  #define PAF(k) __builtin_bit_cast(bf16x8,pw##k)
  #define VFR(i) (bf16x8){vlo[i][0],vlo[i][1],vlo[i][2],vlo[i][3],vhi[i][0],vhi[i][1],vhi[i][2],vhi[i][3]}
  #define PIN(x) asm volatile("":"+v"(x))
  #define MX3(a,b,c) __builtin_fmaxf(__builtin_fmaxf((a),(b)),(c))
  #define GAPA(MF,A0,A1,A2,A3,W0,W1,PW) do{ MF; sacc+=A0; sacc+=A1; sacc+=A2; sacc+=A3; PIN(sacc); W0; W1; PIN(PW); SBAR(); }while(0)
  #define EX(v) __builtin_amdgcn_exp2f(v)
  #define GAPB(MF,X,B) do{ MF; X[B]=EX(X[B]); X[B+1]=EX(X[B+1]); X[B+2]=EX(X[B+2]); X[B+3]=EX(X[B+3]); PIN(X); SBAR(); }while(0)
  #define VRD(i) do{ vlo[i]=vtr(vp_+(((i)>>2)*4096+((i)&3)*1024)); vhi[i]=vtr(vp_+(((i)>>2)*4096+((i)&3)*1024+512)); }while(0)
  #define KRD(G,j) do{ if(G){ kload2(kf,kp0+sl_next,j); SBAR(); } }while(0)
  #define STEP(C0,C1,P0,P1,t,GK,GV,GL) do{ SBAR(); \
    if(MODE==0){ bf16x8 ka0_,ka1_; KAUG(ka0_,cl[64*(t0+(t))+r32]); KAUG(ka1_,cl[64*(t0+(t))+32+r32]); \
      C0=__builtin_amdgcn_mfma_f32_32x32x16_bf16(ka0_,qa,negm,0,0,0); C1=__builtin_amdgcn_mfma_f32_32x32x16_bf16(ka1_,qa,negm,0,0,0); SBAR(); } \
    const lds_cptr vp_=vp0+sl_prev; \
    const bf16x8 qq0=*(const __attribute__((address_space(3))) bf16x8*)(qst),qq1=*(const __attribute__((address_space(3))) bf16x8*)(qst+1024),qq2=*(const __attribute__((address_space(3))) bf16x8*)(qst+2048),qq3=*(const __attribute__((address_space(3))) bf16x8*)(qst+3072); \
    VRD(0); SBAR(); float sacc=(P0[0]+P0[1]); \
    GAPA(C0=__builtin_amdgcn_mfma_f32_32x32x16_bf16(kf[0],qq0,(MODE==0?C0:negm),0,0,0), P0[2],P0[3],P0[4],P0[5],     pw0[0]=PKW(P0,0), pw0[1]=PKW(P0,2), pw0); \
    VRD(4); SBAR(); GAPA(C1=__builtin_amdgcn_mfma_f32_32x32x16_bf16(kf[1],qq0,(MODE==0?C1:negm),0,0,0), P0[6],P0[7],P0[8],P0[9],     pw0[2]=PKW(P0,4), pw0[3]=PKW(P0,6), pw0); \
    VRD(1); SBAR(); GAPA(C0=__builtin_amdgcn_mfma_f32_32x32x16_bf16(kf[2],qq1,C0,0,0,0),   P0[10],P0[11],P0[12],P0[13], pw1[0]=PKW(P0,8), pw1[1]=PKW(P0,10), pw1); \
    VRD(5); SBAR(); GAPA(C1=__builtin_amdgcn_mfma_f32_32x32x16_bf16(kf[3],qq1,C1,0,0,0),   P0[14],P0[15],P1[0],P1[1],   pw1[2]=PKW(P0,12),pw1[3]=PKW(P0,14), pw1); \
    VRD(2); SBAR(); GAPA(C0=__builtin_amdgcn_mfma_f32_32x32x16_bf16(kf[4],qq2,C0,0,0,0),   P1[2],P1[3],P1[4],P1[5],     pw2[0]=PKW(P1,0), pw2[1]=PKW(P1,2), pw2); \
    VRD(6); SBAR(); GAPA(C1=__builtin_amdgcn_mfma_f32_32x32x16_bf16(kf[5],qq2,C1,0,0,0),   P1[6],P1[7],P1[8],P1[9],     pw2[2]=PKW(P1,4), pw2[3]=PKW(P1,6), pw2); \
    VRD(3); SBAR(); GAPA(C0=__builtin_amdgcn_mfma_f32_32x32x16_bf16(kf[6],qq3,C0,0,0,0),   P1[10],P1[11],P1[12],P1[13], pw3[0]=PKW(P1,8), pw3[1]=PKW(P1,10), pw3); \
    VRD(7); SBAR(); GAPA(C1=__builtin_amdgcn_mfma_f32_32x32x16_bf16(kf[7],qq3,C1,0,0,0),   P1[14],P1[15],0.f,0.f,       pw3[2]=PKW(P1,12),pw3[3]=PKW(P1,14), pw3); \
    l_reg+=sacc; \
    if(GK){DMA_K((t)+3,sl_cur);} if(GV){DMA_V((t)+1,sl_next);} \
    CMASK(C0,C1,t); \
    { float a=MX3(C0[0],C0[1],C1[0]),b=MX3(C0[2],C0[3],C1[1]); a=MX3(a,C1[2],C1[3]); \
      _Pragma("unroll") for(int r=4;r<16;r+=4){a=MX3(a,C0[r],C0[r+1]);b=MX3(b,C0[r+2],C0[r+3]);a=MX3(a,C1[r],C1[r+1]);b=MX3(b,C1[r+2],C1[r+3]);} \
      float rm=__builtin_fmaxf(a,b); { auto rr=__builtin_amdgcn_permlane32_swap(__float_as_uint(rm),__float_as_uint(rm),false,false); rm=__builtin_fmaxf(__uint_as_float(rr[0]),__uint_as_float(rr[1])); } \
      resc=false; \
      if(__builtin_expect(__any(rm>(float)THRL),0)){ const float dl=__builtin_fmaxf(rm,0.f); mhat+=dl; if(MODE==0){QAUG(qa,mhat);} \
        _Pragma("unroll") for(int r=0;r<16;++r){C0[r]-=dl;C1[r]-=dl;} \
        const float f=__builtin_amdgcn_exp2f(-dl); l_reg*=f; if(hi==0)wsf[r32]=f; resc=true; } } \
    SBAR(); \
    GAPB(o[0]=__builtin_amdgcn_mfma_f32_32x32x16_bf16(PAF(0),VFR(0),o[0],0,0,0), C0,0); \
    GAPB(o[1]=__builtin_amdgcn_mfma_f32_32x32x16_bf16(PAF(0),VFR(4),o[1],0,0,0), C0,4); \
    KRD(GL,0); GAPB(o[0]=__builtin_amdgcn_mfma_f32_32x32x16_bf16(PAF(1),VFR(1),o[0],0,0,0), C0,8); \
    KRD(GL,1); GAPB(o[1]=__builtin_amdgcn_mfma_f32_32x32x16_bf16(PAF(1),VFR(5),o[1],0,0,0), C0,12); \
    KRD(GL,2); GAPB(o[0]=__builtin_amdgcn_mfma_f32_32x32x16_bf16(PAF(2),VFR(2),o[0],0,0,0), C1,0); \
    KRD(GL,3); GAPB(o[1]=__builtin_amdgcn_mfma_f32_32x32x16_bf16(PAF(2),VFR(6),o[1],0,0,0), C1,4); \
    GAPB(o[0]=__builtin_amdgcn_mfma_f32_32x32x16_bf16(PAF(3),VFR(3),o[0],0,0,0), C1,8); \
    GAPB(o[1]=__builtin_amdgcn_mfma_f32_32x32x16_bf16(PAF(3),VFR(7),o[1],0,0,0), C1,12); \
    }while(0)
  int t=1;
  for(;t+5<NT;t+=2){
    STEP(pB0,pB1,pA0,pA1,t,true,true,true);     WAIT_BAR(2); RESC(); ROT();
    STEP(pA0,pA1,pB0,pB1,t+1,true,true,true);   WAIT_BAR(2); RESC(); ROT();
  }
  #define ENDW(tt) do{ if((tt)+3<NT){WAIT_BAR(2);} else if((tt)+2<NT){WAIT_BAR(1);} else {WAIT_BAR(0);} }while(0)
  for(;t+1<NT;t+=2){
    STEP(pB0,pB1,pA0,pA1,t,(t+3<NT),(t+1<NT),(t+1<NT));       ENDW(t);   RESC(); ROT();
    STEP(pA0,pA1,pB0,pB1,t+1,(t+4<NT),(t+2<NT),(t+2<NT));     ENDW(t+1); RESC(); ROT();
  }
  STEP(pB0,pB1,pA0,pA1,NT-1,false,false,false); RESC();
  { float sacc=pB0[0]+pB0[1]; _Pragma("unroll") for(int r=2;r<16;++r)sacc+=pB0[r]; _Pragma("unroll") for(int r=0;r<16;++r)sacc+=pB1[r]; l_reg+=sacc;
    pw0=(u32x4){PKW(pB0,0),PKW(pB0,2),PKW(pB0,4),PKW(pB0,6)};pw1=(u32x4){PKW(pB0,8),PKW(pB0,10),PKW(pB0,12),PKW(pB0,14)};pw2=(u32x4){PKW(pB1,0),PKW(pB1,2),PKW(pB1,4),PKW(pB1,6)};pw3=(u32x4){PKW(pB1,8),PKW(pB1,10),PKW(pB1,12),PKW(pB1,14)};
    SBAR(); pv(o,vb0+sl_cur,PAF(0),PAF(1),PAF(2),PAF(3)); }
  #undef PKW
  #undef PAF
  #undef VFR
  #undef PIN
  #undef MX3
  #undef GAPA
  #undef GAPB
  #undef EX
  #undef VRD
  #undef KRD
  #undef STEP
  #undef ENDW
  {auto rr=__builtin_amdgcn_permlane32_swap(__float_as_uint(l_reg),__float_as_uint(l_reg),false,false);l_reg=__uint_as_float(rr[0])+__uint_as_float(rr[1]);}
  if(hi==0)wsf[32+r32]=l_reg;asm volatile("s_waitcnt lgkmcnt(0)":::"memory");
  float rli[16];
  #pragma unroll
  for(int r=0;r<16;++r)rli[r]=__builtin_amdgcn_rcpf(wsf[32+crow(r,hi)]);
  { bf16*stg=(bf16*)(shm+LDS_OST)+wid*2048;
    #pragma unroll
    for(int r=0;r<16;++r){const int orow=crow(r,hi);
      #pragma unroll
      for(int d0=0;d0<2;++d0)stg[orow*64+d0*32+r32]=__float2bfloat16(o[d0][r]*rli[r]);}
    asm volatile("s_waitcnt lgkmcnt(0)":::"memory");
    const long tok0=rowbase+q0+wid*QBLK;
    #pragma unroll
    for(int i=0;i<4;++i){const int row=i*8+(lane>>3),ch=lane&7; const u32x4 v=*(const u32x4*)(stg+row*64+ch*8);
      if(MODE==0){ *(u32x4*)(IO_AO16+(tok0+row)*1024+h*D+ch*8)=v; }
      else if(MODE==2){ *(u32x4*)(IO_OW+(tok0+row)*512+h*D+ch*8)=v; }
      else { const u32x4 c=*(const u32x4*)(IO_OC+(tok0+row)*512+h*D+ch*8), w=*(const u32x4*)(IO_OW+(tok0+row)*512+h*D+ch*8);
        const float*gp=IO_FG+(tok0+row)*32+8+h*3;
        const float g0=1.f/(1.f+__expf(-gp[0])),g1=1.f/(1.f+__expf(-gp[1])),g2=1.f/(1.f+__expf(-gp[2]));
        u32x4 o4;
        #pragma unroll
        for(int k=0;k<4;++k){ const float c_lo=__uint_as_float(c[k]<<16),c_hi=__uint_as_float(c[k]&0xffff0000u),s_lo=__uint_as_float(v[k]<<16),s_hi=__uint_as_float(v[k]&0xffff0000u),w_lo=__uint_as_float(w[k]<<16),w_hi=__uint_as_float(w[k]&0xffff0000u);
          o4[k]=cvtpk_s(g0*c_lo+g1*s_lo+g2*w_lo,g0*c_hi+g1*s_hi+g2*w_hi); }
        *(u32x4*)(IO_AO16+(tok0+row)*1024+512+h*D+ch*8)=o4; } } }
  asm volatile("s_waitcnt lgkmcnt(0)\n\ts_barrier":::"memory");
  #undef DMA_K
  #undef DMA_V
  #undef CMASK
  #undef START
  #undef RESC
  #undef ROT
}
constexpr int CL_K=0, CL_V=16384, CL_IMP=32768, CL_SC=CL_IMP+4*64*33*4, CL_OST=CL_SC+64*33*4, CL_DT=CL_OST+NW*4096, CL_END=CL_DT+4096;
static_assert(CL_END<=131072,"cmp phase LDS map");
__device__ __forceinline__ void cmp_unit(int b,int g,int c,const AttnIO&io,char*shm,const int tidv){
  const int tid=tidv,lane=tid&63,r32=lane&31,hi=lane>>5; const int wid=__builtin_amdgcn_readfirstlane(tid>>6);
  const int hr=wid&3, rh=wid>>2, h=g*4+hr; const long rowbase=(long)b*SEQ; const int t0c=c*64;
  const int nkb=min(4,(4*c+3+31)>>5);
  { const bf16*kg=(const bf16*)(io.ws+WS_KVC16)+((long)(b*2+g))*128*64; const bf16*vg=kg+(long)8*2*128*64;
    #pragma unroll
    for(int p=0;p<2;++p){ const int idx=tid+512*p,key=idx>>3,ch=idx&7;
      const u32x4 kv=*(const u32x4*)(kg+key*64+ch*8), vv=*(const u32x4*)(vg+key*64+ch*8);
      *(u32x4*)(shm+CL_K+(ch*128+key)*16)=kv; *(u32x4*)(shm+CL_V+(ch>>2)*8192+key*64+(ch&3)*16)=vv; } }
  const bf16*Qw=IO_PROJ+(rowbase+t0c+rh*32)*DM+1536+h*D;
  bf16x8 qr[4];
  #pragma unroll
  for(int d0=0;d0<4;++d0)qr[d0]=*reinterpret_cast<const bf16x8*>(&Qw[(long)r32*DM+d0*16+hi*8]);
  __syncthreads();
  const lds_cptr shm3=(lds_cptr)shm; const lds_fptr dt=(lds_fptr)(shm+CL_DT)+h*128;
  const int t=t0c+rh*32+r32;
  f32x16 p[4];
  float m=-INFINITY;
  #pragma unroll
  for(int kb=0;kb<4;++kb){ p[kb]=f32x16{};
    if(kb<nkb){
      #pragma unroll
      for(int d0=0;d0<4;++d0){ const bf16x8 kf=*(const __attribute__((address_space(3))) bf16x8*)(shm3+CL_K+((2*d0+hi)*128+32*kb+r32)*16);
        p[kb]=__builtin_amdgcn_mfma_f32_32x32x16_bf16(kf,qr[d0],p[kb],0,0,0); }
      int dbase=t-31-16*(32*kb+4*hi); asm volatile("":"+v"(dbase));
      #pragma unroll
      for(int r=0;r<16;++r){ const int d=dbase-16*((r&3)+8*(r>>2)); const float x=p[kb][r]+dt[min(max(d,0),127)]; p[kb][r]=d>=0?x:-INFINITY; m=fmaxf(m,p[kb][r]); }
    } }
  { auto rr=__builtin_amdgcn_permlane32_swap(__float_as_uint(m),__float_as_uint(m),false,false); m=fmaxf(__uint_as_float(rr[0]),__uint_as_float(rr[1])); }
  const float ms=(m==-INFINITY)?0.f:m;
  float l=0.f;
  #pragma unroll
  for(int kb=0;kb<4;++kb) if(kb<nkb){
    #pragma unroll
    for(int r=0;r<16;++r){ p[kb][r]=__builtin_amdgcn_exp2f(p[kb][r]-ms); l+=p[kb][r]; } }
  { auto rr=__builtin_amdgcn_permlane32_swap(__float_as_uint(l),__float_as_uint(l),false,false); l=__uint_as_float(rr[0])+__uint_as_float(rr[1]); }
  const float il=l>0.f?1.f/l:0.f;
  #pragma unroll
  for(int kb=0;kb<4;++kb) if(kb<nkb){
    #pragma unroll
    for(int r=0;r<16;++r)p[kb][r]*=il; }
  { float* impw=(float*)(shm+CL_IMP)+(hr*64+rh*32+r32)*33;
    float prevlast=0.f;
    #pragma unroll
    for(int i=0;i<16;++i){ const int kb=i>>2,q=i&3;
      const float qs=(p[kb][4*q]+p[kb][4*q+1])+(p[kb][4*q+2]+p[kb][4*q+3]), last=p[kb][4*q+3];
      auto rr=__builtin_amdgcn_permlane32_swap(__float_as_uint(prevlast),__float_as_uint(last),false,false);
      const float recv=hi?__uint_as_float(rr[0]):__uint_as_float(rr[1]);
      impw[2*i+hi]=qs+recv; prevlast=last; } }
  f32x16 o[2]; o[0]=f32x16{}; o[1]=f32x16{};
  { const lds_cptr vp0=shm3+CL_V+((lane>>4)&1)*32+(lane&3)*8+(4*hi+((lane&15)>>2))*64;
    #pragma unroll
    for(int kb=0;kb<4;++kb) if(kb<nkb){
      #pragma unroll
      for(int ks=0;ks<2;++ks){ u32x4 pw;
        #pragma unroll
        for(int k=0;k<4;++k)pw[k]=cvtpk_s(p[kb][8*ks+2*k],p[kb][8*ks+2*k+1]);
        const bf16x8 pa=__builtin_bit_cast(bf16x8,pw);
        #pragma unroll
        for(int d0=0;d0<2;++d0){ const s16x4 vlo=vtr(vp0+d0*8192+(2*kb+ks)*1024), vhi=vtr(vp0+d0*8192+(2*kb+ks)*1024+512);
          const bf16x8 vf=(bf16x8){vlo[0],vlo[1],vlo[2],vlo[3],vhi[0],vhi[1],vhi[2],vhi[3]};
          o[d0]=__builtin_amdgcn_mfma_f32_32x32x16_bf16(pa,vf,o[d0],0,0,0); } } } }
  { bf16*stg=(bf16*)(shm+CL_OST)+wid*2048;
    #pragma unroll
    for(int r=0;r<16;++r){const int orow=crow(r,hi);
      #pragma unroll
      for(int d0=0;d0<2;++d0)stg[orow*64+d0*32+r32]=__float2bfloat16(o[d0][r]);}
    asm volatile("s_waitcnt lgkmcnt(0)":::"memory");
    bf16*oc=(bf16*)(io.ws+WS_OC)+(rowbase+t0c+rh*32)*512+h*D;
    #pragma unroll
    for(int i=0;i<4;++i){const int row=i*8+(lane>>3),ch=lane&7; *(u32x4*)(oc+(long)row*512+ch*8)=*(const u32x4*)(stg+row*64+ch*8);} }
  __syncthreads();
  { const int row=tid>>3,jq=tid&7; const float*imp=(const float*)(shm+CL_IMP); float*scl=(float*)(shm+CL_SC)+row*33;
    float sc[4];
    #pragma unroll
    for(int k=0;k<4;++k){ const int j=4*jq+k; const float v=(imp[(0*64+row)*33+j]+imp[(1*64+row)*33+j])+(imp[(2*64+row)*33+j]+imp[(3*64+row)*33+j]);
      const bool causal=j<=c, forced=(j==0)||(j==c)||(j==c-1); sc[k]=causal?v+(forced?1e4f:0.f):-1e4f; scl[j]=sc[k]; }
    asm volatile("s_waitcnt lgkmcnt(0)":::"memory");
    unsigned bits=0u;
    #pragma unroll
    for(int k=0;k<4;++k){ const int j=4*jq+k; int rank=0;
      #pragma unroll
      for(int i=0;i<32;++i){ const float o2=scl[i]; rank+=(o2>sc[k]||(o2==sc[k]&&i<j))?1:0; }
      bits|=(rank<16?1u:0u)<<j; }
    bits|=__shfl_xor(bits,1); bits|=__shfl_xor(bits,2); bits|=__shfl_xor(bits,4);
    if(jq==0)((unsigned*)(io.ws+WS_SELM))[((long)(b*2+g))*SEQ+t0c+row]=bits; }
  __syncthreads();
}
constexpr int ATTN_LDS_BYTES=LDS_BYTES;
#undef SBAR
#undef WAIT_BAR
}

__device__ __forceinline__ float silu_f(float x) { return x / (1.f + expf(-x)); }
__device__ __forceinline__ float sigmoid_f(float x) { return 1.f / (1.f + expf(-x)); }
__device__ __forceinline__ unsigned f2bf(float f) { unsigned u = __builtin_bit_cast(unsigned, f); return (u + 0x7fffu + ((u >> 16) & 1u)) >> 16; }
__device__ __forceinline__ unsigned pk2(float lo, float hi) { return f2bf(lo) | (f2bf(hi) << 16); }
__device__ __forceinline__ float bf2f(bf16 v) { return __builtin_bit_cast(float, (unsigned)v << 16); }
__device__ __forceinline__ float wave_sum(float v) {
#pragma unroll
    for (int o = 1; o < 64; o <<= 1) v += __shfl_xor(v, o);
    return v;
}
__device__ __forceinline__ int t5_bucket(int dist) {
    const int n = dist < 0 ? 0 : dist;
    if (n < 16) return n;
    int b = 16;
    b += (n >= 19) + (n >= 21) + (n >= 24) + (n >= 27) + (n >= 31) + (n >= 35) + (n >= 40) + (n >= 46) + (n >= 52) + (n >= 59) +
         (n >= 67) + (n >= 77) + (n >= 87) + (n >= 99) + (n >= 113);
    return b;
}

struct Args {
    const float* in[26];
    float* out; unsigned char* ws;
    int ph_lo, ph_hi, li, pad;
};

struct Ctx {
    LAS unsigned char* lds;
    int tid, lane, wave, gtid, GT, gw, NGW;
    const float *x, *c, *w_ada, *b_ada, *w_in, *b_f, *cmp_pos_k, *cmp_w1_k, *cmp_w2_k, *cmp_pos_v, *cmp_w1_v, *cmp_w2_v, *rel_bias, *w_out, *ln1_g, *ln1_b,
        *w_router, *e_bias, *w_gate, *w_up, *w_down, *ws_gate, *ws_up, *ws_down, *ln2_g, *ln2_b;
    float* out;
    float *mod, *cum, *kvc, *posb, *scorebuf, *scores, *ew, *fg, *pc, *lw;
    int* lrow; gu32* ctl; unsigned char* wsb;
    unsigned* selmask; int* eidx;
    bf16 *hbuf, *proj, *h2lo, *win_t, *wout_t, *ao16, *oc, *ow, *wgu, *wdn, *act16, *slot, *w1t, *w2t, *kvc16, *wrt;
};


__device__ __forceinline__ int map_inproj(int n) { return n < 1536 ? n : (n < 1544 ? 2816 + (n - 1536) : (n < 2824 ? n - 8 : n)); }
template <int MAP>
__device__ __forceinline__ void transpose_item(const float* W, int K, int N, bf16* WT, LAS float* scr, int item, int lane) {
    const int nblk = N / 32, kb = item / nblk, nb = item % nblk, k0 = 64 * kb, n0 = 32 * nb;
#pragma unroll 8
    for (int i = 0; i < 32; ++i) { const int kk = 2 * i + (lane >> 5); scr[kk * 33 + (lane & 31)] = W[(size_t)(k0 + kk) * N + n0 + (lane & 31)]; }
    asm volatile("s_waitcnt lgkmcnt(0)" ::: "memory");
    const int c = lane & 7;
#pragma unroll
    for (int j = 0; j < 4; ++j) { const int n = (lane >> 3) + 8 * j; const LAS float* s = scr + (8 * c) * 33 + n;
        u32x4 o; o.x = pk2(s[0 * 33], s[1 * 33]); o.y = pk2(s[2 * 33], s[3 * 33]); o.z = pk2(s[4 * 33], s[5 * 33]); o.w = pk2(s[6 * 33], s[7 * 33]);
        const int dr = MAP == 1 ? map_inproj(n0 + n) : n0 + n;
        *(u32x4*)(WT + (size_t)dr * K + k0 + 8 * c) = o; }
    asm volatile("s_waitcnt lgkmcnt(0)" ::: "memory");
}
__device__ __forceinline__ void ph_prologue(Ctx& C) {
    LAS float* scr = (LAS float*)(C.lds + C.wave * 8704);
    constexpr int I_IN = (D / 64) * (NPROJ / 32), I_OUT = (D / 64) * (D / 32);
    for (int it = C.gw; it < I_IN + I_OUT; it += C.NGW) {
        if (it < I_IN) transpose_item<1>(C.w_in, D, NPROJ, C.win_t, scr, it, C.lane);
        else transpose_item<0>(C.w_out, D, D, C.wout_t, scr, it - I_IN, C.lane);
    }
    constexpr int I_W1 = (2048 / 64) * (256 / 32), I_W2 = (256 / 64) * (64 / 32);
    for (int it = C.gw; it < 2 * (I_W1 + I_W2); it += C.NGW) {
        const int which = it / (I_W1 + I_W2), r = it % (I_W1 + I_W2);
        if (r < I_W1) transpose_item<0>(which ? C.cmp_w1_v : C.cmp_w1_k, 2048, 256, C.w1t + (size_t)which * 256 * 2048, scr, r, C.lane);
        else transpose_item<0>(which ? C.cmp_w2_v : C.cmp_w2_k, 256, 64, C.w2t + (size_t)which * 64 * 256, scr, r - I_W1, C.lane);
    }
    if (blockIdx.x == gridDim.x - 1) {
        const int which = C.tid >> 8, j = C.tid & 255;
        const float* pos = which ? C.cmp_pos_v : C.cmp_pos_k; const float* w1 = which ? C.cmp_w1_v : C.cmp_w1_k;
        float acc = 0.f;
        for (int k = 0; k < 2048; ++k) acc += pos[k] * w1[(size_t)k * 256 + j];
        C.posb[C.tid] = acc;
    }
    for (int i = C.gtid; i < 64 * 128; i += C.GT) {
        const int e = i & 63, k0 = (i >> 6) * 8;
        u32x4 oh, ol;
#pragma unroll
        for (int p = 0; p < 4; ++p) {
            const float a = C.w_router[(size_t)(k0 + 2 * p) * 64 + e], b = C.w_router[(size_t)(k0 + 2 * p + 1) * 64 + e];
            const unsigned h = pk2(a, b);
            oh[p] = h; ol[p] = pk2(a - __builtin_bit_cast(float, h << 16), b - __builtin_bit_cast(float, h & 0xffff0000u));
        }
        *(u32x4*)(C.wrt + (size_t)e * 1024 + k0) = oh; *(u32x4*)(C.wrt + 65536 + (size_t)e * 1024 + k0) = ol;
    }
    for (int i = C.gtid; i < 2 * 8 * 2 * 64; i += C.GT) C.kvc16[((size_t)(i >> 6) * 128 + 127) * 64 + (i & 63)] = 0;
    for (int i = C.gtid; i < (3072 - NPROJ) * D / 8; i += C.GT) *(u32x4*)(C.win_t + (size_t)NPROJ * D + (size_t)i * 8) = (u32x4){0u, 0u, 0u, 0u};
}
__device__ __forceinline__ void ph_mod(Ctx& C) {
    for (int i = C.gtid; i < NB * 6 * D; i += C.GT) {
        const int b = i / (6 * D), e = i % (6 * D);
        float acc = C.b_ada[e];
        for (int d = 0; d < D; ++d) acc += silu_f(C.c[b * D + d]) * C.w_ada[(size_t)d * 6 * D + e];
        C.mod[i] = acc;
    }
}
__device__ __forceinline__ void ph_hpass(Ctx& C) {
    for (int m = C.gw; m < T; m += C.NGW) {
        const int b = m / S;
        const float* md = C.mod + b * 6 * D;
#pragma unroll
        for (int j = 0; j < 4; ++j) {
            const int c0 = (C.lane + 64 * j) * 4;
            const f32x4 xv = *(const f32x4*)(C.x + (size_t)m * D + c0);
            const f32x4 sh = *(const f32x4*)(md + c0), sc = *(const f32x4*)(md + D + c0);
            const f32x4 h = xv * (1.f + sc) + sh;
            u32x2 o; o.x = pk2(h.x, h.y); o.y = pk2(h.z, h.w);
            *(u32x2*)(C.hbuf + (size_t)m * D + c0) = o;
        }
    }
}
__device__ __forceinline__ void ph_cum_cmp1(Ctx& C) {
    for (int w = C.gw; w < NB * 8; w += C.NGW) {
        const int b = w / 8, h = w % 8;
        float carry = 0.f;
        for (int c0 = 0; c0 < S; c0 += 64) {
            const int t = c0 + C.lane;
            const float xx = C.fg[((size_t)b * S + t) * FGW + h] + C.b_f[h];
            float v = fminf(xx, 0.f) - log1pf(expf(-fabsf(xx)));
#pragma unroll
            for (int o = 1; o < 64; o <<= 1) { const float u = __shfl_up(v, o); if (C.lane >= o) v += u; }
            v += carry;
            C.cum[(size_t)w * S + t] = v;
            carry = __shfl(v, 63);
        }
    }
}
typedef short bf16x8_t __attribute__((ext_vector_type(8)));
__device__ __forceinline__ void ph_compress(Ctx& C) {
    LAS bf16* hidL = (LAS bf16*)C.lds;
    const int row = C.lane & 15, kq = C.lane >> 4;
    for (int u = blockIdx.x; u < 2 * NCMP; u += gridDim.x) {
        const int which = u / NCMP, tile = u % NCMP;
        { const int R = tile * 16 + row, b = R / 254, n = (R % 254) >> 1, g = R & 1;
          const bf16* abase = C.proj + ((size_t)b * S + 16 * n) * PITCH + (which ? PC_VC : PC_KC) + g * 64 + 8 * kq;
          const bf16* wb = C.w1t + ((size_t)which * 256 + 32 * C.wave + row) * 2048 + 8 * kq;
          f32x4 acc0 = {0.f, 0.f, 0.f, 0.f}, acc1 = {0.f, 0.f, 0.f, 0.f};
#pragma unroll 4
          for (int k0 = 0; k0 < 2048; k0 += 32) {
              const bf16x8_t a = *(const bf16x8_t*)(abase + (size_t)(k0 >> 6) * PITCH + (k0 & 63));
              const bf16x8_t b0 = *(const bf16x8_t*)(wb + k0), b1 = *(const bf16x8_t*)(wb + 16 * 2048 + k0);
              acc0 = __builtin_amdgcn_mfma_f32_16x16x32_bf16(a, b0, acc0, 0, 0, 0);
              acc1 = __builtin_amdgcn_mfma_f32_16x16x32_bf16(a, b1, acc1, 0, 0, 0);
          }
          const float pb0 = C.posb[which * 256 + 32 * C.wave + row], pb1 = C.posb[which * 256 + 32 * C.wave + 16 + row];
#pragma unroll
          for (int r = 0; r < 4; ++r) {
              hidL[(kq * 4 + r) * 256 + 32 * C.wave + row] = (bf16)f2bf(silu_f(acc0[r] + pb0));
              hidL[(kq * 4 + r) * 256 + 32 * C.wave + 16 + row] = (bf16)f2bf(silu_f(acc1[r] + pb1));
          } }
        __syncthreads();
        if (C.wave < 4) {
            const bf16* w2 = C.w2t + ((size_t)which * 64 + 16 * C.wave + row) * 256 + 8 * kq;
            f32x4 acc = {0.f, 0.f, 0.f, 0.f};
#pragma unroll
            for (int k0 = 0; k0 < 256; k0 += 32) {
                const bf16x8_t a = *(const LAS bf16x8_t*)(hidL + row * 256 + k0 + 8 * kq);
                const bf16x8_t b = *(const bf16x8_t*)(w2 + k0);
                acc = __builtin_amdgcn_mfma_f32_16x16x32_bf16(a, b, acc, 0, 0, 0);
            }
#pragma unroll
            for (int r = 0; r < 4; ++r) {
                const int R = tile * 16 + kq * 4 + r, b = R / 254, n = (R % 254) >> 1, g = R & 1, col = 16 * C.wave + row;
                C.kvc[((size_t)which * (NB * NCMP * 2) + R) * 64 + col] = acc[r];
                C.kvc16[((((size_t)which * 8 + b) * 2 + g) * 128 + n) * 64 + col] = (bf16)f2bf(acc[r]);
            }
        }
        __syncthreads();
    }
}
#if defined(ORACLE) && ORACLE >= 4
__device__ __forceinline__ void cmp_attn_item(Ctx& C, int i, float& sd, float& sr) {
    const int t = i % S, h = (i / S) % 8, b = i / (S * 8), g = h / 4;
    const size_t tok = (size_t)b * S + t;
    const int NR = NB * NCMP * 2;
    const float* kc = C.kvc;
    const float* vc = C.kvc + (size_t)NR * 64;
    float q[64], o[64];
#pragma unroll
    for (int d = 0; d < 64; ++d) { q[d] = bf2f(C.proj[tok * PITCH + PC_NQ + h * 64 + d]); o[d] = 0.f; }
    float* prow = C.pc + ((size_t)(b * 8 + h) * S + t) * 128;
    const int nvalid = t >= 31 ? min(NCMP, (t - 31) / 16 + 1) : 0;
    float m = -1e30f;
    for (int n = 0; n < nvalid; ++n) {
        const float* kr = kc + ((size_t)(b * NCMP + n) * 2 + g) * 64;
        float dot = 0.f;
#pragma unroll
        for (int d = 0; d < 64; ++d) dot += q[d] * kr[d];
        const float lg = dot + C.rel_bias[t5_bucket(t - (16 * n + 31)) * 8 + h] * LOG2E;
        prow[n] = lg;
        m = fmaxf(m, lg);
    }
    float l = 0.f;
    for (int n = 0; n < nvalid; ++n) l += exp2f(prow[n] - m);
    const float il = nvalid ? 1.f / l : 0.f;
    for (int n = 0; n < 128; ++n) {
        float p = 0.f;
        if (n < nvalid) {
            p = exp2f(prow[n] - m) * il;
            const float* vr = vc + ((size_t)(b * NCMP + n) * 2 + g) * 64;
#pragma unroll
            for (int d = 0; d < 64; ++d) o[d] += p * vr[d];
        }
        prow[n] = p;
    }
#pragma unroll
    for (int d = 0; d < 64; ++d) { const float got = bf2f(C.oc[tok * 512 + h * 64 + d]); sd += (got - o[d]) * (got - o[d]); sr += o[d] * o[d]; }
}
__device__ __forceinline__ void ph_imp_topk(Ctx& C, float& sd, float& sr) {
    for (int i = C.gtid; i < NB * 2 * S; i += C.GT) {
        const int t = i % S, g = (i / S) % 2, b = i / (S * 2);
        const int qb = t >> 6;
        float* sc = C.scorebuf + (size_t)i * 32;
        for (int j = 0; j < 32; ++j) {
            float imp = 0.f;
            for (int r = 0; r < 4; ++r) {
                const float* prow = C.pc + ((size_t)(b * 8 + g * 4 + r) * S + t) * 128;
                for (int n = 4 * j - 1; n <= 4 * j + 3; ++n)
                    if (n >= 0 && n < NCMP) imp += prow[n];
            }
            const bool causal = j <= qb, forced = (j == 0) || (j == qb) || (j == qb - 1);
            sc[j] = causal ? imp + (forced ? 1e4f : 0.f) : -1e4f;
        }
        unsigned taken = 0u;
        for (int k = 0; k < 16; ++k) {
            float best = -3e38f; int bi = 0;
            for (int j = 0; j < 32; ++j)
                if (!((taken >> j) & 1u)) { const float v = sc[j]; if (v > best) { best = v; bi = j; } }
            taken |= 1u << bi;
        }
        sd += (C.selmask[i] != taken) ? 1.f : 0.f; sr += 1.f;
    }
}
#endif
#define ATTN_IO(C) attn_body::AttnIO{C.wsb}
__device__ __forceinline__ unsigned pick4(unsigned a, unsigned b, unsigned c, unsigned d, int k) { return k == 0 ? a : (k == 1 ? b : (k == 2 ? c : d)); }
__device__ __forceinline__ void ph_attn_a(Ctx& C, char* shm) {
    const attn_body::AttnIO io = ATTN_IO(C);
    const int c = blockIdx.x, k = c >> 6, j = c & 63, b = j >> 3, h = j & 7;
    if (c >= 256) return;
    attn_body::attn_fill_dt(shm, C.rel_bias);
    { int tv = threadIdx.x; asm volatile("" : "+v"(tv));
    for (unsigned l = pick4(0xF07u, 0xF16u, 0xF25u, 0xF34u, k); (l & 15u) != 15u; l >>= 4) attn_body::attn_unit<0, 8>(b, h, (int)(l & 15u), io, shm, tv); }
    { int tv = threadIdx.x; asm volatile("" : "+v"(tv));
    for (unsigned l = pick4(0xF07u, 0xF16u, 0xF25u, 0xF34u, k); (l & 15u) != 15u; l >>= 4) attn_body::attn_unit<2, 8>(b, h, (int)(l & 15u), io, shm, tv); }
}
__device__ __forceinline__ void ph_attn_b(Ctx& C, char* shm) {
    const attn_body::AttnIO io = ATTN_IO(C);
    const int c = blockIdx.x, k = c >> 6, j = c & 63, b = j >> 3, h = j & 7;
    if (c >= 256) return;
    attn_body::attn_fill_dt(shm, C.rel_bias);
    { int tv = threadIdx.x; asm volatile("" : "+v"(tv));
    for (unsigned l = pick4(0xF07u, 0xF16u, 0xF25u, 0xF34u, k); (l & 15u) != 15u; l >>= 4) attn_body::attn_unit<1, 8>(b, h, (int)(l & 15u), io, shm, tv); }
}

#ifdef ORACLE
constexpr int CW_ORA = 24576;
template <int MODE>
__device__ __forceinline__ void oracle_attn(Ctx& C) {
    float sd = 0.f, sr = 0.f;
    for (int i = C.gtid; i < NB * 8 * S; i += C.GT) {
        const int t = i % S, h = (i / S) % 8, b = i / (S * 8), g = h / 4;
        const size_t tok = (size_t)b * S + t;
        const int qoff = (MODE == 0 ? PC_FQ : PC_NQ) + h * 64;
        const int koff = MODE == 0 ? PC_FK + h * 64 : (MODE == 1 ? PC_KS : PC_KW) + g * 64;
        const int voff = MODE == 0 ? PC_FV + h * 64 : (MODE == 1 ? PC_VS : PC_VW) + g * 64;
        float q[64], o[64];
#pragma unroll
        for (int d = 0; d < 64; ++d) { q[d] = bf2f(C.proj[tok * PITCH + qoff + d]); o[d] = 0.f; }
        float m = -INFINITY, l = 0.f;
        const int s_lo = MODE == 2 ? max(0, t - 511) : 0;
        const unsigned mask = MODE == 1 ? C.selmask[(b * 2 + g) * S + t] : 0xffffffffu;
        const float* cr = C.cum + (size_t)(b * 8 + h) * S;
        const float cumt = MODE == 0 ? cr[t] : 0.f;
        for (int s = s_lo; s <= t; ++s) {
            if (MODE == 1 && !((mask >> (s >> 6)) & 1u)) continue;
            const bf16* kr = C.proj + ((size_t)b * S + s) * PITCH + koff;
            const bf16* vr = C.proj + ((size_t)b * S + s) * PITCH + voff;
            float dot = 0.f;
#pragma unroll
            for (int d = 0; d < 64; ++d) dot += q[d] * bf2f(kr[d]);
            const float bias = MODE == 0 ? cumt - cr[s] : C.rel_bias[t5_bucket(t - s) * 8 + h];
            const float lg = dot + bias * LOG2E;
            const float mn = fmaxf(m, lg), corr = exp2f(m - mn), p = exp2f(lg - mn);
            l = l * corr + p;
#pragma unroll
            for (int d = 0; d < 64; ++d) o[d] = o[d] * corr + p * bf2f(vr[d]);
            m = mn;
        }
        const float il = 1.f / l;
        float g0 = 0.f, g1 = 1.f, g2 = 0.f;
        if (MODE == 1) { g0 = sigmoid_f(C.fg[tok * FGW + 8 + h * 3 + 0]); g1 = sigmoid_f(C.fg[tok * FGW + 8 + h * 3 + 1]); g2 = sigmoid_f(C.fg[tok * FGW + 8 + h * 3 + 2]); }
#pragma unroll
        for (int d = 0; d < 64; ++d) {
            float ref = o[d] * il, got;
            if (MODE == 0) got = bf2f(C.ao16[tok * D + h * 64 + d]);
            else if (MODE == 2) got = bf2f(C.ow[tok * 512 + h * 64 + d]);
            else { ref = g0 * bf2f(C.oc[tok * 512 + h * 64 + d]) + g1 * ref + g2 * bf2f(C.ow[tok * 512 + h * 64 + d]); got = bf2f(C.ao16[tok * D + 512 + h * 64 + d]); }
            sd += (got - ref) * (got - ref); sr += ref * ref;
        }
    }
    sd = wave_sum(sd); sr = wave_sum(sr);
    if (C.lane == 0) { atomicAdd((float*)(C.ctl + CW_ORA), sd); atomicAdd((float*)(C.ctl + CW_ORA + 64), sr); }
}
#endif
__device__ __forceinline__ void ph_cmp_attn(Ctx& C, char* shm) {
    const attn_body::AttnIO io = ATTN_IO(C);
    const int c = blockIdx.x;
    if (c >= 256) return;
    attn_body::attn_fill_dt(shm, C.rel_bias, attn_body::CL_DT);
    { int tv = threadIdx.x; asm volatile("" : "+v"(tv));
      const int bg = c >> 4, i = c & 15;
      attn_body::cmp_unit(bg >> 1, bg & 1, 31 - i, io, shm, tv);
      attn_body::cmp_unit(bg >> 1, bg & 1, i, io, shm, tv); }
}
template <int WHICH>
__device__ __forceinline__ void ph_ln(Ctx& C) {
    const float* gam = WHICH == 1 ? C.ln1_g : C.ln2_g;
    const float* bet = WHICH == 1 ? C.ln1_b : C.ln2_b;
    for (int m = C.gw; m < T; m += C.NGW) {
        const int b = m / S;
        float* row = C.out + (size_t)m * D;
        f32x4 v[4]; float s = 0.f;
#pragma unroll
        for (int j = 0; j < 4; ++j) { v[j] = *(const f32x4*)(row + (C.lane + 64 * j) * 4); s += (v[j].x + v[j].y) + (v[j].z + v[j].w); }
        const float mean = wave_sum(s) * (1.f / D); float s2 = 0.f;
#pragma unroll
        for (int j = 0; j < 4; ++j) { v[j] = v[j] - mean; s2 += (v[j].x * v[j].x + v[j].y * v[j].y) + (v[j].z * v[j].z + v[j].w * v[j].w); }
        const float rstd = rsqrtf(wave_sum(s2) * (1.f / D) + LN_EPS);
#pragma unroll
        for (int j = 0; j < 4; ++j) {
            const int c0 = (C.lane + 64 * j) * 4;
            const f32x4 y = v[j] * rstd * *(const f32x4*)(gam + c0) + *(const f32x4*)(bet + c0);
            *(f32x4*)(row + c0) = y;
            if (WHICH == 1) {
                const float* md = C.mod + b * 6 * D;
                const f32x4 h2 = y * (1.f + *(const f32x4*)(md + 4 * D + c0)) + *(const f32x4*)(md + 3 * D + c0);
                u32x2 hi; hi.x = pk2(h2.x, h2.y); hi.y = pk2(h2.z, h2.w);
                const float r0 = h2.x - __builtin_bit_cast(float, hi.x << 16), r1 = h2.y - __builtin_bit_cast(float, hi.x & 0xffff0000u);
                const float r2 = h2.z - __builtin_bit_cast(float, hi.y << 16), r3 = h2.w - __builtin_bit_cast(float, hi.y & 0xffff0000u);
                u32x2 lo; lo.x = pk2(r0, r1); lo.y = pk2(r2, r3);
                *(u32x2*)(C.hbuf + (size_t)m * D + c0) = hi;
                *(u32x2*)(C.h2lo + (size_t)m * D + c0) = lo;
            }
        }
    }
}
__device__ __forceinline__ void ph_router_route(Ctx& C) {
    LAS float* scr = (LAS float*)(C.lds + C.wave * 4096);
    const int row = C.lane & 15, kq = C.lane >> 4;
    for (int tile = C.gw; tile < T / 16; tile += C.NGW) {
        const int tok0 = tile * 16;
        const bf16* ah = C.hbuf + (size_t)(tok0 + row) * D + 8 * kq;
        const bf16* al = C.h2lo + (size_t)(tok0 + row) * D + 8 * kq;
        const bf16* wh = C.wrt + (size_t)row * 1024 + 8 * kq;
        f32x4 acc[4];
#pragma unroll
        for (int n = 0; n < 4; ++n) acc[n] = (f32x4){0.f, 0.f, 0.f, 0.f};
#pragma unroll 2
        for (int k0 = 0; k0 < D; k0 += 32) {
            const bf16x8_t a_h = *(const bf16x8_t*)(ah + k0), a_l = *(const bf16x8_t*)(al + k0);
#pragma unroll
            for (int n = 0; n < 4; ++n) {
                const bf16x8_t b_h = *(const bf16x8_t*)(wh + (size_t)n * 16 * 1024 + k0), b_l = *(const bf16x8_t*)(wh + 65536 + (size_t)n * 16 * 1024 + k0);
                acc[n] = __builtin_amdgcn_mfma_f32_16x16x32_bf16(a_l, b_l, acc[n], 0, 0, 0);
                acc[n] = __builtin_amdgcn_mfma_f32_16x16x32_bf16(a_l, b_h, acc[n], 0, 0, 0);
                acc[n] = __builtin_amdgcn_mfma_f32_16x16x32_bf16(a_h, b_l, acc[n], 0, 0, 0);
                acc[n] = __builtin_amdgcn_mfma_f32_16x16x32_bf16(a_h, b_h, acc[n], 0, 0, 0);
            }
        }
#pragma unroll
        for (int n = 0; n < 4; ++n)
#pragma unroll
            for (int r = 0; r < 4; ++r) scr[(kq * 4 + r) * 64 + n * 16 + row] = acc[n][r];
        asm volatile("s_waitcnt lgkmcnt(0)" ::: "memory");
        const int e = C.lane, g = e >> 3;
        const float eb = C.e_bias[e];
        for (int tl = 0; tl < 16; ++tl) {
            const int tok = tok0 + tl;
            const float sc = sigmoid_f(scr[tl * 64 + e]);
            const float bsc = sc + eb;
            float m1 = bsc;
            m1 = fmaxf(m1, __shfl_xor(m1, 1)); m1 = fmaxf(m1, __shfl_xor(m1, 2)); m1 = fmaxf(m1, __shfl_xor(m1, 4));
            const unsigned long long eq = __ballot(bsc == m1) & (0xFFull << (8 * g));
            const int first = __ffsll((long long)eq) - 1;
            float m2 = (e == first) ? -INFINITY : bsc;
            m2 = fmaxf(m2, __shfl_xor(m2, 1)); m2 = fmaxf(m2, __shfl_xor(m2, 2)); m2 = fmaxf(m2, __shfl_xor(m2, 4));
            const float gs = m1 + m2;
            int grank = 0;
#pragma unroll
            for (int gg = 0; gg < 8; ++gg) { const float o = __shfl(gs, gg * 8); grank += (o > gs || (o == gs && gg < g)) ? 1 : 0; }
            const float mv = grank < 4 ? bsc : -INFINITY;
            int rank = 0;
#pragma unroll
            for (int e2 = 0; e2 < 64; ++e2) { const float o = __shfl(mv, e2); rank += (o > mv || (o == mv && e2 < e)) ? 1 : 0; }
            const bool sel = rank < 8;
            const float wsum = wave_sum(sel ? sc : 0.f);
            if (sel) {
                const float w = sc / wsum * 2.5f;
                const unsigned pos = __hip_atomic_fetch_add(C.ctl + CW_CNT + 64 * e, 1u, RLX_AGENT);
                C.lrow[(size_t)e * 16384 + pos] = tok * 16 + rank; C.lw[(size_t)e * 16384 + pos] = w;
            }
            if (e == 0) { C.lrow[(size_t)64 * 16384 + tok] = tok * 16 + 8; C.lw[(size_t)64 * 16384 + tok] = 1.f; }
        }
    }
}
__device__ __forceinline__ void ph_convert_experts(Ctx& C) {
    LAS float* scr = (LAS float*)(C.lds + C.wave * 8704);
    for (int it = C.gw; it < 65 * 384; it += C.NGW) {
        const int e = it / 384, r = it % 384, kind = r / 128, item = r % 128;
        if (kind < 2) {
            const float* W = e < 64 ? (kind == 0 ? C.w_gate : C.w_up) + (size_t)e * D * 256 : (kind == 0 ? C.ws_gate : C.ws_up);
            const int n0 = 32 * (item % 8);
            bf16* WT = C.wgu + ((size_t)e * 512 + (n0 / 128) * 128 + kind * 128) * D;
            transpose_item<0>(W, D, 256, WT, scr, item, C.lane);
        } else {
            const float* W = e < 64 ? C.w_down + (size_t)e * 256 * D : C.ws_down;
            transpose_item<0>(W, 256, D, C.wdn + (size_t)e * D * 256, scr, item, C.lane);
        }
    }
}
__device__ __forceinline__ int moe_tables(Ctx& C) {
    LAS int* tstart = (LAS int*)(C.lds + LDS_TSTART); LAS int* cntl = (LAS int*)(C.lds + LDS_CNT);
    if (C.tid < 64) cntl[C.tid] = (int)__hip_atomic_load(C.ctl + CW_CNT + 64 * C.tid, RLX_AGENT);
    if (C.tid == 64) cntl[64] = T;
    __syncthreads();
    if (C.tid == 0) { int s = 0; for (int e = 0; e < 65; ++e) { tstart[e] = s; s += (cntl[e] + 255) >> 8; } tstart[65] = s; }
    __syncthreads();
    return tstart[65];
}
__device__ __forceinline__ void ph_moe_gateup(Ctx& C) {
    const int MT = moe_tables(C);
    pg8::MoeSched So{(const LAS int*)(C.lds + LDS_TSTART), (const LAS int*)(C.lds + LDS_CNT), C.lrow, C.lw, (const char*)C.wgu, (size_t)512 * D * 2, (size_t)256 * D * 2, MT, 2, 0, (int)gridDim.x, (int)blockIdx.x};
    pg8::EpiAct E{C.act16};
    pg8::gemm_phase_g<pg8::EpiAct, pg8::MoeSched, true>(C.lds, C.lds + LDS_TAB, C.hbuf, D, So, E);
}
template <int HF>
__device__ __forceinline__ void ph_moe_down(Ctx& C) {
    const int MT = moe_tables(C);
    pg8::MoeSched So{(const LAS int*)(C.lds + LDS_TSTART), (const LAS int*)(C.lds + LDS_CNT), C.lrow, C.lw, (const char*)C.wdn, (size_t)D * 256 * 2, (size_t)256 * 256 * 2, MT, 2, 2 * HF, (int)gridDim.x, (int)blockIdx.x};
    pg8::EpiSlot E{C.slot, 2 * HF, (unsigned)T * 9u};
    pg8::gemm_phase_g<pg8::EpiSlot, pg8::MoeSched, false>(C.lds, C.lds + LDS_TAB, C.act16, 256, So, E);
}
template <int HF>
__device__ __forceinline__ void ph_combine(Ctx& C) {
    for (int m = C.gw; m < T; m += C.NGW) {
        const int b = m / S, c0 = HF * 512 + C.lane * 8;
        float acc[8];
#pragma unroll
        for (int i = 0; i < 8; ++i) acc[i] = 0.f;
#pragma unroll
        for (int s = 0; s < 9; ++s) {
            const u32x4 v = *(const u32x4*)(C.slot + ((size_t)m * 9 + s) * 512 + C.lane * 8);
            acc[0] += __builtin_bit_cast(float, v.x << 16); acc[1] += __builtin_bit_cast(float, v.x & 0xffff0000u);
            acc[2] += __builtin_bit_cast(float, v.y << 16); acc[3] += __builtin_bit_cast(float, v.y & 0xffff0000u);
            acc[4] += __builtin_bit_cast(float, v.z << 16); acc[5] += __builtin_bit_cast(float, v.z & 0xffff0000u);
            acc[6] += __builtin_bit_cast(float, v.w << 16); acc[7] += __builtin_bit_cast(float, v.w & 0xffff0000u);
        }
        float* row = C.out + (size_t)m * D;
        const float* g2 = C.mod + b * 6 * D + 5 * D + c0;
        f32x4 y0 = *(const f32x4*)(row + c0) * ALPHA + *(const f32x4*)g2 * (f32x4){acc[0], acc[1], acc[2], acc[3]};
        f32x4 y1 = *(const f32x4*)(row + c0 + 4) * ALPHA + *(const f32x4*)(g2 + 4) * (f32x4){acc[4], acc[5], acc[6], acc[7]};
        if (HF == 0) { *(f32x4*)(row + c0) = y0; *(f32x4*)(row + c0 + 4) = y1; }
        else {
            f32x4 z0 = *(const f32x4*)(row + C.lane * 8), z1 = *(const f32x4*)(row + C.lane * 8 + 4);
            float s = (y0.x + y0.y) + (y0.z + y0.w) + (y1.x + y1.y) + (y1.z + y1.w) + (z0.x + z0.y) + (z0.z + z0.w) + (z1.x + z1.y) + (z1.z + z1.w);
            const float mean = wave_sum(s) * (1.f / D);
            y0 = y0 - mean; y1 = y1 - mean; z0 = z0 - mean; z1 = z1 - mean;
            float q = (y0.x * y0.x + y0.y * y0.y) + (y0.z * y0.z + y0.w * y0.w) + (y1.x * y1.x + y1.y * y1.y) + (y1.z * y1.z + y1.w * y1.w)
                    + (z0.x * z0.x + z0.y * z0.y) + (z0.z * z0.z + z0.w * z0.w) + (z1.x * z1.x + z1.y * z1.y) + (z1.z * z1.z + z1.w * z1.w);
            float rstd = rsqrtf(wave_sum(q) * (1.f / D) + LN_EPS);
            const int cz = C.lane * 8;
#ifdef ORACLE
            { const float sd_ = __uint_as_float(__hip_atomic_load(C.ctl + CW_ORA, RLX_AGENT)), sr_ = __uint_as_float(__hip_atomic_load(C.ctl + CW_ORA + 64, RLX_AGENT)); rstd *= 1.f + 10.f * sqrtf(sd_ / sr_); }
#endif
            *(f32x4*)(row + cz) = z0 * rstd * *(const f32x4*)(C.ln2_g + cz) + *(const f32x4*)(C.ln2_b + cz);
            *(f32x4*)(row + cz + 4) = z1 * rstd * *(const f32x4*)(C.ln2_g + cz + 4) + *(const f32x4*)(C.ln2_b + cz + 4);
            *(f32x4*)(row + c0) = y0 * rstd * *(const f32x4*)(C.ln2_g + c0) + *(const f32x4*)(C.ln2_b + c0);
            *(f32x4*)(row + c0 + 4) = y1 * rstd * *(const f32x4*)(C.ln2_g + c0 + 4) + *(const f32x4*)(C.ln2_b + c0 + 4);
        }
    }
}

__device__ __forceinline__ void mkctx(Ctx& C, const Args& args_unused, LAS unsigned char* ldsp) {
    typedef const __attribute__((address_space(4))) Args* kargp; kargp ap = (kargp)__builtin_amdgcn_kernarg_segment_ptr(); asm volatile("" : "+s"(ap));
#define args (*ap)
    C.lds = ldsp;
    C.tid = threadIdx.x; C.lane = C.tid & 63; C.wave = __builtin_amdgcn_readfirstlane(C.tid >> 6);
    C.gtid = blockIdx.x * NTHR + C.tid; C.GT = gridDim.x * NTHR; C.gw = blockIdx.x * NWAVES + C.wave; C.NGW = gridDim.x * NWAVES;
    C.x = args.in[0]; C.c = args.in[1]; C.w_ada = args.in[2]; C.b_ada = args.in[3]; C.w_in = args.in[4]; C.b_f = args.in[5];
    C.cmp_pos_k = args.in[6]; C.cmp_w1_k = args.in[7]; C.cmp_w2_k = args.in[8]; C.cmp_pos_v = args.in[9]; C.cmp_w1_v = args.in[10]; C.cmp_w2_v = args.in[11];
    C.rel_bias = args.in[12]; C.w_out = args.in[13]; C.ln1_g = args.in[14]; C.ln1_b = args.in[15]; C.w_router = args.in[16]; C.e_bias = args.in[17];
    C.w_gate = args.in[18]; C.w_up = args.in[19]; C.w_down = args.in[20]; C.ws_gate = args.in[21]; C.ws_up = args.in[22]; C.ws_down = args.in[23];
    C.ln2_g = args.in[24]; C.ln2_b = args.in[25];
    C.out = args.out;
    unsigned char* ws = args.ws; C.wsb = ws;
    C.mod = (float*)(ws + WS_MOD); C.cum = (float*)(ws + WS_CUM); C.kvc = (float*)(ws + WS_KVC); C.posb = (float*)(ws + WS_POSB); C.w1t = (bf16*)(ws + WS_W1T); C.w2t = (bf16*)(ws + WS_W2T); C.kvc16 = (bf16*)(ws + WS_KVC16); C.wrt = (bf16*)(ws + WS_WRT);
    C.selmask = (unsigned*)(ws + WS_SELM); C.scorebuf = (float*)(ws + WS_SCB); C.scores = (float*)(ws + WS_SCORES);
    C.eidx = (int*)(ws + WS_EIDX); C.ew = (float*)(ws + WS_EW); C.fg = (float*)(ws + WS_FG);
    C.win_t = (bf16*)(ws + WS_WIN_T); C.wout_t = (bf16*)(ws + WS_WOUT_T); C.ao16 = (bf16*)(ws + WS_AO16); C.oc = (bf16*)(ws + WS_OC); C.ow = (bf16*)(ws + WS_OW);
    C.hbuf = (bf16*)(ws + WS_HBUF); C.proj = (bf16*)(ws + WS_PROJ); C.h2lo = (bf16*)(ws + WS_PROJ);
    C.pc = (float*)(ws + WS_PC);
    C.wgu = (bf16*)(ws + WS_WGU); C.wdn = (bf16*)(ws + WS_WDN); C.act16 = (bf16*)(ws + WS_ACT16); C.slot = (bf16*)(ws + WS_SLOT);
    C.lrow = (int*)(ws + WS_LROW); C.lw = (float*)(ws + WS_LW); C.ctl = (gu32*)(ws + WS_CTL);
#undef args
}
#if defined(ORACLE) && ORACLE >= 4
__global__ void __launch_bounds__(256) k_oracle4a(Args args) {
    Ctx C; mkctx(C, args, (LAS unsigned char*)nullptr);
    float sd = 0.f, sr = 0.f;
    for (int i = blockIdx.x * 256 + threadIdx.x; i < NB * 8 * S; i += gridDim.x * 256) cmp_attn_item(C, i, sd, sr);
    sd = wave_sum(sd); sr = wave_sum(sr);
    if (ORACLE == 4 && (threadIdx.x & 63) == 0) { atomicAdd((float*)(C.ctl + CW_ORA), sd); atomicAdd((float*)(C.ctl + CW_ORA + 64), sr); }
}
__global__ void __launch_bounds__(256) k_oracle4b(Args args) {
    Ctx C; mkctx(C, args, (LAS unsigned char*)nullptr);
    C.gtid = blockIdx.x * 256 + threadIdx.x; C.GT = gridDim.x * 256;
    float sd = 0.f, sr = 0.f;
    ph_imp_topk(C, sd, sr);
    sd = wave_sum(sd); sr = wave_sum(sr);
    if (ORACLE == 5 && (threadIdx.x & 63) == 0) { atomicAdd((float*)(C.ctl + CW_ORA), sd * sd > 0.f ? sd : 0.f); atomicAdd((float*)(C.ctl + CW_ORA + 64), sr); }
}
#endif
#if defined(ORACLE) && ORACLE == 3
__global__ void __launch_bounds__(256) k_oracle3a(Args args) {
    Ctx C; mkctx(C, args, (LAS unsigned char*)nullptr);
    const int NR = NB * NCMP * 2;
    for (int i = blockIdx.x * 256 + threadIdx.x; i < 2 * NR * 256; i += gridDim.x * 256) {
        const int j = i % 256, row = (i / 256) % NR, which = i / (256 * NR);
        const int g = row % 2, n = (row / 2) % NCMP, b = row / (2 * NCMP);
        const float* pos = which ? C.cmp_pos_v : C.cmp_pos_k; const float* w1 = which ? C.cmp_w1_v : C.cmp_w1_k;
        const int off = (which ? PC_VC : PC_KC) + g * 64;
        float acc = 0.f;
        for (int l = 0; l < 32; ++l) { const bf16* xr = C.proj + ((size_t)b * S + 16 * n + l) * PITCH + off;
            for (int d = 0; d < 64; ++d) acc += (bf2f(xr[d]) + pos[l * 64 + d]) * w1[(size_t)(l * 64 + d) * 256 + j]; }
        C.scorebuf[i] = silu_f(acc);
    }
}
__global__ void __launch_bounds__(256) k_oracle3b(Args args) {
    Ctx C; mkctx(C, args, (LAS unsigned char*)nullptr);
    const int NR = NB * NCMP * 2; float sd = 0.f, sr = 0.f;
    for (int i = blockIdx.x * 256 + threadIdx.x; i < 2 * NR * 64; i += gridDim.x * 256) {
        const int d = i % 64, row = (i / 64) % NR, which = i / (64 * NR);
        const float* w2 = which ? C.cmp_w2_v : C.cmp_w2_k; const float* hr = C.scorebuf + ((size_t)which * NR + row) * 256;
        float acc = 0.f; for (int j = 0; j < 256; ++j) acc += hr[j] * w2[j * 64 + d];
        const int g = row % 2, n = (row / 2) % NCMP, b = row / (2 * NCMP);
        const float got = bf2f(C.kvc16[((((size_t)which * 8 + b) * 2 + g) * 128 + n) * 64 + d]);
        const float got2 = C.kvc[i];
        sd += (got - acc) * (got - acc) + (got2 - acc) * (got2 - acc); sr += 2.f * acc * acc;
    }
    sd = wave_sum(sd); sr = wave_sum(sr);
    if ((threadIdx.x & 63) == 0) { atomicAdd((float*)(C.ctl + CW_ORA), sd); atomicAdd((float*)(C.ctl + CW_ORA + 64), sr); }
}
#endif
#if defined(ORACLE) && ORACLE < 3
__global__ void __launch_bounds__(256) k_oracle(Args args) {
    Ctx C; mkctx(C, args, (LAS unsigned char*)nullptr);
    C.gtid = blockIdx.x * 256 + threadIdx.x; C.GT = gridDim.x * 256;
    oracle_attn<ORACLE>(C);
}
#endif
constexpr int N_PHASES = 17;
__global__ void __launch_bounds__(NTHR, 2) mk_fwd(Args args) {
    extern __shared__ __attribute__((aligned(16))) unsigned char lds[];
    volatile LAS unsigned* MISC = (volatile LAS unsigned*)((LAS unsigned char*)lds + MISC_OFF);
    if (threadIdx.x < 32) MISC[threadIdx.x] = 0u;
    __syncthreads();
    (void)xcd_barrier_post((unsigned*)((gu32*)(args.ws + WS_CTL) + CW_BAR) + args.li * XCD_BAR_WORDS, MISC + 8);
#define bar (XcdBarrier{(unsigned*)((gu32*)(args.ws + WS_CTL) + CW_BAR) + args.li * XCD_BAR_WORDS, xb_xcc_id(), (volatile LAS unsigned*)((LAS unsigned char*)lds + MISC_OFF) + 8})
    const int lo = args.ph_lo, hi = args.ph_hi;
#ifndef PHASE_MASK
#define PHASE_MASK 0xffffffffu
#endif
#define IN(k) (((PHASE_MASK >> (k)) & 1u) && lo <= (k) && (k) < hi)
#define SEAM(k) do { if (IN(k) && IN((k) + 1)) xcd_barrier(bar); } while (0)
#ifndef DUP_MASK
#define DUP_MASK 0u
#endif
#define DUP(k) (((DUP_MASK >> (k)) & 1u) != 0u)
    if (IN(0)) { Ctx C; mkctx(C, args, (LAS unsigned char*)lds); for (int rep = 0; rep < (DUP(0) ? 2 : 1); ++rep) { if (rep) xcd_barrier(bar); if (!rep) ph_prologue(C); ph_mod(C); } }
    SEAM(0);
    if (IN(1)) { Ctx C; mkctx(C, args, (LAS unsigned char*)lds); ph_hpass(C); }
    SEAM(1);
    if (IN(2)) { Ctx C; mkctx(C, args, (LAS unsigned char*)lds);
        pg8::Gemm g{C.hbuf, C.win_t, T, 3072, D}; pg8::StaticOrder So; So.init(T, 3072, (int)gridDim.x, (int)blockIdx.x);
        pg8::EpiProj E{C.proj, C.fg, PITCH, C2};
        pg8::gemm_phase<pg8::EpiProj, pg8::StaticOrder, true, true>(C.lds, g, So, E);
    }
    SEAM(2);
    if (IN(3)) { Ctx C; mkctx(C, args, (LAS unsigned char*)lds); ph_cum_cmp1(C); ph_compress(C); }
    SEAM(3);
    if (IN(4)) { Ctx C; mkctx(C, args, (LAS unsigned char*)lds); ph_cmp_attn(C, (char*)lds); }
    SEAM(4);
    if (IN(5)) { Ctx C; mkctx(C, args, (LAS unsigned char*)lds); ph_attn_a(C, (char*)lds); }
    if (IN(5) && IN(7)) xcd_barrier(bar);
    if (IN(7)) { Ctx C; mkctx(C, args, (LAS unsigned char*)lds); ph_attn_b(C, (char*)lds); }
    SEAM(7);
    if (IN(8)) { Ctx C; mkctx(C, args, (LAS unsigned char*)lds);
        pg8::Gemm g{C.ao16, C.wout_t, T, D, D}; pg8::StaticOrder So; So.init(T, D, (int)gridDim.x, (int)blockIdx.x);
        pg8::EpiOut E{C.x, C.mod, C.out, ALPHA};
        pg8::gemm_phase<pg8::EpiOut, pg8::StaticOrder, true, true>(C.lds, g, So, E);
    }
    SEAM(8);
    if (IN(9)) { Ctx C; mkctx(C, args, (LAS unsigned char*)lds); ph_ln<1>(C); ph_convert_experts(C); }
    SEAM(9);
    if (IN(10)) { Ctx C; mkctx(C, args, (LAS unsigned char*)lds); ph_router_route(C); }
    if (IN(10) && IN(12)) xcd_barrier(bar);
    if (IN(12)) { Ctx C; mkctx(C, args, (LAS unsigned char*)lds); ph_moe_gateup(C); }
    SEAM(12);
    if (IN(13)) { Ctx C; mkctx(C, args, (LAS unsigned char*)lds); ph_moe_down<0>(C); }
    SEAM(13);
    if (IN(14)) { Ctx C; mkctx(C, args, (LAS unsigned char*)lds); ph_combine<0>(C); }
    SEAM(14);
    if (IN(15)) { Ctx C; mkctx(C, args, (LAS unsigned char*)lds); ph_moe_down<1>(C); }
    SEAM(15);
    if (IN(16)) { Ctx C; mkctx(C, args, (LAS unsigned char*)lds); ph_combine<1>(C); }
#undef IN
#undef SEAM
#undef bar
}

extern "C" void kernel_launch(void* const* d_in, const int* in_sizes, int n_in, void* d_out, int out_size, void* d_ws, size_t ws_size, hipStream_t stream) {
    static int grid = 0;
    if (grid == 0) {
        if (n_in != 26 || out_size != T * D || ws_size < WS_END) { fprintf(stderr, "kernel_launch: unexpected problem (n_in %d out %d ws %zu)\n", n_in, out_size, ws_size); grid = -1; return; }
        int dev = 0, cus = 0, per_cu = 0;
        if (hipGetDevice(&dev) != hipSuccess || hipDeviceGetAttribute(&cus, hipDeviceAttributeMultiprocessorCount, dev) != hipSuccess) { grid = -1; return; }
        if (hipFuncSetAttribute((const void*)mk_fwd, hipFuncAttributeMaxDynamicSharedMemorySize, LDS_BYTES) != hipSuccess) { fprintf(stderr, "kernel_launch: hipFuncSetAttribute failed\n"); grid = -1; return; }
        if (hipOccupancyMaxActiveBlocksPerMultiprocessor(&per_cu, (const void*)mk_fwd, NTHR, LDS_BYTES) != hipSuccess || per_cu < 1) { fprintf(stderr, "kernel_launch: occupancy query says %d\n", per_cu); grid = -1; (void)hipGetLastError(); return; }
        grid = cus;
    }
    if (grid < 0) return;
    (void)hipMemsetAsync((char*)d_ws + WS_CTL, 0, CTL_ZERO_BYTES, stream);
    Args a{};
    for (int i = 0; i < 26; ++i) a.in[i] = (const float*)d_in[i];
    a.out = (float*)d_out; a.ws = (unsigned char*)d_ws; a.ph_lo = 0; a.ph_hi = N_PHASES;
#ifdef ORACLE
    a.ph_hi = 8; hipLaunchKernelGGL(mk_fwd, dim3(grid), dim3(NTHR), LDS_BYTES, stream, a);
#if ORACLE >= 4
    hipLaunchKernelGGL(k_oracle4a, dim3(512), dim3(256), 0, stream, a); hipLaunchKernelGGL(k_oracle4b, dim3(128), dim3(256), 0, stream, a);
#elif ORACLE == 3
    hipLaunchKernelGGL(k_oracle3a, dim3(2048), dim3(256), 0, stream, a); hipLaunchKernelGGL(k_oracle3b, dim3(512), dim3(256), 0, stream, a);
#else
    hipLaunchKernelGGL(k_oracle, dim3(NB * 8 * S / 256), dim3(256), 0, stream, a);
#endif
    a.ph_lo = 8; a.ph_hi = N_PHASES; a.li = 1;
#endif
    hipLaunchKernelGGL(mk_fwd, dim3(grid), dim3(NTHR), LDS_BYTES, stream, a);
}
```

```cpp
#include <hip/hip_runtime.h>
#include <cstdio>
#include <cstdint>
#include <hip/hip_bf16.h>
#include <cmath>

#define GAS __attribute__((address_space(1)))
#define LAS __attribute__((address_space(3)))
typedef unsigned short bf16;
typedef float f32x4 __attribute__((ext_vector_type(4)));
typedef unsigned u32x4 __attribute__((ext_vector_type(4)));
typedef unsigned u32x2 __attribute__((ext_vector_type(2)));
typedef GAS unsigned gu32;
#define RLX_AGENT __ATOMIC_RELAXED, __HIP_MEMORY_SCOPE_AGENT

constexpr int D = 1024, NB = 8, S = 2048, T = NB * S;
constexpr int NPROJ = 2848;
constexpr int PITCH = 2816;
constexpr int PC_FQ = 0, PC_FK = 512, PC_FV = 1024, PC_NQ = 1536, PC_KC = 2048, PC_VC = 2176, PC_KS = 2304, PC_VS = 2432, PC_KW = 2560, PC_VW = 2688;
constexpr int FGW = 32;
constexpr int NCMP = 127;
constexpr float ALPHA = 1.189207115002721f;
constexpr float LN_EPS = 1e-5f;
constexpr float LOG2E = 1.4426950408889634f;
constexpr float C2 = 0.125f * LOG2E;
constexpr int NWAVES = 8, NTHR = NWAVES * 64;

constexpr size_t MiB = 1u << 20;
constexpr size_t WS_CTL = 0, CTL_ZERO_BYTES = 1 * MiB;
constexpr size_t WS_MOD = 1 * MiB, WS_CUM = 2 * MiB, WS_KVC = 3 * MiB, WS_W1T = 4 * MiB  , WS_KVC16 = 6 * MiB  , WS_W2T = 21 * MiB  , WS_POSB = 21 * MiB + 65536  , WS_WRT = 21 * MiB + 131072  , WS_SELM = 8 * MiB, WS_SCB = 9 * MiB, WS_SCORES = 13 * MiB,
                 WS_EIDX = 17 * MiB, WS_EW = 18 * MiB, WS_FG = 19 * MiB;
constexpr size_t WS_WIN_T = 22 * MiB;
constexpr size_t WS_WOUT_T = 28 * MiB;
constexpr size_t WS_HBUF = 30 * MiB;
constexpr size_t WS_PROJ = 62 * MiB;
constexpr size_t WS_PC = 150 * MiB;
constexpr size_t WS_AO16 = 214 * MiB;
constexpr size_t WS_OC = 246 * MiB, WS_OW = 262 * MiB;
constexpr size_t WS_WGU = 94 * MiB;
constexpr size_t WS_WDN = 167 * MiB;
constexpr size_t WS_ACT16 = 200 * MiB;
constexpr size_t WS_SLOT = 22 * MiB;
constexpr size_t WS_LROW = 280 * MiB, WS_LW = 285 * MiB;
constexpr size_t WS_END = 290 * MiB;
constexpr int CW_CNT = 16384;
constexpr int CW_BAR = 4096;

constexpr int LDS_BYTES = 147456;
constexpr int MISC_OFF = 131072 + 320;
constexpr int LDS_TSTART = 131072 + 1024, LDS_CNT = 131072 + 1536, LDS_TAB = 131072 + 2048;

#define XB_TMO      128
#define XB_XCNT(j)  (256  + 64 * (j))
#define XB_XSUB(j)  (1280 + 64 * (j))
#define XB_XGEN(j)  (2304 + 64 * (j))
#define XB_TOP      3328
#define XB_TOPGEN   3392
#define XCD_BAR_WORDS 3456
#define XB_SPIN_CAP (1u << 20)
__device__ __forceinline__ unsigned xb_ld(unsigned* p)              { return __hip_atomic_load(p, __ATOMIC_RELAXED, __HIP_MEMORY_SCOPE_AGENT); }
__device__ __forceinline__ unsigned xb_add(unsigned* p, unsigned v) { return __hip_atomic_fetch_add(p, v, __ATOMIC_RELAXED, __HIP_MEMORY_SCOPE_AGENT); }
__device__ __forceinline__ unsigned xb_xcc_id() { return (unsigned)__builtin_amdgcn_s_getreg((3 << 11) | 20) & 0xFu; }
#define XB_SPIN(cond, bar) do { unsigned _sp = 0; while (cond) { __builtin_amdgcn_s_sleep(1); \
    if ((++_sp & 255u) == 0u) { if (xb_ld(&(bar)[XB_TMO])) break; if (_sp > XB_SPIN_CAP) { atomicAdd(&(bar)[XB_TMO], 1u); break; } } } } while (0)
struct XcdBarrier { unsigned* bar; unsigned x; volatile LAS unsigned* st; };
__device__ __forceinline__ XcdBarrier xcd_barrier_post(unsigned* bar, volatile LAS unsigned* st) {
    XcdBarrier b; b.bar = bar; b.x = xb_xcc_id(); b.st = st;
    if (threadIdx.x == 0) (void)xb_add(&bar[XB_XCNT(b.x)], 1u);
    return b;
}
__device__ __forceinline__ void xcd_barrier_complete(unsigned* bar, unsigned x, unsigned& nloc, unsigned& nx) {
    const unsigned G = gridDim.x * gridDim.y * gridDim.z;
    unsigned sum, cnt, mine, sp = 0u;
    for (;;) {
        sum = 0u; cnt = 0u; mine = 0u;
#pragma unroll
        for (unsigned j = 0; j < 16; ++j) { const unsigned c = xb_ld(&bar[XB_XCNT(j)]); sum += c; cnt += (c > 0u) ? 1u : 0u; mine = (j == x) ? c : mine; }
        if (sum == G) break;
        __builtin_amdgcn_s_sleep(1);
        if ((++sp & 255u) == 0u) { if (xb_ld(&bar[XB_TMO])) break; if (sp > XB_SPIN_CAP) { atomicAdd(&bar[XB_TMO], 1u); break; } }
    }
    nloc = mine > 0u ? mine : 1u; nx = cnt > 0u ? cnt : 1u;
}
__device__ __forceinline__ void xcd_barrier(const XcdBarrier& b) {
    asm volatile("s_waitcnt vmcnt(0)" ::: "memory");
    __syncthreads();
    if (threadIdx.x == 0) {
        unsigned* bar = b.bar;
        __builtin_amdgcn_s_waitcnt(0);
        unsigned nloc = b.st[0], nx = b.st[1];
        if (nloc == 0u) { xcd_barrier_complete(bar, b.x, nloc, nx); b.st[0] = nloc; b.st[1] = nx; }
        const unsigned old = xb_add(&bar[XB_XSUB(b.x)], 1u);
        const unsigned gen = old / nloc;
        if (old + 1u == (gen + 1u) * nloc) {
            __builtin_amdgcn_fence(__ATOMIC_RELEASE, "agent");
            asm volatile("s_waitcnt vmcnt(0)" ::: "memory");
            const unsigned og = xb_add(&bar[XB_TOP], 1u);
            const unsigned tg = og / nx;
            if (og + 1u == (tg + 1u) * nx) xb_add(&bar[XB_TOPGEN], 1u);
            else XB_SPIN(xb_ld(&bar[XB_TOPGEN]) == tg, bar);
            __builtin_amdgcn_fence(__ATOMIC_ACQUIRE, "agent");
            xb_add(&bar[XB_XGEN(b.x)], 1u);
            asm volatile("s_waitcnt vmcnt(0)" ::: "memory");
        } else {
            XB_SPIN(xb_ld(&bar[XB_XGEN(b.x)]) == gen, bar);
            __builtin_amdgcn_fence(__ATOMIC_ACQUIRE, "agent");
            asm volatile("s_waitcnt vmcnt(0)" ::: "memory");
        }
    }
    __syncthreads();
}

namespace pg8 {
#define PG8_LAS __attribute__((address_space(3)))
typedef unsigned short bf16_t;
typedef short bf16x8 __attribute__((ext_vector_type(8)));
typedef float f32x4 __attribute__((ext_vector_type(4)));
typedef unsigned u32x4 __attribute__((ext_vector_type(4)));
constexpr int BM = 256, BK = 64, HALF = 128, HTB = HALF * BK * 2  , STAGE_BYTES = 8 * HTB, NXCD = 8, WGM = 8;

__host__ __device__ __forceinline__ int lds_byte(int r, int c) { const int st = (r >> 4) * 2 + (c >> 5), rr = r & 15, cc = c & 31, ob = rr * 64 + cc * 2; return st * 1024 + (ob ^ (((ob >> 9) & 1) << 5)); }
__host__ __device__ __forceinline__ void stage_rc(int b, int& R, int& C) { const int st = b / 1024, sb = b % 1024, swz = sb ^ (((sb >> 9) & 1) << 5); R = (st >> 1) * 16 + swz / 64; C = (st & 1) * 32 + (swz % 64) / 2; }
__host__ __device__ __forceinline__ int perm32(int rho) { const int n = rho >> 4, i = rho & 15; return 8 * (i >> 2) + 4 * n + (i & 3); }

struct Unit { int pm, pn; };
struct Gemm { const bf16_t* A; const bf16_t* Bt; int M, N, K; };

struct StaticOrder {
    int nM, nN, nwg, G, c;
    __host__ __device__ void init(int M, int N, int G_, int c_) { nM = M / BM; nN = N / BM; nwg = nM * nN; G = G_; c = c_; }
    __host__ __device__ bool next(int i, Unit& u) const {
        const long L = (long)i * G + c; if (L >= nwg) return false;
        int wgid = (int)L; { const int q = nwg / NXCD, r = nwg % NXCD, xcd = wgid % NXCD, off = wgid / NXCD; wgid = (xcd < r ? xcd * (q + 1) : r * (q + 1) + (xcd - r) * q) + off; }
        const int nig = WGM * nN, gid = wgid / nig, fm = gid * WGM, gsz = (nM - fm) < WGM ? (nM - fm) : WGM;
        u.pm = fm + ((wgid % nig) % gsz); u.pn = (wgid % nig) / gsz; return true;
    }
    __device__ __forceinline__ void a_ready(const Unit&) const {}
    __device__ __forceinline__ void done(const Unit&) const {}
};


__device__ __forceinline__ unsigned cvt_pk_bf16(float lo, float hi) { unsigned r; asm volatile("v_cvt_pk_bf16_f32 %0, %1, %2" : "=v"(r) : "v"(lo), "v"(hi)); return r; }
struct EpiProj {
    static constexpr bool PERM = true, AFTER_DRAIN = false;
    bf16_t* proj; float* fg; int pitch; float qscale;
    __device__ __forceinline__ void operator()(const f32x4 (&acc)[2][2][4][2], const Unit& u, int wr, int wc, int fr, int fq) const {
        const int row0 = u.pm * BM + wr * 64 + fr;
        if (u.pn < 11) {
            const float sc = (u.pn < 2 || u.pn == 6 || u.pn == 7) ? qscale : 1.f;
            const int col0 = u.pn * BM + wc * 32 + 8 * fq;
#pragma unroll
            for (int ai = 0; ai < 2; ++ai)
#pragma unroll
                for (int m = 0; m < 4; ++m) { bf16_t* rowp = proj + (size_t)(row0 + ai * HALF + m * 16) * pitch + col0;
#pragma unroll
                    for (int bj = 0; bj < 2; ++bj) { const f32x4 v0 = acc[ai][bj][m][0] * sc, v1 = acc[ai][bj][m][1] * sc;
                        u32x4 w; w.x = cvt_pk_bf16(v0[0], v0[1]); w.y = cvt_pk_bf16(v0[2], v0[3]); w.z = cvt_pk_bf16(v1[0], v1[1]); w.w = cvt_pk_bf16(v1[2], v1[3]);
                        *(u32x4*)(rowp + bj * HALF) = w; } }
        } else if (wc == 0) {
#pragma unroll
            for (int ai = 0; ai < 2; ++ai)
#pragma unroll
                for (int m = 0; m < 4; ++m) { float* fp = fg + (size_t)(row0 + ai * HALF + m * 16) * 32 + 8 * fq;
                    *(f32x4*)fp = acc[ai][0][m][0]; *(f32x4*)(fp + 4) = acc[ai][0][m][1]; }
        }
    }
};
struct EpiOut {
    static constexpr bool PERM = false, AFTER_DRAIN = false;
    const float* x; const float* mod; float* out; float alpha;
    __device__ __forceinline__ void operator()(const f32x4 (&acc)[2][2][4][2], const Unit& u, int wr, int wc, int fr, int fq) const {
        const int row0 = u.pm * BM + wr * 64 + fr;
#pragma unroll
        for (int ai = 0; ai < 2; ++ai)
#pragma unroll
            for (int m = 0; m < 4; ++m) { const int r = row0 + ai * HALF + m * 16; const float* g1 = mod + (r / 2048) * 6144 + 2048;
#pragma unroll
                for (int bj = 0; bj < 2; ++bj)
#pragma unroll
                    for (int n = 0; n < 2; ++n) { const int c = u.pn * BM + bj * HALF + wc * 32 + 16 * n + 4 * fq;
                        const f32x4 xv = *(const f32x4*)(x + (size_t)r * 1024 + c), gv = *(const f32x4*)(g1 + c);
                        *(f32x4*)(out + (size_t)r * 1024 + c) = xv * alpha + gv * acc[ai][bj][m][n]; } }
    }
};
template <class Epi, class Sched, bool ALIGN_EPI = false, bool SP2 = false>
__device__ __forceinline__ void gemm_phase(PG8_LAS unsigned char* lds, const Gemm g, const Sched& S, const Epi& E) {
    int tid_ = threadIdx.x; asm volatile("" : "+v"(tid_));
    const int tid = tid_, wid = __builtin_amdgcn_readfirstlane(tid >> 6), lane = tid & 63, wr = wid >> 2, wc = wid & 3, fr = lane & 15, fq = lane >> 4;
    const int K = g.K, nt = K / BK;
    unsigned voffA[2], voffB[2];
#pragma unroll
    for (int i = 0; i < 2; ++i) { int R, C; stage_rc(tid * 16 + i * 8192, R, C); const int Rb = Epi::PERM ? ((R & ~31) + perm32(R & 31)) : R;
        voffA[i] = (unsigned)(R * K + C) * 2u; voffB[i] = (unsigned)(Rb * K + C) * 2u; }
    const size_t kstep = (size_t)(BK * 2);
    const size_t hstep = (size_t)HALF * K * 2;
    const size_t tstep = 2 * hstep;
    const unsigned ldsw = (unsigned)wid * 1024u;
    const int aoff = lds_byte(wr * 64 + fr, fq * 8), boff = lds_byte(wc * 32 + fr, fq * 8);
#define PG8_SA(b, h) (((b) * 2 + (h)) * HTB)
#define PG8_SB(b, h) ((4 + (b) * 2 + (h)) * HTB)
#define PG8_STAGE(bufoff, gbase, voff) do { _Pragma("unroll") for (int _i = 0; _i < 2; ++_i) \
        __builtin_amdgcn_global_load_lds((const unsigned*)((const char*)(gbase) + (voff)[_i]), (PG8_LAS unsigned*)(lds + (bufoff) + ldsw + _i * 8192), 16, 0, 0); } while (0)
#define PG8_LDA(dst, b, h) do { _Pragma("unroll") for (int m = 0; m < 4; ++m) _Pragma("unroll") for (int k = 0; k < 2; ++k) dst[m][k] = *(const PG8_LAS bf16x8*)(lds + PG8_SA(b, h) + aoff + m * 2048 + k * 1024); } while (0)
#define PG8_LDB(dst, b, h) do { _Pragma("unroll") for (int n = 0; n < 2; ++n) _Pragma("unroll") for (int k = 0; k < 2; ++k) dst[n][k] = *(const PG8_LAS bf16x8*)(lds + PG8_SB(b, h) + boff + n * 2048 + k * 1024); } while (0)
#define PG8_MMA(ai, bj, At, Bt) do { __builtin_amdgcn_s_setprio(1); _Pragma("unroll") for (int m = 0; m < 4; ++m) _Pragma("unroll") for (int n = 0; n < 2; ++n) _Pragma("unroll") for (int k = 0; k < 2; ++k) \
        acc[ai][bj][m][n] = __builtin_amdgcn_mfma_f32_16x16x32_bf16(Bt[n][k], At[m][k], acc[ai][bj][m][n], 0, 0, 0); __builtin_amdgcn_s_setprio(0); } while (0)
#define PG8_WAIT_V(n) asm volatile("s_waitcnt vmcnt(" #n ")" ::: "memory")
#define PG8_WAIT_L(n) asm volatile("s_waitcnt lgkmcnt(" #n ")" ::: "memory")
#define PG8_BAR __builtin_amdgcn_s_barrier()
#define PG8_SCHED __builtin_amdgcn_sched_barrier(0)
    Unit cur, nxt; int ui = 0;
    if (!S.next(0, cur)) return;
    f32x4 acc[2][2][4][2];
#pragma unroll
    for (int a = 0; a < 2; ++a)
#pragma unroll
        for (int b = 0; b < 2; ++b)
#pragma unroll
            for (int m = 0; m < 4; ++m)
#pragma unroll
                for (int n = 0; n < 2; ++n) acc[a][b][m][n] = (f32x4){0.f, 0.f, 0.f, 0.f};
    bf16x8 At[4][2], B0[2][2], B1[2][2];
    const char* cA = (const char*)g.A + (size_t)cur.pm * tstep; const char* cB = (const char*)g.Bt + (size_t)cur.pn * tstep;
    S.a_ready(cur);
    if constexpr (SP2) {
        PG8_STAGE(PG8_SB(0, 0), cB, voffB); PG8_STAGE(PG8_SB(0, 1), cB + hstep, voffB); PG8_STAGE(PG8_SA(0, 0), cA, voffA); PG8_STAGE(PG8_SA(0, 1), cA + hstep, voffA);
        if (wr == 1) PG8_BAR;
        PG8_WAIT_V(2); PG8_BAR;
        PG8_STAGE(PG8_SB(1, 0), cB + kstep, voffB); PG8_STAGE(PG8_SA(1, 0), cA + kstep, voffA); PG8_STAGE(PG8_SB(1, 1), cB + hstep + kstep, voffB);
        PG8_WAIT_V(6); PG8_BAR;
    } else {
        PG8_STAGE(PG8_SB(0, 0), cB, voffB); PG8_STAGE(PG8_SA(0, 0), cA, voffA); PG8_STAGE(PG8_SB(0, 1), cB + hstep, voffB); PG8_STAGE(PG8_SA(0, 1), cA + hstep, voffA);
        if (wr == 1) PG8_BAR;
        PG8_WAIT_V(4); PG8_BAR;
        PG8_STAGE(PG8_SB(1, 0), cB + kstep, voffB); PG8_STAGE(PG8_SA(1, 0), cA + kstep, voffA); PG8_STAGE(PG8_SB(1, 1), cB + hstep + kstep, voffB);
        PG8_WAIT_V(6); PG8_BAR;
    }
    for (;;) {
        const bool has_next = S.next(ui + 1, nxt);
        const char* nA = has_next ? (const char*)g.A + (size_t)nxt.pm * tstep : cA; const char* nB = has_next ? (const char*)g.Bt + (size_t)nxt.pn * tstep : cB;
        for (int t = 0; t < nt; t += 2) {
            const bool last = (t == nt - 2);
            const char* a1 = cA + (size_t)(t + 1) * kstep;
            const char* a2 = last ? nA : cA + (size_t)(t + 2) * kstep; const char* b2 = last ? nB : cB + (size_t)(t + 2) * kstep;
            const char* a3 = a2 + kstep; const char* b3 = b2 + kstep;
            if (last && has_next) S.a_ready(nxt);
            if constexpr (SP2) {
            PG8_LDB(B0, 0, 0); PG8_LDB(B1, 0, 1); PG8_SCHED; PG8_LDA(At, 0, 0); PG8_STAGE(PG8_SA(1, 1), a1 + hstep, voffA);
            PG8_WAIT_V(8); PG8_WAIT_L(0); PG8_BAR; PG8_MMA(0, 0, At, B0); PG8_MMA(0, 1, At, B1); PG8_BAR; PG8_SCHED;
            PG8_LDA(At, 0, 1); PG8_STAGE(PG8_SB(0, 0), b2, voffB); PG8_STAGE(PG8_SB(0, 1), b2 + hstep, voffB); PG8_STAGE(PG8_SA(0, 0), a2, voffA);
            PG8_WAIT_V(8); PG8_WAIT_L(0); PG8_BAR; PG8_MMA(1, 0, At, B0); PG8_MMA(1, 1, At, B1); PG8_BAR; PG8_SCHED;
            PG8_LDB(B0, 1, 0); PG8_LDB(B1, 1, 1); PG8_SCHED; PG8_LDA(At, 1, 0); PG8_STAGE(PG8_SA(0, 1), a2 + hstep, voffA);
            PG8_WAIT_V(8); PG8_WAIT_L(0); PG8_BAR; PG8_MMA(0, 0, At, B0); PG8_MMA(0, 1, At, B1); PG8_BAR; PG8_SCHED;
            PG8_LDA(At, 1, 1); PG8_STAGE(PG8_SB(1, 0), b3, voffB); PG8_STAGE(PG8_SB(1, 1), b3 + hstep, voffB); PG8_STAGE(PG8_SA(1, 0), a3, voffA);
            PG8_WAIT_V(8); PG8_WAIT_L(0); PG8_BAR; PG8_MMA(1, 0, At, B0); PG8_MMA(1, 1, At, B1); PG8_BAR; PG8_SCHED;
            } else {
            PG8_LDB(B0, 0, 0); PG8_SCHED; PG8_LDA(At, 0, 0); PG8_STAGE(PG8_SA(1, 1), a1 + hstep, voffA);
            PG8_WAIT_L(8); PG8_BAR; PG8_WAIT_L(0); PG8_MMA(0, 0, At, B0); PG8_BAR; PG8_SCHED;
            PG8_LDB(B1, 0, 1); PG8_STAGE(PG8_SB(0, 0), b2, voffB);
            PG8_BAR; PG8_WAIT_L(0); PG8_MMA(0, 1, At, B1); PG8_BAR;
            PG8_LDA(At, 0, 1); PG8_STAGE(PG8_SA(0, 0), a2, voffA);
            PG8_BAR; PG8_WAIT_L(0); PG8_MMA(1, 0, At, B0); PG8_BAR; PG8_SCHED;
            PG8_STAGE(PG8_SB(0, 1), b2 + hstep, voffB);
            PG8_WAIT_V(6); PG8_BAR; PG8_MMA(1, 1, At, B1); PG8_BAR;
            PG8_LDB(B0, 1, 0); PG8_SCHED; PG8_LDA(At, 1, 0); PG8_STAGE(PG8_SA(0, 1), a2 + hstep, voffA);
            PG8_WAIT_L(8); PG8_BAR; PG8_WAIT_L(0); PG8_MMA(0, 0, At, B0); PG8_BAR; PG8_SCHED;
            PG8_LDB(B1, 1, 1); PG8_STAGE(PG8_SB(1, 0), b3, voffB);
            PG8_BAR; PG8_WAIT_L(0); PG8_MMA(0, 1, At, B1); PG8_BAR;
            PG8_LDA(At, 1, 1); PG8_STAGE(PG8_SA(1, 0), a3, voffA);
            PG8_BAR; PG8_WAIT_L(0); PG8_MMA(1, 0, At, B0); PG8_BAR; PG8_SCHED;
            PG8_STAGE(PG8_SB(1, 1), b3 + hstep, voffB);
            PG8_WAIT_V(6); PG8_BAR; PG8_MMA(1, 1, At, B1); PG8_BAR;
            }
        }
        if constexpr (ALIGN_EPI) { if (wr == 0) PG8_BAR; }
        if constexpr (!Epi::AFTER_DRAIN) { E(acc, cur, wr, wc, fr, fq); S.done(cur); }
        if (!has_next) break;
#pragma unroll
        for (int a = 0; a < 2; ++a)
#pragma unroll
            for (int b = 0; b < 2; ++b)
#pragma unroll
                for (int m = 0; m < 4; ++m)
#pragma unroll
                    for (int n = 0; n < 2; ++n) acc[a][b][m][n] = (f32x4){0.f, 0.f, 0.f, 0.f};
        cur = nxt; cA = nA; cB = nB; ++ui;
        if constexpr (ALIGN_EPI) { if (wr == 1) PG8_BAR; }
    }
    PG8_WAIT_V(0);
    if constexpr (!ALIGN_EPI) { if (wr == 0) PG8_BAR; }
    PG8_BAR;
    if constexpr (Epi::AFTER_DRAIN) { E.fused(acc, cur, wr, wc, fr, fq, lds, wid, lane); S.done(cur); }
#undef PG8_SA
#undef PG8_SB
#undef PG8_STAGE
#undef PG8_LDA
#undef PG8_LDB
#undef PG8_MMA
#undef PG8_WAIT_V
#undef PG8_WAIT_L
#undef PG8_BAR
#undef PG8_SCHED
}
struct UnitM { int e, mt, pn, arow0, nvalid; };
constexpr int TAB_SLOT_BYTES = 2048;
template <class Epi, class Sched, bool GATHER>
__device__ __forceinline__ void gemm_phase_g(PG8_LAS unsigned char* lds, PG8_LAS unsigned char* tab, const bf16_t* A, const int K, const Sched& S, const Epi& E) {
    int tid_ = threadIdx.x; asm volatile("" : "+v"(tid_));
    const int tid = tid_, wid = __builtin_amdgcn_readfirstlane(tid >> 6), lane = tid & 63, wr = wid >> 2, wc = wid & 3, fr = lane & 15, fq = lane >> 4;
    const int nt = K / BK;
    unsigned voffB[2];
#pragma unroll
    for (int i = 0; i < 2; ++i) { int R, C; stage_rc(tid * 16 + i * 8192, R, C); const int Rb = Epi::PERM ? ((R & ~31) + perm32(R & 31)) : R;
        voffB[i] = (unsigned)(Rb * K + C) * 2u; }
    const size_t kstep = (size_t)(BK * 2);
    const size_t hstep = (size_t)HALF * K * 2;
    const unsigned ldsw = (unsigned)wid * 1024u;
    const int aoff = lds_byte(wr * 64 + fr, fq * 8), boff = lds_byte(wc * 32 + fr, fq * 8);
#define PG8_SA(b, h) (((b) * 2 + (h)) * HTB)
#define PG8_SB(b, h) ((4 + (b) * 2 + (h)) * HTB)
#define PG8_STAGE(bufoff, gbase, voff) do { _Pragma("unroll") for (int _i = 0; _i < 2; ++_i) \
        __builtin_amdgcn_global_load_lds((const unsigned*)((const char*)(gbase) + (voff)[_i]), (PG8_LAS unsigned*)(lds + (bufoff) + ldsw + _i * 8192), 16, 0, 0); } while (0)
#define PG8_STAGEA(bufoff, gbase, o0, o1) do { \
        __builtin_amdgcn_global_load_lds((const unsigned*)((const char*)(gbase) + (o0)), (PG8_LAS unsigned*)(lds + (bufoff) + ldsw), 16, 0, 0); \
        __builtin_amdgcn_global_load_lds((const unsigned*)((const char*)(gbase) + (o1)), (PG8_LAS unsigned*)(lds + (bufoff) + ldsw + 8192), 16, 0, 0); } while (0)
#define PG8_LDA(dst, b, h) do { _Pragma("unroll") for (int m = 0; m < 4; ++m) _Pragma("unroll") for (int k = 0; k < 2; ++k) dst[m][k] = *(const PG8_LAS bf16x8*)(lds + PG8_SA(b, h) + aoff + m * 2048 + k * 1024); } while (0)
#define PG8_LDB(dst, b, h) do { _Pragma("unroll") for (int n = 0; n < 2; ++n) _Pragma("unroll") for (int k = 0; k < 2; ++k) dst[n][k] = *(const PG8_LAS bf16x8*)(lds + PG8_SB(b, h) + boff + n * 2048 + k * 1024); } while (0)
#define PG8_MMA(ai, bj, At, Bt) do { __builtin_amdgcn_s_setprio(1); _Pragma("unroll") for (int m = 0; m < 4; ++m) _Pragma("unroll") for (int n = 0; n < 2; ++n) _Pragma("unroll") for (int k = 0; k < 2; ++k) \
        acc[ai][bj][m][n] = __builtin_amdgcn_mfma_f32_16x16x32_bf16(Bt[n][k], At[m][k], acc[ai][bj][m][n], 0, 0, 0); __builtin_amdgcn_s_setprio(0); } while (0)
#define PG8_WAIT_V(n) asm volatile("s_waitcnt vmcnt(" #n ")" ::: "memory")
#define PG8_WAIT_L(n) asm volatile("s_waitcnt lgkmcnt(" #n ")" ::: "memory")
#define PG8_BAR __builtin_amdgcn_s_barrier()
#define PG8_SCHED __builtin_amdgcn_sched_barrier(0)
#define PG8_AOFFS(dst, u, tslot) do { _Pragma("unroll") for (int h = 0; h < 2; ++h) _Pragma("unroll") for (int i = 0; i < 2; ++i) { int RA_, CA_; stage_rc(tid * 16 + i * 8192, RA_, CA_); const int R_ = h * HALF + RA_; int row_; \
        if (GATHER) { const int inf_ = *(const PG8_LAS int*)(tab + (tslot) * TAB_SLOT_BYTES + R_ * 4); row_ = R_ < (u).nvalid ? (inf_ >> 4) : 0; } else row_ = (u).arow0 + R_; \
        dst[h][i] = (unsigned)(row_ * K + CA_) * 2u; } } while (0)
    UnitM cur, nxt; int ui = 0;
    if (!S.next(0, cur)) return;
    if (wid == 0) S.load_tab(cur, tab, lane);
    asm volatile("s_waitcnt vmcnt(0)" ::: "memory"); __builtin_amdgcn_s_barrier(); asm volatile("" ::: "memory");
    f32x4 acc[2][2][4][2];
#pragma unroll
    for (int a = 0; a < 2; ++a)
#pragma unroll
        for (int b = 0; b < 2; ++b)
#pragma unroll
            for (int m = 0; m < 4; ++m)
#pragma unroll
                for (int n = 0; n < 2; ++n) acc[a][b][m][n] = (f32x4){0.f, 0.f, 0.f, 0.f};
    bf16x8 At[4][2], B0[2][2], B1[2][2];
    unsigned cao[2][2];
    PG8_AOFFS(cao, cur, 0);
    const char* cB = S.b_base(cur);
    const char* Ab = (const char*)A;
    PG8_STAGE(PG8_SB(0, 0), cB, voffB); PG8_STAGE(PG8_SB(0, 1), cB + hstep, voffB); PG8_STAGEA(PG8_SA(0, 0), Ab, cao[0][0], cao[0][1]); PG8_STAGEA(PG8_SA(0, 1), Ab, cao[1][0], cao[1][1]);
    if (wr == 1) PG8_BAR;
    PG8_WAIT_V(2); PG8_BAR;
    PG8_STAGE(PG8_SB(1, 0), cB + kstep, voffB); PG8_STAGEA(PG8_SA(1, 0), Ab + kstep, cao[0][0], cao[0][1]); PG8_STAGE(PG8_SB(1, 1), cB + hstep + kstep, voffB);
    PG8_WAIT_V(6); PG8_BAR;
    for (;;) {
        const bool has_next = S.next(ui + 1, nxt);
        const int tslot_n = (ui + 1) % 3;
        if (has_next && wid == 0) S.load_tab(nxt, tab + tslot_n * TAB_SLOT_BYTES, lane);
        const char* nB = has_next ? S.b_base(nxt) : cB;
#pragma unroll 1
        for (int t = 0; t < nt; t += 2) {
            const bool last = (t == nt - 2);
            const char* a1 = Ab + (size_t)(t + 1) * kstep;
            const char* a2 = last ? Ab : Ab + (size_t)(t + 2) * kstep; const char* b2 = last ? nB : cB + (size_t)(t + 2) * kstep;
            const char* a3 = a2 + kstep; const char* b3 = b2 + kstep;
            PG8_LDB(B0, 0, 0); PG8_LDB(B1, 0, 1); PG8_SCHED; PG8_LDA(At, 0, 0); PG8_STAGEA(PG8_SA(1, 1), a1, cao[1][0], cao[1][1]);
            PG8_WAIT_V(8); PG8_WAIT_L(0); PG8_BAR; PG8_MMA(0, 0, At, B0); PG8_MMA(0, 1, At, B1); PG8_BAR; PG8_SCHED;
            if (last && has_next) { PG8_AOFFS(cao, nxt, tslot_n); }
            PG8_LDA(At, 0, 1); PG8_STAGE(PG8_SB(0, 0), b2, voffB); PG8_STAGE(PG8_SB(0, 1), b2 + hstep, voffB); PG8_STAGEA(PG8_SA(0, 0), a2, cao[0][0], cao[0][1]);
            PG8_WAIT_V(8); PG8_WAIT_L(0); PG8_BAR; PG8_MMA(1, 0, At, B0); PG8_MMA(1, 1, At, B1); PG8_BAR; PG8_SCHED;
            PG8_LDB(B0, 1, 0); PG8_LDB(B1, 1, 1); PG8_SCHED; PG8_LDA(At, 1, 0); PG8_STAGEA(PG8_SA(0, 1), a2, cao[1][0], cao[1][1]);
            PG8_WAIT_V(8); PG8_WAIT_L(0); PG8_BAR; PG8_MMA(0, 0, At, B0); PG8_MMA(0, 1, At, B1); PG8_BAR; PG8_SCHED;
            PG8_LDA(At, 1, 1); PG8_STAGE(PG8_SB(1, 0), b3, voffB); PG8_STAGE(PG8_SB(1, 1), b3 + hstep, voffB); PG8_STAGEA(PG8_SA(1, 0), a3, cao[0][0], cao[0][1]);
            PG8_WAIT_V(8); PG8_WAIT_L(0); PG8_BAR; PG8_MMA(1, 0, At, B0); PG8_MMA(1, 1, At, B1); PG8_BAR; PG8_SCHED;
        }
        if (wr == 0) PG8_BAR;
        E(acc, cur, wr, wc, fr, fq, tab + (ui % 3) * TAB_SLOT_BYTES);
        if (!has_next) break;
#pragma unroll
        for (int a = 0; a < 2; ++a)
#pragma unroll
            for (int b = 0; b < 2; ++b)
#pragma unroll
                for (int m = 0; m < 4; ++m)
#pragma unroll
                    for (int n = 0; n < 2; ++n) acc[a][b][m][n] = (f32x4){0.f, 0.f, 0.f, 0.f};
        cur = nxt; cB = nB; ++ui;
        if (wr == 1) PG8_BAR;
    }
    PG8_WAIT_V(0);
    PG8_BAR;
#undef PG8_SA
#undef PG8_SB
#undef PG8_STAGE
#undef PG8_STAGEA
#undef PG8_LDA
#undef PG8_LDB
#undef PG8_MMA
#undef PG8_WAIT_V
#undef PG8_WAIT_L
#undef PG8_BAR
#undef PG8_SCHED
#undef PG8_AOFFS
}
struct MoeSched {
    const PG8_LAS int* tstart; const PG8_LAS int* cnt;
    const int* lrow; const float* lw;
    const char* Bt; size_t e_stride, pn_stride;
    int MT, NP, pn0, G, c;
    __device__ __forceinline__ bool next(int i, UnitM& u) const {
        const int L = i * G + c; if (L >= MT * NP) return false;
        const int mtg = L / NP; u.pn = pn0 + L % NP;
        int e = 0;
        for (int k = 1; k < 65; ++k) e += (tstart[k] <= mtg) ? 1 : 0;
        u.e = e; u.mt = mtg - tstart[e]; u.arow0 = mtg * 256; const int rem = cnt[e] - u.mt * 256; u.nvalid = rem < 256 ? rem : 256;
        return true;
    }
    __device__ __forceinline__ const char* b_base(const UnitM& u) const { return Bt + (size_t)u.e * e_stride + (size_t)u.pn * pn_stride; }
    __device__ __forceinline__ void load_tab(const UnitM& u, PG8_LAS unsigned char* dst, int lane) const {
        const size_t off = (size_t)u.e * 16384 + u.mt * 256 + lane * 4;
        __builtin_amdgcn_global_load_lds((const unsigned*)(lrow + off), (PG8_LAS unsigned*)dst, 16, 0, 0);
        __builtin_amdgcn_global_load_lds((const unsigned*)(lw + off), (PG8_LAS unsigned*)(dst + 1024), 16, 0, 0);
    }
};
struct EpiAct {
    static constexpr bool PERM = true;
    bf16_t* act;
    __device__ __forceinline__ void operator()(const f32x4 (&acc)[2][2][4][2], const UnitM& u, int wr, int wc, int fr, int fq, const PG8_LAS unsigned char* tab) const {
#pragma unroll
        for (int ai = 0; ai < 2; ++ai)
#pragma unroll
            for (int m = 0; m < 4; ++m) { const int r = ai * HALF + wr * 64 + m * 16 + fr;
                float w = *(const PG8_LAS float*)(tab + 1024 + r * 4); w = r < u.nvalid ? w : 0.f;
                float v[8];
#pragma unroll
                for (int n = 0; n < 2; ++n)
#pragma unroll
                    for (int i = 0; i < 4; ++i) { const float g = acc[ai][0][m][n][i], up = acc[ai][1][m][n][i];
                        v[n * 4 + i] = g * __builtin_amdgcn_rcpf(1.f + __builtin_amdgcn_exp2f(-1.4426950408889634f * g)) * up * w; }
                u32x4 o; o.x = cvt_pk_bf16(v[0], v[1]); o.y = cvt_pk_bf16(v[2], v[3]); o.z = cvt_pk_bf16(v[4], v[5]); o.w = cvt_pk_bf16(v[6], v[7]);
                *(u32x4*)(act + (size_t)(u.arow0 + r) * 256 + u.pn * 128 + wc * 32 + 8 * fq) = o; }
    }
};
struct EpiSlot {
    static constexpr bool PERM = true;
    bf16_t* slot; int pn_half0; unsigned dump_row;
    __device__ __forceinline__ void operator()(const f32x4 (&acc)[2][2][4][2], const UnitM& u, int wr, int wc, int fr, int fq, const PG8_LAS unsigned char* tab) const {
#pragma unroll
        for (int ai = 0; ai < 2; ++ai)
#pragma unroll
            for (int m = 0; m < 4; ++m) { const int r = ai * HALF + wr * 64 + m * 16 + fr;
                const int inf = *(const PG8_LAS int*)(tab + r * 4);
                const unsigned srow = r < u.nvalid ? (unsigned)(inf >> 4) * 9u + (unsigned)(inf & 15) : dump_row;
                char* dst = (char*)slot + (srow * 1024u + (unsigned)(((u.pn - pn_half0) * 256 + wc * 32 + 8 * fq) * 2));
#pragma unroll
                for (int bj = 0; bj < 2; ++bj) { const f32x4 v0 = acc[ai][bj][m][0], v1 = acc[ai][bj][m][1];
                    u32x4 o; o.x = cvt_pk_bf16(v0[0], v0[1]); o.y = cvt_pk_bf16(v0[2], v0[3]); o.z = cvt_pk_bf16(v1[0], v1[1]); o.w = cvt_pk_bf16(v1[2], v1[3]);
                    *(u32x4*)(dst + bj * HALF * 2) = o; }
                asm volatile("" ::: "memory"); }
    }
};
}

namespace attn_body {
using bf16=__hip_bfloat16;
using bf16x8=__attribute__((ext_vector_type(8)))short;
using s16x4=__attribute__((ext_vector_type(4)))short;
using f32x16=__attribute__((ext_vector_type(16)))float;
using u32x4=__attribute__((ext_vector_type(4)))unsigned;
using f32x4_t=__attribute__((ext_vector_type(4)))float;
constexpr int SEQ=2048,D=64,DM=2816;
constexpr int NW=8,QBLK=32,QB=QBLK*NW,KVBLK=64,NQB=SEQ/QB;
__device__ __forceinline__ int crow(int r,int hi){return (r&3)+8*(r>>2)+4*hi;}
#define SBAR() __builtin_amdgcn_sched_barrier(0)
__device__ __forceinline__ void cmask(f32x16&p0,f32x16&p1,int jb,int qrel,int hi){
  const float NEG=-INFINITY; int lim=qrel-64*jb-4*hi; asm volatile("":"+v"(lim));
  #pragma unroll
  for(int r=0;r<16;++r){const int c=(r&3)+8*(r>>2); if(c>lim)p0[r]=NEG; if(c+32>lim)p1[r]=NEG;}
}

typedef __attribute__((address_space(3))) const float* lds_fptr;
template<int MODE> __device__ __forceinline__ void tilefix(f32x16&p0,f32x16&p1,int t,int NT,int ta,int qrel,int hi,lds_fptr cl,lds_fptr dt,unsigned maskq,float mhat){
  const float NEG=-INFINITY;
  if(MODE==0){
  } else {
    #pragma unroll
    for(int r=0;r<16;++r){p0[r]-=mhat;p1[r]-=mhat;}
  }
  if(MODE==1){ if(__any(((maskq>>ta)&1u)==0u)){ const bool off=((maskq>>ta)&1u)==0u;
      #pragma unroll
      for(int r=0;r<16;++r){p0[r]=off?NEG:p0[r];p1[r]=off?NEG:p1[r];} } }
  if(MODE!=0){
    int dbase=qrel+64*(NT-4-t)-4*hi; asm volatile("":"+v"(dbase));
    if(MODE==2 && t<4){
      { int e511=dbase-511; asm volatile("":"+v"(e511));
      #pragma unroll
      for(int r=0;r<16;++r){ if(e511>((r&3)+8*(r>>2)))p0[r]=NEG; if(e511>((r&3)+8*(r>>2)+32))p1[r]=NEG; } } }
    if(t>=NT-6){
      #pragma unroll
      for(int g=0;g<4;++g){
        #pragma unroll
        for(int i=0;i<4;++i){const int r=4*g+i; const int d=dbase-((r&3)+8*(r>>2)); const int i0=min(max(d,0),127),i1=min(max(d-32,0),127); p0[r]+=dt[i0]; p1[r]+=dt[i1];}
        __builtin_amdgcn_sched_barrier(0); } }
  }
  { const int jb=t-(NT-4); if(jb>=0)cmask(p0,p1,jb,qrel,hi); }
}

constexpr int NSLOT=3, SLOTB=8192;
constexpr int LDS_K=0, LDS_V=NSLOT*SLOTB, LDS_WS=2*NSLOT*SLOTB, LDS_OST=LDS_WS+NW*64*4, LDS_CUM=LDS_OST+NW*4096, LDS_DT=LDS_CUM+8192, LDS_BYTES=LDS_DT+4096;
constexpr float C2=0.125f*1.4426950408889634f;
__device__ __forceinline__ void glds16(const void*gsrc,unsigned lds_dst){unsigned keep;
  asm volatile("s_mov_b32 %0, m0\n\ts_mov_b32 m0, %2\n\ts_nop 0\n\tglobal_load_lds_dwordx4 %1, off\n\ts_mov_b32 m0, %0":"=&s"(keep):"v"(gsrc),"s"(lds_dst):"memory");}
__device__ __forceinline__ float max3f(float a,float b,float c){float r;asm("v_max3_f32 %0, %1, %2, %3":"=v"(r):"v"(a),"v"(b),"v"(c));return r;}
__device__ __forceinline__ float max2f(float a,float b){float r;asm("v_max_f32_e32 %0, %1, %2":"=v"(r):"v"(a),"v"(b));return r;}
__device__ __forceinline__ float fadd_s(float a,float b){float r;asm("v_add_f32_e32 %0, %1, %2":"=v"(r):"v"(a),"v"(b));return r;}
__device__ __forceinline__ float fsub_s(float a,float b){float r;asm("v_sub_f32_e32 %0, %1, %2":"=v"(r):"v"(a),"v"(b));return r;}
typedef float f32x2_t __attribute__((ext_vector_type(2))); typedef __bf16 bf16x2_t __attribute__((ext_vector_type(2)));
__device__ __forceinline__ unsigned cvtpk_s(float lo,float hi){f32x2_t v={lo,hi};bf16x2_t b=__builtin_convertvector(v,bf16x2_t);return __builtin_bit_cast(unsigned,b);}
#define WAIT_BAR(N) asm volatile("s_waitcnt vmcnt(" #N ") lgkmcnt(0)\n\ts_barrier":::"memory")

__device__ __forceinline__ void qkt(f32x16&p0,f32x16&p1,const char*Kslot,const bf16x8*qr,const f32x16&ci0,const f32x16&ci1,int r32,int hi){
  const char*kb=Kslot+hi*1024+r32*16;
  #pragma unroll
  for(int d0=0;d0<4;++d0){
    const bf16x8 b0=*reinterpret_cast<const bf16x8*>(kb+d0*2048);
    const bf16x8 b1=*reinterpret_cast<const bf16x8*>(kb+d0*2048+512);
    if(d0==0){p0=__builtin_amdgcn_mfma_f32_32x32x16_bf16(b0,qr[0],ci0,0,0,0);p1=__builtin_amdgcn_mfma_f32_32x32x16_bf16(b1,qr[0],ci1,0,0,0);}
    else{p0=__builtin_amdgcn_mfma_f32_32x32x16_bf16(b0,qr[d0],p0,0,0,0);p1=__builtin_amdgcn_mfma_f32_32x32x16_bf16(b1,qr[d0],p1,0,0,0);}}
}
typedef __attribute__((address_space(3))) const char* lds_cptr;
typedef short v4i16_t __attribute__((ext_vector_type(4)));
__device__ __forceinline__ void kload8(bf16x8*kf,lds_cptr kp){
  kf[0]=*(const __attribute__((address_space(3))) bf16x8*)(kp);      kf[1]=*(const __attribute__((address_space(3))) bf16x8*)(kp+512);
  kf[2]=*(const __attribute__((address_space(3))) bf16x8*)(kp+2048); kf[3]=*(const __attribute__((address_space(3))) bf16x8*)(kp+2560);
  kf[4]=*(const __attribute__((address_space(3))) bf16x8*)(kp+4096); kf[5]=*(const __attribute__((address_space(3))) bf16x8*)(kp+4608);
  kf[6]=*(const __attribute__((address_space(3))) bf16x8*)(kp+6144); kf[7]=*(const __attribute__((address_space(3))) bf16x8*)(kp+6656);
}
__device__ __forceinline__ void kload2(bf16x8*kf,lds_cptr kp,int j){ kf[2*j]=*(const __attribute__((address_space(3))) bf16x8*)(kp+j*2048); kf[2*j+1]=*(const __attribute__((address_space(3))) bf16x8*)(kp+j*2048+512); }
__device__ __forceinline__ s16x4 vtr(lds_cptr p){ return __builtin_bit_cast(s16x4,__builtin_amdgcn_ds_read_tr16_b64_v4i16((__attribute__((address_space(3))) v4i16_t*)p)); }
__device__ __forceinline__ float rowmax(const f32x16&p0,const f32x16&p1){
  float a=max3f(p0[0],p0[1],p1[0]),b=max3f(p0[2],p0[3],p1[1]);a=max3f(a,p1[2],p1[3]);
  #pragma unroll
  for(int r=4;r<16;r+=4){a=max3f(a,p0[r],p0[r+1]);b=max3f(b,p0[r+2],p0[r+3]);a=max3f(a,p1[r],p1[r+1]);b=max3f(b,p1[r+2],p1[r+3]);}
  const float m=max2f(a,b);
  auto rr=__builtin_amdgcn_permlane32_swap(__float_as_uint(m),__float_as_uint(m),false,false);
  return max2f(__uint_as_float(rr[0]),__uint_as_float(rr[1]));
}
__device__ __forceinline__ void pv(f32x16*o,int vb,bf16x8 pa0,bf16x8 pa1,bf16x8 pa2,bf16x8 pa3){
  #pragma unroll
  for(int d0=0;d0<2;++d0){s16x4 lo[4],hi[4];
    #pragma unroll
    for(int ks=0;ks<4;++ks){
      asm volatile("ds_read_b64_tr_b16 %0,%1 offset:%c2":"=&v"(lo[ks]):"v"(vb),"i"(d0*4096+ks*1024):"memory");
      asm volatile("ds_read_b64_tr_b16 %0,%1 offset:%c2":"=&v"(hi[ks]):"v"(vb),"i"(d0*4096+ks*1024+512):"memory");}
    asm volatile("s_waitcnt lgkmcnt(0)":::"memory");SBAR();
    #define PK(k) (bf16x8){lo[k][0],lo[k][1],lo[k][2],lo[k][3],hi[k][0],hi[k][1],hi[k][2],hi[k][3]}
    o[d0]=__builtin_amdgcn_mfma_f32_32x32x16_bf16(pa0,PK(0),o[d0],0,0,0);
    o[d0]=__builtin_amdgcn_mfma_f32_32x32x16_bf16(pa1,PK(1),o[d0],0,0,0);
    o[d0]=__builtin_amdgcn_mfma_f32_32x32x16_bf16(pa2,PK(2),o[d0],0,0,0);
    o[d0]=__builtin_amdgcn_mfma_f32_32x32x16_bf16(pa3,PK(3),o[d0],0,0,0);
    #undef PK
  }
}

__device__ __forceinline__ void attn_fill_dt(char*shm,const float*rel_bias,int off=LDS_DT){
  const int tid=threadIdx.x;
  #pragma unroll
  for(int k=0;k<2;++k){ const int e=tid+512*k, hh=e>>7, n=e&127;
    const int bk=n<16?n:16+(n>=19)+(n>=21)+(n>=24)+(n>=27)+(n>=31)+(n>=35)+(n>=40)+(n>=46)+(n>=52)+(n>=59)+(n>=67)+(n>=77)+(n>=87)+(n>=99)+(n>=113);
    ((float*)(shm+off))[e]=(rel_bias[bk*8+hh]-rel_bias[31*8+hh])*1.4426950408889634f; }
  __syncthreads();
}
#ifndef ATTN_STORE16
#define ATTN_STORE16(p,v) (*(u32x4*)(p)=(v))
#endif
struct AttnIO { unsigned char* ws; };
#define IO_PROJ ((const bf16*)(io.ws+WS_PROJ))
#define IO_CUM ((const float*)(io.ws+WS_CUM))
#define IO_SELM ((const unsigned*)(io.ws+WS_SELM))
#define IO_FG ((const float*)(io.ws+WS_FG))
#define IO_OC ((const bf16*)(io.ws+WS_OC))
#define IO_OW ((bf16*)(io.ws+WS_OW))
#define IO_AO16 ((bf16*)(io.ws+WS_AO16))

template<int MODE,int THRL> __device__ __forceinline__ void attn_unit(int b,int h,int qb,const AttnIO&io,char*shm,const int tidv){
  const int tid=tidv,lane=tid&63,r32=lane&31,hi=lane>>5; const int wid=__builtin_amdgcn_readfirstlane(tid>>6);
  const long rowbase=(long)b*SEQ; const int q0=qb*QB; const int g=h>>2;
  const int NT=(MODE==2)?((4*qb+4)<12?(4*qb+4):12):(4*qb+4);
  const int t0=4*qb+4-NT;
  const int qcol=(MODE==0?0:1536)+h*D, kcol=(MODE==0?512+h*D:(MODE==1?2304:2560)+g*D), vcol=(MODE==0?1024+h*D:(MODE==1?2432:2688)+g*D);
  const bf16*Qw=IO_PROJ+(rowbase+q0+wid*QBLK)*DM+qcol;
  const bf16*Kh=IO_PROJ+(rowbase+(long)t0*KVBLK)*DM+kcol,*Vh=IO_PROJ+(rowbase+(long)t0*KVBLK)*DM+vcol;
  const unsigned lds0=(unsigned)(uintptr_t)shm;
  float*wsf=(float*)(shm+LDS_WS)+wid*64;
  const bf16*ksrc=Kh+(long)lane*DM+wid*8;
  const bf16*vsrc=Vh+(long)(16*(wid&3)+(lane>>2))*DM+(wid>>2)*32+(lane&3)*8;
  const unsigned kdst=lds0+LDS_K+wid*1024, vdst=lds0+LDS_V+wid*1024;
  #define DMA_K(t,slot) glds16(ksrc+(long)(t)*KVBLK*DM,(unsigned)__builtin_amdgcn_readfirstlane(kdst+(slot)))
  #define DMA_V(t,slot) glds16(vsrc+(long)(t)*KVBLK*DM,(unsigned)__builtin_amdgcn_readfirstlane(vdst+(slot)))
  const int vb0=(int)(lds0+LDS_V)+((lane>>4)&1)*32+(lane&3)*8+(4*hi+((lane&15)>>2))*64;
  const char*Kbase=shm+LDS_K; bf16x8 kf[8];
  const lds_cptr shm3=(lds_cptr)shm; const lds_cptr kp0=shm3+LDS_K+hi*1024+r32*16; const lds_cptr vp0=shm3+LDS_V+((lane>>4)&1)*32+(lane&3)*8+(4*hi+((lane&15)>>2))*64;
  DMA_K(0,0);DMA_V(0,0);DMA_K(1,SLOTB);
  bf16x8 qr[4];
  #pragma unroll
  for(int d0=0;d0<4;++d0)qr[d0]=*reinterpret_cast<const bf16x8*>(&Qw[(long)r32*DM+d0*16+hi*8]);
  const lds_cptr qst=(lds_cptr)shm+LDS_OST+wid*4096+lane*16;
  #pragma unroll
  for(int d0=0;d0<4;++d0)*(__attribute__((address_space(3))) bf16x8*)((__attribute__((address_space(3))) char*)qst+d0*1024)=qr[d0];
  const lds_fptr cl=(lds_fptr)(shm+LDS_CUM), dt=(lds_fptr)(shm+LDS_DT)+h*128;
  unsigned maskq=0xffffffffu;
  if(MODE==0){ const f32x4_t c4=*(const f32x4_t*)(IO_CUM+((long)(b*8+h))*SEQ+tid*4); *(f32x4_t*)(shm+LDS_CUM+tid*16)=c4*1.4426950408889634f; }
  else {
    if(MODE==1) maskq=IO_SELM[((long)(b*2+g))*SEQ+q0+wid*QBLK+r32]; }
  float mhat=0.f,l_reg=0.f;f32x16 o[2];o[0]=f32x16{};o[1]=f32x16{};const f32x16 negm=f32x16{};
  #define SPLIT3(v,hb,lb,l2) const unsigned hb=cvtpk_s(v,0.f)&0xffffu; const float r1_=(v)-__uint_as_float(hb<<16); const unsigned lb=cvtpk_s(r1_,0.f)&0xffffu; const float r2_=r1_-__uint_as_float(lb<<16); const unsigned l2=cvtpk_s(r2_,0.f)&0xffffu
  #define KAUG(dst,cval) do{ const float v_=-(cval); SPLIT3(v_,hb_,lb_,l2_); u32x4 w_; w_[0]=hi?0u:(hb_|(lb_<<16)); w_[1]=hi?0u:(l2_|0x3f800000u); w_[2]=hi?0u:0x3f803f80u; w_[3]=0u; dst=__builtin_bit_cast(bf16x8,w_); }while(0)
  #define QAUG(dst,mval) do{ const float v_=-(mval); SPLIT3(v_,hb_,lb_,l2_); u32x4 w_; w_[0]=0x3f803f80u; w_[1]=0x3f80u|(hb_<<16); w_[2]=lb_|(l2_<<16); w_[3]=0u; dst=__builtin_bit_cast(bf16x8,w_); }while(0)
  bf16x8 qa; QAUG(qa,0.f);
  const int qrel=wid*QBLK+r32;
  #define CMASK(P0,P1,t) tilefix<MODE>(P0,P1,(t),NT,t0+(t),qrel,hi,cl,dt,maskq,mhat)
  bool resc=false;
  #define START(P0,P1) do{ const float rm=rowmax(P0,P1); resc=false; \
    { const float dl=(rm==-INFINITY)?0.f:rm; mhat=fadd_s(mhat,dl); if(MODE==0){QAUG(qa,mhat);} \
      _Pragma("unroll") for(int r=0;r<16;++r){P0[r]=fsub_s(P0[r],dl);P1[r]=fsub_s(P1[r],dl);} \
      } \
    _Pragma("unroll") for(int r=0;r<16;++r)P0[r]=__builtin_amdgcn_exp2f(P0[r]); }while(0)
  #define RESC() do{ if(resc){ asm volatile("s_waitcnt lgkmcnt(0)":::"memory"); \
      _Pragma("unroll") for(int d_=0;d_<2;++d_) _Pragma("unroll") for(int r=0;r<16;++r)o[d_][r]*=wsf[crow(r,hi)]; } }while(0)
  f32x16 pA0,pA1,pB0,pB1;
  int sl_prev=0,sl_cur=0,sl_next=SLOTB;
  #define ROT() do{sl_prev=sl_cur;sl_cur=sl_next;sl_next=(sl_next==(NSLOT-1)*SLOTB)?0:sl_next+SLOTB;}while(0)
  DMA_K(2,2*SLOTB);
  WAIT_BAR(3);
  if(MODE==0){ bf16x8 ka0,ka1; KAUG(ka0,cl[64*t0+r32]); KAUG(ka1,cl[64*t0+32+r32]);
    pA0=__builtin_amdgcn_mfma_f32_32x32x16_bf16(ka0,qa,negm,0,0,0); pA1=__builtin_amdgcn_mfma_f32_32x32x16_bf16(ka1,qa,negm,0,0,0); qkt(pA0,pA1,Kbase,qr,pA0,pA1,r32,hi); }
  else qkt(pA0,pA1,Kbase,qr,negm,negm,r32,hi);
  asm volatile("s_nop 15\n\ts_nop 7":"+v"(pA0),"+v"(pA1));CMASK(pA0,pA1,0);
  START(pA0,pA1);
  _Pragma("unroll") for(int r=0;r<16;++r)pA1[r]=__builtin_amdgcn_exp2f(pA1[r]);
  WAIT_BAR(0);
  DMA_K(3,0);DMA_V(1,SLOTB);
  ROT();
  kload8(kf,kp0+sl_cur);
  WAIT_BAR(2);
  s16x4 vlo[8],vhi[8]; u32x4 pw0,pw1,pw2,pw3;
  #define PKW(P,B) cvtpk_s(P[B],P[B+1])
  #define PAF(k) __builtin_bit_cast(bf16x8,pw##k)
  #define VFR(i) (bf16x8){vlo[i][0],vlo[i][1],vlo[i][2],vlo[i][3],vhi[i][0],vhi[i][1],vhi[i][2],vhi[i][3]}
  #define PIN(x) asm volatile("":"+v"(x))
  #define MX3(a,b,c) __builtin_fmaxf(__builtin_fmaxf((a),(b)),(c))
  #define GAPA(MF,A0,A1,A2,A3,W0,W1,PW) do{ MF; sacc+=A0; sacc+=A1; sacc+=A2; sacc+=A3; PIN(sacc); W0; W1; PIN(PW); SBAR(); }while(0)
  #define EX(v) __builtin_amdgcn_exp2f(v)
  #define GAPB(MF,X,B) do{ MF; X[B]=EX(X[B]); X[B+1]=EX(X[B+1]); X[B+2]=EX(X[B+2]); X[B+3]=EX(X[B+3]); PIN(X); SBAR(); }while(0)
  #define VRD(i) do{ vlo[i]=vtr(vp_+(((i)>>2)*4096+((i)&3)*1024)); vhi[i]=vtr(vp_+(((i)>>2)*4096+((i)&3)*1024+512)); }while(0)
  #define KRD(G,j) do{ if(G){ kload2(kf,kp0+sl_next,j); SBAR(); } }while(0)
  #define STEP(C0,C1,P0,P1,t,GK,GV,GL) do{ SBAR(); \
    if(MODE==0){ bf16x8 ka0_,ka1_; KAUG(ka0_,cl[64*(t0+(t))+r32]); KAUG(ka1_,cl[64*(t0+(t))+32+r32]); \
      C0=__builtin_amdgcn_mfma_f32_32x32x16_bf16(ka0_,qa,negm,0,0,0); C1=__builtin_amdgcn_mfma_f32_32x32x16_bf16(ka1_,qa,negm,0,0,0); SBAR(); } \
    const lds_cptr vp_=vp0+sl_prev; \
    const bf16x8 qq0=*(const __attribute__((address_space(3))) bf16x8*)(qst),qq1=*(const __attribute__((address_space(3))) bf16x8*)(qst+1024),qq2=*(const __attribute__((address_space(3))) bf16x8*)(qst+2048),qq3=*(const __attribute__((address_space(3))) bf16x8*)(qst+3072); \
    VRD(0); SBAR(); float sacc=(P0[0]+P0[1]); \
    GAPA(C0=__builtin_amdgcn_mfma_f32_32x32x16_bf16(kf[0],qq0,(MODE==0?C0:negm),0,0,0), P0[2],P0[3],P0[4],P0[5],     pw0[0]=PKW(P0,0), pw0[1]=PKW(P0,2), pw0); \
    VRD(4); SBAR(); GAPA(C1=__builtin_amdgcn_mfma_f32_32x32x16_bf16(kf[1],qq0,(MODE==0?C1:negm),0,0,0), P0[6],P0[7],P0[8],P0[9],     pw0[2]=PKW(P0,4), pw0[3]=PKW(P0,6), pw0); \
    VRD(1); SBAR(); GAPA(C0=__builtin_amdgcn_mfma_f32_32x32x16_bf16(kf[2],qq1,C0,0,0,0),   P0[10],P0[11],P0[12],P0[13], pw1[0]=PKW(P0,8), pw1[1]=PKW(P0,10), pw1); \
    VRD(5); SBAR(); GAPA(C1=__builtin_amdgcn_mfma_f32_32x32x16_bf16(kf[3],qq1,C1,0,0,0),   P0[14],P0[15],P1[0],P1[1],   pw1[2]=PKW(P0,12),pw1[3]=PKW(P0,14), pw1); \
    VRD(2); SBAR(); GAPA(C0=__builtin_amdgcn_mfma_f32_32x32x16_bf16(kf[4],qq2,C0,0,0,0),   P1[2],P1[3],P1[4],P1[5],     pw2[0]=PKW(P1,0), pw2[1]=PKW(P1,2), pw2); \
    VRD(6); SBAR(); GAPA(C1=__builtin_amdgcn_mfma_f32_32x32x16_bf16(kf[5],qq2,C1,0,0,0),   P1[6],P1[7],P1[8],P1[9],     pw2[2]=PKW(P1,4), pw2[3]=PKW(P1,6), pw2); \
    VRD(3); SBAR(); GAPA(C0=__builtin_amdgcn_mfma_f32_32x32x16_bf16(kf[6],qq3,C0,0,0,0),   P1[10],P1[11],P1[12],P1[13], pw3[0]=PKW(P1,8), pw3[1]=PKW(P1,10), pw3); \
    VRD(7); SBAR(); GAPA(C1=__builtin_amdgcn_mfma_f32_32x32x16_bf16(kf[7],qq3,C1,0,0,0),   P1[14],P1[15],0.f,0.f,       pw3[2]=PKW(P1,12),pw3[3]=PKW(P1,14), pw3); \
    l_reg+=sacc; \
    if(GK){DMA_K((t)+3,sl_cur);} if(GV){DMA_V((t)+1,sl_next);} \
    CMASK(C0,C1,t); \
    { float a=MX3(C0[0],C0[1],C1[0]),b=MX3(C0[2],C0[3],C1[1]); a=MX3(a,C1[2],C1[3]); \
      _Pragma("unroll") for(int r=4;r<16;r+=4){a=MX3(a,C0[r],C0[r+1]);b=MX3(b,C0[r+2],C0[r+3]);a=MX3(a,C1[r],C1[r+1]);b=MX3(b,C1[r+2],C1[r+3]);} \
      float rm=__builtin_fmaxf(a,b); { auto rr=__builtin_amdgcn_permlane32_swap(__float_as_uint(rm),__float_as_uint(rm),false,false); rm=__builtin_fmaxf(__uint_as_float(rr[0]),__uint_as_float(rr[1])); } \
      resc=false; \
      if(__builtin_expect(__any(rm>(float)THRL),0)){ const float dl=__builtin_fmaxf(rm,0.f); mhat+=dl; if(MODE==0){QAUG(qa,mhat);} \
        _Pragma("unroll") for(int r=0;r<16;++r){C0[r]-=dl;C1[r]-=dl;} \
        const float f=__builtin_amdgcn_exp2f(-dl); l_reg*=f; if(hi==0)wsf[r32]=f; resc=true; } } \
    SBAR(); \
    GAPB(o[0]=__builtin_amdgcn_mfma_f32_32x32x16_bf16(PAF(0),VFR(0),o[0],0,0,0), C0,0); \
    GAPB(o[1]=__builtin_amdgcn_mfma_f32_32x32x16_bf16(PAF(0),VFR(4),o[1],0,0,0), C0,4); \
    KRD(GL,0); GAPB(o[0]=__builtin_amdgcn_mfma_f32_32x32x16_bf16(PAF(1),VFR(1),o[0],0,0,0), C0,8); \
    KRD(GL,1); GAPB(o[1]=__builtin_amdgcn_mfma_f32_32x32x16_bf16(PAF(1),VFR(5),o[1],0,0,0), C0,12); \
    KRD(GL,2); GAPB(o[0]=__builtin_amdgcn_mfma_f32_32x32x16_bf16(PAF(2),VFR(2),o[0],0,0,0), C1,0); \
    KRD(GL,3); GAPB(o[1]=__builtin_amdgcn_mfma_f32_32x32x16_bf16(PAF(2),VFR(6),o[1],0,0,0), C1,4); \
    GAPB(o[0]=__builtin_amdgcn_mfma_f32_32x32x16_bf16(PAF(3),VFR(3),o[0],0,0,0), C1,8); \
    GAPB(o[1]=__builtin_amdgcn_mfma_f32_32x32x16_bf16(PAF(3),VFR(7),o[1],0,0,0), C1,12); \
    }while(0)
  int t=1;
  for(;t+5<NT;t+=2){
    STEP(pB0,pB1,pA0,pA1,t,true,true,true);     WAIT_BAR(2); RESC(); ROT();
    STEP(pA0,pA1,pB0,pB1,t+1,true,true,true);   WAIT_BAR(2); RESC(); ROT();
  }
  #define ENDW(tt) do{ if((tt)+3<NT){WAIT_BAR(2);} else if((tt)+2<NT){WAIT_BAR(1);} else {WAIT_BAR(0);} }while(0)
  for(;t+1<NT;t+=2){
    STEP(pB0,pB1,pA0,pA1,t,(t+3<NT),(t+1<NT),(t+1<NT));       ENDW(t);   RESC(); ROT();
    STEP(pA0,pA1,pB0,pB1,t+1,(t+4<NT),(t+2<NT),(t+2<NT));     ENDW(t+1); RESC(); ROT();
  }
  STEP(pB0,pB1,pA0,pA1,NT-1,false,false,false); RESC();
  { float sacc=pB0[0]+pB0[1]; _Pragma("unroll") for(int r=2;r<16;++r)sacc+=pB0[r]; _Pragma("unroll") for(int r=0;r<16;++r)sacc+=pB1[r]; l_reg+=sacc;
    pw0=(u32x4){PKW(pB0,0),PKW(pB0,2),PKW(pB0,4),PKW(pB0,6)};pw1=(u32x4){PKW(pB0,8),PKW(pB0,10),PKW(pB0,12),PKW(pB0,14)};pw2=(u32x4){PKW(pB1,0),PKW(pB1,2),PKW(pB1,4),PKW(pB1,6)};pw3=(u32x4){PKW(pB1,8),PKW(pB1,10),PKW(pB1,12),PKW(pB1,14)};
    SBAR(); pv(o,vb0+sl_cur,PAF(0),PAF(1),PAF(2),PAF(3)); }
  #undef PKW
  #undef PAF
  #undef VFR
  #undef PIN
  #undef MX3
  #undef GAPA
  #undef GAPB
  #undef EX
  #undef VRD
  #undef KRD
  #undef STEP
  #undef ENDW
  {auto rr=__builtin_amdgcn_permlane32_swap(__float_as_uint(l_reg),__float_as_uint(l_reg),false,false);l_reg=__uint_as_float(rr[0])+__uint_as_float(rr[1]);}
  if(hi==0)wsf[32+r32]=l_reg;asm volatile("s_waitcnt lgkmcnt(0)":::"memory");
  float rli[16];
  #pragma unroll
  for(int r=0;r<16;++r)rli[r]=__builtin_amdgcn_rcpf(wsf[32+crow(r,hi)]);
  { bf16*stg=(bf16*)(shm+LDS_OST)+wid*2048;
    #pragma unroll
    for(int r=0;r<16;++r){const int orow=crow(r,hi);
      #pragma unroll
      for(int d0=0;d0<2;++d0)stg[orow*64+d0*32+r32]=__float2bfloat16(o[d0][r]*rli[r]);}
    asm volatile("s_waitcnt lgkmcnt(0)":::"memory");
    const long tok0=rowbase+q0+wid*QBLK;
    #pragma unroll
    for(int i=0;i<4;++i){const int row=i*8+(lane>>3),ch=lane&7; const u32x4 v=*(const u32x4*)(stg+row*64+ch*8);
      if(MODE==0){ *(u32x4*)(IO_AO16+(tok0+row)*1024+h*D+ch*8)=v; }
      else if(MODE==2){ *(u32x4*)(IO_OW+(tok0+row)*512+h*D+ch*8)=v; }
      else { const u32x4 c=*(const u32x4*)(IO_OC+(tok0+row)*512+h*D+ch*8), w=*(const u32x4*)(IO_OW+(tok0+row)*512+h*D+ch*8);
        const float*gp=IO_FG+(tok0+row)*32+8+h*3;
        const float g0=1.f/(1.f+__expf(-gp[0])),g1=1.f/(1.f+__expf(-gp[1])),g2=1.f/(1.f+__expf(-gp[2]));
        u32x4 o4;
        #pragma unroll
        for(int k=0;k<4;++k){ const float c_lo=__uint_as_float(c[k]<<16),c_hi=__uint_as_float(c[k]&0xffff0000u),s_lo=__uint_as_float(v[k]<<16),s_hi=__uint_as_float(v[k]&0xffff0000u),w_lo=__uint_as_float(w[k]<<16),w_hi=__uint_as_float(w[k]&0xffff0000u);
          o4[k]=cvtpk_s(g0*c_lo+g1*s_lo+g2*w_lo,g0*c_hi+g1*s_hi+g2*w_hi); }
        *(u32x4*)(IO_AO16+(tok0+row)*1024+512+h*D+ch*8)=o4; } } }
  asm volatile("s_waitcnt lgkmcnt(0)\n\ts_barrier":::"memory");
  #undef DMA_K
  #undef DMA_V
  #undef CMASK
  #undef START
  #undef RESC
  #undef ROT
}
constexpr int CL_K=0, CL_V=16384, CL_IMP=32768, CL_SC=CL_IMP+4*64*33*4, CL_OST=CL_SC+64*33*4, CL_DT=CL_OST+NW*4096, CL_END=CL_DT+4096;
static_assert(CL_END<=131072,"cmp phase LDS map");
__device__ __forceinline__ void cmp_unit(int b,int g,int c,const AttnIO&io,char*shm,const int tidv){
  const int tid=tidv,lane=tid&63,r32=lane&31,hi=lane>>5; const int wid=__builtin_amdgcn_readfirstlane(tid>>6);
  const int hr=wid&3, rh=wid>>2, h=g*4+hr; const long rowbase=(long)b*SEQ; const int t0c=c*64;
  const int nkb=min(4,(4*c+3+31)>>5);
  { const bf16*kg=(const bf16*)(io.ws+WS_KVC16)+((long)(b*2+g))*128*64; const bf16*vg=kg+(long)8*2*128*64;
    #pragma unroll
    for(int p=0;p<2;++p){ const int idx=tid+512*p,key=idx>>3,ch=idx&7;
      const u32x4 kv=*(const u32x4*)(kg+key*64+ch*8), vv=*(const u32x4*)(vg+key*64+ch*8);
      *(u32x4*)(shm+CL_K+(ch*128+key)*16)=kv; *(u32x4*)(shm+CL_V+(ch>>2)*8192+key*64+(ch&3)*16)=vv; } }
  const bf16*Qw=IO_PROJ+(rowbase+t0c+rh*32)*DM+1536+h*D;
  bf16x8 qr[4];
  #pragma unroll
  for(int d0=0;d0<4;++d0)qr[d0]=*reinterpret_cast<const bf16x8*>(&Qw[(long)r32*DM+d0*16+hi*8]);
  __syncthreads();
  const lds_cptr shm3=(lds_cptr)shm; const lds_fptr dt=(lds_fptr)(shm+CL_DT)+h*128;
  const int t=t0c+rh*32+r32;
  f32x16 p[4];
  float m=-INFINITY;
  #pragma unroll
  for(int kb=0;kb<4;++kb){ p[kb]=f32x16{};
    if(kb<nkb){
      #pragma unroll
      for(int d0=0;d0<4;++d0){ const bf16x8 kf=*(const __attribute__((address_space(3))) bf16x8*)(shm3+CL_K+((2*d0+hi)*128+32*kb+r32)*16);
        p[kb]=__builtin_amdgcn_mfma_f32_32x32x16_bf16(kf,qr[d0],p[kb],0,0,0); }
      int dbase=t-31-16*(32*kb+4*hi); asm volatile("":"+v"(dbase));
      #pragma unroll
      for(int r=0;r<16;++r){ const int d=dbase-16*((r&3)+8*(r>>2)); const float x=p[kb][r]+dt[min(max(d,0),127)]; p[kb][r]=d>=0?x:-INFINITY; m=fmaxf(m,p[kb][r]); }
    } }
  { auto rr=__builtin_amdgcn_permlane32_swap(__float_as_uint(m),__float_as_uint(m),false,false); m=fmaxf(__uint_as_float(rr[0]),__uint_as_float(rr[1])); }
  const float ms=(m==-INFINITY)?0.f:m;
  float l=0.f;
  #pragma unroll
  for(int kb=0;kb<4;++kb) if(kb<nkb){
    #pragma unroll
    for(int r=0;r<16;++r){ p[kb][r]=__builtin_amdgcn_exp2f(p[kb][r]-ms); l+=p[kb][r]; } }
  { auto rr=__builtin_amdgcn_permlane32_swap(__float_as_uint(l),__float_as_uint(l),false,false); l=__uint_as_float(rr[0])+__uint_as_float(rr[1]); }
  const float il=l>0.f?1.f/l:0.f;
  #pragma unroll
  for(int kb=0;kb<4;++kb) if(kb<nkb){
    #pragma unroll
    for(int r=0;r<16;++r)p[kb][r]*=il; }
  { float* impw=(float*)(shm+CL_IMP)+(hr*64+rh*32+r32)*33;
    float prevlast=0.f;
    #pragma unroll
    for(int i=0;i<16;++i){ const int kb=i>>2,q=i&3;
      const float qs=(p[kb][4*q]+p[kb][4*q+1])+(p[kb][4*q+2]+p[kb][4*q+3]), last=p[kb][4*q+3];
      auto rr=__builtin_amdgcn_permlane32_swap(__float_as_uint(prevlast),__float_as_uint(last),false,false);
      const float recv=hi?__uint_as_float(rr[0]):__uint_as_float(rr[1]);
      impw[2*i+hi]=qs+recv; prevlast=last; } }
  f32x16 o[2]; o[0]=f32x16{}; o[1]=f32x16{};
  { const lds_cptr vp0=shm3+CL_V+((lane>>4)&1)*32+(lane&3)*8+(4*hi+((lane&15)>>2))*64;
    #pragma unroll
    for(int kb=0;kb<4;++kb) if(kb<nkb){
      #pragma unroll
      for(int ks=0;ks<2;++ks){ u32x4 pw;
        #pragma unroll
        for(int k=0;k<4;++k)pw[k]=cvtpk_s(p[kb][8*ks+2*k],p[kb][8*ks+2*k+1]);
        const bf16x8 pa=__builtin_bit_cast(bf16x8,pw);
        #pragma unroll
        for(int d0=0;d0<2;++d0){ const s16x4 vlo=vtr(vp0+d0*8192+(2*kb+ks)*1024), vhi=vtr(vp0+d0*8192+(2*kb+ks)*1024+512);
          const bf16x8 vf=(bf16x8){vlo[0],vlo[1],vlo[2],vlo[3],vhi[0],vhi[1],vhi[2],vhi[3]};
          o[d0]=__builtin_amdgcn_mfma_f32_32x32x16_bf16(pa,vf,o[d0],0,0,0); } } } }
  { bf16*stg=(bf16*)(shm+CL_OST)+wid*2048;
    #pragma unroll
    for(int r=0;r<16;++r){const int orow=crow(r,hi);
      #pragma unroll
      for(int d0=0;d0<2;++d0)stg[orow*64+d0*32+r32]=__float2bfloat16(o[d0][r]);}
    asm volatile("s_waitcnt lgkmcnt(0)":::"memory");
    bf16*oc=(bf16*)(io.ws+WS_OC)+(rowbase+t0c+rh*32)*512+h*D;
    #pragma unroll
    for(int i=0;i<4;++i){const int row=i*8+(lane>>3),ch=lane&7; *(u32x4*)(oc+(long)row*512+ch*8)=*(const u32x4*)(stg+row*64+ch*8);} }
  __syncthreads();
  { const int row=tid>>3,jq=tid&7; const float*imp=(const float*)(shm+CL_IMP); float*scl=(float*)(shm+CL_SC)+row*33;
    float sc[4];
    #pragma unroll
    for(int k=0;k<4;++k){ const int j=4*jq+k; const float v=(imp[(0*64+row)*33+j]+imp[(1*64+row)*33+j])+(imp[(2*64+row)*33+j]+imp[(3*64+row)*33+j]);
      const bool causal=j<=c, forced=(j==0)||(j==c)||(j==c-1); sc[k]=causal?v+(forced?1e4f:0.f):-1e4f; scl[j]=sc[k]; }
    asm volatile("s_waitcnt lgkmcnt(0)":::"memory");
    unsigned bits=0u;
    #pragma unroll
    for(int k=0;k<4;++k){ const int j=4*jq+k; int rank=0;
      #pragma unroll
      for(int i=0;i<32;++i){ const float o2=scl[i]; rank+=(o2>sc[k]||(o2==sc[k]&&i<j))?1:0; }
      bits|=(rank<16?1u:0u)<<j; }
    bits|=__shfl_xor(bits,1); bits|=__shfl_xor(bits,2); bits|=__shfl_xor(bits,4);
    if(jq==0)((unsigned*)(io.ws+WS_SELM))[((long)(b*2+g))*SEQ+t0c+row]=bits; }
  __syncthreads();
}
constexpr int ATTN_LDS_BYTES=LDS_BYTES;
#undef SBAR
#undef WAIT_BAR
}

__device__ __forceinline__ float silu_f(float x) { return x / (1.f + expf(-x)); }
__device__ __forceinline__ float sigmoid_f(float x) { return 1.f / (1.f + expf(-x)); }
__device__ __forceinline__ unsigned f2bf(float f) { unsigned u = __builtin_bit_cast(unsigned, f); return (u + 0x7fffu + ((u >> 16) & 1u)) >> 16; }
__device__ __forceinline__ unsigned pk2(float lo, float hi) { return f2bf(lo) | (f2bf(hi) << 16); }
__device__ __forceinline__ float bf2f(bf16 v) { return __builtin_bit_cast(float, (unsigned)v << 16); }
__device__ __forceinline__ float wave_sum(float v) {
#pragma unroll
    for (int o = 1; o < 64; o <<= 1) v += __shfl_xor(v, o);
    return v;
}
__device__ __forceinline__ int t5_bucket(int dist) {
    const int n = dist < 0 ? 0 : dist;
    if (n < 16) return n;
    int b = 16;
    b += (n >= 19) + (n >= 21) + (n >= 24) + (n >= 27) + (n >= 31) + (n >= 35) + (n >= 40) + (n >= 46) + (n >= 52) + (n >= 59) +
         (n >= 67) + (n >= 77) + (n >= 87) + (n >= 99) + (n >= 113);
    return b;
}

struct Args {
    const float* in[26];
    float* out; unsigned char* ws;
    int ph_lo, ph_hi, li, pad;
};

struct Ctx {
    LAS unsigned char* lds;
    int tid, lane, wave, gtid, GT, gw, NGW;
    const float *x, *c, *w_ada, *b_ada, *w_in, *b_f, *cmp_pos_k, *cmp_w1_k, *cmp_w2_k, *cmp_pos_v, *cmp_w1_v, *cmp_w2_v, *rel_bias, *w_out, *ln1_g, *ln1_b,
        *w_router, *e_bias, *w_gate, *w_up, *w_down, *ws_gate, *ws_up, *ws_down, *ln2_g, *ln2_b;
    float* out;
    float *mod, *cum, *kvc, *posb, *scorebuf, *scores, *ew, *fg, *pc, *lw;
    int* lrow; gu32* ctl; unsigned char* wsb;
    unsigned* selmask; int* eidx;
    bf16 *hbuf, *proj, *h2lo, *win_t, *wout_t, *ao16, *oc, *ow, *wgu, *wdn, *act16, *slot, *w1t, *w2t, *kvc16, *wrt;
};


__device__ __forceinline__ int map_inproj(int n) { return n < 1536 ? n : (n < 1544 ? 2816 + (n - 1536) : (n < 2824 ? n - 8 : n)); }
template <int MAP>
__device__ __forceinline__ void transpose_item(const float* W, int K, int N, bf16* WT, LAS float* scr, int item, int lane) {
    const int nblk = N / 32, kb = item / nblk, nb = item % nblk, k0 = 64 * kb, n0 = 32 * nb;
#pragma unroll 8
    for (int i = 0; i < 32; ++i) { const int kk = 2 * i + (lane >> 5); scr[kk * 33 + (lane & 31)] = W[(size_t)(k0 + kk) * N + n0 + (lane & 31)]; }
    asm volatile("s_waitcnt lgkmcnt(0)" ::: "memory");
    const int c = lane & 7;
#pragma unroll
    for (int j = 0; j < 4; ++j) { const int n = (lane >> 3) + 8 * j; const LAS float* s = scr + (8 * c) * 33 + n;
        u32x4 o; o.x = pk2(s[0 * 33], s[1 * 33]); o.y = pk2(s[2 * 33], s[3 * 33]); o.z = pk2(s[4 * 33], s[5 * 33]); o.w = pk2(s[6 * 33], s[7 * 33]);
        const int dr = MAP == 1 ? map_inproj(n0 + n) : n0 + n;
        *(u32x4*)(WT + (size_t)dr * K + k0 + 8 * c) = o; }
    asm volatile("s_waitcnt lgkmcnt(0)" ::: "memory");
}
__device__ __forceinline__ void ph_prologue(Ctx& C) {
    LAS float* scr = (LAS float*)(C.lds + C.wave * 8704);
    constexpr int I_IN = (D / 64) * (NPROJ / 32), I_OUT = (D / 64) * (D / 32);
    for (int it = C.gw; it < I_IN + I_OUT; it += C.NGW) {
        if (it < I_IN) transpose_item<1>(C.w_in, D, NPROJ, C.win_t, scr, it, C.lane);
        else transpose_item<0>(C.w_out, D, D, C.wout_t, scr, it - I_IN, C.lane);
    }
    constexpr int I_W1 = (2048 / 64) * (256 / 32), I_W2 = (256 / 64) * (64 / 32);
    for (int it = C.gw; it < 2 * (I_W1 + I_W2); it += C.NGW) {
        const int which = it / (I_W1 + I_W2), r = it % (I_W1 + I_W2);
        if (r < I_W1) transpose_item<0>(which ? C.cmp_w1_v : C.cmp_w1_k, 2048, 256, C.w1t + (size_t)which * 256 * 2048, scr, r, C.lane);
        else transpose_item<0>(which ? C.cmp_w2_v : C.cmp_w2_k, 256, 64, C.w2t + (size_t)which * 64 * 256, scr, r - I_W1, C.lane);
    }
    if (blockIdx.x == gridDim.x - 1) {
        const int which = C.tid >> 8, j = C.tid & 255;
        const float* pos = which ? C.cmp_pos_v : C.cmp_pos_k; const float* w1 = which ? C.cmp_w1_v : C.cmp_w1_k;
        float acc = 0.f;
        for (int k = 0; k < 2048; ++k) acc += pos[k] * w1[(size_t)k * 256 + j];
        C.posb[C.tid] = acc;
    }
    for (int i = C.gtid; i < 64 * 128; i += C.GT) {
        const int e = i & 63, k0 = (i >> 6) * 8;
        u32x4 oh, ol;
#pragma unroll
        for (int p = 0; p < 4; ++p) {
            const float a = C.w_router[(size_t)(k0 + 2 * p) * 64 + e], b = C.w_router[(size_t)(k0 + 2 * p + 1) * 64 + e];
            const unsigned h = pk2(a, b);
            oh[p] = h; ol[p] = pk2(a - __builtin_bit_cast(float, h << 16), b - __builtin_bit_cast(float, h & 0xffff0000u));
        }
        *(u32x4*)(C.wrt + (size_t)e * 1024 + k0) = oh; *(u32x4*)(C.wrt + 65536 + (size_t)e * 1024 + k0) = ol;
    }
    for (int i = C.gtid; i < 2 * 8 * 2 * 64; i += C.GT) C.kvc16[((size_t)(i >> 6) * 128 + 127) * 64 + (i & 63)] = 0;
    for (int i = C.gtid; i < (3072 - NPROJ) * D / 8; i += C.GT) *(u32x4*)(C.win_t + (size_t)NPROJ * D + (size_t)i * 8) = (u32x4){0u, 0u, 0u, 0u};
}
__device__ __forceinline__ void ph_mod(Ctx& C) {
    if (blockIdx.x >= 96) return;
    LAS float* st = (LAS float*)(C.lds + 73728);
    LAS float* part = (LAS float*)(C.lds + 73728 + 32768);
    for (int i = C.tid; i < NB * D; i += NTHR) { const int b = i >> 10, k = i & 1023; st[k * 8 + b] = silu_f(C.c[i]); }
    __syncthreads();
    const int e0 = blockIdx.x * 64 + C.lane;
    float acc[8];
#pragma unroll
    for (int b = 0; b < 8; ++b) acc[b] = 0.f;
    const float* wp = C.w_ada + (size_t)(128 * C.wave) * (6 * D) + e0;
#pragma unroll 8
    for (int k = 0; k < 128; ++k) {
        const float w = wp[(size_t)k * (6 * D)];
        const f32x4 s0 = *(const LAS f32x4*)(st + (128 * C.wave + k) * 8), s1 = *(const LAS f32x4*)(st + (128 * C.wave + k) * 8 + 4);
        acc[0] += s0.x * w; acc[1] += s0.y * w; acc[2] += s0.z * w; acc[3] += s0.w * w;
        acc[4] += s1.x * w; acc[5] += s1.y * w; acc[6] += s1.z * w; acc[7] += s1.w * w;
    }
#pragma unroll
    for (int b = 0; b < 8; ++b) part[(C.wave * 8 + b) * 64 + C.lane] = acc[b];
    __syncthreads();
    { const int b = C.wave; float s = C.b_ada[e0];
#pragma unroll
      for (int w = 0; w < 8; ++w) s += part[(w * 8 + b) * 64 + C.lane];
      C.mod[b * 6 * D + e0] = s; }
    __syncthreads();
}
__device__ __forceinline__ void ph_hpass(Ctx& C) {
    for (int m = C.gw; m < T; m += C.NGW) {
        const int b = m / S;
        const float* md = C.mod + b * 6 * D;
#pragma unroll
        for (int j = 0; j < 4; ++j) {
            const int c0 = (C.lane + 64 * j) * 4;
            const f32x4 xv = *(const f32x4*)(C.x + (size_t)m * D + c0);
            const f32x4 sh = *(const f32x4*)(md + c0), sc = *(const f32x4*)(md + D + c0);
            const f32x4 h = xv * (1.f + sc) + sh;
            u32x2 o; o.x = pk2(h.x, h.y); o.y = pk2(h.z, h.w);
            *(u32x2*)(C.hbuf + (size_t)m * D + c0) = o;
        }
    }
}
__device__ __forceinline__ void ph_cum_cmp1(Ctx& C) {
    for (int w = C.gw; w < NB * 8; w += C.NGW) {
        const int b = w / 8, h = w % 8;
        float carry = 0.f;
        for (int c0 = 0; c0 < S; c0 += 64) {
            const int t = c0 + C.lane;
            const float xx = C.fg[((size_t)b * S + t) * FGW + h] + C.b_f[h];
            float v = fminf(xx, 0.f) - log1pf(expf(-fabsf(xx)));
#pragma unroll
            for (int o = 1; o < 64; o <<= 1) { const float u = __shfl_up(v, o); if (C.lane >= o) v += u; }
            v += carry;
            C.cum[(size_t)w * S + t] = v;
            carry = __shfl(v, 63);
        }
    }
}
typedef short bf16x8_t __attribute__((ext_vector_type(8)));
__device__ __forceinline__ void ph_compress(Ctx& C) {
    constexpr int PST = 256;
    LAS float* part = (LAS float*)C.lds;
    LAS bf16* hidL = (LAS bf16*)(C.lds + LDS_TAB);
    static_assert(LDS_TAB + 8192 <= LDS_BYTES, "compress LDS map");
    int lane_ = C.lane; asm volatile("" : "+v"(lane_));
    const int row = lane_ & 15, kq = lane_ >> 4;
    for (int u = blockIdx.x; u < 2 * NCMP; u += gridDim.x) {
        const int which = u / NCMP, tile = u % NCMP;
        { const int R = tile * 16 + row, b = R / 254, n = (R % 254) >> 1, g = R & 1;
          const bf16* abase = C.proj + ((size_t)b * S + 16 * n + 4 * C.wave) * PITCH + (which ? PC_VC : PC_KC) + g * 64 + 8 * kq;
          const bf16* wb = C.w1t + ((size_t)which * 256 + row) * 2048 + 256 * C.wave + 8 * kq;
          f32x4 acc[16];
#pragma unroll
          for (int n2 = 0; n2 < 16; ++n2) acc[n2] = (f32x4){0.f, 0.f, 0.f, 0.f};
#pragma unroll 2
          for (int k0 = 0; k0 < 256; k0 += 32) {
              const bf16x8_t a = *(const bf16x8_t*)(abase + (size_t)(k0 >> 6) * PITCH + (k0 & 63));
#pragma unroll
              for (int n2 = 0; n2 < 16; ++n2) { const bf16x8_t bv = *(const bf16x8_t*)(wb + (size_t)n2 * 16 * 2048 + k0);
                  acc[n2] = __builtin_amdgcn_mfma_f32_16x16x32_bf16(a, bv, acc[n2], 0, 0, 0); }
          }
#pragma unroll
          for (int n2 = 0; n2 < 16; ++n2)
#pragma unroll
              for (int r = 0; r < 4; ++r) part[(C.wave * 16 + kq * 4 + r) * PST + ((n2 * 16 + row) ^ ((kq & 1) << 4))] = acc[n2][r]; }
        __syncthreads();
#pragma unroll
        for (int p = 0; p < 8; ++p) { const int idx = C.tid + 512 * p, r = idx >> 8, j = idx & 255;
            float s = C.posb[which * 256 + j];
#pragma unroll
            for (int w = 0; w < 8; ++w) s += part[(w * 16 + r) * PST + (j ^ (((r >> 2) & 1) << 4))];
            hidL[r * 256 + j] = (bf16)f2bf(silu_f(s)); }
        __syncthreads();
        if (C.wave < 4) {
            const bf16* w2 = C.w2t + ((size_t)which * 64 + 16 * C.wave + row) * 256 + 8 * kq;
            f32x4 acc = {0.f, 0.f, 0.f, 0.f};
#pragma unroll
            for (int k0 = 0; k0 < 256; k0 += 32) {
                const bf16x8_t a = *(const LAS bf16x8_t*)(hidL + row * 256 + k0 + 8 * kq);
                const bf16x8_t b = *(const bf16x8_t*)(w2 + k0);
                acc = __builtin_amdgcn_mfma_f32_16x16x32_bf16(a, b, acc, 0, 0, 0);
            }
#pragma unroll
            for (int r = 0; r < 4; ++r) {
                const int R = tile * 16 + kq * 4 + r, b = R / 254, n = (R % 254) >> 1, g = R & 1, col = 16 * C.wave + row;
                C.kvc[((size_t)which * (NB * NCMP * 2) + R) * 64 + col] = acc[r];
                C.kvc16[((((size_t)which * 8 + b) * 2 + g) * 128 + n) * 64 + col] = (bf16)f2bf(acc[r]);
            }
        }
        __syncthreads();
    }
}
#if defined(ORACLE) && ORACLE >= 4
__device__ __forceinline__ void cmp_attn_item(Ctx& C, int i, float& sd, float& sr) {
    const int t = i % S, h = (i / S) % 8, b = i / (S * 8), g = h / 4;
    const size_t tok = (size_t)b * S + t;
    const int NR = NB * NCMP * 2;
    const float* kc = C.kvc;
    const float* vc = C.kvc + (size_t)NR * 64;
    float q[64], o[64];
#pragma unroll
    for (int d = 0; d < 64; ++d) { q[d] = bf2f(C.proj[tok * PITCH + PC_NQ + h * 64 + d]); o[d] = 0.f; }
    float* prow = C.pc + ((size_t)(b * 8 + h) * S + t) * 128;
    const int nvalid = t >= 31 ? min(NCMP, (t - 31) / 16 + 1) : 0;
    float m = -1e30f;
    for (int n = 0; n < nvalid; ++n) {
        const float* kr = kc + ((size_t)(b * NCMP + n) * 2 + g) * 64;
        float dot = 0.f;
#pragma unroll
        for (int d = 0; d < 64; ++d) dot += q[d] * kr[d];
        const float lg = dot + C.rel_bias[t5_bucket(t - (16 * n + 31)) * 8 + h] * LOG2E;
        prow[n] = lg;
        m = fmaxf(m, lg);
    }
    float l = 0.f;
    for (int n = 0; n < nvalid; ++n) l += exp2f(prow[n] - m);
    const float il = nvalid ? 1.f / l : 0.f;
    for (int n = 0; n < 128; ++n) {
        float p = 0.f;
        if (n < nvalid) {
            p = exp2f(prow[n] - m) * il;
            const float* vr = vc + ((size_t)(b * NCMP + n) * 2 + g) * 64;
#pragma unroll
            for (int d = 0; d < 64; ++d) o[d] += p * vr[d];
        }
        prow[n] = p;
    }
#pragma unroll
    for (int d = 0; d < 64; ++d) { const float got = bf2f(C.oc[tok * 512 + h * 64 + d]); sd += (got - o[d]) * (got - o[d]); sr += o[d] * o[d]; }
}
__device__ __forceinline__ void ph_imp_topk(Ctx& C, float& sd, float& sr) {
    for (int i = C.gtid; i < NB * 2 * S; i += C.GT) {
        const int t = i % S, g = (i / S) % 2, b = i / (S * 2);
        const int qb = t >> 6;
        float* sc = C.scorebuf + (size_t)i * 32;
        for (int j = 0; j < 32; ++j) {
            float imp = 0.f;
            for (int r = 0; r < 4; ++r) {
                const float* prow = C.pc + ((size_t)(b * 8 + g * 4 + r) * S + t) * 128;
                for (int n = 4 * j - 1; n <= 4 * j + 3; ++n)
                    if (n >= 0 && n < NCMP) imp += prow[n];
            }
            const bool causal = j <= qb, forced = (j == 0) || (j == qb) || (j == qb - 1);
            sc[j] = causal ? imp + (forced ? 1e4f : 0.f) : -1e4f;
        }
        unsigned taken = 0u;
        for (int k = 0; k < 16; ++k) {
            float best = -3e38f; int bi = 0;
            for (int j = 0; j < 32; ++j)
                if (!((taken >> j) & 1u)) { const float v = sc[j]; if (v > best) { best = v; bi = j; } }
            taken |= 1u << bi;
        }
        sd += (C.selmask[i] != taken) ? 1.f : 0.f; sr += 1.f;
    }
}
#endif
#define ATTN_IO(C) attn_body::AttnIO{C.wsb}
__device__ __forceinline__ unsigned pick4(unsigned a, unsigned b, unsigned c, unsigned d, int k) { return k == 0 ? a : (k == 1 ? b : (k == 2 ? c : d)); }
__device__ __forceinline__ void ph_attn_a(Ctx& C, char* shm) {
    const attn_body::AttnIO io = ATTN_IO(C);
    const int c = blockIdx.x, k = c >> 6, j = c & 63, b = j >> 3, h = j & 7;
    if (c >= 256) return;
    attn_body::attn_fill_dt(shm, C.rel_bias);
    { int tv = threadIdx.x; asm volatile("" : "+v"(tv));
    for (unsigned l = pick4(0xF07u, 0xF16u, 0xF25u, 0xF34u, k); (l & 15u) != 15u; l >>= 4) attn_body::attn_unit<0, 8>(b, h, (int)(l & 15u), io, shm, tv); }
    { int tv = threadIdx.x; asm volatile("" : "+v"(tv));
    for (unsigned l = pick4(0xF07u, 0xF16u, 0xF25u, 0xF34u, k); (l & 15u) != 15u; l >>= 4) attn_body::attn_unit<2, 8>(b, h, (int)(l & 15u), io, shm, tv); }
}
__device__ __forceinline__ void ph_attn_b(Ctx& C, char* shm) {
    const attn_body::AttnIO io = ATTN_IO(C);
    const int c = blockIdx.x, k = c >> 6, j = c & 63, b = j >> 3, h = j & 7;
    if (c >= 256) return;
    attn_body::attn_fill_dt(shm, C.rel_bias);
    { int tv = threadIdx.x; asm volatile("" : "+v"(tv));
    for (unsigned l = pick4(0xF07u, 0xF16u, 0xF25u, 0xF34u, k); (l & 15u) != 15u; l >>= 4) attn_body::attn_unit<1, 8>(b, h, (int)(l & 15u), io, shm, tv); }
}

#ifdef ORACLE
constexpr int CW_ORA = 24576;
template <int MODE>
__device__ __forceinline__ void oracle_attn(Ctx& C) {
    float sd = 0.f, sr = 0.f;
    for (int i = C.gtid; i < NB * 8 * S; i += C.GT) {
        const int t = i % S, h = (i / S) % 8, b = i / (S * 8), g = h / 4;
        const size_t tok = (size_t)b * S + t;
        const int qoff = (MODE == 0 ? PC_FQ : PC_NQ) + h * 64;
        const int koff = MODE == 0 ? PC_FK + h * 64 : (MODE == 1 ? PC_KS : PC_KW) + g * 64;
        const int voff = MODE == 0 ? PC_FV + h * 64 : (MODE == 1 ? PC_VS : PC_VW) + g * 64;
        float q[64], o[64];
#pragma unroll
        for (int d = 0; d < 64; ++d) { q[d] = bf2f(C.proj[tok * PITCH + qoff + d]); o[d] = 0.f; }
        float m = -INFINITY, l = 0.f;
        const int s_lo = MODE == 2 ? max(0, t - 511) : 0;
        const unsigned mask = MODE == 1 ? C.selmask[(b * 2 + g) * S + t] : 0xffffffffu;
        const float* cr = C.cum + (size_t)(b * 8 + h) * S;
        const float cumt = MODE == 0 ? cr[t] : 0.f;
        for (int s = s_lo; s <= t; ++s) {
            if (MODE == 1 && !((mask >> (s >> 6)) & 1u)) continue;
            const bf16* kr = C.proj + ((size_t)b * S + s) * PITCH + koff;
            const bf16* vr = C.proj + ((size_t)b * S + s) * PITCH + voff;
            float dot = 0.f;
#pragma unroll
            for (int d = 0; d < 64; ++d) dot += q[d] * bf2f(kr[d]);
            const float bias = MODE == 0 ? cumt - cr[s] : C.rel_bias[t5_bucket(t - s) * 8 + h];
            const float lg = dot + bias * LOG2E;
            const float mn = fmaxf(m, lg), corr = exp2f(m - mn), p = exp2f(lg - mn);
            l = l * corr + p;
#pragma unroll
            for (int d = 0; d < 64; ++d) o[d] = o[d] * corr + p * bf2f(vr[d]);
            m = mn;
        }
        const float il = 1.f / l;
        float g0 = 0.f, g1 = 1.f, g2 = 0.f;
        if (MODE == 1) { g0 = sigmoid_f(C.fg[tok * FGW + 8 + h * 3 + 0]); g1 = sigmoid_f(C.fg[tok * FGW + 8 + h * 3 + 1]); g2 = sigmoid_f(C.fg[tok * FGW + 8 + h * 3 + 2]); }
#pragma unroll
        for (int d = 0; d < 64; ++d) {
            float ref = o[d] * il, got;
            if (MODE == 0) got = bf2f(C.ao16[tok * D + h * 64 + d]);
            else if (MODE == 2) got = bf2f(C.ow[tok * 512 + h * 64 + d]);
            else { ref = g0 * bf2f(C.oc[tok * 512 + h * 64 + d]) + g1 * ref + g2 * bf2f(C.ow[tok * 512 + h * 64 + d]); got = bf2f(C.ao16[tok * D + 512 + h * 64 + d]); }
            sd += (got - ref) * (got - ref); sr += ref * ref;
        }
    }
    sd = wave_sum(sd); sr = wave_sum(sr);
    if (C.lane == 0) { atomicAdd((float*)(C.ctl + CW_ORA), sd); atomicAdd((float*)(C.ctl + CW_ORA + 64), sr); }
}
#endif
__device__ __forceinline__ void ph_cmp_attn(Ctx& C, char* shm) {
    const attn_body::AttnIO io = ATTN_IO(C);
    const int c = blockIdx.x;
    if (c >= 256) return;
    attn_body::attn_fill_dt(shm, C.rel_bias, attn_body::CL_DT);
    { int tv = threadIdx.x; asm volatile("" : "+v"(tv));
      const int bg = c >> 4, i = c & 15;
      attn_body::cmp_unit(bg >> 1, bg & 1, 31 - i, io, shm, tv);
      attn_body::cmp_unit(bg >> 1, bg & 1, i, io, shm, tv); }
}
template <int WHICH>
__device__ __forceinline__ void ph_ln(Ctx& C) {
    const float* gam = WHICH == 1 ? C.ln1_g : C.ln2_g;
    const float* bet = WHICH == 1 ? C.ln1_b : C.ln2_b;
    for (int m = C.gw; m < T; m += C.NGW) {
        const int b = m / S;
        float* row = C.out + (size_t)m * D;
        f32x4 v[4]; float s = 0.f;
#pragma unroll
        for (int j = 0; j < 4; ++j) { v[j] = *(const f32x4*)(row + (C.lane + 64 * j) * 4); s += (v[j].x + v[j].y) + (v[j].z + v[j].w); }
        const float mean = wave_sum(s) * (1.f / D); float s2 = 0.f;
#pragma unroll
        for (int j = 0; j < 4; ++j) { v[j] = v[j] - mean; s2 += (v[j].x * v[j].x + v[j].y * v[j].y) + (v[j].z * v[j].z + v[j].w * v[j].w); }
        const float rstd = rsqrtf(wave_sum(s2) * (1.f / D) + LN_EPS);
#pragma unroll
        for (int j = 0; j < 4; ++j) {
            const int c0 = (C.lane + 64 * j) * 4;
            const f32x4 y = v[j] * rstd * *(const f32x4*)(gam + c0) + *(const f32x4*)(bet + c0);
            *(f32x4*)(row + c0) = y;
            if (WHICH == 1) {
                const float* md = C.mod + b * 6 * D;
                const f32x4 h2 = y * (1.f + *(const f32x4*)(md + 4 * D + c0)) + *(const f32x4*)(md + 3 * D + c0);
                u32x2 hi; hi.x = pk2(h2.x, h2.y); hi.y = pk2(h2.z, h2.w);
                const float r0 = h2.x - __builtin_bit_cast(float, hi.x << 16), r1 = h2.y - __builtin_bit_cast(float, hi.x & 0xffff0000u);
                const float r2 = h2.z - __builtin_bit_cast(float, hi.y << 16), r3 = h2.w - __builtin_bit_cast(float, hi.y & 0xffff0000u);
                u32x2 lo; lo.x = pk2(r0, r1); lo.y = pk2(r2, r3);
                *(u32x2*)(C.hbuf + (size_t)m * D + c0) = hi;
                *(u32x2*)(C.h2lo + (size_t)m * D + c0) = lo;
            }
        }
    }
}
__device__ __forceinline__ void ph_router_route(Ctx& C) {
    LAS float* scr = (LAS float*)(C.lds + C.wave * 4096);
    LAS float* mvs = (LAS float*)(C.lds + 32768 + C.wave * 256);
    const int row = C.lane & 15, kq = C.lane >> 4;
    for (int tile = C.gw; tile < T / 16; tile += C.NGW) {
        const int tok0 = tile * 16;
        const bf16* ah = C.hbuf + (size_t)(tok0 + row) * D + 8 * kq;
        const bf16* al = C.h2lo + (size_t)(tok0 + row) * D + 8 * kq;
        const bf16* wh = C.wrt + (size_t)row * 1024 + 8 * kq;
        f32x4 acc[4];
#pragma unroll
        for (int n = 0; n < 4; ++n) acc[n] = (f32x4){0.f, 0.f, 0.f, 0.f};
#pragma unroll 2
        for (int k0 = 0; k0 < D; k0 += 32) {
            const bf16x8_t a_h = *(const bf16x8_t*)(ah + k0), a_l = *(const bf16x8_t*)(al + k0);
#pragma unroll
            for (int n = 0; n < 4; ++n) {
                const bf16x8_t b_h = *(const bf16x8_t*)(wh + (size_t)n * 16 * 1024 + k0), b_l = *(const bf16x8_t*)(wh + 65536 + (size_t)n * 16 * 1024 + k0);
                acc[n] = __builtin_amdgcn_mfma_f32_16x16x32_bf16(a_l, b_l, acc[n], 0, 0, 0);
                acc[n] = __builtin_amdgcn_mfma_f32_16x16x32_bf16(a_l, b_h, acc[n], 0, 0, 0);
                acc[n] = __builtin_amdgcn_mfma_f32_16x16x32_bf16(a_h, b_l, acc[n], 0, 0, 0);
                acc[n] = __builtin_amdgcn_mfma_f32_16x16x32_bf16(a_h, b_h, acc[n], 0, 0, 0);
            }
        }
#pragma unroll
        for (int n = 0; n < 4; ++n)
#pragma unroll
            for (int r = 0; r < 4; ++r) scr[(kq * 4 + r) * 64 + n * 16 + row] = acc[n][r];
        asm volatile("s_waitcnt lgkmcnt(0)" ::: "memory");
        const int e = C.lane, g = e >> 3;
        const float eb = C.e_bias[e];
        for (int tl = 0; tl < 16; ++tl) {
            const int tok = tok0 + tl;
            const float sc = sigmoid_f(scr[tl * 64 + e]);
            const float bsc = sc + eb;
            float m1 = bsc;
            m1 = fmaxf(m1, __shfl_xor(m1, 1)); m1 = fmaxf(m1, __shfl_xor(m1, 2)); m1 = fmaxf(m1, __shfl_xor(m1, 4));
            const unsigned long long eq = __ballot(bsc == m1) & (0xFFull << (8 * g));
            const int first = __ffsll((long long)eq) - 1;
            float m2 = (e == first) ? -INFINITY : bsc;
            m2 = fmaxf(m2, __shfl_xor(m2, 1)); m2 = fmaxf(m2, __shfl_xor(m2, 2)); m2 = fmaxf(m2, __shfl_xor(m2, 4));
            const float gs = m1 + m2;
            int grank = 0;
#pragma unroll
            for (int gg = 0; gg < 8; ++gg) { const float o = __shfl(gs, gg * 8); grank += (o > gs || (o == gs && gg < g)) ? 1 : 0; }
            const float mv = grank < 4 ? bsc : -INFINITY;
            mvs[e] = mv;
            asm volatile("s_waitcnt lgkmcnt(0)" ::: "memory");
            int rank = 0;
#pragma unroll
            for (int c4 = 0; c4 < 16; ++c4) { const f32x4 o = *(const LAS f32x4*)(mvs + 4 * c4);
#pragma unroll
                for (int q = 0; q < 4; ++q) rank += (o[q] > mv || (o[q] == mv && 4 * c4 + q < e)) ? 1 : 0; }
            asm volatile("" ::: "memory");
            const bool sel = rank < 8;
            const float wsum = wave_sum(sel ? sc : 0.f);
            if (sel) {
                const float w = sc / wsum * 2.5f;
                const unsigned pos = __hip_atomic_fetch_add(C.ctl + CW_CNT + 64 * e, 1u, RLX_AGENT);
                C.lrow[(size_t)e * 16384 + pos] = tok * 16 + rank; C.lw[(size_t)e * 16384 + pos] = w;
            }
            if (e == 0) { C.lrow[(size_t)64 * 16384 + tok] = tok * 16 + 8; C.lw[(size_t)64 * 16384 + tok] = 1.f; }
        }
    }
}
__device__ __forceinline__ void ph_convert_experts(Ctx& C) {
    LAS float* scr = (LAS float*)(C.lds + C.wave * 8704);
    for (int it = C.gw; it < 65 * 384; it += C.NGW) {
        const int e = it / 384, r = it % 384, kind = r / 128, item = r % 128;
        if (kind < 2) {
            const float* W = e < 64 ? (kind == 0 ? C.w_gate : C.w_up) + (size_t)e * D * 256 : (kind == 0 ? C.ws_gate : C.ws_up);
            const int n0 = 32 * (item % 8);
            bf16* WT = C.wgu + ((size_t)e * 512 + (n0 / 128) * 128 + kind * 128) * D;
            transpose_item<0>(W, D, 256, WT, scr, item, C.lane);
        } else {
            const float* W = e < 64 ? C.w_down + (size_t)e * 256 * D : C.ws_down;
            transpose_item<0>(W, 256, D, C.wdn + (size_t)e * D * 256, scr, item, C.lane);
        }
    }
}
__device__ __forceinline__ int moe_tables(Ctx& C) {
    LAS int* tstart = (LAS int*)(C.lds + LDS_TSTART); LAS int* cntl = (LAS int*)(C.lds + LDS_CNT);
    if (C.tid < 64) cntl[C.tid] = (int)__hip_atomic_load(C.ctl + CW_CNT + 64 * C.tid, RLX_AGENT);
    if (C.tid == 64) cntl[64] = T;
    __syncthreads();
    if (C.tid == 0) { int s = 0; for (int e = 0; e < 65; ++e) { tstart[e] = s; s += (cntl[e] + 255) >> 8; } tstart[65] = s; }
    __syncthreads();
    return tstart[65];
}
__device__ __forceinline__ void ph_moe_gateup(Ctx& C) {
    const int MT = moe_tables(C);
    pg8::MoeSched So{(const LAS int*)(C.lds + LDS_TSTART), (const LAS int*)(C.lds + LDS_CNT), C.lrow, C.lw, (const char*)C.wgu, (size_t)512 * D * 2, (size_t)256 * D * 2, MT, 2, 0, (int)gridDim.x, (int)blockIdx.x};
    pg8::EpiAct E{C.act16};
    pg8::gemm_phase_g<pg8::EpiAct, pg8::MoeSched, true>(C.lds, C.lds + LDS_TAB, C.hbuf, D, So, E);
}
template <int HF>
__device__ __forceinline__ void ph_moe_down(Ctx& C) {
    const int MT = moe_tables(C);
    pg8::MoeSched So{(const LAS int*)(C.lds + LDS_TSTART), (const LAS int*)(C.lds + LDS_CNT), C.lrow, C.lw, (const char*)C.wdn, (size_t)D * 256 * 2, (size_t)256 * 256 * 2, MT, 2, 2 * HF, (int)gridDim.x, (int)blockIdx.x};
    pg8::EpiSlot E{C.slot, 2 * HF, (unsigned)T * 9u};
    pg8::gemm_phase_g<pg8::EpiSlot, pg8::MoeSched, false>(C.lds, C.lds + LDS_TAB, C.act16, 256, So, E);
}
template <int HF>
__device__ __forceinline__ void ph_combine(Ctx& C) {
    for (int m = C.gw; m < T; m += C.NGW) {
        const int b = m / S, c0 = HF * 512 + C.lane * 8;
        float acc[8];
#pragma unroll
        for (int i = 0; i < 8; ++i) acc[i] = 0.f;
#pragma unroll
        for (int s = 0; s < 9; ++s) {
            const u32x4 v = *(const u32x4*)(C.slot + ((size_t)m * 9 + s) * 512 + C.lane * 8);
            acc[0] += __builtin_bit_cast(float, v.x << 16); acc[1] += __builtin_bit_cast(float, v.x & 0xffff0000u);
            acc[2] += __builtin_bit_cast(float, v.y << 16); acc[3] += __builtin_bit_cast(float, v.y & 0xffff0000u);
            acc[4] += __builtin_bit_cast(float, v.z << 16); acc[5] += __builtin_bit_cast(float, v.z & 0xffff0000u);
            acc[6] += __builtin_bit_cast(float, v.w << 16); acc[7] += __builtin_bit_cast(float, v.w & 0xffff0000u);
        }
        float* row = C.out + (size_t)m * D;
        const float* g2 = C.mod + b * 6 * D + 5 * D + c0;
        f32x4 y0 = *(const f32x4*)(row + c0) * ALPHA + *(const f32x4*)g2 * (f32x4){acc[0], acc[1], acc[2], acc[3]};
        f32x4 y1 = *(const f32x4*)(row + c0 + 4) * ALPHA + *(const f32x4*)(g2 + 4) * (f32x4){acc[4], acc[5], acc[6], acc[7]};
        if (HF == 0) { *(f32x4*)(row + c0) = y0; *(f32x4*)(row + c0 + 4) = y1; }
        else {
            f32x4 z0 = *(const f32x4*)(row + C.lane * 8), z1 = *(const f32x4*)(row + C.lane * 8 + 4);
            float s = (y0.x + y0.y) + (y0.z + y0.w) + (y1.x + y1.y) + (y1.z + y1.w) + (z0.x + z0.y) + (z0.z + z0.w) + (z1.x + z1.y) + (z1.z + z1.w);
            const float mean = wave_sum(s) * (1.f / D);
            y0 = y0 - mean; y1 = y1 - mean; z0 = z0 - mean; z1 = z1 - mean;
            float q = (y0.x * y0.x + y0.y * y0.y) + (y0.z * y0.z + y0.w * y0.w) + (y1.x * y1.x + y1.y * y1.y) + (y1.z * y1.z + y1.w * y1.w)
                    + (z0.x * z0.x + z0.y * z0.y) + (z0.z * z0.z + z0.w * z0.w) + (z1.x * z1.x + z1.y * z1.y) + (z1.z * z1.z + z1.w * z1.w);
            float rstd = rsqrtf(wave_sum(q) * (1.f / D) + LN_EPS);
            const int cz = C.lane * 8;
#ifdef ORACLE
            { const float sd_ = __uint_as_float(__hip_atomic_load(C.ctl + CW_ORA, RLX_AGENT)), sr_ = __uint_as_float(__hip_atomic_load(C.ctl + CW_ORA + 64, RLX_AGENT)); rstd *= 1.f + 10.f * sqrtf(sd_ / sr_); }
#endif
            *(f32x4*)(row + cz) = z0 * rstd * *(const f32x4*)(C.ln2_g + cz) + *(const f32x4*)(C.ln2_b + cz);
            *(f32x4*)(row + cz + 4) = z1 * rstd * *(const f32x4*)(C.ln2_g + cz + 4) + *(const f32x4*)(C.ln2_b + cz + 4);
            *(f32x4*)(row + c0) = y0 * rstd * *(const f32x4*)(C.ln2_g + c0) + *(const f32x4*)(C.ln2_b + c0);
            *(f32x4*)(row + c0 + 4) = y1 * rstd * *(const f32x4*)(C.ln2_g + c0 + 4) + *(const f32x4*)(C.ln2_b + c0 + 4);
        }
    }
}

__device__ __forceinline__ void mkctx(Ctx& C, const Args& args_unused, LAS unsigned char* ldsp) {
    typedef const __attribute__((address_space(4))) Args* kargp; kargp ap = (kargp)__builtin_amdgcn_kernarg_segment_ptr(); asm volatile("" : "+s"(ap));
#define args (*ap)
    C.lds = ldsp;
    C.tid = threadIdx.x; C.lane = C.tid & 63; C.wave = __builtin_amdgcn_readfirstlane(C.tid >> 6);
    C.gtid = blockIdx.x * NTHR + C.tid; C.GT = gridDim.x * NTHR; C.gw = blockIdx.x * NWAVES + C.wave; C.NGW = gridDim.x * NWAVES;
    C.x = args.in[0]; C.c = args.in[1]; C.w_ada = args.in[2]; C.b_ada = args.in[3]; C.w_in = args.in[4]; C.b_f = args.in[5];
    C.cmp_pos_k = args.in[6]; C.cmp_w1_k = args.in[7]; C.cmp_w2_k = args.in[8]; C.cmp_pos_v = args.in[9]; C.cmp_w1_v = args.in[10]; C.cmp_w2_v = args.in[11];
    C.rel_bias = args.in[12]; C.w_out = args.in[13]; C.ln1_g = args.in[14]; C.ln1_b = args.in[15]; C.w_router = args.in[16]; C.e_bias = args.in[17];
    C.w_gate = args.in[18]; C.w_up = args.in[19]; C.w_down = args.in[20]; C.ws_gate = args.in[21]; C.ws_up = args.in[22]; C.ws_down = args.in[23];
    C.ln2_g = args.in[24]; C.ln2_b = args.in[25];
    C.out = args.out;
    unsigned char* ws = args.ws; C.wsb = ws;
    C.mod = (float*)(ws + WS_MOD); C.cum = (float*)(ws + WS_CUM); C.kvc = (float*)(ws + WS_KVC); C.posb = (float*)(ws + WS_POSB); C.w1t = (bf16*)(ws + WS_W1T); C.w2t = (bf16*)(ws + WS_W2T); C.kvc16 = (bf16*)(ws + WS_KVC16); C.wrt = (bf16*)(ws + WS_WRT);
    C.selmask = (unsigned*)(ws + WS_SELM); C.scorebuf = (float*)(ws + WS_SCB); C.scores = (float*)(ws + WS_SCORES);
    C.eidx = (int*)(ws + WS_EIDX); C.ew = (float*)(ws + WS_EW); C.fg = (float*)(ws + WS_FG);
    C.win_t = (bf16*)(ws + WS_WIN_T); C.wout_t = (bf16*)(ws + WS_WOUT_T); C.ao16 = (bf16*)(ws + WS_AO16); C.oc = (bf16*)(ws + WS_OC); C.ow = (bf16*)(ws + WS_OW);
    C.hbuf = (bf16*)(ws + WS_HBUF); C.proj = (bf16*)(ws + WS_PROJ); C.h2lo = (bf16*)(ws + WS_PROJ);
    C.pc = (float*)(ws + WS_PC);
    C.wgu = (bf16*)(ws + WS_WGU); C.wdn = (bf16*)(ws + WS_WDN); C.act16 = (bf16*)(ws + WS_ACT16); C.slot = (bf16*)(ws + WS_SLOT);
    C.lrow = (int*)(ws + WS_LROW); C.lw = (float*)(ws + WS_LW); C.ctl = (gu32*)(ws + WS_CTL);
#undef args
}
#if defined(ORACLE) && ORACLE >= 4
__global__ void __launch_bounds__(256) k_oracle4a(Args args) {
    Ctx C; mkctx(C, args, (LAS unsigned char*)nullptr);
    float sd = 0.f, sr = 0.f;
    for (int i = blockIdx.x * 256 + threadIdx.x; i < NB * 8 * S; i += gridDim.x * 256) cmp_attn_item(C, i, sd, sr);
    sd = wave_sum(sd); sr = wave_sum(sr);
    if (ORACLE == 4 && (threadIdx.x & 63) == 0) { atomicAdd((float*)(C.ctl + CW_ORA), sd); atomicAdd((float*)(C.ctl + CW_ORA + 64), sr); }
}
__global__ void __launch_bounds__(256) k_oracle4b(Args args) {
    Ctx C; mkctx(C, args, (LAS unsigned char*)nullptr);
    C.gtid = blockIdx.x * 256 + threadIdx.x; C.GT = gridDim.x * 256;
    float sd = 0.f, sr = 0.f;
    ph_imp_topk(C, sd, sr);
    sd = wave_sum(sd); sr = wave_sum(sr);
    if (ORACLE == 5 && (threadIdx.x & 63) == 0) { atomicAdd((float*)(C.ctl + CW_ORA), sd * sd > 0.f ? sd : 0.f); atomicAdd((float*)(C.ctl + CW_ORA + 64), sr); }
}
#endif
#if defined(ORACLE) && ORACLE == 3
__global__ void __launch_bounds__(256) k_oracle3a(Args args) {
    Ctx C; mkctx(C, args, (LAS unsigned char*)nullptr);
    const int NR = NB * NCMP * 2;
    for (int i = blockIdx.x * 256 + threadIdx.x; i < 2 * NR * 256; i += gridDim.x * 256) {
        const int j = i % 256, row = (i / 256) % NR, which = i / (256 * NR);
        const int g = row % 2, n = (row / 2) % NCMP, b = row / (2 * NCMP);
        const float* pos = which ? C.cmp_pos_v : C.cmp_pos_k; const float* w1 = which ? C.cmp_w1_v : C.cmp_w1_k;
        const int off = (which ? PC_VC : PC_KC) + g * 64;
        float acc = 0.f;
        for (int l = 0; l < 32; ++l) { const bf16* xr = C.proj + ((size_t)b * S + 16 * n + l) * PITCH + off;
            for (int d = 0; d < 64; ++d) acc += (bf2f(xr[d]) + pos[l * 64 + d]) * w1[(size_t)(l * 64 + d) * 256 + j]; }
        C.scorebuf[i] = silu_f(acc);
    }
}
__global__ void __launch_bounds__(256) k_oracle3b(Args args) {
    Ctx C; mkctx(C, args, (LAS unsigned char*)nullptr);
    const int NR = NB * NCMP * 2; float sd = 0.f, sr = 0.f;
    for (int i = blockIdx.x * 256 + threadIdx.x; i < 2 * NR * 64; i += gridDim.x * 256) {
        const int d = i % 64, row = (i / 64) % NR, which = i / (64 * NR);
        const float* w2 = which ? C.cmp_w2_v : C.cmp_w2_k; const float* hr = C.scorebuf + ((size_t)which * NR + row) * 256;
        float acc = 0.f; for (int j = 0; j < 256; ++j) acc += hr[j] * w2[j * 64 + d];
        const int g = row % 2, n = (row / 2) % NCMP, b = row / (2 * NCMP);
        const float got = bf2f(C.kvc16[((((size_t)which * 8 + b) * 2 + g) * 128 + n) * 64 + d]);
        const float got2 = C.kvc[i];
        sd += (got - acc) * (got - acc) + (got2 - acc) * (got2 - acc); sr += 2.f * acc * acc;
    }
    sd = wave_sum(sd); sr = wave_sum(sr);
    if ((threadIdx.x & 63) == 0) { atomicAdd((float*)(C.ctl + CW_ORA), sd); atomicAdd((float*)(C.ctl + CW_ORA + 64), sr); }
}
#endif
#if defined(ORACLE) && ORACLE < 3
__global__ void __launch_bounds__(256) k_oracle(Args args) {
    Ctx C; mkctx(C, args, (LAS unsigned char*)nullptr);
    C.gtid = blockIdx.x * 256 + threadIdx.x; C.GT = gridDim.x * 256;
    oracle_attn<ORACLE>(C);
}
#endif
constexpr int N_PHASES = 17;
__global__ void __launch_bounds__(NTHR, 2) mk_fwd(Args args) {
    extern __shared__ __attribute__((aligned(16))) unsigned char lds[];
    volatile LAS unsigned* MISC = (volatile LAS unsigned*)((LAS unsigned char*)lds + MISC_OFF);
    if (threadIdx.x < 32) MISC[threadIdx.x] = 0u;
    __syncthreads();
    (void)xcd_barrier_post((unsigned*)((gu32*)(args.ws + WS_CTL) + CW_BAR) + args.li * XCD_BAR_WORDS, MISC + 8);
#define bar (XcdBarrier{(unsigned*)((gu32*)(args.ws + WS_CTL) + CW_BAR) + args.li * XCD_BAR_WORDS, xb_xcc_id(), (volatile LAS unsigned*)((LAS unsigned char*)lds + MISC_OFF) + 8})
    const int lo = args.ph_lo, hi = args.ph_hi;
#ifndef PHASE_MASK
#define PHASE_MASK 0xffffffffu
#endif
#define IN(k) (((PHASE_MASK >> (k)) & 1u) && lo <= (k) && (k) < hi)
#define SEAM(k) do { if (IN(k) && IN((k) + 1)) xcd_barrier(bar); } while (0)
#ifndef DUP_MASK
#define DUP_MASK 0u
#endif
#define DUP(k) (((DUP_MASK >> (k)) & 1u) != 0u)
    if (IN(0)) { Ctx C; mkctx(C, args, (LAS unsigned char*)lds); ph_mod(C); ph_prologue(C); }
    SEAM(0);
    if (IN(1)) { Ctx C; mkctx(C, args, (LAS unsigned char*)lds); for (int rep = 0; rep < (DUP(1) ? 2 : 1); ++rep) { if (rep) xcd_barrier(bar); ph_hpass(C); } }
    SEAM(1);
    if (IN(2)) { Ctx C; mkctx(C, args, (LAS unsigned char*)lds);
        pg8::Gemm g{C.hbuf, C.win_t, T, 3072, D}; pg8::StaticOrder So; So.init(T, 3072, (int)gridDim.x, (int)blockIdx.x);
        pg8::EpiProj E{C.proj, C.fg, PITCH, C2};
        for (int rep = 0; rep < (DUP(2) ? 2 : 1); ++rep) { if (rep) xcd_barrier(bar); pg8::gemm_phase<pg8::EpiProj, pg8::StaticOrder, true, true>(C.lds, g, So, E); }
    }
    SEAM(2);
    if (IN(3)) { Ctx C; mkctx(C, args, (LAS unsigned char*)lds); for (int rep = 0; rep < (DUP(3) ? 2 : 1); ++rep) { if (rep) xcd_barrier(bar); ph_cum_cmp1(C); ph_compress(C); } }
    if (IN(3) && IN(5)) xcd_barrier(bar);
    if (IN(5)) { Ctx C; mkctx(C, args, (LAS unsigned char*)lds); for (int rep = 0; rep < (DUP(5) ? 2 : 1); ++rep) { if (rep) xcd_barrier(bar); ph_cmp_attn(C, (char*)lds); ph_attn_a(C, (char*)lds); } }
    if (IN(5) && IN(7)) xcd_barrier(bar);
    if (IN(7)) { Ctx C; mkctx(C, args, (LAS unsigned char*)lds); for (int rep = 0; rep < (DUP(7) ? 2 : 1); ++rep) { if (rep) xcd_barrier(bar); ph_attn_b(C, (char*)lds); } }
    SEAM(7);
    if (IN(8)) { Ctx C; mkctx(C, args, (LAS unsigned char*)lds);
        pg8::Gemm g{C.ao16, C.wout_t, T, D, D}; pg8::StaticOrder So; So.init(T, D, (int)gridDim.x, (int)blockIdx.x);
        pg8::EpiOut E{C.x, C.mod, C.out, ALPHA};
        for (int rep = 0; rep < (DUP(8) ? 2 : 1); ++rep) { if (rep) xcd_barrier(bar); pg8::gemm_phase<pg8::EpiOut, pg8::StaticOrder, true, true>(C.lds, g, So, E); }
    }
    SEAM(8);
    if (IN(9)) { Ctx C; mkctx(C, args, (LAS unsigned char*)lds); ph_ln<1>(C); for (int rep = 0; rep < (DUP(9) ? 2 : 1); ++rep) { if (rep) xcd_barrier(bar); ph_convert_experts(C); } }
    SEAM(9);
    if (IN(10)) { Ctx C; mkctx(C, args, (LAS unsigned char*)lds); ph_router_route(C); }
    if (IN(10) && IN(12)) xcd_barrier(bar);
    if (IN(12)) { Ctx C; mkctx(C, args, (LAS unsigned char*)lds); for (int rep = 0; rep < (DUP(12) ? 2 : 1); ++rep) { if (rep) xcd_barrier(bar); ph_moe_gateup(C); } }
    SEAM(12);
    if (IN(13)) { Ctx C; mkctx(C, args, (LAS unsigned char*)lds); for (int rep = 0; rep < (DUP(13) ? 2 : 1); ++rep) { if (rep) xcd_barrier(bar); ph_moe_down<0>(C); } }
    SEAM(13);
    if (IN(14)) { Ctx C; mkctx(C, args, (LAS unsigned char*)lds); ph_combine<0>(C); }
    SEAM(14);
    if (IN(15)) { Ctx C; mkctx(C, args, (LAS unsigned char*)lds); for (int rep = 0; rep < (DUP(15) ? 2 : 1); ++rep) { if (rep) xcd_barrier(bar); ph_moe_down<1>(C); } }
    SEAM(15);
    if (IN(16)) { Ctx C; mkctx(C, args, (LAS unsigned char*)lds); ph_combine<1>(C); }
#undef IN
#undef SEAM
#undef bar
}

extern "C" void kernel_launch(void* const* d_in, const int* in_sizes, int n_in, void* d_out, int out_size, void* d_ws, size_t ws_size, hipStream_t stream) {
    static int grid = 0;
    if (grid == 0) {
        if (n_in != 26 || out_size != T * D || ws_size < WS_END) { fprintf(stderr, "kernel_launch: unexpected problem (n_in %d out %d ws %zu)\n", n_in, out_size, ws_size); grid = -1; return; }
        int dev = 0, cus = 0, per_cu = 0;
        if (hipGetDevice(&dev) != hipSuccess || hipDeviceGetAttribute(&cus, hipDeviceAttributeMultiprocessorCount, dev) != hipSuccess) { grid = -1; return; }
        if (hipFuncSetAttribute((const void*)mk_fwd, hipFuncAttributeMaxDynamicSharedMemorySize, LDS_BYTES) != hipSuccess) { fprintf(stderr, "kernel_launch: hipFuncSetAttribute failed\n"); grid = -1; return; }
        if (hipOccupancyMaxActiveBlocksPerMultiprocessor(&per_cu, (const void*)mk_fwd, NTHR, LDS_BYTES) != hipSuccess || per_cu < 1) { fprintf(stderr, "kernel_launch: occupancy query says %d\n", per_cu); grid = -1; (void)hipGetLastError(); return; }
        grid = cus;
    }
    if (grid < 0) return;
    (void)hipMemsetAsync((char*)d_ws + WS_CTL, 0, CTL_ZERO_BYTES, stream);
    Args a{};
    for (int i = 0; i < 26; ++i) a.in[i] = (const float*)d_in[i];
    a.out = (float*)d_out; a.ws = (unsigned char*)d_ws; a.ph_lo = 0; a.ph_hi = N_PHASES;
#ifdef ORACLE
    a.ph_hi = 8; hipLaunchKernelGGL(mk_fwd, dim3(grid), dim3(NTHR), LDS_BYTES, stream, a);
#if ORACLE >= 4
    hipLaunchKernelGGL(k_oracle4a, dim3(512), dim3(256), 0, stream, a); hipLaunchKernelGGL(k_oracle4b, dim3(128), dim3(256), 0, stream, a);
#elif ORACLE == 3
    hipLaunchKernelGGL(k_oracle3a, dim3(2048), dim3(256), 0, stream, a); hipLaunchKernelGGL(k_oracle3b, dim3(512), dim3(256), 0, stream, a);
#else
    hipLaunchKernelGGL(k_oracle, dim3(NB * 8 * S / 256), dim3(256), 0, stream, a);
#endif
    a.ph_lo = 8; a.ph_hi = N_PHASES; a.li = 1;
#endif
    hipLaunchKernelGGL(mk_fwd, dim3(grid), dim3(NTHR), LDS_BYTES, stream, a);
}
```

```cpp
#include <hip/hip_runtime.h>
#include <cstdio>
#include <cstdint>
#include <hip/hip_bf16.h>
#include <cmath>

#define GAS __attribute__((address_space(1)))
#define LAS __attribute__((address_space(3)))
typedef unsigned short bf16;
typedef float f32x4 __attribute__((ext_vector_type(4)));
typedef unsigned u32x4 __attribute__((ext_vector_type(4)));
typedef unsigned u32x2 __attribute__((ext_vector_type(2)));
typedef GAS unsigned gu32;
#define RLX_AGENT __ATOMIC_RELAXED, __HIP_MEMORY_SCOPE_AGENT

constexpr int D = 1024, NB = 8, S = 2048, T = NB * S;
constexpr int NPROJ = 2848;
constexpr int PITCH = 2816;
constexpr int PC_FQ = 0, PC_FK = 512, PC_FV = 1024, PC_NQ = 1536, PC_KC = 2048, PC_VC = 2176, PC_KS = 2304, PC_VS = 2432, PC_KW = 2560, PC_VW = 2688;
constexpr int FGW = 32;
constexpr int NCMP = 127;
constexpr float ALPHA = 1.189207115002721f;
constexpr float LN_EPS = 1e-5f;
constexpr float LOG2E = 1.4426950408889634f;
constexpr float C2 = 0.125f * LOG2E;
constexpr int NWAVES = 8, NTHR = NWAVES * 64;

constexpr size_t MiB = 1u << 20;
constexpr size_t WS_CTL = 0, CTL_ZERO_BYTES = 1 * MiB;
constexpr size_t WS_MOD = 1 * MiB, WS_CUM = 2 * MiB, WS_KVC = 3 * MiB, WS_W1T = 4 * MiB  , WS_KVC16 = 6 * MiB  , WS_W2T = 21 * MiB  , WS_POSB = 21 * MiB + 65536  , WS_WRT = 21 * MiB + 131072  , WS_SELM = 8 * MiB, WS_SCB = 9 * MiB, WS_SCORES = 13 * MiB,
                 WS_EIDX = 17 * MiB, WS_EW = 18 * MiB, WS_FG = 19 * MiB;
constexpr size_t WS_WIN_T = 22 * MiB;
constexpr size_t WS_WOUT_T = 28 * MiB;
constexpr size_t WS_HBUF = 30 * MiB;
constexpr size_t WS_PROJ = 62 * MiB;
constexpr size_t WS_PC = 150 * MiB;
constexpr size_t WS_AO16 = 214 * MiB;
constexpr size_t WS_OC = 246 * MiB, WS_OW = 262 * MiB;
constexpr size_t WS_WGU = 94 * MiB;
constexpr size_t WS_WDN = 167 * MiB;
constexpr size_t WS_ACT16 = 200 * MiB;
constexpr size_t WS_SLOT = 22 * MiB;
constexpr size_t WS_LROW = 280 * MiB, WS_LW = 285 * MiB;
constexpr size_t WS_END = 290 * MiB;
constexpr int CW_CNT = 16384;
constexpr int CW_BAR = 4096;

constexpr int LDS_BYTES = 147456;
constexpr int MISC_OFF = 131072 + 320;
constexpr int LDS_TSTART = 131072 + 1024, LDS_CNT = 131072 + 1536, LDS_TAB = 131072 + 2048;

#define XB_TMO      128
#define XB_XCNT(j)  (256  + 64 * (j))
#define XB_XSUB(j)  (1280 + 64 * (j))
#define XB_XGEN(j)  (2304 + 64 * (j))
#define XB_TOP      3328
#define XB_TOPGEN   3392
#define XCD_BAR_WORDS 3456
#define XB_SPIN_CAP (1u << 20)
__device__ __forceinline__ unsigned xb_ld(unsigned* p)              { return __hip_atomic_load(p, __ATOMIC_RELAXED, __HIP_MEMORY_SCOPE_AGENT); }
__device__ __forceinline__ unsigned xb_add(unsigned* p, unsigned v) { return __hip_atomic_fetch_add(p, v, __ATOMIC_RELAXED, __HIP_MEMORY_SCOPE_AGENT); }
__device__ __forceinline__ unsigned xb_xcc_id() { return (unsigned)__builtin_amdgcn_s_getreg((3 << 11) | 20) & 0xFu; }
#define XB_SPIN(cond, bar) do { unsigned _sp = 0; while (cond) { __builtin_amdgcn_s_sleep(1); \
    if ((++_sp & 255u) == 0u) { if (xb_ld(&(bar)[XB_TMO])) break; if (_sp > XB_SPIN_CAP) { atomicAdd(&(bar)[XB_TMO], 1u); break; } } } } while (0)
struct XcdBarrier { unsigned* bar; unsigned x; volatile LAS unsigned* st; };
__device__ __forceinline__ XcdBarrier xcd_barrier_post(unsigned* bar, volatile LAS unsigned* st) {
    XcdBarrier b; b.bar = bar; b.x = xb_xcc_id(); b.st = st;
    if (threadIdx.x == 0) (void)xb_add(&bar[XB_XCNT(b.x)], 1u);
    return b;
}
__device__ __forceinline__ void xcd_barrier_complete(unsigned* bar, unsigned x, unsigned& nloc, unsigned& nx) {
    const unsigned G = gridDim.x * gridDim.y * gridDim.z;
    unsigned sum, cnt, mine, sp = 0u;
    for (;;) {
        sum = 0u; cnt = 0u; mine = 0u;
#pragma unroll
        for (unsigned j = 0; j < 16; ++j) { const unsigned c = xb_ld(&bar[XB_XCNT(j)]); sum += c; cnt += (c > 0u) ? 1u : 0u; mine = (j == x) ? c : mine; }
        if (sum == G) break;
        __builtin_amdgcn_s_sleep(1);
        if ((++sp & 255u) == 0u) { if (xb_ld(&bar[XB_TMO])) break; if (sp > XB_SPIN_CAP) { atomicAdd(&bar[XB_TMO], 1u); break; } }
    }
    nloc = mine > 0u ? mine : 1u; nx = cnt > 0u ? cnt : 1u;
}
__device__ __forceinline__ void xcd_barrier(const XcdBarrier& b) {
    asm volatile("s_waitcnt vmcnt(0)" ::: "memory");
    __syncthreads();
    if (threadIdx.x == 0) {
        unsigned* bar = b.bar;
        __builtin_amdgcn_s_waitcnt(0);
        unsigned nloc = b.st[0], nx = b.st[1];
        if (nloc == 0u) { xcd_barrier_complete(bar, b.x, nloc, nx); b.st[0] = nloc; b.st[1] = nx; }
        const unsigned old = xb_add(&bar[XB_XSUB(b.x)], 1u);
        const unsigned gen = old / nloc;
        if (old + 1u == (gen + 1u) * nloc) {
            __builtin_amdgcn_fence(__ATOMIC_RELEASE, "agent");
            asm volatile("s_waitcnt vmcnt(0)" ::: "memory");
            const unsigned og = xb_add(&bar[XB_TOP], 1u);
            const unsigned tg = og / nx;
            if (og + 1u == (tg + 1u) * nx) xb_add(&bar[XB_TOPGEN], 1u);
            else XB_SPIN(xb_ld(&bar[XB_TOPGEN]) == tg, bar);
            __builtin_amdgcn_fence(__ATOMIC_ACQUIRE, "agent");
            xb_add(&bar[XB_XGEN(b.x)], 1u);
            asm volatile("s_waitcnt vmcnt(0)" ::: "memory");
        } else {
            XB_SPIN(xb_ld(&bar[XB_XGEN(b.x)]) == gen, bar);
            __builtin_amdgcn_fence(__ATOMIC_ACQUIRE, "agent");
            asm volatile("s_waitcnt vmcnt(0)" ::: "memory");
        }
    }
    __syncthreads();
}

namespace pg8 {
#define PG8_LAS __attribute__((address_space(3)))
typedef unsigned short bf16_t;
typedef short bf16x8 __attribute__((ext_vector_type(8)));
typedef float f32x4 __attribute__((ext_vector_type(4)));
typedef unsigned u32x4 __attribute__((ext_vector_type(4)));
constexpr int BM = 256, BK = 64, HALF = 128, HTB = HALF * BK * 2  , STAGE_BYTES = 8 * HTB, NXCD = 8, WGM = 8;

__host__ __device__ __forceinline__ int lds_byte(int r, int c) { const int st = (r >> 4) * 2 + (c >> 5), rr = r & 15, cc = c & 31, ob = rr * 64 + cc * 2; return st * 1024 + (ob ^ (((ob >> 9) & 1) << 5)); }
__host__ __device__ __forceinline__ void stage_rc(int b, int& R, int& C) { const int st = b / 1024, sb = b % 1024, swz = sb ^ (((sb >> 9) & 1) << 5); R = (st >> 1) * 16 + swz / 64; C = (st & 1) * 32 + (swz % 64) / 2; }
__host__ __device__ __forceinline__ int perm32(int rho) { const int n = rho >> 4, i = rho & 15; return 8 * (i >> 2) + 4 * n + (i & 3); }

struct Unit { int pm, pn; };
struct Gemm { const bf16_t* A; const bf16_t* Bt; int M, N, K; };

struct StaticOrder {
    int nM, nN, nwg, G, c;
    __host__ __device__ void init(int M, int N, int G_, int c_) { nM = M / BM; nN = N / BM; nwg = nM * nN; G = G_; c = c_; }
    __host__ __device__ bool next(int i, Unit& u) const {
        const long L = (long)i * G + c; if (L >= nwg) return false;
        int wgid = (int)L; { const int q = nwg / NXCD, r = nwg % NXCD, xcd = wgid % NXCD, off = wgid / NXCD; wgid = (xcd < r ? xcd * (q + 1) : r * (q + 1) + (xcd - r) * q) + off; }
        const int nig = WGM * nN, gid = wgid / nig, fm = gid * WGM, gsz = (nM - fm) < WGM ? (nM - fm) : WGM;
        u.pm = fm + ((wgid % nig) % gsz); u.pn = (wgid % nig) / gsz; return true;
    }
    __device__ __forceinline__ void a_ready(const Unit&) const {}
    __device__ __forceinline__ void done(const Unit&) const {}
};


__device__ __forceinline__ unsigned cvt_pk_bf16(float lo, float hi) { unsigned r; asm volatile("v_cvt_pk_bf16_f32 %0, %1, %2" : "=v"(r) : "v"(lo), "v"(hi)); return r; }
struct EpiProj {
    static constexpr bool PERM = true, AFTER_DRAIN = false;
    bf16_t* proj; float* fg; int pitch; float qscale;
    __device__ __forceinline__ void operator()(const f32x4 (&acc)[2][2][4][2], const Unit& u, int wr, int wc, int fr, int fq) const {
        const int row0 = u.pm * BM + wr * 64 + fr;
        if (u.pn < 11) {
            const float sc = (u.pn < 2 || u.pn == 6 || u.pn == 7) ? qscale : 1.f;
            const int col0 = u.pn * BM + wc * 32 + 8 * fq;
#pragma unroll
            for (int ai = 0; ai < 2; ++ai)
#pragma unroll
                for (int m = 0; m < 4; ++m) { bf16_t* rowp = proj + (size_t)(row0 + ai * HALF + m * 16) * pitch + col0;
#pragma unroll
                    for (int bj = 0; bj < 2; ++bj) { const f32x4 v0 = acc[ai][bj][m][0] * sc, v1 = acc[ai][bj][m][1] * sc;
                        u32x4 w; w.x = cvt_pk_bf16(v0[0], v0[1]); w.y = cvt_pk_bf16(v0[2], v0[3]); w.z = cvt_pk_bf16(v1[0], v1[1]); w.w = cvt_pk_bf16(v1[2], v1[3]);
                        *(u32x4*)(rowp + bj * HALF) = w; } }
        } else if (wc == 0) {
#pragma unroll
            for (int ai = 0; ai < 2; ++ai)
#pragma unroll
                for (int m = 0; m < 4; ++m) { float* fp = fg + (size_t)(row0 + ai * HALF + m * 16) * 32 + 8 * fq;
                    *(f32x4*)fp = acc[ai][0][m][0]; *(f32x4*)(fp + 4) = acc[ai][0][m][1]; }
        }
    }
};
struct EpiOut {
    static constexpr bool PERM = false, AFTER_DRAIN = false;
    const float* x; const float* mod; float* out; float alpha;
    __device__ __forceinline__ void operator()(const f32x4 (&acc)[2][2][4][2], const Unit& u, int wr, int wc, int fr, int fq) const {
        const int row0 = u.pm * BM + wr * 64 + fr;
#pragma unroll
        for (int ai = 0; ai < 2; ++ai)
#pragma unroll
            for (int m = 0; m < 4; ++m) { const int r = row0 + ai * HALF + m * 16; const float* g1 = mod + (r / 2048) * 6144 + 2048;
#pragma unroll
                for (int bj = 0; bj < 2; ++bj)
#pragma unroll
                    for (int n = 0; n < 2; ++n) { const int c = u.pn * BM + bj * HALF + wc * 32 + 16 * n + 4 * fq;
                        const f32x4 xv = *(const f32x4*)(x + (size_t)r * 1024 + c), gv = *(const f32x4*)(g1 + c);
                        *(f32x4*)(out + (size_t)r * 1024 + c) = xv * alpha + gv * acc[ai][bj][m][n]; } }
    }
};
template <class Epi, class Sched, bool ALIGN_EPI = false, bool SP2 = false>
__device__ __forceinline__ void gemm_phase(PG8_LAS unsigned char* lds, const Gemm g, const Sched& S, const Epi& E) {
    int tid_ = threadIdx.x; asm volatile("" : "+v"(tid_));
    const int tid = tid_, wid = __builtin_amdgcn_readfirstlane(tid >> 6), lane = tid & 63, wr = wid >> 2, wc = wid & 3, fr = lane & 15, fq = lane >> 4;
    const int K = g.K, nt = K / BK;
    unsigned voffA[2], voffB[2];
#pragma unroll
    for (int i = 0; i < 2; ++i) { int R, C; stage_rc(tid * 16 + i * 8192, R, C); const int Rb = Epi::PERM ? ((R & ~31) + perm32(R & 31)) : R;
        voffA[i] = (unsigned)(R * K + C) * 2u; voffB[i] = (unsigned)(Rb * K + C) * 2u; }
    const size_t kstep = (size_t)(BK * 2);
    const size_t hstep = (size_t)HALF * K * 2;
    const size_t tstep = 2 * hstep;
    const unsigned ldsw = (unsigned)wid * 1024u;
    const int aoff = lds_byte(wr * 64 + fr, fq * 8), boff = lds_byte(wc * 32 + fr, fq * 8);
#define PG8_SA(b, h) (((b) * 2 + (h)) * HTB)
#define PG8_SB(b, h) ((4 + (b) * 2 + (h)) * HTB)
#define PG8_STAGE(bufoff, gbase, voff) do { _Pragma("unroll") for (int _i = 0; _i < 2; ++_i) \
        __builtin_amdgcn_global_load_lds((const unsigned*)((const char*)(gbase) + (voff)[_i]), (PG8_LAS unsigned*)(lds + (bufoff) + ldsw + _i * 8192), 16, 0, 0); } while (0)
#define PG8_LDA(dst, b, h) do { _Pragma("unroll") for (int m = 0; m < 4; ++m) _Pragma("unroll") for (int k = 0; k < 2; ++k) dst[m][k] = *(const PG8_LAS bf16x8*)(lds + PG8_SA(b, h) + aoff + m * 2048 + k * 1024); } while (0)
#define PG8_LDB(dst, b, h) do { _Pragma("unroll") for (int n = 0; n < 2; ++n) _Pragma("unroll") for (int k = 0; k < 2; ++k) dst[n][k] = *(const PG8_LAS bf16x8*)(lds + PG8_SB(b, h) + boff + n * 2048 + k * 1024); } while (0)
#define PG8_MMA(ai, bj, At, Bt) do { __builtin_amdgcn_s_setprio(1); _Pragma("unroll") for (int m = 0; m < 4; ++m) _Pragma("unroll") for (int n = 0; n < 2; ++n) _Pragma("unroll") for (int k = 0; k < 2; ++k) \
        acc[ai][bj][m][n] = __builtin_amdgcn_mfma_f32_16x16x32_bf16(Bt[n][k], At[m][k], acc[ai][bj][m][n], 0, 0, 0); __builtin_amdgcn_s_setprio(0); } while (0)
#define PG8_WAIT_V(n) asm volatile("s_waitcnt vmcnt(" #n ")" ::: "memory")
#define PG8_WAIT_L(n) asm volatile("s_waitcnt lgkmcnt(" #n ")" ::: "memory")
#define PG8_BAR __builtin_amdgcn_s_barrier()
#define PG8_SCHED __builtin_amdgcn_sched_barrier(0)
    Unit cur, nxt; int ui = 0;
    if (!S.next(0, cur)) return;
    f32x4 acc[2][2][4][2];
#pragma unroll
    for (int a = 0; a < 2; ++a)
#pragma unroll
        for (int b = 0; b < 2; ++b)
#pragma unroll
            for (int m = 0; m < 4; ++m)
#pragma unroll
                for (int n = 0; n < 2; ++n) acc[a][b][m][n] = (f32x4){0.f, 0.f, 0.f, 0.f};
    bf16x8 At[4][2], B0[2][2], B1[2][2];
    const char* cA = (const char*)g.A + (size_t)cur.pm * tstep; const char* cB = (const char*)g.Bt + (size_t)cur.pn * tstep;
    S.a_ready(cur);
    if constexpr (SP2) {
        PG8_STAGE(PG8_SB(0, 0), cB, voffB); PG8_STAGE(PG8_SB(0, 1), cB + hstep, voffB); PG8_STAGE(PG8_SA(0, 0), cA, voffA); PG8_STAGE(PG8_SA(0, 1), cA + hstep, voffA);
        if (wr == 1) PG8_BAR;
        PG8_WAIT_V(2); PG8_BAR;
        PG8_STAGE(PG8_SB(1, 0), cB + kstep, voffB); PG8_STAGE(PG8_SA(1, 0), cA + kstep, voffA); PG8_STAGE(PG8_SB(1, 1), cB + hstep + kstep, voffB);
        PG8_WAIT_V(6); PG8_BAR;
    } else {
        PG8_STAGE(PG8_SB(0, 0), cB, voffB); PG8_STAGE(PG8_SA(0, 0), cA, voffA); PG8_STAGE(PG8_SB(0, 1), cB + hstep, voffB); PG8_STAGE(PG8_SA(0, 1), cA + hstep, voffA);
        if (wr == 1) PG8_BAR;
        PG8_WAIT_V(4); PG8_BAR;
        PG8_STAGE(PG8_SB(1, 0), cB + kstep, voffB); PG8_STAGE(PG8_SA(1, 0), cA + kstep, voffA); PG8_STAGE(PG8_SB(1, 1), cB + hstep + kstep, voffB);
        PG8_WAIT_V(6); PG8_BAR;
    }
    for (;;) {
        const bool has_next = S.next(ui + 1, nxt);
        const char* nA = has_next ? (const char*)g.A + (size_t)nxt.pm * tstep : cA; const char* nB = has_next ? (const char*)g.Bt + (size_t)nxt.pn * tstep : cB;
        for (int t = 0; t < nt; t += 2) {
            const bool last = (t == nt - 2);
            const char* a1 = cA + (size_t)(t + 1) * kstep;
            const char* a2 = last ? nA : cA + (size_t)(t + 2) * kstep; const char* b2 = last ? nB : cB + (size_t)(t + 2) * kstep;
            const char* a3 = a2 + kstep; const char* b3 = b2 + kstep;
            if (last && has_next) S.a_ready(nxt);
            if constexpr (SP2) {
            PG8_LDB(B0, 0, 0); PG8_LDB(B1, 0, 1); PG8_SCHED; PG8_LDA(At, 0, 0); PG8_STAGE(PG8_SA(1, 1), a1 + hstep, voffA);
            PG8_WAIT_V(8); PG8_WAIT_L(0); PG8_BAR; PG8_MMA(0, 0, At, B0); PG8_MMA(0, 1, At, B1); PG8_BAR; PG8_SCHED;
            PG8_LDA(At, 0, 1); PG8_STAGE(PG8_SB(0, 0), b2, voffB); PG8_STAGE(PG8_SB(0, 1), b2 + hstep, voffB); PG8_STAGE(PG8_SA(0, 0), a2, voffA);
            PG8_WAIT_V(8); PG8_WAIT_L(0); PG8_BAR; PG8_MMA(1, 0, At, B0); PG8_MMA(1, 1, At, B1); PG8_BAR; PG8_SCHED;
            PG8_LDB(B0, 1, 0); PG8_LDB(B1, 1, 1); PG8_SCHED; PG8_LDA(At, 1, 0); PG8_STAGE(PG8_SA(0, 1), a2 + hstep, voffA);
            PG8_WAIT_V(8); PG8_WAIT_L(0); PG8_BAR; PG8_MMA(0, 0, At, B0); PG8_MMA(0, 1, At, B1); PG8_BAR; PG8_SCHED;
            PG8_LDA(At, 1, 1); PG8_STAGE(PG8_SB(1, 0), b3, voffB); PG8_STAGE(PG8_SB(1, 1), b3 + hstep, voffB); PG8_STAGE(PG8_SA(1, 0), a3, voffA);
            PG8_WAIT_V(8); PG8_WAIT_L(0); PG8_BAR; PG8_MMA(1, 0, At, B0); PG8_MMA(1, 1, At, B1); PG8_BAR; PG8_SCHED;
            } else {
            PG8_LDB(B0, 0, 0); PG8_SCHED; PG8_LDA(At, 0, 0); PG8_STAGE(PG8_SA(1, 1), a1 + hstep, voffA);
            PG8_WAIT_L(8); PG8_BAR; PG8_WAIT_L(0); PG8_MMA(0, 0, At, B0); PG8_BAR; PG8_SCHED;
            PG8_LDB(B1, 0, 1); PG8_STAGE(PG8_SB(0, 0), b2, voffB);
            PG8_BAR; PG8_WAIT_L(0); PG8_MMA(0, 1, At, B1); PG8_BAR;
            PG8_LDA(At, 0, 1); PG8_STAGE(PG8_SA(0, 0), a2, voffA);
            PG8_BAR; PG8_WAIT_L(0); PG8_MMA(1, 0, At, B0); PG8_BAR; PG8_SCHED;
            PG8_STAGE(PG8_SB(0, 1), b2 + hstep, voffB);
            PG8_WAIT_V(6); PG8_BAR; PG8_MMA(1, 1, At, B1); PG8_BAR;
            PG8_LDB(B0, 1, 0); PG8_SCHED; PG8_LDA(At, 1, 0); PG8_STAGE(PG8_SA(0, 1), a2 + hstep, voffA);
            PG8_WAIT_L(8); PG8_BAR; PG8_WAIT_L(0); PG8_MMA(0, 0, At, B0); PG8_BAR; PG8_SCHED;
            PG8_LDB(B1, 1, 1); PG8_STAGE(PG8_SB(1, 0), b3, voffB);
            PG8_BAR; PG8_WAIT_L(0); PG8_MMA(0, 1, At, B1); PG8_BAR;
            PG8_LDA(At, 1, 1); PG8_STAGE(PG8_SA(1, 0), a3, voffA);
            PG8_BAR; PG8_WAIT_L(0); PG8_MMA(1, 0, At, B0); PG8_BAR; PG8_SCHED;
            PG8_STAGE(PG8_SB(1, 1), b3 + hstep, voffB);
            PG8_WAIT_V(6); PG8_BAR; PG8_MMA(1, 1, At, B1); PG8_BAR;
            }
        }
        if constexpr (ALIGN_EPI) { if (wr == 0) PG8_BAR; }
        if constexpr (!Epi::AFTER_DRAIN) { E(acc, cur, wr, wc, fr, fq); S.done(cur); }
        if (!has_next) break;
#pragma unroll
        for (int a = 0; a < 2; ++a)
#pragma unroll
            for (int b = 0; b < 2; ++b)
#pragma unroll
                for (int m = 0; m < 4; ++m)
#pragma unroll
                    for (int n = 0; n < 2; ++n) acc[a][b][m][n] = (f32x4){0.f, 0.f, 0.f, 0.f};
        cur = nxt; cA = nA; cB = nB; ++ui;
        if constexpr (ALIGN_EPI) { if (wr == 1) PG8_BAR; }
    }
    PG8_WAIT_V(0);
    if constexpr (!ALIGN_EPI) { if (wr == 0) PG8_BAR; }
    PG8_BAR;
    if constexpr (Epi::AFTER_DRAIN) { E.fused(acc, cur, wr, wc, fr, fq, lds, wid, lane); S.done(cur); }
#undef PG8_SA
#undef PG8_SB
#undef PG8_STAGE
#undef PG8_LDA
#undef PG8_LDB
#undef PG8_MMA
#undef PG8_WAIT_V
#undef PG8_WAIT_L
#undef PG8_BAR
#undef PG8_SCHED
}
struct UnitM { int e, mt, pn, arow0, nvalid; };
constexpr int TAB_SLOT_BYTES = 2048;
template <class Epi, class Sched, bool GATHER>
__device__ __forceinline__ void gemm_phase_g(PG8_LAS unsigned char* lds, PG8_LAS unsigned char* tab, const bf16_t* A, const int K, const Sched& S, const Epi& E) {
    int tid_ = threadIdx.x; asm volatile("" : "+v"(tid_));
    const int tid = tid_, wid = __builtin_amdgcn_readfirstlane(tid >> 6), lane = tid & 63, wr = wid >> 2, wc = wid & 3, fr = lane & 15, fq = lane >> 4;
    const int nt = K / BK;
    unsigned voffB[2];
#pragma unroll
    for (int i = 0; i < 2; ++i) { int R, C; stage_rc(tid * 16 + i * 8192, R, C); const int Rb = Epi::PERM ? ((R & ~31) + perm32(R & 31)) : R;
        voffB[i] = (unsigned)(Rb * K + C) * 2u; }
    const size_t kstep = (size_t)(BK * 2);
    const size_t hstep = (size_t)HALF * K * 2;
    const unsigned ldsw = (unsigned)wid * 1024u;
    const int aoff = lds_byte(wr * 64 + fr, fq * 8), boff = lds_byte(wc * 32 + fr, fq * 8);
#define PG8_SA(b, h) (((b) * 2 + (h)) * HTB)
#define PG8_SB(b, h) ((4 + (b) * 2 + (h)) * HTB)
#define PG8_STAGE(bufoff, gbase, voff) do { _Pragma("unroll") for (int _i = 0; _i < 2; ++_i) \
        __builtin_amdgcn_global_load_lds((const unsigned*)((const char*)(gbase) + (voff)[_i]), (PG8_LAS unsigned*)(lds + (bufoff) + ldsw + _i * 8192), 16, 0, 0); } while (0)
#define PG8_STAGEA(bufoff, gbase, o0, o1) do { \
        __builtin_amdgcn_global_load_lds((const unsigned*)((const char*)(gbase) + (o0)), (PG8_LAS unsigned*)(lds + (bufoff) + ldsw), 16, 0, 0); \
        __builtin_amdgcn_global_load_lds((const unsigned*)((const char*)(gbase) + (o1)), (PG8_LAS unsigned*)(lds + (bufoff) + ldsw + 8192), 16, 0, 0); } while (0)
#define PG8_LDA(dst, b, h) do { _Pragma("unroll") for (int m = 0; m < 4; ++m) _Pragma("unroll") for (int k = 0; k < 2; ++k) dst[m][k] = *(const PG8_LAS bf16x8*)(lds + PG8_SA(b, h) + aoff + m * 2048 + k * 1024); } while (0)
#define PG8_LDB(dst, b, h) do { _Pragma("unroll") for (int n = 0; n < 2; ++n) _Pragma("unroll") for (int k = 0; k < 2; ++k) dst[n][k] = *(const PG8_LAS bf16x8*)(lds + PG8_SB(b, h) + boff + n * 2048 + k * 1024); } while (0)
#define PG8_MMA(ai, bj, At, Bt) do { __builtin_amdgcn_s_setprio(1); _Pragma("unroll") for (int m = 0; m < 4; ++m) _Pragma("unroll") for (int n = 0; n < 2; ++n) _Pragma("unroll") for (int k = 0; k < 2; ++k) \
        acc[ai][bj][m][n] = __builtin_amdgcn_mfma_f32_16x16x32_bf16(Bt[n][k], At[m][k], acc[ai][bj][m][n], 0, 0, 0); __builtin_amdgcn_s_setprio(0); } while (0)
#define PG8_WAIT_V(n) asm volatile("s_waitcnt vmcnt(" #n ")" ::: "memory")
#define PG8_WAIT_L(n) asm volatile("s_waitcnt lgkmcnt(" #n ")" ::: "memory")
#define PG8_BAR __builtin_amdgcn_s_barrier()
#define PG8_SCHED __builtin_amdgcn_sched_barrier(0)
#define PG8_AOFFS(dst, u, tslot) do { _Pragma("unroll") for (int h = 0; h < 2; ++h) _Pragma("unroll") for (int i = 0; i < 2; ++i) { int RA_, CA_; stage_rc(tid * 16 + i * 8192, RA_, CA_); const int R_ = h * HALF + RA_; int row_; \
        if (GATHER) { const int inf_ = *(const PG8_LAS int*)(tab + (tslot) * TAB_SLOT_BYTES + R_ * 4); row_ = R_ < (u).nvalid ? (inf_ >> 4) : 0; } else row_ = (u).arow0 + R_; \
        dst[h][i] = (unsigned)(row_ * K + CA_) * 2u; } } while (0)
    UnitM cur, nxt; int ui = 0;
    if (!S.next(0, cur)) return;
    if (wid == 0) S.load_tab(cur, tab, lane);
    asm volatile("s_waitcnt vmcnt(0)" ::: "memory"); __builtin_amdgcn_s_barrier(); asm volatile("" ::: "memory");
    f32x4 acc[2][2][4][2];
#pragma unroll
    for (int a = 0; a < 2; ++a)
#pragma unroll
        for (int b = 0; b < 2; ++b)
#pragma unroll
            for (int m = 0; m < 4; ++m)
#pragma unroll
                for (int n = 0; n < 2; ++n) acc[a][b][m][n] = (f32x4){0.f, 0.f, 0.f, 0.f};
    bf16x8 At[4][2], B0[2][2], B1[2][2];
    unsigned cao[2][2];
    PG8_AOFFS(cao, cur, 0);
    const char* cB = S.b_base(cur);
    const char* Ab = (const char*)A;
    PG8_STAGE(PG8_SB(0, 0), cB, voffB); PG8_STAGE(PG8_SB(0, 1), cB + hstep, voffB); PG8_STAGEA(PG8_SA(0, 0), Ab, cao[0][0], cao[0][1]); PG8_STAGEA(PG8_SA(0, 1), Ab, cao[1][0], cao[1][1]);
    if (wr == 1) PG8_BAR;
    PG8_WAIT_V(2); PG8_BAR;
    PG8_STAGE(PG8_SB(1, 0), cB + kstep, voffB); PG8_STAGEA(PG8_SA(1, 0), Ab + kstep, cao[0][0], cao[0][1]); PG8_STAGE(PG8_SB(1, 1), cB + hstep + kstep, voffB);
    PG8_WAIT_V(6); PG8_BAR;
    for (;;) {
        const bool has_next = S.next(ui + 1, nxt);
        const int tslot_n = (ui + 1) % 3;
        if (has_next && wid == 0) S.load_tab(nxt, tab + tslot_n * TAB_SLOT_BYTES, lane);
        const char* nB = has_next ? S.b_base(nxt) : cB;
#pragma unroll 1
        for (int t = 0; t < nt; t += 2) {
            const bool last = (t == nt - 2);
            const char* a1 = Ab + (size_t)(t + 1) * kstep;
            const char* a2 = last ? Ab : Ab + (size_t)(t + 2) * kstep; const char* b2 = last ? nB : cB + (size_t)(t + 2) * kstep;
            const char* a3 = a2 + kstep; const char* b3 = b2 + kstep;
            PG8_LDB(B0, 0, 0); PG8_LDB(B1, 0, 1); PG8_SCHED; PG8_LDA(At, 0, 0); PG8_STAGEA(PG8_SA(1, 1), a1, cao[1][0], cao[1][1]);
            PG8_WAIT_V(8); PG8_WAIT_L(0); PG8_BAR; PG8_MMA(0, 0, At, B0); PG8_MMA(0, 1, At, B1); PG8_BAR; PG8_SCHED;
            if (last && has_next) { PG8_AOFFS(cao, nxt, tslot_n); }
            PG8_LDA(At, 0, 1); PG8_STAGE(PG8_SB(0, 0), b2, voffB); PG8_STAGE(PG8_SB(0, 1), b2 + hstep, voffB); PG8_STAGEA(PG8_SA(0, 0), a2, cao[0][0], cao[0][1]);
            PG8_WAIT_V(8); PG8_WAIT_L(0); PG8_BAR; PG8_MMA(1, 0, At, B0); PG8_MMA(1, 1, At, B1); PG8_BAR; PG8_SCHED;
            PG8_LDB(B0, 1, 0); PG8_LDB(B1, 1, 1); PG8_SCHED; PG8_LDA(At, 1, 0); PG8_STAGEA(PG8_SA(0, 1), a2, cao[1][0], cao[1][1]);
            PG8_WAIT_V(8); PG8_WAIT_L(0); PG8_BAR; PG8_MMA(0, 0, At, B0); PG8_MMA(0, 1, At, B1); PG8_BAR; PG8_SCHED;
            PG8_LDA(At, 1, 1); PG8_STAGE(PG8_SB(1, 0), b3, voffB); PG8_STAGE(PG8_SB(1, 1), b3 + hstep, voffB); PG8_STAGEA(PG8_SA(1, 0), a3, cao[0][0], cao[0][1]);
            PG8_WAIT_V(8); PG8_WAIT_L(0); PG8_BAR; PG8_MMA(1, 0, At, B0); PG8_MMA(1, 1, At, B1); PG8_BAR; PG8_SCHED;
        }
        if (wr == 0) PG8_BAR;
        E(acc, cur, wr, wc, fr, fq, tab + (ui % 3) * TAB_SLOT_BYTES);
        if (!has_next) break;
#pragma unroll
        for (int a = 0; a < 2; ++a)
#pragma unroll
            for (int b = 0; b < 2; ++b)
#pragma unroll
                for (int m = 0; m < 4; ++m)
#pragma unroll
                    for (int n = 0; n < 2; ++n) acc[a][b][m][n] = (f32x4){0.f, 0.f, 0.f, 0.f};
        cur = nxt; cB = nB; ++ui;
        if (wr == 1) PG8_BAR;
    }
    PG8_WAIT_V(0);
    PG8_BAR;
#undef PG8_SA
#undef PG8_SB
#undef PG8_STAGE
#undef PG8_STAGEA
#undef PG8_LDA
#undef PG8_LDB
#undef PG8_MMA
#undef PG8_WAIT_V
#undef PG8_WAIT_L
#undef PG8_BAR
#undef PG8_SCHED
#undef PG8_AOFFS
}
struct MoeSched {
    const PG8_LAS int* tstart; const PG8_LAS int* cnt;
    const int* lrow; const float* lw;
    const char* Bt; size_t e_stride, pn_stride;
    int MT, NP, pn0, G, c;
    __device__ __forceinline__ bool next(int i, UnitM& u) const {
        const int L = i * G + c; if (L >= MT * NP) return false;
        const int mtg = L / NP; u.pn = pn0 + L % NP;
        int e = 0;
        for (int k = 1; k < 65; ++k) e += (tstart[k] <= mtg) ? 1 : 0;
        u.e = e; u.mt = mtg - tstart[e]; u.arow0 = mtg * 256; const int rem = cnt[e] - u.mt * 256; u.nvalid = rem < 256 ? rem : 256;
        return true;
    }
    __device__ __forceinline__ const char* b_base(const UnitM& u) const { return Bt + (size_t)u.e * e_stride + (size_t)u.pn * pn_stride; }
    __device__ __forceinline__ void load_tab(const UnitM& u, PG8_LAS unsigned char* dst, int lane) const {
        const size_t off = (size_t)u.e * 16384 + u.mt * 256 + lane * 4;
        __builtin_amdgcn_global_load_lds((const unsigned*)(lrow + off), (PG8_LAS unsigned*)dst, 16, 0, 0);
        __builtin_amdgcn_global_load_lds((const unsigned*)(lw + off), (PG8_LAS unsigned*)(dst + 1024), 16, 0, 0);
    }
};
struct EpiAct {
    static constexpr bool PERM = true;
    bf16_t* act;
    __device__ __forceinline__ void operator()(const f32x4 (&acc)[2][2][4][2], const UnitM& u, int wr, int wc, int fr, int fq, const PG8_LAS unsigned char* tab) const {
#pragma unroll
        for (int ai = 0; ai < 2; ++ai)
#pragma unroll
            for (int m = 0; m < 4; ++m) { const int r = ai * HALF + wr * 64 + m * 16 + fr;
                float w = *(const PG8_LAS float*)(tab + 1024 + r * 4); w = r < u.nvalid ? w : 0.f;
                float v[8];
#pragma unroll
                for (int n = 0; n < 2; ++n)
#pragma unroll
                    for (int i = 0; i < 4; ++i) { const float g = acc[ai][0][m][n][i], up = acc[ai][1][m][n][i];
                        v[n * 4 + i] = g * __builtin_amdgcn_rcpf(1.f + __builtin_amdgcn_exp2f(-1.4426950408889634f * g)) * up * w; }
                u32x4 o; o.x = cvt_pk_bf16(v[0], v[1]); o.y = cvt_pk_bf16(v[2], v[3]); o.z = cvt_pk_bf16(v[4], v[5]); o.w = cvt_pk_bf16(v[6], v[7]);
                *(u32x4*)(act + (size_t)(u.arow0 + r) * 256 + u.pn * 128 + wc * 32 + 8 * fq) = o; }
    }
};
constexpr float SLOT_SCALE = 16.f;
struct EpiSlot {
    static constexpr bool PERM = true;
    unsigned char* slot; unsigned dump_row;
    __device__ __forceinline__ void operator()(const f32x4 (&acc)[2][2][4][2], const UnitM& u, int wr, int wc, int fr, int fq, const PG8_LAS unsigned char* tab) const {
#pragma unroll
        for (int ai = 0; ai < 2; ++ai)
#pragma unroll
            for (int m = 0; m < 4; ++m) { const int r = ai * HALF + wr * 64 + m * 16 + fr;
                const int inf = *(const PG8_LAS int*)(tab + r * 4);
                const unsigned srow = r < u.nvalid ? (unsigned)(inf >> 4) * 9u + (unsigned)(inf & 15) : dump_row;
                unsigned char* dst = slot + (srow * 1024u + (unsigned)(u.pn * 256 + wc * 32 + 8 * fq));
#pragma unroll
                for (int bj = 0; bj < 2; ++bj) { const f32x4 v0 = acc[ai][bj][m][0] * SLOT_SCALE, v1 = acc[ai][bj][m][1] * SLOT_SCALE;
                    int w0 = __builtin_amdgcn_cvt_pk_fp8_f32(v0[0], v0[1], 0, false); w0 = __builtin_amdgcn_cvt_pk_fp8_f32(v0[2], v0[3], w0, true);
                    int w1 = __builtin_amdgcn_cvt_pk_fp8_f32(v1[0], v1[1], 0, false); w1 = __builtin_amdgcn_cvt_pk_fp8_f32(v1[2], v1[3], w1, true);
                    typedef int i32x2 __attribute__((ext_vector_type(2)));
                    *(i32x2*)(dst + bj * HALF) = (i32x2){w0, w1}; }
                asm volatile("" ::: "memory"); }
    }
};
}

namespace attn_body {
using bf16=__hip_bfloat16;
using bf16x8=__attribute__((ext_vector_type(8)))short;
using s16x4=__attribute__((ext_vector_type(4)))short;
using f32x16=__attribute__((ext_vector_type(16)))float;
using u32x4=__attribute__((ext_vector_type(4)))unsigned;
using f32x4_t=__attribute__((ext_vector_type(4)))float;
constexpr int SEQ=2048,D=64,DM=2816;
constexpr int NW=8,QBLK=32,QB=QBLK*NW,KVBLK=64,NQB=SEQ/QB;
__device__ __forceinline__ int crow(int r,int hi){return (r&3)+8*(r>>2)+4*hi;}
#define SBAR() __builtin_amdgcn_sched_barrier(0)
__device__ __forceinline__ void cmask(f32x16&p0,f32x16&p1,int jb,int qrel,int hi){
  const float NEG=-INFINITY; int lim=qrel-64*jb-4*hi; asm volatile("":"+v"(lim));
  #pragma unroll
  for(int r=0;r<16;++r){const int c=(r&3)+8*(r>>2); if(c>lim)p0[r]=NEG; if(c+32>lim)p1[r]=NEG;}
}

typedef __attribute__((address_space(3))) const float* lds_fptr;
template<int MODE> __device__ __forceinline__ void tilefix(f32x16&p0,f32x16&p1,int t,int NT,int ta,int qrel,int hi,lds_fptr cl,lds_fptr dt,unsigned maskq,float mhat){
  const float NEG=-INFINITY;
  if(MODE==1){ if(__any(((maskq>>ta)&1u)==0u)){ const bool off=((maskq>>ta)&1u)==0u;
      #pragma unroll
      for(int r=0;r<16;++r){p0[r]=off?NEG:p0[r];p1[r]=off?NEG:p1[r];} } }
  if(MODE!=0){
    int dbase=qrel+64*(NT-4-t)-4*hi; asm volatile("":"+v"(dbase));
    if(MODE==2 && t<4){
      { int e511=dbase-511; asm volatile("":"+v"(e511));
      #pragma unroll
      for(int r=0;r<16;++r){ if(e511>((r&3)+8*(r>>2)))p0[r]=NEG; if(e511>((r&3)+8*(r>>2)+32))p1[r]=NEG; } } }
    if(t>=NT-6){
      #pragma unroll
      for(int g=0;g<4;++g){
        #pragma unroll
        for(int i=0;i<4;++i){const int r=4*g+i; const int d=dbase-((r&3)+8*(r>>2)); const int i0=min(max(d,0),127),i1=min(max(d-32,0),127); p0[r]+=dt[i0]; p1[r]+=dt[i1];}
        __builtin_amdgcn_sched_barrier(0); } }
  }
  { const int jb=t-(NT-4); if(jb>=0)cmask(p0,p1,jb,qrel,hi); }
}

constexpr int NSLOT=3, SLOTB=8192;
constexpr int LDS_K=0, LDS_V=NSLOT*SLOTB, LDS_WS=2*NSLOT*SLOTB, LDS_OST=LDS_WS+NW*64*4, LDS_CUM=LDS_OST+NW*4096, LDS_DT=LDS_CUM+8192, LDS_BYTES=LDS_DT+4096;
constexpr float C2=0.125f*1.4426950408889634f;
__device__ __forceinline__ void glds16(const void*gsrc,unsigned lds_dst){unsigned keep;
  asm volatile("s_mov_b32 %0, m0\n\ts_mov_b32 m0, %2\n\ts_nop 0\n\tglobal_load_lds_dwordx4 %1, off\n\ts_mov_b32 m0, %0":"=&s"(keep):"v"(gsrc),"s"(lds_dst):"memory");}
__device__ __forceinline__ float max3f(float a,float b,float c){float r;asm("v_max3_f32 %0, %1, %2, %3":"=v"(r):"v"(a),"v"(b),"v"(c));return r;}
__device__ __forceinline__ float max2f(float a,float b){float r;asm("v_max_f32_e32 %0, %1, %2":"=v"(r):"v"(a),"v"(b));return r;}
__device__ __forceinline__ float fadd_s(float a,float b){float r;asm("v_add_f32_e32 %0, %1, %2":"=v"(r):"v"(a),"v"(b));return r;}
__device__ __forceinline__ float fsub_s(float a,float b){float r;asm("v_sub_f32_e32 %0, %1, %2":"=v"(r):"v"(a),"v"(b));return r;}
typedef float f32x2_t __attribute__((ext_vector_type(2))); typedef __bf16 bf16x2_t __attribute__((ext_vector_type(2)));
__device__ __forceinline__ unsigned cvtpk_s(float lo,float hi){f32x2_t v={lo,hi};bf16x2_t b=__builtin_convertvector(v,bf16x2_t);return __builtin_bit_cast(unsigned,b);}
#define WAIT_BAR(N) asm volatile("s_waitcnt vmcnt(" #N ") lgkmcnt(0)\n\ts_barrier":::"memory")

__device__ __forceinline__ void qkt(f32x16&p0,f32x16&p1,const char*Kslot,const bf16x8*qr,const f32x16&ci0,const f32x16&ci1,int r32,int hi){
  const char*kb=Kslot+hi*1024+r32*16;
  #pragma unroll
  for(int d0=0;d0<4;++d0){
    const bf16x8 b0=*reinterpret_cast<const bf16x8*>(kb+d0*2048);
    const bf16x8 b1=*reinterpret_cast<const bf16x8*>(kb+d0*2048+512);
    if(d0==0){p0=__builtin_amdgcn_mfma_f32_32x32x16_bf16(b0,qr[0],ci0,0,0,0);p1=__builtin_amdgcn_mfma_f32_32x32x16_bf16(b1,qr[0],ci1,0,0,0);}
    else{p0=__builtin_amdgcn_mfma_f32_32x32x16_bf16(b0,qr[d0],p0,0,0,0);p1=__builtin_amdgcn_mfma_f32_32x32x16_bf16(b1,qr[d0],p1,0,0,0);}}
}
typedef __attribute__((address_space(3))) const char* lds_cptr;
typedef short v4i16_t __attribute__((ext_vector_type(4)));
__device__ __forceinline__ void kload8(bf16x8*kf,lds_cptr kp){
  kf[0]=*(const __attribute__((address_space(3))) bf16x8*)(kp);      kf[1]=*(const __attribute__((address_space(3))) bf16x8*)(kp+512);
  kf[2]=*(const __attribute__((address_space(3))) bf16x8*)(kp+2048); kf[3]=*(const __attribute__((address_space(3))) bf16x8*)(kp+2560);
  kf[4]=*(const __attribute__((address_space(3))) bf16x8*)(kp+4096); kf[5]=*(const __attribute__((address_space(3))) bf16x8*)(kp+4608);
  kf[6]=*(const __attribute__((address_space(3))) bf16x8*)(kp+6144); kf[7]=*(const __attribute__((address_space(3))) bf16x8*)(kp+6656);
}
__device__ __forceinline__ void kload2(bf16x8*kf,lds_cptr kp,int j){ kf[2*j]=*(const __attribute__((address_space(3))) bf16x8*)(kp+j*2048); kf[2*j+1]=*(const __attribute__((address_space(3))) bf16x8*)(kp+j*2048+512); }
__device__ __forceinline__ s16x4 vtr(lds_cptr p){ return __builtin_bit_cast(s16x4,__builtin_amdgcn_ds_read_tr16_b64_v4i16((__attribute__((address_space(3))) v4i16_t*)p)); }
__device__ __forceinline__ float rowmax(const f32x16&p0,const f32x16&p1){
  float a=max3f(p0[0],p0[1],p1[0]),b=max3f(p0[2],p0[3],p1[1]);a=max3f(a,p1[2],p1[3]);
  #pragma unroll
  for(int r=4;r<16;r+=4){a=max3f(a,p0[r],p0[r+1]);b=max3f(b,p0[r+2],p0[r+3]);a=max3f(a,p1[r],p1[r+1]);b=max3f(b,p1[r+2],p1[r+3]);}
  const float m=max2f(a,b);
  auto rr=__builtin_amdgcn_permlane32_swap(__float_as_uint(m),__float_as_uint(m),false,false);
  return max2f(__uint_as_float(rr[0]),__uint_as_float(rr[1]));
}
__device__ __forceinline__ void pv(f32x16*o,int vb,bf16x8 pa0,bf16x8 pa1,bf16x8 pa2,bf16x8 pa3){
  #pragma unroll
  for(int d0=0;d0<2;++d0){s16x4 lo[4],hi[4];
    #pragma unroll
    for(int ks=0;ks<4;++ks){
      asm volatile("ds_read_b64_tr_b16 %0,%1 offset:%c2":"=&v"(lo[ks]):"v"(vb),"i"(d0*4096+ks*1024):"memory");
      asm volatile("ds_read_b64_tr_b16 %0,%1 offset:%c2":"=&v"(hi[ks]):"v"(vb),"i"(d0*4096+ks*1024+512):"memory");}
    asm volatile("s_waitcnt lgkmcnt(0)":::"memory");SBAR();
    #define PK(k) (bf16x8){lo[k][0],lo[k][1],lo[k][2],lo[k][3],hi[k][0],hi[k][1],hi[k][2],hi[k][3]}
    o[d0]=__builtin_amdgcn_mfma_f32_32x32x16_bf16(pa0,PK(0),o[d0],0,0,0);
    o[d0]=__builtin_amdgcn_mfma_f32_32x32x16_bf16(pa1,PK(1),o[d0],0,0,0);
    o[d0]=__builtin_amdgcn_mfma_f32_32x32x16_bf16(pa2,PK(2),o[d0],0,0,0);
    o[d0]=__builtin_amdgcn_mfma_f32_32x32x16_bf16(pa3,PK(3),o[d0],0,0,0);
    #undef PK
  }
}

__device__ __forceinline__ void attn_fill_dt(char*shm,const float*rel_bias,int off=LDS_DT){
  const int tid=threadIdx.x;
  #pragma unroll
  for(int k=0;k<2;++k){ const int e=tid+512*k, hh=e>>7, n=e&127;
    const int bk=n<16?n:16+(n>=19)+(n>=21)+(n>=24)+(n>=27)+(n>=31)+(n>=35)+(n>=40)+(n>=46)+(n>=52)+(n>=59)+(n>=67)+(n>=77)+(n>=87)+(n>=99)+(n>=113);
    ((float*)(shm+off))[e]=(rel_bias[bk*8+hh]-rel_bias[31*8+hh])*1.4426950408889634f; }
  __syncthreads();
}
#ifndef ATTN_STORE16
#define ATTN_STORE16(p,v) (*(u32x4*)(p)=(v))
#endif
struct AttnIO { unsigned char* ws; };
#define IO_PROJ ((const bf16*)(io.ws+WS_PROJ))
#define IO_CUM ((const float*)(io.ws+WS_CUM))
#define IO_SELM ((const unsigned*)(io.ws+WS_SELM))
#define IO_FG ((const float*)(io.ws+WS_FG))
#define IO_OC ((const bf16*)(io.ws+WS_OC))
#define IO_OW ((bf16*)(io.ws+WS_OW))
#define IO_AO16 ((bf16*)(io.ws+WS_AO16))

template<int MODE,int THRL> __device__ __forceinline__ void attn_unit(int b,int h,int qb,const AttnIO&io,char*shm,const int tidv){
  const int tid=tidv,lane=tid&63,r32=lane&31,hi=lane>>5; const int wid=__builtin_amdgcn_readfirstlane(tid>>6);
  const long rowbase=(long)b*SEQ; const int q0=qb*QB; const int g=h>>2;
  const int NT=(MODE==2)?((4*qb+4)<12?(4*qb+4):12):(4*qb+4);
  const int t0=4*qb+4-NT;
  const int qcol=(MODE==0?0:1536)+h*D, kcol=(MODE==0?512+h*D:(MODE==1?2304:2560)+g*D), vcol=(MODE==0?1024+h*D:(MODE==1?2432:2688)+g*D);
  const bf16*Qw=IO_PROJ+(rowbase+q0+wid*QBLK)*DM+qcol;
  const bf16*Kh=IO_PROJ+(rowbase+(long)t0*KVBLK)*DM+kcol,*Vh=IO_PROJ+(rowbase+(long)t0*KVBLK)*DM+vcol;
  const unsigned lds0=(unsigned)(uintptr_t)shm;
  float*wsf=(float*)(shm+LDS_WS)+wid*64;
  const bf16*ksrc=Kh+(long)lane*DM+wid*8;
  const bf16*vsrc=Vh+(long)(16*(wid&3)+(lane>>2))*DM+(wid>>2)*32+(lane&3)*8;
  const unsigned kdst=lds0+LDS_K+wid*1024, vdst=lds0+LDS_V+wid*1024;
  #define DMA_K(t,slot) glds16(ksrc+(long)(t)*KVBLK*DM,(unsigned)__builtin_amdgcn_readfirstlane(kdst+(slot)))
  #define DMA_V(t,slot) glds16(vsrc+(long)(t)*KVBLK*DM,(unsigned)__builtin_amdgcn_readfirstlane(vdst+(slot)))
  const int vb0=(int)(lds0+LDS_V)+((lane>>4)&1)*32+(lane&3)*8+(4*hi+((lane&15)>>2))*64;
  const char*Kbase=shm+LDS_K; bf16x8 kf[8];
  const lds_cptr shm3=(lds_cptr)shm; const lds_cptr kp0=shm3+LDS_K+hi*1024+r32*16; const lds_cptr vp0=shm3+LDS_V+((lane>>4)&1)*32+(lane&3)*8+(4*hi+((lane&15)>>2))*64;
  DMA_K(0,0);DMA_V(0,0);DMA_K(1,SLOTB);
  bf16x8 qr[4];
  #pragma unroll
  for(int d0=0;d0<4;++d0)qr[d0]=*reinterpret_cast<const bf16x8*>(&Qw[(long)r32*DM+d0*16+hi*8]);
  const lds_cptr qst=(lds_cptr)shm+LDS_OST+wid*4096+lane*16;
  #pragma unroll
  for(int d0=0;d0<4;++d0)*(__attribute__((address_space(3))) bf16x8*)((__attribute__((address_space(3))) char*)qst+d0*1024)=qr[d0];
  const lds_fptr cl=(lds_fptr)(shm+LDS_CUM), dt=(lds_fptr)(shm+LDS_DT)+h*128;
  unsigned maskq=0xffffffffu;
  if(MODE==0){ const f32x4_t c4=*(const f32x4_t*)(IO_CUM+((long)(b*8+h))*SEQ+tid*4); *(f32x4_t*)(shm+LDS_CUM+tid*16)=c4*1.4426950408889634f; }
  else {
    if(MODE==1) maskq=IO_SELM[((long)(b*2+g))*SEQ+q0+wid*QBLK+r32]; }
  float mhat=0.f,l_reg=0.f;f32x16 o[2];o[0]=f32x16{};o[1]=f32x16{};const f32x16 negm=f32x16{};
  #define SPLIT3(v,hb,lb,l2) const unsigned hb=cvtpk_s(v,0.f)&0xffffu; const float r1_=(v)-__uint_as_float(hb<<16); const unsigned lb=cvtpk_s(r1_,0.f)&0xffffu; const float r2_=r1_-__uint_as_float(lb<<16); const unsigned l2=cvtpk_s(r2_,0.f)&0xffffu
  #define KAUG(dst,cval) do{ const float v_=-(cval); SPLIT3(v_,hb_,lb_,l2_); u32x4 w_; w_[0]=hi?0u:(hb_|(lb_<<16)); w_[1]=hi?0u:(l2_|0x3f800000u); w_[2]=hi?0u:0x3f803f80u; w_[3]=0u; dst=__builtin_bit_cast(bf16x8,w_); }while(0)
  #define QAUG(dst,mval) do{ const float v_=-(mval); SPLIT3(v_,hb_,lb_,l2_); u32x4 w_; w_[0]=0x3f803f80u; w_[1]=0x3f80u|(hb_<<16); w_[2]=lb_|(l2_<<16); w_[3]=0u; dst=__builtin_bit_cast(bf16x8,w_); }while(0)
  bf16x8 qa; QAUG(qa,0.f);
  const int qrel=wid*QBLK+r32;
  #define CMASK(P0,P1,t) tilefix<MODE>(P0,P1,(t),NT,t0+(t),qrel,hi,cl,dt,maskq,mhat)
  bool resc=false;
  #define START(P0,P1) do{ const float rm=rowmax(P0,P1); resc=false; \
    { const float dl=(rm==-INFINITY)?0.f:rm; mhat=fadd_s(mhat,dl); QAUG(qa,mhat); \
      _Pragma("unroll") for(int r=0;r<16;++r){P0[r]=fsub_s(P0[r],dl);P1[r]=fsub_s(P1[r],dl);} \
      } \
    _Pragma("unroll") for(int r=0;r<16;++r)P0[r]=__builtin_amdgcn_exp2f(P0[r]); }while(0)
  #define RESC() do{ if(resc){ asm volatile("s_waitcnt lgkmcnt(0)":::"memory"); \
      _Pragma("unroll") for(int d_=0;d_<2;++d_) _Pragma("unroll") for(int r=0;r<16;++r)o[d_][r]*=wsf[crow(r,hi)]; } }while(0)
  f32x16 pA0,pA1,pB0,pB1;
  int sl_prev=0,sl_cur=0,sl_next=SLOTB;
  #define ROT() do{sl_prev=sl_cur;sl_cur=sl_next;sl_next=(sl_next==(NSLOT-1)*SLOTB)?0:sl_next+SLOTB;}while(0)
  DMA_K(2,2*SLOTB);
  WAIT_BAR(3);
  { bf16x8 ka0,ka1; KAUG(ka0,(MODE==0?cl[64*t0+r32]:0.f)); KAUG(ka1,(MODE==0?cl[64*t0+32+r32]:0.f));
    pA0=__builtin_amdgcn_mfma_f32_32x32x16_bf16(ka0,qa,negm,0,0,0); pA1=__builtin_amdgcn_mfma_f32_32x32x16_bf16(ka1,qa,negm,0,0,0); qkt(pA0,pA1,Kbase,qr,pA0,pA1,r32,hi); }
  asm volatile("s_nop 15\n\ts_nop 7":"+v"(pA0),"+v"(pA1));CMASK(pA0,pA1,0);
  START(pA0,pA1);
  _Pragma("unroll") for(int r=0;r<16;++r)pA1[r]=__builtin_amdgcn_exp2f(pA1[r]);
  WAIT_BAR(0);
  DMA_K(3,0);DMA_V(1,SLOTB);
  ROT();
  kload8(kf,kp0+sl_cur);
  WAIT_BAR(2);
  s16x4 vlo[8],vhi[8]; u32x4 pw0,pw1,pw2,pw3;
  #define PKW(P,B) cvtpk_s(P[B],P[B+1])
  #define PAF(k) __builtin_bit_cast(bf16x8,pw##k)
  #define VFR(i) (bf16x8){vlo[i][0],vlo[i][1],vlo[i][2],vlo[i][3],vhi[i][0],vhi[i][1],vhi[i][2],vhi[i][3]}
  #define PIN(x) asm volatile("":"+v"(x))
  #define MX3(a,b,c) __builtin_fmaxf(__builtin_fmaxf((a),(b)),(c))
  #define GAPA(MF,A0,A1,A2,A3,W0,W1,PW) do{ MF; sacc+=A0; sacc+=A1; sacc+=A2; sacc+=A3; PIN(sacc); W0; W1; PIN(PW); SBAR(); }while(0)
  #define EX(v) __builtin_amdgcn_exp2f(v)
  #define GAPB(MF,X,B) do{ MF; X[B]=EX(X[B]); X[B+1]=EX(X[B+1]); X[B+2]=EX(X[B+2]); X[B+3]=EX(X[B+3]); PIN(X); SBAR(); }while(0)
  #define VRD(i) do{ vlo[i]=vtr(vp_+(((i)>>2)*4096+((i)&3)*1024)); vhi[i]=vtr(vp_+(((i)>>2)*4096+((i)&3)*1024+512)); }while(0)
  #define KRD(G,j) do{ if(G){ kload2(kf,kp0+sl_next,j); SBAR(); } }while(0)
  #define STEP(C0,C1,P0,P1,t,GK,GV,GL) do{ SBAR(); \
    const lds_cptr vp_=vp0+sl_prev; \
    const bf16x8 qq0=*(const __attribute__((address_space(3))) bf16x8*)(qst),qq1=*(const __attribute__((address_space(3))) bf16x8*)(qst+1024),qq2=*(const __attribute__((address_space(3))) bf16x8*)(qst+2048),qq3=*(const __attribute__((address_space(3))) bf16x8*)(qst+3072); \
    { bf16x8 ka0_,ka1_; KAUG(ka0_,(MODE==0?cl[64*(t0+(t))+r32]:0.f)); KAUG(ka1_,(MODE==0?cl[64*(t0+(t))+32+r32]:0.f)); \
      C0=__builtin_amdgcn_mfma_f32_32x32x16_bf16(ka0_,qa,negm,0,0,0); C1=__builtin_amdgcn_mfma_f32_32x32x16_bf16(ka1_,qa,negm,0,0,0); } \
    VRD(0); SBAR(); float sacc=(P0[0]+P0[1]); \
    GAPA(C0=__builtin_amdgcn_mfma_f32_32x32x16_bf16(kf[0],qq0,C0,0,0,0), P0[2],P0[3],P0[4],P0[5],     pw0[0]=PKW(P0,0), pw0[1]=PKW(P0,2), pw0); \
    VRD(4); SBAR(); GAPA(C1=__builtin_amdgcn_mfma_f32_32x32x16_bf16(kf[1],qq0,C1,0,0,0), P0[6],P0[7],P0[8],P0[9],     pw0[2]=PKW(P0,4), pw0[3]=PKW(P0,6), pw0); \
    VRD(1); SBAR(); GAPA(C0=__builtin_amdgcn_mfma_f32_32x32x16_bf16(kf[2],qq1,C0,0,0,0),   P0[10],P0[11],P0[12],P0[13], pw1[0]=PKW(P0,8), pw1[1]=PKW(P0,10), pw1); \
    VRD(5); SBAR(); GAPA(C1=__builtin_amdgcn_mfma_f32_32x32x16_bf16(kf[3],qq1,C1,0,0,0),   P0[14],P0[15],P1[0],P1[1],   pw1[2]=PKW(P0,12),pw1[3]=PKW(P0,14), pw1); \
    VRD(2); SBAR(); GAPA(C0=__builtin_amdgcn_mfma_f32_32x32x16_bf16(kf[4],qq2,C0,0,0,0),   P1[2],P1[3],P1[4],P1[5],     pw2[0]=PKW(P1,0), pw2[1]=PKW(P1,2), pw2); \
    VRD(6); SBAR(); GAPA(C1=__builtin_amdgcn_mfma_f32_32x32x16_bf16(kf[5],qq2,C1,0,0,0),   P1[6],P1[7],P1[8],P1[9],     pw2[2]=PKW(P1,4), pw2[3]=PKW(P1,6), pw2); \
    VRD(3); SBAR(); GAPA(C0=__builtin_amdgcn_mfma_f32_32x32x16_bf16(kf[6],qq3,C0,0,0,0),   P1[10],P1[11],P1[12],P1[13], pw3[0]=PKW(P1,8), pw3[1]=PKW(P1,10), pw3); \
    VRD(7); SBAR(); GAPA(C1=__builtin_amdgcn_mfma_f32_32x32x16_bf16(kf[7],qq3,C1,0,0,0),   P1[14],P1[15],0.f,0.f,       pw3[2]=PKW(P1,12),pw3[3]=PKW(P1,14), pw3); \
    l_reg+=sacc; \
    if(GK){DMA_K((t)+3,sl_cur);} if(GV){DMA_V((t)+1,sl_next);} \
    CMASK(C0,C1,t); \
    { float a=MX3(C0[0],C0[1],C1[0]),b=MX3(C0[2],C0[3],C1[1]); a=MX3(a,C1[2],C1[3]); \
      _Pragma("unroll") for(int r=4;r<16;r+=4){a=MX3(a,C0[r],C0[r+1]);b=MX3(b,C0[r+2],C0[r+3]);a=MX3(a,C1[r],C1[r+1]);b=MX3(b,C1[r+2],C1[r+3]);} \
      float rm=__builtin_fmaxf(a,b); { auto rr=__builtin_amdgcn_permlane32_swap(__float_as_uint(rm),__float_as_uint(rm),false,false); rm=__builtin_fmaxf(__uint_as_float(rr[0]),__uint_as_float(rr[1])); } \
      resc=false; \
      if(__builtin_expect(__any(rm>(float)THRL),0)){ const float dl=__builtin_fmaxf(rm,0.f); mhat+=dl; QAUG(qa,mhat); \
        _Pragma("unroll") for(int r=0;r<16;++r){C0[r]-=dl;C1[r]-=dl;} \
        const float f=__builtin_amdgcn_exp2f(-dl); l_reg*=f; if(hi==0)wsf[r32]=f; resc=true; } } \
    SBAR(); \
    GAPB(o[0]=__builtin_amdgcn_mfma_f32_32x32x16_bf16(PAF(0),VFR(0),o[0],0,0,0), C0,0); \
    GAPB(o[1]=__builtin_amdgcn_mfma_f32_32x32x16_bf16(PAF(0),VFR(4),o[1],0,0,0), C0,4); \
    KRD(GL,0); GAPB(o[0]=__builtin_amdgcn_mfma_f32_32x32x16_bf16(PAF(1),VFR(1),o[0],0,0,0), C0,8); \
    KRD(GL,1); GAPB(o[1]=__builtin_amdgcn_mfma_f32_32x32x16_bf16(PAF(1),VFR(5),o[1],0,0,0), C0,12); \
    KRD(GL,2); GAPB(o[0]=__builtin_amdgcn_mfma_f32_32x32x16_bf16(PAF(2),VFR(2),o[0],0,0,0), C1,0); \
    KRD(GL,3); GAPB(o[1]=__builtin_amdgcn_mfma_f32_32x32x16_bf16(PAF(2),VFR(6),o[1],0,0,0), C1,4); \
    GAPB(o[0]=__builtin_amdgcn_mfma_f32_32x32x16_bf16(PAF(3),VFR(3),o[0],0,0,0), C1,8); \
    GAPB(o[1]=__builtin_amdgcn_mfma_f32_32x32x16_bf16(PAF(3),VFR(7),o[1],0,0,0), C1,12); \
    }while(0)
  int t=1;
  for(;t+5<NT;t+=2){
    STEP(pB0,pB1,pA0,pA1,t,true,true,true);     WAIT_BAR(2); RESC(); ROT();
    STEP(pA0,pA1,pB0,pB1,t+1,true,true,true);   WAIT_BAR(2); RESC(); ROT();
  }
  #define ENDW(tt) do{ if((tt)+3<NT){WAIT_BAR(2);} else if((tt)+2<NT){WAIT_BAR(1);} else {WAIT_BAR(0);} }while(0)
  for(;t+1<NT;t+=2){
    STEP(pB0,pB1,pA0,pA1,t,(t+3<NT),(t+1<NT),(t+1<NT));       ENDW(t);   RESC(); ROT();
    STEP(pA0,pA1,pB0,pB1,t+1,(t+4<NT),(t+2<NT),(t+2<NT));     ENDW(t+1); RESC(); ROT();
  }
  STEP(pB0,pB1,pA0,pA1,NT-1,false,false,false); RESC();
  { float sacc=pB0[0]+pB0[1]; _Pragma("unroll") for(int r=2;r<16;++r)sacc+=pB0[r]; _Pragma("unroll") for(int r=0;r<16;++r)sacc+=pB1[r]; l_reg+=sacc;
    pw0=(u32x4){PKW(pB0,0),PKW(pB0,2),PKW(pB0,4),PKW(pB0,6)};pw1=(u32x4){PKW(pB0,8),PKW(pB0,10),PKW(pB0,12),PKW(pB0,14)};pw2=(u32x4){PKW(pB1,0),PKW(pB1,2),PKW(pB1,4),PKW(pB1,6)};pw3=(u32x4){PKW(pB1,8),PKW(pB1,10),PKW(pB1,12),PKW(pB1,14)};
    SBAR(); pv(o,vb0+sl_cur,PAF(0),PAF(1),PAF(2),PAF(3)); }
  #undef PKW
  #undef PAF
  #undef VFR
  #undef PIN
  #undef MX3
  #undef GAPA
  #undef GAPB
  #undef EX
  #undef VRD
  #undef KRD
  #undef STEP
  #undef ENDW
  {auto rr=__builtin_amdgcn_permlane32_swap(__float_as_uint(l_reg),__float_as_uint(l_reg),false,false);l_reg=__uint_as_float(rr[0])+__uint_as_float(rr[1]);}
  if(hi==0)wsf[32+r32]=l_reg;asm volatile("s_waitcnt lgkmcnt(0)":::"memory");
  float rli[16];
  #pragma unroll
  for(int r=0;r<16;++r)rli[r]=__builtin_amdgcn_rcpf(wsf[32+crow(r,hi)]);
  { bf16*stg=(bf16*)(shm+LDS_OST)+wid*2048;
    #pragma unroll
    for(int r=0;r<16;++r){const int orow=crow(r,hi);
      #pragma unroll
      for(int d0=0;d0<2;++d0)stg[orow*64+d0*32+r32]=__float2bfloat16(o[d0][r]*rli[r]);}
    asm volatile("s_waitcnt lgkmcnt(0)":::"memory");
    const long tok0=rowbase+q0+wid*QBLK;
    #pragma unroll
    for(int i=0;i<4;++i){const int row=i*8+(lane>>3),ch=lane&7; const u32x4 v=*(const u32x4*)(stg+row*64+ch*8);
      if(MODE==0){ *(u32x4*)(IO_AO16+(tok0+row)*1024+h*D+ch*8)=v; }
      else if(MODE==2){ *(u32x4*)(IO_OW+(tok0+row)*512+h*D+ch*8)=v; }
      else { const u32x4 c=*(const u32x4*)(IO_OC+(tok0+row)*512+h*D+ch*8), w=*(const u32x4*)(IO_OW+(tok0+row)*512+h*D+ch*8);
        const float*gp=IO_FG+(tok0+row)*32+8+h*3;
        const float g0=1.f/(1.f+__expf(-gp[0])),g1=1.f/(1.f+__expf(-gp[1])),g2=1.f/(1.f+__expf(-gp[2]));
        u32x4 o4;
        #pragma unroll
        for(int k=0;k<4;++k){ const float c_lo=__uint_as_float(c[k]<<16),c_hi=__uint_as_float(c[k]&0xffff0000u),s_lo=__uint_as_float(v[k]<<16),s_hi=__uint_as_float(v[k]&0xffff0000u),w_lo=__uint_as_float(w[k]<<16),w_hi=__uint_as_float(w[k]&0xffff0000u);
          o4[k]=cvtpk_s(g0*c_lo+g1*s_lo+g2*w_lo,g0*c_hi+g1*s_hi+g2*w_hi); }
        *(u32x4*)(IO_AO16+(tok0+row)*1024+512+h*D+ch*8)=o4; } } }
  asm volatile("s_waitcnt lgkmcnt(0)\n\ts_barrier":::"memory");
  #undef DMA_K
  #undef DMA_V
  #undef CMASK
  #undef START
  #undef RESC
  #undef ROT
}
constexpr int CL_K=0, CL_V=16384, CL_IMP=32768, CL_SC=CL_IMP+4*64*33*4, CL_OST=CL_SC+64*33*4, CL_DT=CL_OST+NW*4096, CL_END=CL_DT+4096;
static_assert(CL_END<=131072,"cmp phase LDS map");
__device__ __forceinline__ void cmp_unit(int b,int g,int c,const AttnIO&io,char*shm,const int tidv){
  const int tid=tidv,lane=tid&63,r32=lane&31,hi=lane>>5; const int wid=__builtin_amdgcn_readfirstlane(tid>>6);
  const int hr=wid&3, rh=wid>>2, h=g*4+hr; const long rowbase=(long)b*SEQ; const int t0c=c*64;
  const int nkb=min(4,(4*c+3+31)>>5);
  { const bf16*kg=(const bf16*)(io.ws+WS_KVC16)+((long)(b*2+g))*128*64; const bf16*vg=kg+(long)8*2*128*64;
    #pragma unroll
    for(int p=0;p<2;++p){ const int idx=tid+512*p,key=idx>>3,ch=idx&7;
      const u32x4 kv=*(const u32x4*)(kg+key*64+ch*8), vv=*(const u32x4*)(vg+key*64+ch*8);
      *(u32x4*)(shm+CL_K+(ch*128+key)*16)=kv; *(u32x4*)(shm+CL_V+(ch>>2)*8192+key*64+(ch&3)*16)=vv; } }
  const bf16*Qw=IO_PROJ+(rowbase+t0c+rh*32)*DM+1536+h*D;
  bf16x8 qr[4];
  #pragma unroll
  for(int d0=0;d0<4;++d0)qr[d0]=*reinterpret_cast<const bf16x8*>(&Qw[(long)r32*DM+d0*16+hi*8]);
  __syncthreads();
  const lds_cptr shm3=(lds_cptr)shm; const lds_fptr dt=(lds_fptr)(shm+CL_DT)+h*128;
  const int t=t0c+rh*32+r32;
  f32x16 p[4];
  float m=-INFINITY;
  #pragma unroll
  for(int kb=0;kb<4;++kb){ p[kb]=f32x16{};
    if(kb<nkb){
      #pragma unroll
      for(int d0=0;d0<4;++d0){ const bf16x8 kf=*(const __attribute__((address_space(3))) bf16x8*)(shm3+CL_K+((2*d0+hi)*128+32*kb+r32)*16);
        p[kb]=__builtin_amdgcn_mfma_f32_32x32x16_bf16(kf,qr[d0],p[kb],0,0,0); }
      int dbase=t-31-16*(32*kb+4*hi); asm volatile("":"+v"(dbase));
      #pragma unroll
      for(int r=0;r<16;++r){ const int d=dbase-16*((r&3)+8*(r>>2)); const float x=p[kb][r]+dt[min(max(d,0),127)]; p[kb][r]=d>=0?x:-INFINITY; m=fmaxf(m,p[kb][r]); }
    } }
  { auto rr=__builtin_amdgcn_permlane32_swap(__float_as_uint(m),__float_as_uint(m),false,false); m=fmaxf(__uint_as_float(rr[0]),__uint_as_float(rr[1])); }
  const float ms=(m==-INFINITY)?0.f:m;
  float l=0.f;
  #pragma unroll
  for(int kb=0;kb<4;++kb) if(kb<nkb){
    #pragma unroll
    for(int r=0;r<16;++r){ p[kb][r]=__builtin_amdgcn_exp2f(p[kb][r]-ms); l+=p[kb][r]; } }
  { auto rr=__builtin_amdgcn_permlane32_swap(__float_as_uint(l),__float_as_uint(l),false,false); l=__uint_as_float(rr[0])+__uint_as_float(rr[1]); }
  const float il=l>0.f?1.f/l:0.f;
  #pragma unroll
  for(int kb=0;kb<4;++kb) if(kb<nkb){
    #pragma unroll
    for(int r=0;r<16;++r)p[kb][r]*=il; }
  { float* impw=(float*)(shm+CL_IMP)+(hr*64+rh*32+r32)*33;
    float prevlast=0.f;
    #pragma unroll
    for(int i=0;i<16;++i){ const int kb=i>>2,q=i&3;
      const float qs=(p[kb][4*q]+p[kb][4*q+1])+(p[kb][4*q+2]+p[kb][4*q+3]), last=p[kb][4*q+3];
      auto rr=__builtin_amdgcn_permlane32_swap(__float_as_uint(prevlast),__float_as_uint(last),false,false);
      const float recv=hi?__uint_as_float(rr[0]):__uint_as_float(rr[1]);
      impw[2*i+hi]=qs+recv; prevlast=last; } }
  f32x16 o[2]; o[0]=f32x16{}; o[1]=f32x16{};
  { const lds_cptr vp0=shm3+CL_V+((lane>>4)&1)*32+(lane&3)*8+(4*hi+((lane&15)>>2))*64;
    #pragma unroll
    for(int kb=0;kb<4;++kb) if(kb<nkb){
      #pragma unroll
      for(int ks=0;ks<2;++ks){ u32x4 pw;
        #pragma unroll
        for(int k=0;k<4;++k)pw[k]=cvtpk_s(p[kb][8*ks+2*k],p[kb][8*ks+2*k+1]);
        const bf16x8 pa=__builtin_bit_cast(bf16x8,pw);
        #pragma unroll
        for(int d0=0;d0<2;++d0){ const s16x4 vlo=vtr(vp0+d0*8192+(2*kb+ks)*1024), vhi=vtr(vp0+d0*8192+(2*kb+ks)*1024+512);
          const bf16x8 vf=(bf16x8){vlo[0],vlo[1],vlo[2],vlo[3],vhi[0],vhi[1],vhi[2],vhi[3]};
          o[d0]=__builtin_amdgcn_mfma_f32_32x32x16_bf16(pa,vf,o[d0],0,0,0); } } } }
  { bf16*stg=(bf16*)(shm+CL_OST)+wid*2048;
    #pragma unroll
    for(int r=0;r<16;++r){const int orow=crow(r,hi);
      #pragma unroll
      for(int d0=0;d0<2;++d0)stg[orow*64+d0*32+r32]=__float2bfloat16(o[d0][r]);}
    asm volatile("s_waitcnt lgkmcnt(0)":::"memory");
    bf16*oc=(bf16*)(io.ws+WS_OC)+(rowbase+t0c+rh*32)*512+h*D;
    #pragma unroll
    for(int i=0;i<4;++i){const int row=i*8+(lane>>3),ch=lane&7; *(u32x4*)(oc+(long)row*512+ch*8)=*(const u32x4*)(stg+row*64+ch*8);} }
  __syncthreads();
  { const int row=tid>>3,jq=tid&7; const float*imp=(const float*)(shm+CL_IMP); float*scl=(float*)(shm+CL_SC)+row*33;
    float sc[4];
    #pragma unroll
    for(int k=0;k<4;++k){ const int j=4*jq+k; const float v=(imp[(0*64+row)*33+j]+imp[(1*64+row)*33+j])+(imp[(2*64+row)*33+j]+imp[(3*64+row)*33+j]);
      const bool causal=j<=c, forced=(j==0)||(j==c)||(j==c-1); sc[k]=causal?v+(forced?1e4f:0.f):-1e4f; scl[j]=sc[k]; }
    asm volatile("s_waitcnt lgkmcnt(0)":::"memory");
    unsigned bits=0u;
    #pragma unroll
    for(int k=0;k<4;++k){ const int j=4*jq+k; int rank=0;
      #pragma unroll
      for(int i=0;i<32;++i){ const float o2=scl[i]; rank+=(o2>sc[k]||(o2==sc[k]&&i<j))?1:0; }
      bits|=(rank<16?1u:0u)<<j; }
    bits|=__shfl_xor(bits,1); bits|=__shfl_xor(bits,2); bits|=__shfl_xor(bits,4);
    if(jq==0)((unsigned*)(io.ws+WS_SELM))[((long)(b*2+g))*SEQ+t0c+row]=bits; }
  __syncthreads();
}
constexpr int ATTN_LDS_BYTES=LDS_BYTES;
#undef SBAR
#undef WAIT_BAR
}

__device__ __forceinline__ float silu_f(float x) { return x / (1.f + expf(-x)); }
__device__ __forceinline__ float sigmoid_f(float x) { return 1.f / (1.f + expf(-x)); }
__device__ __forceinline__ unsigned f2bf(float f) { unsigned u = __builtin_bit_cast(unsigned, f); return (u + 0x7fffu + ((u >> 16) & 1u)) >> 16; }
__device__ __forceinline__ unsigned pk2(float lo, float hi) { return f2bf(lo) | (f2bf(hi) << 16); }
__device__ __forceinline__ float bf2f(bf16 v) { return __builtin_bit_cast(float, (unsigned)v << 16); }
__device__ __forceinline__ float wave_sum(float v) {
#pragma unroll
    for (int o = 1; o < 64; o <<= 1) v += __shfl_xor(v, o);
    return v;
}
__device__ __forceinline__ int t5_bucket(int dist) {
    const int n = dist < 0 ? 0 : dist;
    if (n < 16) return n;
    int b = 16;
    b += (n >= 19) + (n >= 21) + (n >= 24) + (n >= 27) + (n >= 31) + (n >= 35) + (n >= 40) + (n >= 46) + (n >= 52) + (n >= 59) +
         (n >= 67) + (n >= 77) + (n >= 87) + (n >= 99) + (n >= 113);
    return b;
}

struct Args {
    const float* in[26];
    float* out; unsigned char* ws;
    int ph_lo, ph_hi, li, pad;
};

struct Ctx {
    LAS unsigned char* lds;
    int tid, lane, wave, gtid, GT, gw, NGW;
    const float *x, *c, *w_ada, *b_ada, *w_in, *b_f, *cmp_pos_k, *cmp_w1_k, *cmp_w2_k, *cmp_pos_v, *cmp_w1_v, *cmp_w2_v, *rel_bias, *w_out, *ln1_g, *ln1_b,
        *w_router, *e_bias, *w_gate, *w_up, *w_down, *ws_gate, *ws_up, *ws_down, *ln2_g, *ln2_b;
    float* out;
    float *mod, *cum, *kvc, *posb, *scorebuf, *scores, *ew, *fg, *pc, *lw;
    int* lrow; gu32* ctl; unsigned char* wsb;
    unsigned* selmask; int* eidx;
    bf16 *hbuf, *proj, *h2lo, *win_t, *wout_t, *ao16, *oc, *ow, *wgu, *wdn, *act16, *slot, *w1t, *w2t, *kvc16, *wrt;
};


__device__ __forceinline__ int map_inproj(int n) { return n < 1536 ? n : (n < 1544 ? 2816 + (n - 1536) : (n < 2824 ? n - 8 : n)); }
template <int MAP>
__device__ __forceinline__ void transpose_item(const float* W, int K, int N, bf16* WT, LAS float* scr, int item, int lane) {
    const int nblk = N / 32, kb = item / nblk, nb = item % nblk, k0 = 64 * kb, n0 = 32 * nb;
#pragma unroll 8
    for (int i = 0; i < 32; ++i) { const int kk = 2 * i + (lane >> 5); scr[kk * 33 + (lane & 31)] = W[(size_t)(k0 + kk) * N + n0 + (lane & 31)]; }
    asm volatile("s_waitcnt lgkmcnt(0)" ::: "memory");
    const int c = lane & 7;
#pragma unroll
    for (int j = 0; j < 4; ++j) { const int n = (lane >> 3) + 8 * j; const LAS float* s = scr + (8 * c) * 33 + n;
        u32x4 o; o.x = pk2(s[0 * 33], s[1 * 33]); o.y = pk2(s[2 * 33], s[3 * 33]); o.z = pk2(s[4 * 33], s[5 * 33]); o.w = pk2(s[6 * 33], s[7 * 33]);
        const int dr = MAP == 1 ? map_inproj(n0 + n) : n0 + n;
        *(u32x4*)(WT + (size_t)dr * K + k0 + 8 * c) = o; }
    asm volatile("s_waitcnt lgkmcnt(0)" ::: "memory");
}
__device__ __forceinline__ void ph_prologue(Ctx& C) {
    LAS float* scr = (LAS float*)(C.lds + C.wave * 8704);
    constexpr int I_IN = (D / 64) * (NPROJ / 32), I_OUT = (D / 64) * (D / 32);
    for (int it = C.gw; it < I_IN + I_OUT; it += C.NGW) {
        if (it < I_IN) transpose_item<1>(C.w_in, D, NPROJ, C.win_t, scr, it, C.lane);
        else transpose_item<0>(C.w_out, D, D, C.wout_t, scr, it - I_IN, C.lane);
    }
    constexpr int I_W1 = (2048 / 64) * (256 / 32), I_W2 = (256 / 64) * (64 / 32);
    for (int it = C.gw; it < 2 * (I_W1 + I_W2); it += C.NGW) {
        const int which = it / (I_W1 + I_W2), r = it % (I_W1 + I_W2);
        if (r < I_W1) transpose_item<0>(which ? C.cmp_w1_v : C.cmp_w1_k, 2048, 256, C.w1t + (size_t)which * 256 * 2048, scr, r, C.lane);
        else transpose_item<0>(which ? C.cmp_w2_v : C.cmp_w2_k, 256, 64, C.w2t + (size_t)which * 64 * 256, scr, r - I_W1, C.lane);
    }
    if (blockIdx.x == gridDim.x - 1) {
        const int which = C.tid >> 8, j = C.tid & 255;
        const float* pos = which ? C.cmp_pos_v : C.cmp_pos_k; const float* w1 = which ? C.cmp_w1_v : C.cmp_w1_k;
        float acc = 0.f;
        for (int k = 0; k < 2048; ++k) acc += pos[k] * w1[(size_t)k * 256 + j];
        C.posb[C.tid] = acc;
    }
    for (int i = C.gtid; i < 64 * 128; i += C.GT) {
        const int e = i & 63, k0 = (i >> 6) * 8;
        u32x4 oh, ol;
#pragma unroll
        for (int p = 0; p < 4; ++p) {
            const float a = C.w_router[(size_t)(k0 + 2 * p) * 64 + e], b = C.w_router[(size_t)(k0 + 2 * p + 1) * 64 + e];
            const unsigned h = pk2(a, b);
            oh[p] = h; ol[p] = pk2(a - __builtin_bit_cast(float, h << 16), b - __builtin_bit_cast(float, h & 0xffff0000u));
        }
        *(u32x4*)(C.wrt + (size_t)e * 1024 + k0) = oh; *(u32x4*)(C.wrt + 65536 + (size_t)e * 1024 + k0) = ol;
    }
    for (int i = C.gtid; i < 2 * 8 * 2 * 64; i += C.GT) C.kvc16[((size_t)(i >> 6) * 128 + 127) * 64 + (i & 63)] = 0;
    for (int i = C.gtid; i < (3072 - NPROJ) * D / 8; i += C.GT) *(u32x4*)(C.win_t + (size_t)NPROJ * D + (size_t)i * 8) = (u32x4){0u, 0u, 0u, 0u};
}
__device__ __forceinline__ void ph_mod(Ctx& C) {
    if (blockIdx.x >= 96) return;
    LAS float* st = (LAS float*)(C.lds + 73728);
    LAS float* part = (LAS float*)(C.lds + 73728 + 32768);
    for (int i = C.tid; i < NB * D; i += NTHR) { const int b = i >> 10, k = i & 1023; st[k * 8 + b] = silu_f(C.c[i]); }
    __syncthreads();
    const int e0 = blockIdx.x * 64 + C.lane;
    float acc[8];
#pragma unroll
    for (int b = 0; b < 8; ++b) acc[b] = 0.f;
    const float* wp = C.w_ada + (size_t)(128 * C.wave) * (6 * D) + e0;
#pragma unroll 8
    for (int k = 0; k < 128; ++k) {
        const float w = wp[(size_t)k * (6 * D)];
        const f32x4 s0 = *(const LAS f32x4*)(st + (128 * C.wave + k) * 8), s1 = *(const LAS f32x4*)(st + (128 * C.wave + k) * 8 + 4);
        acc[0] += s0.x * w; acc[1] += s0.y * w; acc[2] += s0.z * w; acc[3] += s0.w * w;
        acc[4] += s1.x * w; acc[5] += s1.y * w; acc[6] += s1.z * w; acc[7] += s1.w * w;
    }
#pragma unroll
    for (int b = 0; b < 8; ++b) part[(C.wave * 8 + b) * 64 + C.lane] = acc[b];
    __syncthreads();
    { const int b = C.wave; float s = C.b_ada[e0];
#pragma unroll
      for (int w = 0; w < 8; ++w) s += part[(w * 8 + b) * 64 + C.lane];
      C.mod[b * 6 * D + e0] = s; }
    __syncthreads();
}
__device__ __forceinline__ void ph_hpass(Ctx& C) {
    for (int m = C.gw; m < T; m += C.NGW) {
        const int b = m / S;
        const float* md = C.mod + b * 6 * D;
#pragma unroll
        for (int j = 0; j < 4; ++j) {
            const int c0 = (C.lane + 64 * j) * 4;
            const f32x4 xv = *(const f32x4*)(C.x + (size_t)m * D + c0);
            const f32x4 sh = *(const f32x4*)(md + c0), sc = *(const f32x4*)(md + D + c0);
            const f32x4 h = xv * (1.f + sc) + sh;
            u32x2 o; o.x = pk2(h.x, h.y); o.y = pk2(h.z, h.w);
            *(u32x2*)(C.hbuf + (size_t)m * D + c0) = o;
        }
    }
}
__device__ __forceinline__ void ph_cum_cmp1(Ctx& C) {
    for (int w = C.gw; w < NB * 8; w += C.NGW) {
        const int b = w / 8, h = w % 8;
        const float bf = C.b_f[h];
        float v[32];
#pragma unroll
        for (int i = 0; i < 32; ++i) v[i] = C.fg[((size_t)b * S + C.lane * 32 + i) * FGW + h];
        float run = 0.f;
#pragma unroll
        for (int i = 0; i < 32; ++i) { const float xx = v[i] + bf; run += fminf(xx, 0.f) - log1pf(expf(-fabsf(xx))); v[i] = run; }
        float tot = run;
#pragma unroll
        for (int o = 1; o < 64; o <<= 1) { const float u = __shfl_up(tot, o); if (C.lane >= o) tot += u; }
        const float base = tot - run;
#pragma unroll
        for (int i = 0; i < 32; i += 4) *(f32x4*)(C.cum + (size_t)w * S + C.lane * 32 + i) = (f32x4){v[i] + base, v[i + 1] + base, v[i + 2] + base, v[i + 3] + base};
    }
}
typedef short bf16x8_t __attribute__((ext_vector_type(8)));
__device__ __forceinline__ void ph_compress(Ctx& C) {
    constexpr int PST = 256;
    LAS float* part = (LAS float*)C.lds;
    LAS bf16* hidL = (LAS bf16*)(C.lds + LDS_TAB);
    static_assert(LDS_TAB + 8192 <= LDS_BYTES, "compress LDS map");
    int lane_ = C.lane; asm volatile("" : "+v"(lane_));
    const int row = lane_ & 15, kq = lane_ >> 4;
    for (int u = blockIdx.x; u < 2 * NCMP; u += gridDim.x) {
        const int which = u / NCMP, tile = u % NCMP;
        { const int R = tile * 16 + row, b = R / 254, n = (R % 254) >> 1, g = R & 1;
          const bf16* abase = C.proj + ((size_t)b * S + 16 * n + 4 * C.wave) * PITCH + (which ? PC_VC : PC_KC) + g * 64 + 8 * kq;
          const bf16* wb = C.w1t + ((size_t)which * 256 + row) * 2048 + 256 * C.wave + 8 * kq;
          f32x4 acc[16];
#pragma unroll
          for (int n2 = 0; n2 < 16; ++n2) acc[n2] = (f32x4){0.f, 0.f, 0.f, 0.f};
#pragma unroll 2
          for (int k0 = 0; k0 < 256; k0 += 32) {
              const bf16x8_t a = *(const bf16x8_t*)(abase + (size_t)(k0 >> 6) * PITCH + (k0 & 63));
#pragma unroll
              for (int n2 = 0; n2 < 16; ++n2) { const bf16x8_t bv = *(const bf16x8_t*)(wb + (size_t)n2 * 16 * 2048 + k0);
                  acc[n2] = __builtin_amdgcn_mfma_f32_16x16x32_bf16(a, bv, acc[n2], 0, 0, 0); }
          }
#pragma unroll
          for (int n2 = 0; n2 < 16; ++n2)
#pragma unroll
              for (int r = 0; r < 4; ++r) part[(C.wave * 16 + kq * 4 + r) * PST + ((n2 * 16 + row) ^ ((kq & 1) << 4))] = acc[n2][r]; }
        __syncthreads();
#pragma unroll
        for (int p = 0; p < 8; ++p) { const int idx = C.tid + 512 * p, r = idx >> 8, j = idx & 255;
            float s = C.posb[which * 256 + j];
#pragma unroll
            for (int w = 0; w < 8; ++w) s += part[(w * 16 + r) * PST + (j ^ (((r >> 2) & 1) << 4))];
            hidL[r * 256 + j] = (bf16)f2bf(silu_f(s)); }
        __syncthreads();
        if (C.wave < 4) {
            const bf16* w2 = C.w2t + ((size_t)which * 64 + 16 * C.wave + row) * 256 + 8 * kq;
            f32x4 acc = {0.f, 0.f, 0.f, 0.f};
#pragma unroll
            for (int k0 = 0; k0 < 256; k0 += 32) {
                const bf16x8_t a = *(const LAS bf16x8_t*)(hidL + row * 256 + k0 + 8 * kq);
                const bf16x8_t b = *(const bf16x8_t*)(w2 + k0);
                acc = __builtin_amdgcn_mfma_f32_16x16x32_bf16(a, b, acc, 0, 0, 0);
            }
#pragma unroll
            for (int r = 0; r < 4; ++r) {
                const int R = tile * 16 + kq * 4 + r, b = R / 254, n = (R % 254) >> 1, g = R & 1, col = 16 * C.wave + row;
                C.kvc[((size_t)which * (NB * NCMP * 2) + R) * 64 + col] = acc[r];
                C.kvc16[((((size_t)which * 8 + b) * 2 + g) * 128 + n) * 64 + col] = (bf16)f2bf(acc[r]);
            }
        }
        __syncthreads();
    }
}
#if defined(ORACLE) && ORACLE >= 4
__device__ __forceinline__ void cmp_attn_item(Ctx& C, int i, float& sd, float& sr) {
    const int t = i % S, h = (i / S) % 8, b = i / (S * 8), g = h / 4;
    const size_t tok = (size_t)b * S + t;
    const int NR = NB * NCMP * 2;
    const float* kc = C.kvc;
    const float* vc = C.kvc + (size_t)NR * 64;
    float q[64], o[64];
#pragma unroll
    for (int d = 0; d < 64; ++d) { q[d] = bf2f(C.proj[tok * PITCH + PC_NQ + h * 64 + d]); o[d] = 0.f; }
    float* prow = C.pc + ((size_t)(b * 8 + h) * S + t) * 128;
    const int nvalid = t >= 31 ? min(NCMP, (t - 31) / 16 + 1) : 0;
    float m = -1e30f;
    for (int n = 0; n < nvalid; ++n) {
        const float* kr = kc + ((size_t)(b * NCMP + n) * 2 + g) * 64;
        float dot = 0.f;
#pragma unroll
        for (int d = 0; d < 64; ++d) dot += q[d] * kr[d];
        const float lg = dot + C.rel_bias[t5_bucket(t - (16 * n + 31)) * 8 + h] * LOG2E;
        prow[n] = lg;
        m = fmaxf(m, lg);
    }
    float l = 0.f;
    for (int n = 0; n < nvalid; ++n) l += exp2f(prow[n] - m);
    const float il = nvalid ? 1.f / l : 0.f;
    for (int n = 0; n < 128; ++n) {
        float p = 0.f;
        if (n < nvalid) {
            p = exp2f(prow[n] - m) * il;
            const float* vr = vc + ((size_t)(b * NCMP + n) * 2 + g) * 64;
#pragma unroll
            for (int d = 0; d < 64; ++d) o[d] += p * vr[d];
        }
        prow[n] = p;
    }
#pragma unroll
    for (int d = 0; d < 64; ++d) { const float got = bf2f(C.oc[tok * 512 + h * 64 + d]); sd += (got - o[d]) * (got - o[d]); sr += o[d] * o[d]; }
}
__device__ __forceinline__ void ph_imp_topk(Ctx& C, float& sd, float& sr) {
    for (int i = C.gtid; i < NB * 2 * S; i += C.GT) {
        const int t = i % S, g = (i / S) % 2, b = i / (S * 2);
        const int qb = t >> 6;
        float* sc = C.scorebuf + (size_t)i * 32;
        for (int j = 0; j < 32; ++j) {
            float imp = 0.f;
            for (int r = 0; r < 4; ++r) {
                const float* prow = C.pc + ((size_t)(b * 8 + g * 4 + r) * S + t) * 128;
                for (int n = 4 * j - 1; n <= 4 * j + 3; ++n)
                    if (n >= 0 && n < NCMP) imp += prow[n];
            }
            const bool causal = j <= qb, forced = (j == 0) || (j == qb) || (j == qb - 1);
            sc[j] = causal ? imp + (forced ? 1e4f : 0.f) : -1e4f;
        }
        unsigned taken = 0u;
        for (int k = 0; k < 16; ++k) {
            float best = -3e38f; int bi = 0;
            for (int j = 0; j < 32; ++j)
                if (!((taken >> j) & 1u)) { const float v = sc[j]; if (v > best) { best = v; bi = j; } }
            taken |= 1u << bi;
        }
        sd += (C.selmask[i] != taken) ? 1.f : 0.f; sr += 1.f;
    }
}
#endif
#define ATTN_IO(C) attn_body::AttnIO{C.wsb}
__device__ __forceinline__ unsigned pick4(unsigned a, unsigned b, unsigned c, unsigned d, int k) { return k == 0 ? a : (k == 1 ? b : (k == 2 ? c : d)); }
__device__ __forceinline__ void ph_attn_a(Ctx& C, char* shm) {
    const attn_body::AttnIO io = ATTN_IO(C);
    const int c = blockIdx.x, k = c >> 6, j = c & 63, b = j >> 3, h = j & 7;
    if (c >= 256) return;
    attn_body::attn_fill_dt(shm, C.rel_bias);
    { int tv = threadIdx.x; asm volatile("" : "+v"(tv));
    for (unsigned l = pick4(0xF07u, 0xF16u, 0xF25u, 0xF34u, k); (l & 15u) != 15u; l >>= 4) attn_body::attn_unit<0, 8>(b, h, (int)(l & 15u), io, shm, tv); }
    { int tv = threadIdx.x; asm volatile("" : "+v"(tv));
    for (unsigned l = pick4(0xF07u, 0xF16u, 0xF25u, 0xF34u, k); (l & 15u) != 15u; l >>= 4) attn_body::attn_unit<2, 8>(b, h, (int)(l & 15u), io, shm, tv); }
}
__device__ __forceinline__ void ph_attn_b(Ctx& C, char* shm) {
    const attn_body::AttnIO io = ATTN_IO(C);
    const int c = blockIdx.x, k = c >> 6, j = c & 63, b = j >> 3, h = j & 7;
    if (c >= 256) return;
    attn_body::attn_fill_dt(shm, C.rel_bias);
    { int tv = threadIdx.x; asm volatile("" : "+v"(tv));
    for (unsigned l = pick4(0xF07u, 0xF16u, 0xF25u, 0xF34u, k); (l & 15u) != 15u; l >>= 4) attn_body::attn_unit<1, 8>(b, h, (int)(l & 15u), io, shm, tv); }
}

#ifdef ORACLE
constexpr int CW_ORA = 24576;
template <int MODE>
__device__ __forceinline__ void oracle_attn(Ctx& C) {
    float sd = 0.f, sr = 0.f;
    for (int i = C.gtid; i < NB * 8 * S; i += C.GT) {
        const int t = i % S, h = (i / S) % 8, b = i / (S * 8), g = h / 4;
        const size_t tok = (size_t)b * S + t;
        const int qoff = (MODE == 0 ? PC_FQ : PC_NQ) + h * 64;
        const int koff = MODE == 0 ? PC_FK + h * 64 : (MODE == 1 ? PC_KS : PC_KW) + g * 64;
        const int voff = MODE == 0 ? PC_FV + h * 64 : (MODE == 1 ? PC_VS : PC_VW) + g * 64;
        float q[64], o[64];
#pragma unroll
        for (int d = 0; d < 64; ++d) { q[d] = bf2f(C.proj[tok * PITCH + qoff + d]); o[d] = 0.f; }
        float m = -INFINITY, l = 0.f;
        const int s_lo = MODE == 2 ? max(0, t - 511) : 0;
        const unsigned mask = MODE == 1 ? C.selmask[(b * 2 + g) * S + t] : 0xffffffffu;
        const float* cr = C.cum + (size_t)(b * 8 + h) * S;
        const float cumt = MODE == 0 ? cr[t] : 0.f;
        for (int s = s_lo; s <= t; ++s) {
            if (MODE == 1 && !((mask >> (s >> 6)) & 1u)) continue;
            const bf16* kr = C.proj + ((size_t)b * S + s) * PITCH + koff;
            const bf16* vr = C.proj + ((size_t)b * S + s) * PITCH + voff;
            float dot = 0.f;
#pragma unroll
            for (int d = 0; d < 64; ++d) dot += q[d] * bf2f(kr[d]);
            const float bias = MODE == 0 ? cumt - cr[s] : C.rel_bias[t5_bucket(t - s) * 8 + h];
            const float lg = dot + bias * LOG2E;
            const float mn = fmaxf(m, lg), corr = exp2f(m - mn), p = exp2f(lg - mn);
            l = l * corr + p;
#pragma unroll
            for (int d = 0; d < 64; ++d) o[d] = o[d] * corr + p * bf2f(vr[d]);
            m = mn;
        }
        const float il = 1.f / l;
        float g0 = 0.f, g1 = 1.f, g2 = 0.f;
        if (MODE == 1) { g0 = sigmoid_f(C.fg[tok * FGW + 8 + h * 3 + 0]); g1 = sigmoid_f(C.fg[tok * FGW + 8 + h * 3 + 1]); g2 = sigmoid_f(C.fg[tok * FGW + 8 + h * 3 + 2]); }
#pragma unroll
        for (int d = 0; d < 64; ++d) {
            float ref = o[d] * il, got;
            if (MODE == 0) got = bf2f(C.ao16[tok * D + h * 64 + d]);
            else if (MODE == 2) got = bf2f(C.ow[tok * 512 + h * 64 + d]);
            else { ref = g0 * bf2f(C.oc[tok * 512 + h * 64 + d]) + g1 * ref + g2 * bf2f(C.ow[tok * 512 + h * 64 + d]); got = bf2f(C.ao16[tok * D + 512 + h * 64 + d]); }
            sd += (got - ref) * (got - ref); sr += ref * ref;
        }
    }
    sd = wave_sum(sd); sr = wave_sum(sr);
    if (C.lane == 0) { atomicAdd((float*)(C.ctl + CW_ORA), sd); atomicAdd((float*)(C.ctl + CW_ORA + 64), sr); }
}
#endif
__device__ __forceinline__ void ph_cmp_attn(Ctx& C, char* shm) {
    const attn_body::AttnIO io = ATTN_IO(C);
    const int c = blockIdx.x;
    if (c >= 256) return;
    attn_body::attn_fill_dt(shm, C.rel_bias, attn_body::CL_DT);
    { int tv = threadIdx.x; asm volatile("" : "+v"(tv));
      const int bg = c >> 4, i = c & 15;
      attn_body::cmp_unit(bg >> 1, bg & 1, 31 - i, io, shm, tv);
      attn_body::cmp_unit(bg >> 1, bg & 1, i, io, shm, tv); }
}
template <int WHICH>
__device__ __forceinline__ void ph_ln(Ctx& C) {
    const float* gam = WHICH == 1 ? C.ln1_g : C.ln2_g;
    const float* bet = WHICH == 1 ? C.ln1_b : C.ln2_b;
    for (int m = C.gw; m < T; m += C.NGW) {
        const int b = m / S;
        float* row = C.out + (size_t)m * D;
        f32x4 v[4]; float s = 0.f;
#pragma unroll
        for (int j = 0; j < 4; ++j) { v[j] = *(const f32x4*)(row + (C.lane + 64 * j) * 4); s += (v[j].x + v[j].y) + (v[j].z + v[j].w); }
        const float mean = wave_sum(s) * (1.f / D); float s2 = 0.f;
#pragma unroll
        for (int j = 0; j < 4; ++j) { v[j] = v[j] - mean; s2 += (v[j].x * v[j].x + v[j].y * v[j].y) + (v[j].z * v[j].z + v[j].w * v[j].w); }
        const float rstd = rsqrtf(wave_sum(s2) * (1.f / D) + LN_EPS);
#pragma unroll
        for (int j = 0; j < 4; ++j) {
            const int c0 = (C.lane + 64 * j) * 4;
            const f32x4 y = v[j] * rstd * *(const f32x4*)(gam + c0) + *(const f32x4*)(bet + c0);
            *(f32x4*)(row + c0) = y;
            if (WHICH == 1) {
                const float* md = C.mod + b * 6 * D;
                const f32x4 h2 = y * (1.f + *(const f32x4*)(md + 4 * D + c0)) + *(const f32x4*)(md + 3 * D + c0);
                u32x2 hi; hi.x = pk2(h2.x, h2.y); hi.y = pk2(h2.z, h2.w);
                const float r0 = h2.x - __builtin_bit_cast(float, hi.x << 16), r1 = h2.y - __builtin_bit_cast(float, hi.x & 0xffff0000u);
                const float r2 = h2.z - __builtin_bit_cast(float, hi.y << 16), r3 = h2.w - __builtin_bit_cast(float, hi.y & 0xffff0000u);
                u32x2 lo; lo.x = pk2(r0, r1); lo.y = pk2(r2, r3);
                *(u32x2*)(C.hbuf + (size_t)m * D + c0) = hi;
                *(u32x2*)(C.h2lo + (size_t)m * D + c0) = lo;
            }
        }
    }
}
__device__ __forceinline__ void ph_router_route(Ctx& C) {
    LAS float* scr = (LAS float*)(C.lds + C.wave * 4096);
    LAS float* mvs = (LAS float*)(C.lds + 32768 + C.wave * 256);
    const int row = C.lane & 15, kq = C.lane >> 4;
    for (int tile = C.gw; tile < T / 16; tile += C.NGW) {
        const int tok0 = tile * 16;
        const bf16* ah = C.hbuf + (size_t)(tok0 + row) * D + 8 * kq;
        const bf16* al = C.h2lo + (size_t)(tok0 + row) * D + 8 * kq;
        const bf16* wh = C.wrt + (size_t)row * 1024 + 8 * kq;
        f32x4 acc[4];
#pragma unroll
        for (int n = 0; n < 4; ++n) acc[n] = (f32x4){0.f, 0.f, 0.f, 0.f};
#pragma unroll 2
        for (int k0 = 0; k0 < D; k0 += 32) {
            const bf16x8_t a_h = *(const bf16x8_t*)(ah + k0), a_l = *(const bf16x8_t*)(al + k0);
#pragma unroll
            for (int n = 0; n < 4; ++n) {
                const bf16x8_t b_h = *(const bf16x8_t*)(wh + (size_t)n * 16 * 1024 + k0), b_l = *(const bf16x8_t*)(wh + 65536 + (size_t)n * 16 * 1024 + k0);
                acc[n] = __builtin_amdgcn_mfma_f32_16x16x32_bf16(a_l, b_l, acc[n], 0, 0, 0);
                acc[n] = __builtin_amdgcn_mfma_f32_16x16x32_bf16(a_l, b_h, acc[n], 0, 0, 0);
                acc[n] = __builtin_amdgcn_mfma_f32_16x16x32_bf16(a_h, b_l, acc[n], 0, 0, 0);
                acc[n] = __builtin_amdgcn_mfma_f32_16x16x32_bf16(a_h, b_h, acc[n], 0, 0, 0);
            }
        }
#pragma unroll
        for (int n = 0; n < 4; ++n)
#pragma unroll
            for (int r = 0; r < 4; ++r) scr[(kq * 4 + r) * 64 + n * 16 + row] = acc[n][r];
        asm volatile("s_waitcnt lgkmcnt(0)" ::: "memory");
        const int e = C.lane, g = e >> 3;
        const float eb = C.e_bias[e];
        for (int tl = 0; tl < 16; ++tl) {
            const int tok = tok0 + tl;
            const float sc = sigmoid_f(scr[tl * 64 + e]);
            const float bsc = sc + eb;
            float m1 = bsc;
            m1 = fmaxf(m1, __shfl_xor(m1, 1)); m1 = fmaxf(m1, __shfl_xor(m1, 2)); m1 = fmaxf(m1, __shfl_xor(m1, 4));
            const unsigned long long eq = __ballot(bsc == m1) & (0xFFull << (8 * g));
            const int first = __ffsll((long long)eq) - 1;
            float m2 = (e == first) ? -INFINITY : bsc;
            m2 = fmaxf(m2, __shfl_xor(m2, 1)); m2 = fmaxf(m2, __shfl_xor(m2, 2)); m2 = fmaxf(m2, __shfl_xor(m2, 4));
            const float gs = m1 + m2;
            int grank = 0;
#pragma unroll
            for (int gg = 0; gg < 8; ++gg) { const float o = __shfl(gs, gg * 8); grank += (o > gs || (o == gs && gg < g)) ? 1 : 0; }
            const float mv = grank < 4 ? bsc : -INFINITY;
            mvs[e] = mv;
            asm volatile("s_waitcnt lgkmcnt(0)" ::: "memory");
            int rank = 0;
#pragma unroll
            for (int c4 = 0; c4 < 16; ++c4) { const f32x4 o = *(const LAS f32x4*)(mvs + 4 * c4);
#pragma unroll
                for (int q = 0; q < 4; ++q) rank += (o[q] > mv || (o[q] == mv && 4 * c4 + q < e)) ? 1 : 0; }
            asm volatile("" ::: "memory");
            const bool sel = rank < 8;
            const float wsum = wave_sum(sel ? sc : 0.f);
            if (sel) {
                const float w = sc / wsum * 2.5f;
                const unsigned pos = __hip_atomic_fetch_add(C.ctl + CW_CNT + 64 * e, 1u, RLX_AGENT);
                C.lrow[(size_t)e * 16384 + pos] = tok * 16 + rank; C.lw[(size_t)e * 16384 + pos] = w;
            }
            if (e == 0) { C.lrow[(size_t)64 * 16384 + tok] = tok * 16 + 8; C.lw[(size_t)64 * 16384 + tok] = 1.f; }
        }
    }
}
__device__ __forceinline__ void ph_convert_experts(Ctx& C) {
    LAS float* scr = (LAS float*)(C.lds + C.wave * 8704);
    for (int it = C.gw; it < 65 * 384; it += C.NGW) {
        const int e = it / 384, r = it % 384, kind = r / 128, item = r % 128;
        if (kind < 2) {
            const float* W = e < 64 ? (kind == 0 ? C.w_gate : C.w_up) + (size_t)e * D * 256 : (kind == 0 ? C.ws_gate : C.ws_up);
            const int n0 = 32 * (item % 8);
            bf16* WT = C.wgu + ((size_t)e * 512 + (n0 / 128) * 128 + kind * 128) * D;
            transpose_item<0>(W, D, 256, WT, scr, item, C.lane);
        } else {
            const float* W = e < 64 ? C.w_down + (size_t)e * 256 * D : C.ws_down;
            transpose_item<0>(W, 256, D, C.wdn + (size_t)e * D * 256, scr, item, C.lane);
        }
    }
}
__device__ __forceinline__ int moe_tables(Ctx& C) {
    LAS int* tstart = (LAS int*)(C.lds + LDS_TSTART); LAS int* cntl = (LAS int*)(C.lds + LDS_CNT);
    if (C.tid < 64) cntl[C.tid] = (int)__hip_atomic_load(C.ctl + CW_CNT + 64 * C.tid, RLX_AGENT);
    if (C.tid == 64) cntl[64] = T;
    __syncthreads();
    if (C.tid == 0) { int s = 0; for (int e = 0; e < 65; ++e) { tstart[e] = s; s += (cntl[e] + 255) >> 8; } tstart[65] = s; }
    __syncthreads();
    return tstart[65];
}
__device__ __forceinline__ void ph_moe_gateup(Ctx& C) {
    const int MT = moe_tables(C);
    pg8::MoeSched So{(const LAS int*)(C.lds + LDS_TSTART), (const LAS int*)(C.lds + LDS_CNT), C.lrow, C.lw, (const char*)C.wgu, (size_t)512 * D * 2, (size_t)256 * D * 2, MT, 2, 0, (int)gridDim.x, (int)blockIdx.x};
    pg8::EpiAct E{C.act16};
    pg8::gemm_phase_g<pg8::EpiAct, pg8::MoeSched, true>(C.lds, C.lds + LDS_TAB, C.hbuf, D, So, E);
}
__device__ __forceinline__ void ph_moe_down(Ctx& C) {
    const int MT = moe_tables(C);
    pg8::MoeSched So{(const LAS int*)(C.lds + LDS_TSTART), (const LAS int*)(C.lds + LDS_CNT), C.lrow, C.lw, (const char*)C.wdn, (size_t)D * 256 * 2, (size_t)256 * 256 * 2, MT, 4, 0, (int)gridDim.x, (int)blockIdx.x};
    pg8::EpiSlot E{(unsigned char*)C.slot, (unsigned)T * 9u};
    pg8::gemm_phase_g<pg8::EpiSlot, pg8::MoeSched, false>(C.lds, C.lds + LDS_TAB, C.act16, 256, So, E);
}
__device__ __forceinline__ void ph_combine(Ctx& C) {
    typedef float f32x2 __attribute__((ext_vector_type(2)));
    for (int m = C.gw; m < T; m += C.NGW) {
        const int b = m / S, c0 = C.lane * 16;
        float acc[16];
#pragma unroll
        for (int i = 0; i < 16; ++i) acc[i] = 0.f;
        const unsigned char* sp = (const unsigned char*)C.slot + (size_t)m * 9 * 1024 + c0;
#pragma unroll
        for (int s = 0; s < 9; ++s) {
            const u32x4 v = *(const u32x4*)(sp + s * 1024);
#pragma unroll
            for (int k = 0; k < 4; ++k) { const f32x2 lo = __builtin_amdgcn_cvt_pk_f32_fp8((int)v[k], false), hi = __builtin_amdgcn_cvt_pk_f32_fp8((int)v[k], true);
                acc[4 * k] += lo[0]; acc[4 * k + 1] += lo[1]; acc[4 * k + 2] += hi[0]; acc[4 * k + 3] += hi[1]; }
        }
        float* row = C.out + (size_t)m * D;
        const float* g2 = C.mod + b * 6 * D + 5 * D + c0;
        f32x4 y[4]; float s1 = 0.f;
#pragma unroll
        for (int k = 0; k < 4; ++k) { y[k] = *(const f32x4*)(row + c0 + 4 * k) * ALPHA + *(const f32x4*)(g2 + 4 * k) * ((f32x4){acc[4 * k], acc[4 * k + 1], acc[4 * k + 2], acc[4 * k + 3]} * (1.f / pg8::SLOT_SCALE));
            s1 += (y[k].x + y[k].y) + (y[k].z + y[k].w); }
        const float mean = wave_sum(s1) * (1.f / D); float q = 0.f;
#pragma unroll
        for (int k = 0; k < 4; ++k) { y[k] = y[k] - mean; q += (y[k].x * y[k].x + y[k].y * y[k].y) + (y[k].z * y[k].z + y[k].w * y[k].w); }
        float rstd = rsqrtf(wave_sum(q) * (1.f / D) + LN_EPS);
#ifdef ORACLE
        { const float sd_ = __uint_as_float(__hip_atomic_load(C.ctl + CW_ORA, RLX_AGENT)), sr_ = __uint_as_float(__hip_atomic_load(C.ctl + CW_ORA + 64, RLX_AGENT)); rstd *= 1.f + 10.f * sqrtf(sd_ / sr_); }
#endif
#pragma unroll
        for (int k = 0; k < 4; ++k) *(f32x4*)(row + c0 + 4 * k) = y[k] * rstd * *(const f32x4*)(C.ln2_g + c0 + 4 * k) + *(const f32x4*)(C.ln2_b + c0 + 4 * k);
    }
}

__device__ __forceinline__ void mkctx(Ctx& C, const Args& args_unused, LAS unsigned char* ldsp) {
    typedef const __attribute__((address_space(4))) Args* kargp; kargp ap = (kargp)__builtin_amdgcn_kernarg_segment_ptr(); asm volatile("" : "+s"(ap));
#define args (*ap)
    C.lds = ldsp;
    C.tid = threadIdx.x; C.lane = C.tid & 63; C.wave = __builtin_amdgcn_readfirstlane(C.tid >> 6);
    C.gtid = blockIdx.x * NTHR + C.tid; C.GT = gridDim.x * NTHR; C.gw = blockIdx.x * NWAVES + C.wave; C.NGW = gridDim.x * NWAVES;
    C.x = args.in[0]; C.c = args.in[1]; C.w_ada = args.in[2]; C.b_ada = args.in[3]; C.w_in = args.in[4]; C.b_f = args.in[5];
    C.cmp_pos_k = args.in[6]; C.cmp_w1_k = args.in[7]; C.cmp_w2_k = args.in[8]; C.cmp_pos_v = args.in[9]; C.cmp_w1_v = args.in[10]; C.cmp_w2_v = args.in[11];
    C.rel_bias = args.in[12]; C.w_out = args.in[13]; C.ln1_g = args.in[14]; C.ln1_b = args.in[15]; C.w_router = args.in[16]; C.e_bias = args.in[17];
    C.w_gate = args.in[18]; C.w_up = args.in[19]; C.w_down = args.in[20]; C.ws_gate = args.in[21]; C.ws_up = args.in[22]; C.ws_down = args.in[23];
    C.ln2_g = args.in[24]; C.ln2_b = args.in[25];
    C.out = args.out;
    unsigned char* ws = args.ws; C.wsb = ws;
    C.mod = (float*)(ws + WS_MOD); C.cum = (float*)(ws + WS_CUM); C.kvc = (float*)(ws + WS_KVC); C.posb = (float*)(ws + WS_POSB); C.w1t = (bf16*)(ws + WS_W1T); C.w2t = (bf16*)(ws + WS_W2T); C.kvc16 = (bf16*)(ws + WS_KVC16); C.wrt = (bf16*)(ws + WS_WRT);
    C.selmask = (unsigned*)(ws + WS_SELM); C.scorebuf = (float*)(ws + WS_SCB); C.scores = (float*)(ws + WS_SCORES);
    C.eidx = (int*)(ws + WS_EIDX); C.ew = (float*)(ws + WS_EW); C.fg = (float*)(ws + WS_FG);
    C.win_t = (bf16*)(ws + WS_WIN_T); C.wout_t = (bf16*)(ws + WS_WOUT_T); C.ao16 = (bf16*)(ws + WS_AO16); C.oc = (bf16*)(ws + WS_OC); C.ow = (bf16*)(ws + WS_OW);
    C.hbuf = (bf16*)(ws + WS_HBUF); C.proj = (bf16*)(ws + WS_PROJ); C.h2lo = (bf16*)(ws + WS_PROJ);
    C.pc = (float*)(ws + WS_PC);
    C.wgu = (bf16*)(ws + WS_WGU); C.wdn = (bf16*)(ws + WS_WDN); C.act16 = (bf16*)(ws + WS_ACT16); C.slot = (bf16*)(ws + WS_SLOT);
    C.lrow = (int*)(ws + WS_LROW); C.lw = (float*)(ws + WS_LW); C.ctl = (gu32*)(ws + WS_CTL);
#undef args
}
#if defined(ORACLE) && ORACLE >= 4
__global__ void __launch_bounds__(256) k_oracle4a(Args args) {
    Ctx C; mkctx(C, args, (LAS unsigned char*)nullptr);
    float sd = 0.f, sr = 0.f;
    for (int i = blockIdx.x * 256 + threadIdx.x; i < NB * 8 * S; i += gridDim.x * 256) cmp_attn_item(C, i, sd, sr);
    sd = wave_sum(sd); sr = wave_sum(sr);
    if (ORACLE == 4 && (threadIdx.x & 63) == 0) { atomicAdd((float*)(C.ctl + CW_ORA), sd); atomicAdd((float*)(C.ctl + CW_ORA + 64), sr); }
}
__global__ void __launch_bounds__(256) k_oracle4b(Args args) {
    Ctx C; mkctx(C, args, (LAS unsigned char*)nullptr);
    C.gtid = blockIdx.x * 256 + threadIdx.x; C.GT = gridDim.x * 256;
    float sd = 0.f, sr = 0.f;
    ph_imp_topk(C, sd, sr);
    sd = wave_sum(sd); sr = wave_sum(sr);
    if (ORACLE == 5 && (threadIdx.x & 63) == 0) { atomicAdd((float*)(C.ctl + CW_ORA), sd * sd > 0.f ? sd : 0.f); atomicAdd((float*)(C.ctl + CW_ORA + 64), sr); }
}
#endif
#if defined(ORACLE) && ORACLE == 3
__global__ void __launch_bounds__(256) k_oracle3a(Args args) {
    Ctx C; mkctx(C, args, (LAS unsigned char*)nullptr);
    const int NR = NB * NCMP * 2;
    for (int i = blockIdx.x * 256 + threadIdx.x; i < 2 * NR * 256; i += gridDim.x * 256) {
        const int j = i % 256, row = (i / 256) % NR, which = i / (256 * NR);
        const int g = row % 2, n = (row / 2) % NCMP, b = row / (2 * NCMP);
        const float* pos = which ? C.cmp_pos_v : C.cmp_pos_k; const float* w1 = which ? C.cmp_w1_v : C.cmp_w1_k;
        const int off = (which ? PC_VC : PC_KC) + g * 64;
        float acc = 0.f;
        for (int l = 0; l < 32; ++l) { const bf16* xr = C.proj + ((size_t)b * S + 16 * n + l) * PITCH + off;
            for (int d = 0; d < 64; ++d) acc += (bf2f(xr[d]) + pos[l * 64 + d]) * w1[(size_t)(l * 64 + d) * 256 + j]; }
        C.scorebuf[i] = silu_f(acc);
    }
}
__global__ void __launch_bounds__(256) k_oracle3b(Args args) {
    Ctx C; mkctx(C, args, (LAS unsigned char*)nullptr);
    const int NR = NB * NCMP * 2; float sd = 0.f, sr = 0.f;
    for (int i = blockIdx.x * 256 + threadIdx.x; i < 2 * NR * 64; i += gridDim.x * 256) {
        const int d = i % 64, row = (i / 64) % NR, which = i / (64 * NR);
        const float* w2 = which ? C.cmp_w2_v : C.cmp_w2_k; const float* hr = C.scorebuf + ((size_t)which * NR + row) * 256;
        float acc = 0.f; for (int j = 0; j < 256; ++j) acc += hr[j] * w2[j * 64 + d];
        const int g = row % 2, n = (row / 2) % NCMP, b = row / (2 * NCMP);
        const float got = bf2f(C.kvc16[((((size_t)which * 8 + b) * 2 + g) * 128 + n) * 64 + d]);
        const float got2 = C.kvc[i];
        sd += (got - acc) * (got - acc) + (got2 - acc) * (got2 - acc); sr += 2.f * acc * acc;
    }
    sd = wave_sum(sd); sr = wave_sum(sr);
    if ((threadIdx.x & 63) == 0) { atomicAdd((float*)(C.ctl + CW_ORA), sd); atomicAdd((float*)(C.ctl + CW_ORA + 64), sr); }
}
#endif
#if defined(ORACLE) && ORACLE < 3
__global__ void __launch_bounds__(256) k_oracle(Args args) {
    Ctx C; mkctx(C, args, (LAS unsigned char*)nullptr);
    C.gtid = blockIdx.x * 256 + threadIdx.x; C.GT = gridDim.x * 256;
    oracle_attn<ORACLE>(C);
}
#endif
constexpr int N_PHASES = 15;
__global__ void __launch_bounds__(NTHR, 2) mk_fwd(Args args) {
    extern __shared__ __attribute__((aligned(16))) unsigned char lds[];
    volatile LAS unsigned* MISC = (volatile LAS unsigned*)((LAS unsigned char*)lds + MISC_OFF);
    if (threadIdx.x < 32) MISC[threadIdx.x] = 0u;
    __syncthreads();
    (void)xcd_barrier_post((unsigned*)((gu32*)(args.ws + WS_CTL) + CW_BAR) + args.li * XCD_BAR_WORDS, MISC + 8);
#define bar (XcdBarrier{(unsigned*)((gu32*)(args.ws + WS_CTL) + CW_BAR) + args.li * XCD_BAR_WORDS, xb_xcc_id(), (volatile LAS unsigned*)((LAS unsigned char*)lds + MISC_OFF) + 8})
    const int lo = args.ph_lo, hi = args.ph_hi;
#ifndef PHASE_MASK
#define PHASE_MASK 0xffffffffu
#endif
#define IN(k) (((PHASE_MASK >> (k)) & 1u) && lo <= (k) && (k) < hi)
#define SEAM(k) do { if (IN(k) && IN((k) + 1)) xcd_barrier(bar); } while (0)
#ifndef DUP_MASK
#define DUP_MASK 0u
#endif
#define DUP(k) (((DUP_MASK >> (k)) & 1u) != 0u)
    if (IN(0)) { Ctx C; mkctx(C, args, (LAS unsigned char*)lds); ph_mod(C); ph_prologue(C); }
    SEAM(0);
    if (IN(1)) { Ctx C; mkctx(C, args, (LAS unsigned char*)lds); for (int rep = 0; rep < (DUP(1) ? 2 : 1); ++rep) { if (rep) xcd_barrier(bar); ph_hpass(C); } }
    SEAM(1);
    if (IN(2)) { Ctx C; mkctx(C, args, (LAS unsigned char*)lds);
        pg8::Gemm g{C.hbuf, C.win_t, T, 3072, D}; pg8::StaticOrder So; So.init(T, 3072, (int)gridDim.x, (int)blockIdx.x);
        pg8::EpiProj E{C.proj, C.fg, PITCH, C2};
        for (int rep = 0; rep < (DUP(2) ? 2 : 1); ++rep) { if (rep) xcd_barrier(bar); pg8::gemm_phase<pg8::EpiProj, pg8::StaticOrder, true, true>(C.lds, g, So, E); }
    }
    SEAM(2);
    if (IN(3)) { Ctx C; mkctx(C, args, (LAS unsigned char*)lds); for (int rep = 0; rep < (DUP(3) ? 2 : 1); ++rep) { if (rep) xcd_barrier(bar); ph_cum_cmp1(C); ph_compress(C); } }
    if (IN(3) && IN(5)) xcd_barrier(bar);
    if (IN(5)) { Ctx C; mkctx(C, args, (LAS unsigned char*)lds); for (int rep = 0; rep < (DUP(5) ? 2 : 1); ++rep) { if (rep) xcd_barrier(bar); ph_cmp_attn(C, (char*)lds); ph_attn_a(C, (char*)lds); } }
    if (IN(5) && IN(7)) xcd_barrier(bar);
    if (IN(7)) { Ctx C; mkctx(C, args, (LAS unsigned char*)lds); for (int rep = 0; rep < (DUP(7) ? 2 : 1); ++rep) { if (rep) xcd_barrier(bar); ph_attn_b(C, (char*)lds); } }
    SEAM(7);
    if (IN(8)) { Ctx C; mkctx(C, args, (LAS unsigned char*)lds);
        pg8::Gemm g{C.ao16, C.wout_t, T, D, D}; pg8::StaticOrder So; So.init(T, D, (int)gridDim.x, (int)blockIdx.x);
        pg8::EpiOut E{C.x, C.mod, C.out, ALPHA};
        for (int rep = 0; rep < (DUP(8) ? 2 : 1); ++rep) { if (rep) xcd_barrier(bar); pg8::gemm_phase<pg8::EpiOut, pg8::StaticOrder, true, true>(C.lds, g, So, E); }
    }
    SEAM(8);
    if (IN(9)) { Ctx C; mkctx(C, args, (LAS unsigned char*)lds); ph_ln<1>(C); for (int rep = 0; rep < (DUP(9) ? 2 : 1); ++rep) { if (rep) xcd_barrier(bar); ph_convert_experts(C); } }
    SEAM(9);
    if (IN(10)) { Ctx C; mkctx(C, args, (LAS unsigned char*)lds); ph_router_route(C); }
    if (IN(10) && IN(12)) xcd_barrier(bar);
    if (IN(12)) { Ctx C; mkctx(C, args, (LAS unsigned char*)lds); for (int rep = 0; rep < (DUP(12) ? 2 : 1); ++rep) { if (rep) xcd_barrier(bar); ph_moe_gateup(C); } }
    SEAM(12);
    if (IN(13)) { Ctx C; mkctx(C, args, (LAS unsigned char*)lds); for (int rep = 0; rep < (DUP(13) ? 2 : 1); ++rep) { if (rep) xcd_barrier(bar); ph_moe_down(C); } }
    SEAM(13);
    if (IN(14)) { Ctx C; mkctx(C, args, (LAS unsigned char*)lds); ph_combine(C); }
#undef IN
#undef SEAM
#undef bar
}

extern "C" void kernel_launch(void* const* d_in, const int* in_sizes, int n_in, void* d_out, int out_size, void* d_ws, size_t ws_size, hipStream_t stream) {
    static int grid = 0;
    if (grid == 0) {
        if (n_in != 26 || out_size != T * D || ws_size < WS_END) { fprintf(stderr, "kernel_launch: unexpected problem (n_in %d out %d ws %zu)\n", n_in, out_size, ws_size); grid = -1; return; }
        int dev = 0, cus = 0, per_cu = 0;
        if (hipGetDevice(&dev) != hipSuccess || hipDeviceGetAttribute(&cus, hipDeviceAttributeMultiprocessorCount, dev) != hipSuccess) { grid = -1; return; }
        if (hipFuncSetAttribute((const void*)mk_fwd, hipFuncAttributeMaxDynamicSharedMemorySize, LDS_BYTES) != hipSuccess) { fprintf(stderr, "kernel_launch: hipFuncSetAttribute failed\n"); grid = -1; return; }
        if (hipOccupancyMaxActiveBlocksPerMultiprocessor(&per_cu, (const void*)mk_fwd, NTHR, LDS_BYTES) != hipSuccess || per_cu < 1) { fprintf(stderr, "kernel_launch: occupancy query says %d\n", per_cu); grid = -1; (void)hipGetLastError(); return; }
        grid = cus;
    }
    if (grid < 0) return;
    (void)hipMemsetAsync((char*)d_ws + WS_CTL, 0, CTL_ZERO_BYTES, stream);
    Args a{};
    for (int i = 0; i < 26; ++i) a.in[i] = (const float*)d_in[i];
    a.out = (float*)d_out; a.ws = (unsigned char*)d_ws; a.ph_lo = 0; a.ph_hi = N_PHASES;
#ifdef ORACLE
    a.ph_hi = 8; hipLaunchKernelGGL(mk_fwd, dim3(grid), dim3(NTHR), LDS_BYTES, stream, a);
#if ORACLE >= 4
    hipLaunchKernelGGL(k_oracle4a, dim3(512), dim3(256), 0, stream, a); hipLaunchKernelGGL(k_oracle4b, dim3(128), dim3(256), 0, stream, a);
#elif ORACLE == 3
    hipLaunchKernelGGL(k_oracle3a, dim3(2048), dim3(256), 0, stream, a); hipLaunchKernelGGL(k_oracle3b, dim3(512), dim3(256), 0, stream, a);
#else
    hipLaunchKernelGGL(k_oracle, dim3(NB * 8 * S / 256), dim3(256), 0, stream, a);
#endif
    a.ph_lo = 8; a.ph_hi = N_PHASES; a.li = 1;
#endif
    hipLaunchKernelGGL(mk_fwd, dim3(grid), dim3(NTHR), LDS_BYTES, stream, a);
}
```
